# Optimizing an MI355X kernel written in HIP

```python
import math
import jax, jax.numpy as jnp
from jax import lax
import numpy as np

D_MODEL = 1024
BATCH = 8
SEQ = 2048
DEPTH = 2
DEC_BATCH = 16
DEC_SEQ = 4096
PAST_LEN = 128

N_MIXERS = 4
D_MIX = D_MODEL
W_GRP = D_MIX // N_MIXERS
N_DIR = 2
LRU_HD = 64
LRU_HEADS = W_GRP // LRU_HD
LRU_CONV = 4
LRU_C = 8.0
S5_CH = 16
S5_GROUPS = W_GRP // S5_CH
S5_STATE = 64
GDN_HD = 64
GDN_HEADS = W_GRP // GDN_HD
GDN_CONV = 4
GDN_CHUNK = 64
HY_ORDER = 2
HY_CONV = 3
HY_EMB = 33
HY_FW = 64
HY_FAST_DECAY = 0.3
HY_SLOW_DECAY = 1.5
HY_TARGET = 1e-2
D_FF = 2816
FFN_CONV = 3
EPS = 1e-6

OFF_A_X = 0
OFF_A_GATE = OFF_A_X + W_GRP
OFF_B_U = OFF_A_GATE + W_GRP
OFF_C_QKV = OFF_B_U + W_GRP
OFF_C_GATE = OFF_C_QKV + 3 * W_GRP
OFF_C_BETA = OFF_C_GATE + W_GRP
OFF_C_ALPHA = OFF_C_BETA + N_DIR * GDN_HEADS
OFF_D = OFF_C_ALPHA + N_DIR * GDN_HEADS
N_IN = OFF_D + (HY_ORDER + 1) * W_GRP

kernel_name = 'hybrid_bidir_parallel_groups_encoder'

F32 = jnp.float32


def rmsnorm(x, g):
    xf = x.astype(F32)
    y = xf * lax.rsqrt(jnp.mean(xf * xf, axis=-1, keepdims=True) + EPS)
    return (y * g.astype(F32)).astype(x.dtype)


def dwconv(x, w, pad_left):
    K = w.shape[0]
    L = x.shape[1]
    xp = jnp.pad(x, ((0, 0), (pad_left, K - 1 - pad_left), (0, 0)))
    w = w.astype(x.dtype)
    y = xp[:, 0:L] * w[0]
    for k in range(1, K):
        y = y + xp[:, k:k + L] * w[k]
    return y


def _linear_combine(left, right):
    a1, b1 = left
    a2, b2 = right
    return a1 * a2, a2 * b1 + b2


def linear_scan(a, b, reverse):
    return lax.associative_scan(_linear_combine, (a, b), axis=1, reverse=reverse)[1]


def rglru_mixer(xb, gate, conv_w, conv_b, w_r, b_r, w_i, b_i, lam):
    bsz, L, _ = xb.shape
    xc = (dwconv(xb, conv_w, LRU_CONV // 2) + conv_b).astype(F32)
    xh = xc.reshape(bsz, L, LRU_HEADS, LRU_HD)
    r = jax.nn.sigmoid(jnp.einsum('blhi,dhij->dblhj', xh, w_r).reshape(N_DIR, bsz, L, W_GRP) + b_r[:, None, None, :])
    i = jax.nn.sigmoid(jnp.einsum('blhi,dhij->dblhj', xh, w_i).reshape(N_DIR, bsz, L, W_GRP) + b_i[:, None, None, :])
    log_a = -LRU_C * r * jax.nn.softplus(-lam.astype(F32))[:, None, None, :]
    a = jnp.exp(log_a)
    u = jnp.sqrt(-jnp.expm1(2.0 * log_a)) * (i * xc[None])
    h = linear_scan(a[0], u[0], False) + linear_scan(a[1], u[1], True)
    return (h * jax.nn.gelu(gate.astype(F32))).astype(xb.dtype)


def _complex_combine(left, right):
    ar1, ai1, br1, bi1 = left
    ar2, ai2, br2, bi2 = right
    return (ar1 * ar2 - ai1 * ai2, ar1 * ai2 + ai1 * ar2,
            ar2 * br1 - ai2 * bi1 + br2, ar2 * bi1 + ai2 * br1 + bi2)


def s5_direction(u, a_re, a_im, log_dt, b_re, b_im, c_re, c_im, reverse):
    a_re, a_im = a_re.astype(F32), a_im.astype(F32)
    b_re, b_im, c_re, c_im = b_re.astype(F32), b_im.astype(F32), c_re.astype(F32), c_im.astype(F32)
    dt = jnp.exp(log_dt.astype(F32))[:, None]
    mag = jnp.exp(dt * a_re)
    ang = dt * a_im
    ab_re = mag * jnp.cos(ang)
    ab_im = mag * jnp.sin(ang)
    den = a_re * a_re + a_im * a_im
    n_re = ab_re - 1.0
    q_re = (n_re * a_re + ab_im * a_im) / den
    q_im = (ab_im * a_re - n_re * a_im) / den
    bb_re = q_re[..., None] * b_re - q_im[..., None] * b_im
    bb_im = q_re[..., None] * b_im + q_im[..., None] * b_re
    bu_re = jnp.einsum('blgh,gph->blgp', u, bb_re)
    bu_im = jnp.einsum('blgh,gph->blgp', u, bb_im)
    shape = (1, u.shape[1]) + ab_re.shape
    _, _, s_re, s_im = lax.associative_scan(
        _complex_combine,
        (jnp.broadcast_to(ab_re, shape), jnp.broadcast_to(ab_im, shape), bu_re, bu_im),
        axis=1, reverse=reverse)
    return jnp.einsum('blgp,ghp->blgh', s_re, c_re) - jnp.einsum('blgp,ghp->blgh', s_im, c_im)


def s5_mixer(u, a_re, a_im, log_dt, b_re, b_im, c_re, c_im, d, glu_w, glu_b):
    bsz, L, _ = u.shape
    uf = u.astype(F32)
    ug = uf.reshape(bsz, L, S5_GROUPS, S5_CH)
    y = s5_direction(ug, a_re[0], a_im[0], log_dt[0], b_re[0], b_im[0], c_re[0], c_im[0], False)
    y = y + s5_direction(ug, a_re[1], a_im[1], log_dt[1], b_re[1], b_im[1], c_re[1], c_im[1], True)
    y = y.reshape(bsz, L, W_GRP) + d * uf
    z = jax.nn.gelu(y)
    return (z * jax.nn.sigmoid(z @ glu_w + glu_b)).astype(u.dtype)


def l2norm(x):
    return x * lax.rsqrt(jnp.sum(x * x, axis=-1, keepdims=True) + EPS)


def chunk_gated_delta(q, k, v, beta, g):
    bsz, L, H, dk = q.shape
    dv = v.shape[-1]
    C = GDN_CHUNK
    n = L // C

    def blocks(t):
        return jnp.moveaxis(t, 2, 1).reshape((bsz, H, n, C) + t.shape[3:])

    q, k, v, beta, g = blocks(q), blocks(k), blocks(v), blocks(beta), blocks(g)
    gc = jnp.cumsum(g, axis=-1)
    idx = jnp.arange(C)
    incl = idx[:, None] >= idx[None, :]
    strict = idx[:, None] > idx[None, :]
    decay = jnp.exp(jnp.where(incl, gc[..., :, None] - gc[..., None, :], -jnp.inf))
    kb = k * beta[..., None]
    a_mat = jnp.where(strict, jnp.einsum('bhncd,bhnmd->bhncm', kb, k) * decay, 0.0)
    eye = jnp.eye(C, dtype=F32)
    t_mat = lax.linalg.triangular_solve(a_mat + eye, jnp.broadcast_to(eye, a_mat.shape),
                                        left_side=True, lower=True, unit_diagonal=True)
    w = jnp.einsum('bhncm,bhnmd->bhncd', t_mat, kb * jnp.exp(gc)[..., None])
    u = jnp.einsum('bhncm,bhnmd->bhncd', t_mat, v * beta[..., None])
    attn = jnp.einsum('bhncd,bhnmd->bhncm', q, k) * decay
    q_dec = q * jnp.exp(gc)[..., None]
    k_dec = k * jnp.exp(gc[..., -1:] - gc)[..., None]
    g_last = jnp.exp(gc[..., -1])

    def step(state, blk):
        w_i, u_i, attn_i, qd_i, kd_i, gl_i = blk
        v_new = u_i - jnp.einsum('bhcd,bhde->bhce', w_i, state)
        o_i = jnp.einsum('bhcd,bhde->bhce', qd_i, state) + jnp.einsum('bhcm,bhme->bhce', attn_i, v_new)
        state = state * gl_i[..., None, None] + jnp.einsum('bhcd,bhce->bhde', kd_i, v_new)
        return state, o_i

    xs = (jnp.moveaxis(w, 2, 0), jnp.moveaxis(u, 2, 0), jnp.moveaxis(attn, 2, 0),
          jnp.moveaxis(q_dec, 2, 0), jnp.moveaxis(k_dec, 2, 0), jnp.moveaxis(g_last, 2, 0))
    s0 = jnp.zeros((bsz, H, dk, dv), F32)
    _, o = lax.scan(step, s0, xs)
    return jnp.transpose(o, (1, 0, 3, 2, 4)).reshape(bsz, L, H, dv)


def gdn_mixer(qkv, gate, beta_in, alpha_in, conv_w, a_log, dt_bias, norm_w):
    bsz, L, _ = qkv.shape
    h = jax.nn.silu(dwconv(qkv, conv_w, GDN_CONV // 2)).astype(F32).reshape(bsz, L, 3, GDN_HEADS, GDN_HD)
    q = l2norm(h[:, :, 0]) * (GDN_HD ** -0.5)
    k = l2norm(h[:, :, 1])
    v = h[:, :, 2]
    beta = jax.nn.sigmoid(beta_in.astype(F32)).reshape(bsz, L, N_DIR, GDN_HEADS)
    g = -jnp.exp(a_log.astype(F32)) * jax.nn.softplus(
        alpha_in.astype(F32).reshape(bsz, L, N_DIR, GDN_HEADS) + dt_bias.astype(F32))
    o = chunk_gated_delta(q, k, v, beta[:, :, 0], g[:, :, 0])
    fl = lambda t: jnp.flip(t, axis=1)
    o = o + fl(chunk_gated_delta(fl(q), fl(k), fl(v), fl(beta[:, :, 1]), fl(g[:, :, 1])))
    o = rmsnorm(o, norm_w) * jax.nn.silu(gate.astype(F32).reshape(bsz, L, GDN_HEADS, GDN_HD))
    return o.reshape(bsz, L, W_GRP).astype(qkv.dtype)


def hyena_filters(L, w1, b1, freq, w2, b2, w3):
    t = jnp.linspace(0.0, 1.0, L, dtype=F32)[:, None]
    bands = (HY_EMB - 1) // 2
    w_ang = 2.0 * math.pi * jnp.arange(L, dtype=F32)[:, None] / L
    f = jnp.linspace(1e-4, bands - 1, bands, dtype=F32)[None, :]
    z = jnp.concatenate([t, jnp.cos(f * w_ang), -jnp.sin(f * w_ang)], axis=-1)
    hdn = jnp.sin(freq * (z @ w1 + b1))
    hdn = jnp.sin(freq * (hdn @ w2 + b2))
    h = (hdn @ w3).astype(F32).reshape(L, HY_ORDER, N_DIR, W_GRP)
    max_decay = math.log(HY_TARGET) / HY_FAST_DECAY
    min_decay = math.log(HY_TARGET) / HY_SLOW_DECAY
    deltas = jnp.abs(jnp.linspace(min_decay, max_decay, W_GRP, dtype=F32))
    h = h * jnp.exp(-t[:, :, None, None] * deltas)
    h = h / jnp.sum(jnp.abs(h), axis=(0, 2), keepdims=True)
    return jnp.transpose(h, (1, 2, 0, 3))


def bidir_fftconv(u, h_fwd, h_bwd, bias):
    L = u.shape[1]
    k = jnp.concatenate([h_fwd[:1] + h_bwd[:1], h_fwd[1:], jnp.zeros_like(h_fwd[:1]), h_bwd[:0:-1]], axis=0)
    y = jnp.fft.irfft(jnp.fft.rfft(u, n=2 * L, axis=1) * jnp.fft.rfft(k, axis=0)[None], n=2 * L, axis=1)[:, :L]
    return y + u * bias


def hyena_mixer(proj, conv_w, conv_b, w1, b1, freq, w2, b2, w3, bias):
    L = proj.shape[1]
    z = (dwconv(proj, conv_w, HY_CONV // 2) + conv_b).astype(F32)
    v, x1, x2 = jnp.split(z, HY_ORDER + 1, axis=-1)
    h = hyena_filters(L, w1, b1, freq, w2, b2, w3)
    bias = bias.astype(F32)
    y = x1 * bidir_fftconv(v, h[0, 0], h[0, 1], bias[0])
    y = x2 * bidir_fftconv(y, h[1, 0], h[1, 1], bias[1])
    return y.astype(proj.dtype)


def conv_ffn(x, w_up, conv_w, conv_b, w_down):
    h = dwconv(x @ w_up, conv_w, FFN_CONV // 2) + conv_b
    gate, val = jnp.split(h, 2, axis=-1)
    return (jax.nn.silu(gate) * val) @ w_down


def encoder_trunk(x, p):
    for l in range(DEPTH):
        z = rmsnorm(x, p['norm_mix'][l]) @ p['w_in'][l]
        ya = rglru_mixer(z[..., OFF_A_X:OFF_A_GATE], z[..., OFF_A_GATE:OFF_B_U],
                         p['lru_conv_w'][l], p['lru_conv_b'][l], p['lru_w_r'][l], p['lru_b_r'][l],
                         p['lru_w_i'][l], p['lru_b_i'][l], p['lru_lambda'][l])
        yb = s5_mixer(z[..., OFF_B_U:OFF_C_QKV], p['s5_a_re'][l], p['s5_a_im'][l], p['s5_log_dt'][l],
                      p['s5_b_re'][l], p['s5_b_im'][l], p['s5_c_re'][l], p['s5_c_im'][l],
                      p['s5_d'][l], p['s5_glu_w'][l], p['s5_glu_b'][l])
        yc = gdn_mixer(z[..., OFF_C_QKV:OFF_C_GATE], z[..., OFF_C_GATE:OFF_C_BETA],
                       z[..., OFF_C_BETA:OFF_C_ALPHA], z[..., OFF_C_ALPHA:OFF_D],
                       p['gdn_conv_w'][l], p['gdn_a_log'][l], p['gdn_dt_bias'][l], p['gdn_norm'][l])
        yd = hyena_mixer(z[..., OFF_D:N_IN], p['hy_conv_w'][l], p['hy_conv_b'][l], p['hy_w1'][l],
                         p['hy_b1'][l], p['hy_freq'][l], p['hy_w2'][l], p['hy_b2'][l], p['hy_w3'][l],
                         p['hy_bias'][l])
        gn = p['grp_norm'][l]
        mix = jnp.concatenate([rmsnorm(ya, gn[0]), rmsnorm(yb, gn[1]), yc.astype(ya.dtype),
                               rmsnorm(yd, gn[2])], axis=-1)
        x = x + (mix @ p['w_out'][l]).astype(x.dtype)
        x = x + conv_ffn(rmsnorm(x, p['norm_ffn'][l]), p['w_up'][l], p['ffn_conv_w'][l],
                         p['ffn_conv_b'][l], p['w_down'][l]).astype(x.dtype)
    return rmsnorm(x, p['final_norm'])


def setup_inputs(seed: int = 0) -> dict:
    key = jax.random.key(seed)
    ks = jax.random.split(key, 64)
    it = iter([ks[i] for i in range(64)])

    def nrm(shape, scale=1.0):
        return scale * jax.random.normal(next(it), shape, F32)

    def unif(shape, lo, hi):
        return jax.random.uniform(next(it), shape, F32, lo, hi)

    def gain(shape):
        return 1.0 + 0.01 * nrm(shape)

    x_prompt = nrm((BATCH, SEQ, D_MODEL))
    x_sample = nrm((DEC_BATCH, DEC_SEQ, D_MODEL))
    lru_a = unif((DEPTH, N_DIR, W_GRP), 0.9, 0.999) ** (1.0 / LRU_C)
    lru_lambda = jnp.log(lru_a) - jnp.log1p(-lru_a)
    gdn_dt = jnp.exp(unif((DEPTH, N_DIR, GDN_HEADS), math.log(1e-3), math.log(1e-1)))
    return {
        'x_prompt': x_prompt,
        'x_sample': x_sample,
        'norm_mix': gain((DEPTH, D_MODEL)),
        'w_in': nrm((DEPTH, D_MODEL, N_IN), D_MODEL ** -0.5),
        'lru_conv_w': nrm((DEPTH, LRU_CONV, W_GRP), LRU_CONV ** -0.5),
        'lru_conv_b': nrm((DEPTH, W_GRP), 0.01),
        'lru_w_r': nrm((DEPTH, N_DIR, LRU_HEADS, LRU_HD, LRU_HD), LRU_HD ** -0.5),
        'lru_b_r': nrm((DEPTH, N_DIR, W_GRP), 0.01),
        'lru_w_i': nrm((DEPTH, N_DIR, LRU_HEADS, LRU_HD, LRU_HD), LRU_HD ** -0.5),
        'lru_b_i': nrm((DEPTH, N_DIR, W_GRP), 0.01),
        'lru_lambda': lru_lambda,
        's5_a_re': -0.5 + 0.01 * nrm((DEPTH, N_DIR, S5_GROUPS, S5_STATE)),
        's5_a_im': math.pi * jnp.arange(S5_STATE, dtype=F32) + 0.01 * nrm((DEPTH, N_DIR, S5_GROUPS, S5_STATE)),
        's5_log_dt': unif((DEPTH, N_DIR, S5_GROUPS), math.log(1e-3), math.log(1e-1)),
        's5_b_re': nrm((DEPTH, N_DIR, S5_GROUPS, S5_STATE, S5_CH), (2 * S5_CH) ** -0.5),
        's5_b_im': nrm((DEPTH, N_DIR, S5_GROUPS, S5_STATE, S5_CH), (2 * S5_CH) ** -0.5),
        's5_c_re': nrm((DEPTH, N_DIR, S5_GROUPS, S5_CH, S5_STATE), (2 * S5_STATE) ** -0.5),
        's5_c_im': nrm((DEPTH, N_DIR, S5_GROUPS, S5_CH, S5_STATE), (2 * S5_STATE) ** -0.5),
        's5_d': nrm((DEPTH, W_GRP)),
        's5_glu_w': nrm((DEPTH, W_GRP, W_GRP), W_GRP ** -0.5),
        's5_glu_b': nrm((DEPTH, W_GRP), 0.01),
        'gdn_conv_w': nrm((DEPTH, GDN_CONV, 3 * W_GRP), GDN_CONV ** -0.5),
        'gdn_a_log': jnp.log(unif((DEPTH, N_DIR, GDN_HEADS), 1.0, 16.0)),
        'gdn_dt_bias': gdn_dt + jnp.log(-jnp.expm1(-gdn_dt)),
        'gdn_norm': gain((DEPTH, GDN_HD)),
        'hy_conv_w': nrm((DEPTH, HY_CONV, (HY_ORDER + 1) * W_GRP), HY_CONV ** -0.5),
        'hy_conv_b': nrm((DEPTH, (HY_ORDER + 1) * W_GRP), 0.01),
        'hy_w1': nrm((DEPTH, HY_EMB, HY_FW), HY_EMB ** -0.5),
        'hy_b1': nrm((DEPTH, HY_FW), 0.1),
        'hy_freq': gain((DEPTH, HY_FW)),
        'hy_w2': nrm((DEPTH, HY_FW, HY_FW), HY_FW ** -0.5),
        'hy_b2': nrm((DEPTH, HY_FW), 0.1),
        'hy_w3': nrm((DEPTH, HY_FW, HY_ORDER * N_DIR * W_GRP), HY_FW ** -0.5),
        'hy_bias': nrm((DEPTH, HY_ORDER, W_GRP)),
        'grp_norm': gain((DEPTH, 3, W_GRP)),
        'w_out': nrm((DEPTH, D_MIX, D_MODEL), D_MIX ** -0.5),
        'norm_ffn': gain((DEPTH, D_MODEL)),
        'w_up': nrm((DEPTH, D_MODEL, 2 * D_FF), D_MODEL ** -0.5),
        'ffn_conv_w': nrm((DEPTH, FFN_CONV, 2 * D_FF), FFN_CONV ** -0.5),
        'ffn_conv_b': nrm((DEPTH, 2 * D_FF), 0.01),
        'w_down': nrm((DEPTH, D_FF, D_MODEL), D_FF ** -0.5),
        'final_norm': gain((D_MODEL,)),
    }


def reference(x_prompt, x_sample, norm_mix, w_in, lru_conv_w, lru_conv_b, lru_w_r, lru_b_r, lru_w_i,
              lru_b_i, lru_lambda, s5_a_re, s5_a_im, s5_log_dt, s5_b_re, s5_b_im, s5_c_re, s5_c_im,
              s5_d, s5_glu_w, s5_glu_b, gdn_conv_w, gdn_a_log, gdn_dt_bias, gdn_norm, hy_conv_w,
              hy_conv_b, hy_w1, hy_b1, hy_freq, hy_w2, hy_b2, hy_w3, hy_bias, grp_norm, w_out,
              norm_ffn, w_up, ffn_conv_w, ffn_conv_b, w_down, final_norm):
    p = dict(norm_mix=norm_mix, w_in=w_in, lru_conv_w=lru_conv_w, lru_conv_b=lru_conv_b,
             lru_w_r=lru_w_r, lru_b_r=lru_b_r, lru_w_i=lru_w_i, lru_b_i=lru_b_i, lru_lambda=lru_lambda,
             s5_a_re=s5_a_re, s5_a_im=s5_a_im, s5_log_dt=s5_log_dt, s5_b_re=s5_b_re, s5_b_im=s5_b_im,
             s5_c_re=s5_c_re, s5_c_im=s5_c_im, s5_d=s5_d, s5_glu_w=s5_glu_w, s5_glu_b=s5_glu_b,
             gdn_conv_w=gdn_conv_w, gdn_a_log=gdn_a_log, gdn_dt_bias=gdn_dt_bias, gdn_norm=gdn_norm,
             hy_conv_w=hy_conv_w, hy_conv_b=hy_conv_b, hy_w1=hy_w1, hy_b1=hy_b1, hy_freq=hy_freq,
             hy_w2=hy_w2, hy_b2=hy_b2, hy_w3=hy_w3, hy_bias=hy_bias, grp_norm=grp_norm, w_out=w_out,
             norm_ffn=norm_ffn, w_up=w_up, ffn_conv_w=ffn_conv_w, ffn_conv_b=ffn_conv_b,
             w_down=w_down, final_norm=final_norm)
    y_prompt = encoder_trunk(x_prompt, p)
    y_sample = encoder_trunk(x_sample, p)
    return (y_prompt, y_sample)
```

```cpp
#include <hip/hip_runtime.h>
#include <hip/hip_bf16.h>
#include <hip/hip_cooperative_groups.h>
#include <cstdio>
namespace cg = cooperative_groups;

typedef unsigned short u16;
using bf16x8 = __attribute__((ext_vector_type(8))) short;
using f32x4 = __attribute__((ext_vector_type(4))) float;

#define T_ALL 81920
#define T_P 16384
#define DM 1024
#define NZ 2688
#define DFF 2816
#define NCH32 2560
#define NCH64 1280
#define EPSF 1e-6f

constexpr size_t al(size_t x) { return (x + 255) & ~(size_t)255; }
constexpr size_t O_WIN = 0;
constexpr size_t O_WOUT = O_WIN + al((size_t)NZ * 1024 * 2);
constexpr size_t O_WUP = O_WOUT + al((size_t)1024 * 1024 * 2);
constexpr size_t O_WDN = O_WUP + al((size_t)5632 * 1024 * 2);
constexpr size_t O_WLRU = O_WDN + al((size_t)1024 * 2816 * 2);
constexpr size_t O_WGLU = O_WLRU + al((size_t)4 * 256 * 64 * 2);
constexpr size_t O_AB64 = O_WGLU + al((size_t)256 * 256 * 2);
constexpr size_t O_KTAB = O_AB64 + 2 * al((size_t)2 * 16 * 64 * 2 * 4);
constexpr size_t O_BTY = O_KTAB + al((size_t)16 * 2 * 64 * 256 * 4);
constexpr size_t O_BTS = O_BTY + al((size_t)16 * 1024 * 1280 * 2);
constexpr size_t O_HYKR = O_BTS + al((size_t)16 * 256 * 1024 * 2);
constexpr size_t HYKR1 = (size_t)2 * 256 * 4096;
constexpr size_t O_HYPS = O_HYKR + al((size_t)2 * 256 * (4096 + 8192) * 2);
constexpr size_t O_XN = O_HYPS + al((size_t)(32 + 64) * 512 * 4);
constexpr size_t O_ZA = O_XN + al((size_t)T_ALL * 1024 * 2);
constexpr size_t O_UH = O_ZA + al((size_t)T_ALL * 512 * 2);
constexpr size_t O_ZC = O_UH + al((size_t)16 * 1280 * 1280 * 2);
constexpr size_t O_BA = O_ZC + al((size_t)T_ALL * 1024 * 2);
constexpr size_t O_DT = O_BA + al((size_t)T_ALL * 16 * 4);
constexpr size_t O_WU = O_DT + al((size_t)768 * T_ALL * 2);
constexpr size_t O_GC = O_WU + al((size_t)NCH64 * 4 * 2 * 2 * 4096 * 2);
constexpr size_t O_OD = O_GC + al((size_t)T_ALL * 8 * 4);
constexpr size_t O_Y1 = O_OD + al((size_t)2 * T_ALL * 256 * 2);
constexpr size_t O_SEND = O_Y1 + al((size_t)256 * T_ALL * 2);
constexpr size_t O_LCAR = O_SEND + al((size_t)16 * 1280 * 256 * 4);
constexpr size_t O_LHIN = O_LCAR + al((size_t)NCH32 * 512 * 8);
constexpr size_t O_BAR = O_LHIN + al((size_t)NCH32 * 512 * 4);
constexpr size_t WS_TOTAL = O_BAR + 256;
static_assert(WS_TOTAL <= (size_t)1073741824, "ws");
constexpr size_t O_HMID = O_ZA;
static_assert(O_HMID + (size_t)T_ALL * DFF * 2 <= O_GC, "hmid alias");

struct Params {
  const float* in[42];
  float* out;
  char* ws;
};

#define SMEM_BYTES 73728
#ifndef MIXMASK
#define MIXMASK 15
#endif

__device__ __forceinline__ u16 f2bf(float f) {
  unsigned u = __float_as_uint(f);
  u += 0x7fffu + ((u >> 16) & 1u);
  return (u16)(u >> 16);
}
__device__ __forceinline__ float bf2f(u16 h) { return __uint_as_float(((unsigned)h) << 16); }
__device__ __forceinline__ float sigmoidf_(float x) { return 1.f / (1.f + __expf(-x)); }
__device__ __forceinline__ float siluf_(float x) { return x / (1.f + __expf(-x)); }
__device__ __forceinline__ float softplusf_(float x) { return x > 20.f ? x : log1pf(expf(x)); }
__device__ __forceinline__ float geluf_(float x) {
  float t = tanhf(0.7978845608028654f * (x + 0.044715f * x * x * x));
  return 0.5f * x * (1.f + t);
}
__device__ __forceinline__ float wave_sum(float v) {
#pragma unroll
  for (int o = 32; o > 0; o >>= 1) v += __shfl_xor(v, o);
  return v;
}
__device__ __forceinline__ const float* xrow(const Params& p, int l, int tok) {
  const float* a = p.in[0]; const float* b = p.in[1]; const float* o = p.out;
  const float* r0 = a + (size_t)tok * DM;
  const float* r1 = b + (size_t)(tok - T_P) * DM;
  const float* r2 = o + (size_t)tok * DM;
  return l == 0 ? (tok < T_P ? r0 : r1) : r2;
}
__device__ __forceinline__ void seq_bounds(int tok, int& lo, int& hi) {
  if (tok < T_P) { lo = tok & ~2047; hi = lo + 2048; }
  else { lo = T_P + ((tok - T_P) & ~4095); hi = lo + 4096; }
}

#define GST 72
#define HST 132
__device__ __forceinline__ const float* gemm_tile(u16* smem, const u16* __restrict__ A, long lda, int arow0, int alo, int ahi,
                                          int segK, size_t segStride,
                                          const u16* __restrict__ Bt, long ldb, int K) {
  u16* sA = smem;
  u16* sB = smem + 2 * 128 * GST;
  int tid = threadIdx.x; asm volatile("" : "+v"(tid)); const int _tid_pad = 0, lane = tid & 63, w = tid >> 6;
  const int wm = w >> 1, wn = w & 1, fr = lane & 15, fq = lane >> 4;
  const int cc = tid & 7, r0 = tid >> 3;
  f32x4 acc[4][4];
#pragma unroll
  for (int i = 0; i < 4; i++)
#pragma unroll
    for (int j = 0; j < 4; j++) acc[i][j] = (f32x4){0.f, 0.f, 0.f, 0.f};
  uint4 ra0, ra1, ra2, ra3, rb0, rb1, rb2, rb3;
  const int nk = K >> 6;
#define GLOAD1(i_, RA, RB) {                                                       \
      int ar_ = arow0 + r0 + 32 * i_;                                                 \
      bool ok_ = ar_ >= alo && ar_ < ahi;                                             \
      uint4 t_ = *(const uint4*)(Ab_ + (long)(ok_ ? ar_ : alo) * lda);                \
      RA = ok_ ? t_ : make_uint4(0, 0, 0, 0);                                         \
      RB = *(const uint4*)(Bt + (long)(r0 + 32 * i_) * ldb + k0_ + cc * 8); }
#define GLOAD(kt_) do {                                                            \
    const int k0_ = (kt_) << 6;                                                       \
    const int kk_ = k0_ + cc * 8;                                                     \
    const int sg_ = kk_ / segK, kin_ = kk_ - sg_ * segK;                              \
    const u16* Ab_ = A + (size_t)sg_ * segStride + kin_;                              \
    GLOAD1(0, ra0, rb0) GLOAD1(1, ra1, rb1) GLOAD1(2, ra2, rb2) GLOAD1(3, ra3, rb3)   \
    } while (0)
#define SWRITE1(buf_, i_, RA, RB) {                                                 \
      *(uint4*)(sA + (buf_) * 128 * GST + (r0 + 32 * i_) * GST + cc * 8) = RA;        \
      *(uint4*)(sB + (buf_) * 128 * GST + (r0 + 32 * i_) * GST + cc * 8) = RB; }
#define SWRITE(buf_) do {                                                           \
    SWRITE1(buf_, 0, ra0, rb0) SWRITE1(buf_, 1, ra1, rb1) SWRITE1(buf_, 2, ra2, rb2) SWRITE1(buf_, 3, ra3, rb3) \
    } while (0)
  __syncthreads();
  GLOAD(0);
  SWRITE(0);
  __syncthreads();
#pragma unroll 1
  for (int kt = 0; kt < nk; kt++) {
    if (kt + 1 < nk) GLOAD(kt + 1);
    const u16* a = sA + (kt & 1) * 128 * GST;
    const u16* b = sB + (kt & 1) * 128 * GST;
#pragma unroll
    for (int ks = 0; ks < 2; ks++) {
      bf16x8 af[4], bfr[4];
#pragma unroll
      for (int i = 0; i < 4; i++) {
        af[i] = *(const bf16x8*)(a + (64 * wm + 16 * i + fr) * GST + ks * 32 + fq * 8);
        bfr[i] = *(const bf16x8*)(b + (64 * wn + 16 * i + fr) * GST + ks * 32 + fq * 8);
      }
#pragma unroll
      for (int i = 0; i < 4; i++)
#pragma unroll
        for (int j = 0; j < 4; j++) acc[i][j] = __builtin_amdgcn_mfma_f32_16x16x32_bf16(af[i], bfr[j], acc[i][j], 0, 0, 0);
    }
    if (kt + 1 < nk) SWRITE((kt + 1) & 1);
    __syncthreads();
  }
  float* H = (float*)smem;
#pragma unroll
  for (int i = 0; i < 4; i++)
#pragma unroll
    for (int j = 0; j < 4; j++)
#pragma unroll
      for (int e = 0; e < 4; e++) H[(64 * wm + 16 * i + 4 * fq + e) * HST + 64 * wn + 16 * j + fr] = acc[i][j][e];
  __syncthreads();
  return H;
}
__device__ __forceinline__ uint2 pack4(float a, float b, float c, float d) {
  uint2 pk; pk.x = f2bf(a) | ((unsigned)f2bf(b) << 16); pk.y = f2bf(c) | ((unsigned)f2bf(d) << 16); return pk;
}
#define EPI_ROWS(H, BODY...)                                                     \
  _Pragma("unroll 2") for (int _it = 0; _it < 16; _it++) {                       \
    const int r = (threadIdx.x >> 5) + 8 * _it, c = (threadIdx.x & 31) * 4;      \
    const float4 v = *(const float4*)((H) + r * HST + c); BODY }

__device__ __forceinline__ int colmap(int mode, int n) {
  if (mode == 0) {
    if (n < 1792) return n;
    if (n < 2560) return n + 16;
    if (n < 2576) return 1792 + (n - 2560);
    return -1;
  }
  if (mode == 2) { int nt = n >> 7, c = n & 127; return c < 64 ? nt * 64 + c : DFF + nt * 64 + (c - 64); }
  return n;
}
__device__ __forceinline__ void transpose_tile(float* sm, const float* __restrict__ src, int ldsrc, const float* __restrict__ gain,
                               u16* __restrict__ dst, int K, int mode, int n0, int k0) {
  int tid = threadIdx.x; asm volatile("" : "+v"(tid)); const int _tid_pad = 0;
  __syncthreads();
  {
    int nn = tid & 63;
    int sc = colmap(mode, n0 + nn);
#pragma unroll
    for (int i = 0; i < 16; i++) {
      int kk = (tid >> 6) + 4 * i;
      float v = 0.f;
      if (sc >= 0) { v = src[(size_t)(k0 + kk) * ldsrc + sc]; if (gain) v *= gain[k0 + kk]; }
      sm[kk * 65 + nn] = v;
    }
  }
  __syncthreads();
  {
    int c = tid & 7;
#pragma unroll
    for (int i = 0; i < 2; i++) {
      int nn = (tid >> 3) + 32 * i;
      u16 h[8];
#pragma unroll
      for (int e = 0; e < 8; e++) h[e] = f2bf(sm[(c * 8 + e) * 65 + nn]);
      uint4 pk;
      pk.x = h[0] | ((unsigned)h[1] << 16); pk.y = h[2] | ((unsigned)h[3] << 16);
      pk.z = h[4] | ((unsigned)h[5] << 16); pk.w = h[6] | ((unsigned)h[7] << 16);
      *(uint4*)(dst + (size_t)(n0 + nn) * K + k0 + c * 8) = pk;
    }
  }
}

__device__ __forceinline__ void s5_prep_item(float* sm, const Params& p, int l, int item) {
  int tid = threadIdx.x; asm volatile("" : "+v"(tid)); const int _tid_pad = 0;
  const int m = item % 65, d = (item / 65) & 1, g = item / 130;
  float* s_abm = sm;
  float* s_q = sm + 128;
  const int ldg = (l * 2 + d) * 16 + g;
  __syncthreads();
  if (tid < 64) {
    int pi = ldg * 64 + tid;
    float dt = expf(p.in[13][ldg]);
    float are = p.in[11][pi], aim = p.in[12][pi];
    float mag = expf(dt * are), ang = dt * aim;
    float abr = mag * cosf(ang), abi = mag * sinf(ang);
    float den = are * are + aim * aim;
    float nre = abr - 1.f;
    s_q[tid * 2] = (nre * are + abi * aim) / den;
    s_q[tid * 2 + 1] = (abi * are - nre * aim) / den;
    float mm = expf((float)m * dt * are), am = (float)m * ang;
    float pr = mm * cosf(am), pim = mm * sinf(am);
    s_abm[tid * 2] = pr; s_abm[tid * 2 + 1] = pim;
    if (m == 64) {
      float* ab64 = (float*)(p.ws + O_AB64) + (size_t)l * 2 * 16 * 64 * 2;
      ab64[((d * 16 + g) * 64 + tid) * 2] = pr;
      ab64[((d * 16 + g) * 64 + tid) * 2 + 1] = pim;
    }
  }
  __syncthreads();
  const float* bre = p.in[14] + (size_t)ldg * 64 * 16;
  const float* bim = p.in[15] + (size_t)ldg * 64 * 16;
  const float* cre = p.in[16] + (size_t)ldg * 16 * 64;
  const float* cim = p.in[17] + (size_t)ldg * 16 * 64;
  u16* bty = (u16*)(p.ws + O_BTY) + (size_t)g * 1024 * 1280;
  u16* bts = (u16*)(p.ws + O_BTS) + (size_t)g * 256 * 1024;
  if (m <= 63) {
    int ho = tid >> 4, hi = tid & 15;
    float acc = 0.f;
    for (int pp = 0; pp < 64; pp++) {
      float cr = cre[ho * 64 + pp], ci = cim[ho * 64 + pp];
      float ar = s_abm[pp * 2], ai = s_abm[pp * 2 + 1];
      float t1r = cr * ar - ci * ai, t1i = cr * ai + ci * ar;
      float qr = s_q[pp * 2], qi = s_q[pp * 2 + 1];
      float br = bre[pp * 16 + hi], bi = bim[pp * 16 + hi];
      float bbr = qr * br - qi * bi, bbi = qr * bi + qi * br;
      acc += t1r * bbr - t1i * bbi;
    }
    float* kt = (float*)(p.ws + O_KTAB);
    kt[((size_t)((g * 2 + d) * 64 + m)) * 256 + ho * 16 + hi] = acc;
  }
  if (m >= 1) {
    int t = d == 0 ? m - 1 : 64 - m;
    for (int e = tid; e < 1024; e += 256) {
      int ho = e >> 6, pp = e & 63;
      float cr = cre[ho * 64 + pp], ci = cim[ho * 64 + pp];
      float ar = s_abm[pp * 2], ai = s_abm[pp * 2 + 1];
      float xr = cr * ar - ci * ai, xi = cr * ai + ci * ar;
      size_t o = (size_t)(t * 16 + ho) * 1280 + 1024 + d * 128 + pp * 2;
      bty[o] = f2bf(xr);
      bty[o + 1] = f2bf(-xi);
    }
  }
}
__device__ __forceinline__ void s5_bts_item(const Params& p, int l, int item) {
  int tid = threadIdx.x; asm volatile("" : "+v"(tid));
  const int pp = item & 63, d = (item >> 6) & 1, g = item >> 7;
  const int sp = tid >> 2, hq = tid & 3;
  const int ldg = (l * 2 + d) * 16 + g;
  const int pi = ldg * 64 + pp;
  float dt = expf(p.in[13][ldg]);
  float are = p.in[11][pi], aim = p.in[12][pi];
  float mag = expf(dt * are), ang = dt * aim;
  float abr = mag * cosf(ang), abi = mag * sinf(ang);
  float den = are * are + aim * aim;
  float nre = abr - 1.f;
  float qr = (nre * are + abi * aim) / den, qi = (abi * are - nre * aim) / den;
  const int f = d == 0 ? 63 - sp : sp;
  float mm = expf((float)f * dt * are), am = (float)f * ang;
  float ar = mm * cosf(am), ai = mm * sinf(am);
  const float* bre = p.in[14] + (size_t)ldg * 64 * 16 + pp * 16 + hq * 4;
  const float* bim = p.in[15] + (size_t)ldg * 64 * 16 + pp * 16 + hq * 4;
  float fr_[4], fi_[4];
#pragma unroll
  for (int e = 0; e < 4; e++) {
    float br = bre[e], bi = bim[e];
    float bbr = qr * br - qi * bi, bbi = qr * bi + qi * br;
    fr_[e] = ar * bbr - ai * bbi; fi_[e] = ar * bbi + ai * bbr;
  }
  u16* bts = (u16*)(p.ws + O_BTS) + (size_t)g * 256 * 1024 + (size_t)(d * 128 + pp * 2) * 1024 + sp * 16 + hq * 4;
  *(uint2*)bts = pack4(fr_[0], fr_[1], fr_[2], fr_[3]);
  *(uint2*)(bts + 1024) = pack4(fi_[0], fi_[1], fi_[2], fi_[3]);
}
__device__ __forceinline__ void s5_expand_item(const Params& p, int l, int item) {
  int tid = threadIdx.x; asm volatile("" : "+v"(tid)); const int _tid_pad = 0;
  int g = item >> 10, n = item & 1023, t = n >> 4, ho = n & 15;
  int sp = tid >> 2, hi0 = (tid & 3) * 4;
  const float* kt = (const float*)(p.ws + O_KTAB);
  float v[4] = {0.f, 0.f, 0.f, 0.f};
  if (t >= sp) {
    const float* k0 = kt + ((size_t)((g * 2 + 0) * 64 + (t - sp))) * 256 + ho * 16 + hi0;
#pragma unroll
    for (int e = 0; e < 4; e++) v[e] += k0[e];
  }
  if (sp >= t) {
    const float* k1 = kt + ((size_t)((g * 2 + 1) * 64 + (sp - t))) * 256 + ho * 16 + hi0;
#pragma unroll
    for (int e = 0; e < 4; e++) v[e] += k1[e];
  }
  if (t == sp && ho >= hi0 && ho < hi0 + 4) v[ho - hi0] += p.in[18][l * 256 + g * 16 + ho];
  u16* bty = (u16*)(p.ws + O_BTY) + (size_t)g * 1024 * 1280 + (size_t)n * 1280 + sp * 16 + hi0;
  uint2 pk;
  pk.x = f2bf(v[0]) | ((unsigned)f2bf(v[1]) << 16);
  pk.y = f2bf(v[2]) | ((unsigned)f2bf(v[3]) << 16);
  *(uint2*)bty = pk;
}

__device__ __forceinline__ void hy_filter_item(float* sm, const Params& p, int l, int set, int tb) {
  int tid = threadIdx.x; asm volatile("" : "+v"(tid));
  const int L = 2048 << set;
  float* sz = sm;
  float* h1 = sm + 65 * 33;
  float* h2 = h1 + 65 * 64;
  const float* w1 = p.in[27] + (size_t)l * 33 * 64;
  const float* b1 = p.in[28] + l * 64;
  const float* fq_ = p.in[29] + l * 64;
  const float* w2 = p.in[30] + (size_t)l * 64 * 64;
  const float* b2 = p.in[31] + l * 64;
  const float* w3 = p.in[32] + (size_t)l * 64 * 1024;
  __syncthreads();
  for (int e = tid; e < 65 * 33; e += 256) {
    int tt = e / 33, i = e % 33;
    int t = tb * 64 + tt;
    float val;
    if (i == 0) val = (float)t / (float)(L - 1);
    else {
      int b = (i - 1) & 15;
      float f = 1e-4f + (float)b * ((15.f - 1e-4f) / 15.f);
      float wang = 6.283185307179586f * (float)t / (float)L;
      val = i <= 16 ? cosf(f * wang) : -sinf(f * wang);
    }
    sz[e] = val;
  }
  __syncthreads();
  {
    int j = tid & 63;
    float fj = fq_[j], bj = b1[j];
#pragma unroll 1
    for (int i = 0; i < 17; i++) {
      int tt = (tid >> 6) + 4 * i;
      if (tt < 65) {
        float a = bj;
        for (int k = 0; k < 33; k++) a += sz[tt * 33 + k] * w1[k * 64 + j];
        h1[tt * 64 + j] = sinf(fj * a);
      }
    }
  }
  __syncthreads();
  {
    int j = tid & 63;
    float fj = fq_[j], bj = b2[j];
#pragma unroll 1
    for (int i = 0; i < 17; i++) {
      int tt = (tid >> 6) + 4 * i;
      if (tt < 65) {
        float a = bj;
        for (int k = 0; k < 64; k++) a += h1[tt * 64 + k] * w2[k * 64 + j];
        h2[tt * 64 + j] = sinf(fj * a);
      }
    }
  }
  __syncthreads();
  const int c = tid;
  const float mind = -3.0701134573253943f, maxd = -15.350567286626972f;
  float delta = fabsf(mind + (float)c * ((maxd - mind) / 255.f));
  u16* kr = (u16*)(p.ws + O_HYKR) + (set ? HYKR1 : 0);
  float* ps = (float*)(p.ws + O_HYPS) + (size_t)(set ? 32 * 512 : 0) + (size_t)tb * 512;
#pragma unroll 1
  for (int order = 0; order < 2; order++) {
    u16* krc = kr + ((size_t)order * 256 + c) * (2 * L);
    float asum = 0.f, v00 = 0.f;
#pragma unroll 1
    for (int dir = 0; dir < 2; dir++) {
      float wc[64];
#pragma unroll
      for (int k = 0; k < 64; k++) wc[k] = w3[k * 1024 + order * 512 + dir * 256 + c];
      float hold = 0.f;
      const int ntt = dir == 0 ? 65 : 64;
#pragma unroll 1
      for (int tt = 0; tt < ntt; tt++) {
        float a = 0.f;
#pragma unroll
        for (int k = 0; k < 64; k++) a += h2[tt * 64 + k] * wc[k];
        int t = tb * 64 + tt;
        float tl = (float)t / (float)(L - 1);
        a *= expf(-tl * delta);
        if (t >= L) a = 0.f;
        if (tt < 64) asum += fabsf(a);
        if (dir == 0) {
          if (tt == 0) { if (tb == 0) v00 = a; }
          else if (tt & 1) hold = a;
          else *(unsigned*)(krc + (L - t)) = f2bf(a) | ((unsigned)f2bf(hold) << 16);
        } else {
          if (!(tt & 1)) hold = (t == 0) ? v00 + a : a;
          else *(unsigned*)(krc + (L + t - 1)) = f2bf(hold) | ((unsigned)f2bf(a) << 16);
        }
      }
    }
    ps[order * 256 + c] = asum;
  }
}

__device__ __forceinline__ void rms_rows_to_bf16(const Params& p, int l, int rowblk) {
  int tid_ = threadIdx.x; asm volatile("" : "+v"(tid_));
  const int lane = tid_ & 63, w = tid_ >> 6;
  int tok = rowblk * 4 + w;
  const float* x = xrow(p, l, tok);
  float4 v[4];
  float ss = 0.f;
#pragma unroll
  for (int i = 0; i < 4; i++) {
    v[i] = *(const float4*)(x + i * 256 + lane * 4);
    ss += v[i].x * v[i].x + v[i].y * v[i].y + v[i].z * v[i].z + v[i].w * v[i].w;
  }
  ss = wave_sum(ss);
  float rs = rsqrtf(ss * (1.f / 1024.f) + EPSF);
  u16* xn = (u16*)(p.ws + O_XN) + (size_t)tok * 1024;
#pragma unroll
  for (int i = 0; i < 4; i++) {
    uint2 pk;
    pk.x = f2bf(v[i].x * rs) | ((unsigned)f2bf(v[i].y * rs) << 16);
    pk.y = f2bf(v[i].z * rs) | ((unsigned)f2bf(v[i].w * rs) << 16);
    *(uint2*)(xn + i * 256 + lane * 4) = pk;
  }
}

__device__ __forceinline__ void lru_item(char* smraw, const Params& p, int l, int item, int mode) {
  int tid = threadIdx.x; asm volatile("" : "+v"(tid)); const int _tid_pad = 0, lane = tid & 63, w = tid >> 6, fr = lane & 15, fq = lane >> 4;
  const int cki = item >> 2, head = item & 3;
  const int t0 = cki * 32;
  int lo, hi; seq_bounds(t0, lo, hi);
  float* xc = (float*)smraw;
  u16* xcb = (u16*)(smraw + 8192);
  float* sa = (float*)(smraw + 8192 + 4608);
  float* su = sa + 2 * 32 * 64;
  float* sx = su + 2 * 32 * 64;
  const u16* zA = (const u16*)(p.ws + O_ZA);
  __syncthreads();
  {
    int ch = tid & 63, tq = tid >> 6;
    int gch = head * 64 + ch;
    const float* cw = p.in[4] + l * 4 * 256;
    float w0 = cw[gch], w1 = cw[256 + gch], w2 = cw[512 + gch], w3 = cw[768 + gch];
    float cb = p.in[5][l * 256 + gch];
    float win[11];
#pragma unroll
    for (int i = 0; i < 11; i++) {
      int tok = t0 + tq * 8 + i - 2;
      win[i] = (tok >= lo && tok < hi) ? bf2f(zA[(size_t)tok * 512 + gch]) : 0.f;
    }
#pragma unroll
    for (int i = 0; i < 8; i++) {
      float v = w0 * win[i] + w1 * win[i + 1] + w2 * win[i + 2] + w3 * win[i + 3] + cb;
      int tt = tq * 8 + i;
      xc[tt * 64 + ch] = v;
      xcb[tt * 72 + ch] = f2bf(v);
    }
  }
  __syncthreads();
  {
    const int d = w >> 1, half = w & 1;
    const u16* wl = (const u16*)(p.ws + O_WLRU) + (size_t)head * 256 * 64;
    f32x4 accr[2][2], acci[2][2];
#pragma unroll
    for (int a = 0; a < 2; a++)
#pragma unroll
      for (int b = 0; b < 2; b++) { accr[a][b] = (f32x4){0, 0, 0, 0}; acci[a][b] = (f32x4){0, 0, 0, 0}; }
#pragma unroll
    for (int ks = 0; ks < 2; ks++) {
      bf16x8 af[2], br[2], bi[2];
#pragma unroll
      for (int mt = 0; mt < 2; mt++) af[mt] = *(const bf16x8*)(xcb + (16 * mt + fr) * 72 + ks * 32 + fq * 8);
#pragma unroll
      for (int nt = 0; nt < 2; nt++) {
        int nr = d * 128 + 32 * half + 16 * nt + fr;
        br[nt] = *(const bf16x8*)(wl + (size_t)nr * 64 + ks * 32 + fq * 8);
        bi[nt] = *(const bf16x8*)(wl + (size_t)(nr + 64) * 64 + ks * 32 + fq * 8);
      }
#pragma unroll
      for (int mt = 0; mt < 2; mt++)
#pragma unroll
        for (int nt = 0; nt < 2; nt++) {
          accr[mt][nt] = __builtin_amdgcn_mfma_f32_16x16x32_bf16(af[mt], br[nt], accr[mt][nt], 0, 0, 0);
          acci[mt][nt] = __builtin_amdgcn_mfma_f32_16x16x32_bf16(af[mt], bi[nt], acci[mt][nt], 0, 0, 0);
        }
    }
#pragma unroll
    for (int nt = 0; nt < 2; nt++) {
      int ch = 32 * half + 16 * nt + fr;
      int gch = head * 64 + ch;
      float brr = p.in[7][(l * 2 + d) * 256 + gch], bii = p.in[9][(l * 2 + d) * 256 + gch];
      float sp = softplusf_(-p.in[10][(l * 2 + d) * 256 + gch]);
#pragma unroll
      for (int mt = 0; mt < 2; mt++)
#pragma unroll
        for (int e = 0; e < 4; e++) {
          int tt = 16 * mt + 4 * fq + e;
          float r = 1.f / (1.f + expf(-(accr[mt][nt][e] + brr)));
          float ig = 1.f / (1.f + expf(-(acci[mt][nt][e] + bii)));
          float la = -8.f * r * sp;
          float a = expf(la);
          float u = sqrtf(-expm1f(2.f * la)) * (ig * xc[tt * 64 + ch]);
          sa[(d * 32 + tt) * 64 + ch] = a;
          su[(d * 32 + tt) * 64 + ch] = u;
        }
    }
  }
  __syncthreads();
  {
    const int ch = tid & 63, d = (tid >> 6) & 1, half = tid >> 7;
    float A = 1.f, B = 0.f;
#pragma unroll
    for (int i = 0; i < 16; i++) {
      int tt = d == 0 ? half * 16 + i : half * 16 + 15 - i;
      float a = sa[(d * 32 + tt) * 64 + ch], u = su[(d * 32 + tt) * 64 + ch];
      A = a * A; B = a * B + u;
    }
    sx[((d * 2 + half) * 64 + ch) * 2] = A;
    sx[((d * 2 + half) * 64 + ch) * 2 + 1] = B;
  }
  __syncthreads();
  if (mode == 0) {
    if (tid < 128) {
      int ch = tid & 63, d = tid >> 6;
      int first = d == 0 ? 0 : 1, second = 1 - first;
      float A1 = sx[((d * 2 + first) * 64 + ch) * 2], B1 = sx[((d * 2 + first) * 64 + ch) * 2 + 1];
      float A2 = sx[((d * 2 + second) * 64 + ch) * 2], B2 = sx[((d * 2 + second) * 64 + ch) * 2 + 1];
      float2 cr; cr.x = A2 * A1; cr.y = A2 * B1 + B2;
      ((float2*)(p.ws + O_LCAR))[((size_t)cki * 2 + d) * 256 + head * 64 + ch] = cr;
    }
    return;
  }
  {
    const int ch = tid & 63, d = (tid >> 6) & 1, half = tid >> 7;
    float h = ((const float*)(p.ws + O_LHIN))[((size_t)cki * 2 + d) * 256 + head * 64 + ch];
    int first = d == 0 ? 0 : 1;
    if (half != first) h = sx[((d * 2 + first) * 64 + ch) * 2] * h + sx[((d * 2 + first) * 64 + ch) * 2 + 1];
#pragma unroll
    for (int i = 0; i < 16; i++) {
      int tt = d == 0 ? half * 16 + i : half * 16 + 15 - i;
      float a = sa[(d * 32 + tt) * 64 + ch], u = su[(d * 32 + tt) * 64 + ch];
      h = a * h + u;
      su[(d * 32 + tt) * 64 + ch] = h;
    }
  }
  __syncthreads();
  {
    int ch = tid & 63, tq = tid >> 6;
    u16* mixA = (u16*)(p.ws + O_XN);
#pragma unroll
    for (int i = 0; i < 8; i++) {
      int tt = tq * 8 + i, tok = t0 + tt;
      float hsum = su[tt * 64 + ch] + su[(32 + tt) * 64 + ch];
      float gate = bf2f(zA[(size_t)tok * 512 + 256 + head * 64 + ch]);
      mixA[(size_t)tok * 256 + head * 64 + ch] = f2bf(hsum * geluf_(gate));
    }
  }
}
__device__ __forceinline__ void lru_propagate(const Params& p, int idx) {
  int seq = idx >> 9, d = (idx >> 8) & 1, ch = idx & 255;
  int c0, nc;
  if (seq < 8) { c0 = seq * 64; nc = 64; } else { c0 = 512 + (seq - 8) * 128; nc = 128; }
  const float2* car = (const float2*)(p.ws + O_LCAR);
  float* hin = (float*)(p.ws + O_LHIN);
  float h = 0.f;
  for (int i = 0; i < nc; i++) {
    int ck = d == 0 ? c0 + i : c0 + nc - 1 - i;
    size_t o = ((size_t)ck * 2 + d) * 256 + ch;
    hin[o] = h;
    float2 ab = car[o];
    h = ab.x * h + ab.y;
  }
}
__device__ __forceinline__ void s5_propagate(const Params& p, int l, int idx) {
  int pp = idx & 63, d = (idx >> 6) & 1, g = (idx >> 7) & 15, seq = idx >> 11;
  int c0, nc;
  if (seq < 8) { c0 = seq * 32; nc = 32; } else { c0 = 256 + (seq - 8) * 64; nc = 64; }
  const float* ab64 = (const float*)(p.ws + O_AB64) + (size_t)l * 2 * 16 * 64 * 2;
  float ar = ab64[((d * 16 + g) * 64 + pp) * 2], ai = ab64[((d * 16 + g) * 64 + pp) * 2 + 1];
  const float* send = (const float*)(p.ws + O_SEND) + (size_t)g * 1280 * 256;
  u16* uh = (u16*)(p.ws + O_UH) + (size_t)g * 1280 * 1280;
  float hr = 0.f, hi = 0.f;
  for (int i = 0; i < nc; i++) {
    int ck = d == 0 ? c0 + i : c0 + nc - 1 - i;
    *(unsigned*)(uh + (size_t)ck * 1280 + 1024 + d * 128 + pp * 2) = f2bf(hr) | ((unsigned)f2bf(hi) << 16);
    float2 s = *(const float2*)(send + (size_t)ck * 256 + d * 128 + pp * 2);
    float nr = __fmaf_rn(ar, hr, __fmaf_rn(-ai, hi, s.x));
    float ni = __fmaf_rn(ar, hi, __fmaf_rn(ai, hr, s.y));
    asm volatile("" : "+v"(nr));
    asm volatile("" : "+v"(ni));
    hr = nr; hi = ni;
  }
}

#define AST 68
__device__ __forceinline__ void gdn_g1_item(char* smraw, const Params& p, int l, int item) {
  int tid = threadIdx.x; asm volatile("" : "+v"(tid)); const int _tid_pad = 0, lane = tid & 63, w = tid >> 6, fr = lane & 15, fq = lane >> 4;
  const int ck = item >> 2, h = item & 3;
  const int t0 = ck * 64;
  int lo, hi; seq_bounds(t0, lo, hi);
  u16* sk = (u16*)smraw;
  u16* sv = sk + 64 * 72;
  float* Am = (float*)(smraw + 2 * 64 * 72 * 2);
  float* sgc = Am + 2 * 64 * AST;
  float* sbeta = sgc + 128;
  const u16* zC = (const u16*)(p.ws + O_ZC);
  const float* ba = (const float*)(p.ws + O_BA);
  u16* qg = (u16*)(p.ws + O_XN);
  u16* kg = qg + (size_t)T_ALL * 256;
  u16* vg = kg + (size_t)T_ALL * 256;
  __syncthreads();
  {
    const float* cw = p.in[21] + (size_t)l * 4 * 768;
    float wq[4], wk[4], wv[4];
#pragma unroll
    for (int j = 0; j < 4; j++) {
      wq[j] = cw[j * 768 + h * 64 + lane];
      wk[j] = cw[j * 768 + 256 + h * 64 + lane];
      wv[j] = cw[j * 768 + 512 + h * 64 + lane];
    }
    for (int rr = 0; rr < 16; rr++) {
      int c = w * 16 + rr, tok = t0 + c;
      float q = 0.f, k = 0.f, v = 0.f;
#pragma unroll
      for (int j = 0; j < 4; j++) {
        int tk = tok + j - 2;
        if (tk >= lo && tk < hi) {
          const u16* zr = zC + (size_t)tk * 1024 + h * 64 + lane;
          q += wq[j] * bf2f(zr[0]); k += wk[j] * bf2f(zr[256]); v += wv[j] * bf2f(zr[512]);
        }
      }
      q = siluf_(q); k = siluf_(k); v = siluf_(v);
      float sq = wave_sum(q * q), skk = wave_sum(k * k);
      q = q * rsqrtf(sq + EPSF) * 0.125f;
      k = k * rsqrtf(skk + EPSF);
      u16 kb = f2bf(k), vb = f2bf(v);
      sk[c * 72 + lane] = kb; sv[c * 72 + lane] = vb;
      qg[(size_t)tok * 256 + h * 64 + lane] = f2bf(q);
      kg[(size_t)tok * 256 + h * 64 + lane] = kb;
      vg[(size_t)tok * 256 + h * 64 + lane] = vb;
    }
  }
  if (tid < 128) {
    int d = tid >> 6, c = tid & 63;
    int tok = d == 0 ? t0 + c : t0 + 63 - c;
    float alog = p.in[22][(l * 2 + d) * 4 + h], dtb = p.in[23][(l * 2 + d) * 4 + h];
    float g = -expf(alog) * softplusf_(ba[(size_t)tok * 16 + 8 + d * 4 + h] + dtb);
    float beta = 1.f / (1.f + expf(-ba[(size_t)tok * 16 + d * 4 + h]));
    float s = g;
#pragma unroll
    for (int o = 1; o < 64; o <<= 1) { float t = __shfl_up(s, o); if (c >= o) s += t; }
    sgc[d * 64 + c] = s; sbeta[d * 64 + c] = beta;
    ((float*)(p.ws + O_GC))[(size_t)(h * 2 + d) * T_ALL + tok] = s;
  }
  __syncthreads();
  {
    f32x4 acc[4];
#pragma unroll
    for (int nt = 0; nt < 4; nt++) acc[nt] = (f32x4){0, 0, 0, 0};
#pragma unroll
    for (int ks = 0; ks < 2; ks++) {
      bf16x8 af = *(const bf16x8*)(sk + (16 * w + fr) * 72 + ks * 32 + fq * 8);
#pragma unroll
      for (int nt = 0; nt < 4; nt++) {
        bf16x8 bfm = *(const bf16x8*)(sk + (16 * nt + fr) * 72 + ks * 32 + fq * 8);
        acc[nt] = __builtin_amdgcn_mfma_f32_16x16x32_bf16(af, bfm, acc[nt], 0, 0, 0);
      }
    }
#pragma unroll
    for (int nt = 0; nt < 4; nt++)
#pragma unroll
      for (int e = 0; e < 4; e++) {
        int c = 16 * w + 4 * fq + e, m = 16 * nt + fr;
        float gm = acc[nt][e];
        float a0 = c > m ? sbeta[c] * gm * expf(sgc[c] - sgc[m]) : 0.f;
        Am[m * AST + c] = a0;
        int c1 = 63 - c, m1 = 63 - m;
        float a1 = c1 > m1 ? sbeta[64 + c1] * gm * expf(sgc[64 + c1] - sgc[64 + m1]) : 0.f;
        Am[64 * AST + m1 * AST + c1] = a1;
      }
  }
  __syncthreads();
  {
    const int d = tid >> 7, col = tid & 127;
    const float* AT = Am + d * 64 * AST;
    const u16* src = col < 64 ? sk : sv;
    const int e = col & 63;
    u16* wu = (u16*)(p.ws + O_WU) + ((size_t)(ck * 4 + h) * 2 + d) * 8192 + (col < 64 ? 0 : 4096);
#pragma unroll 1
    for (int b = 0; b < 4; b++) {
      float s[16];
#pragma unroll
      for (int r = 0; r < 16; r++) {
        int i = 16 * b + r;
        int tokr = d == 0 ? i : 63 - i;
        float rv = bf2f(src[tokr * 72 + e]) * sbeta[d * 64 + i];
        if (col < 64) rv *= expf(sgc[d * 64 + i]);
        s[r] = rv;
      }
#pragma unroll 2
      for (int j = 0; j < 16 * b; j++) {
        float xj = bf2f(wu[j * 64 + e]);
        const float4* ar = (const float4*)(AT + j * AST + 16 * b);
        float4 a0 = ar[0], a1 = ar[1], a2 = ar[2], a3 = ar[3];
        s[0] -= a0.x * xj; s[1] -= a0.y * xj; s[2] -= a0.z * xj; s[3] -= a0.w * xj;
        s[4] -= a1.x * xj; s[5] -= a1.y * xj; s[6] -= a1.z * xj; s[7] -= a1.w * xj;
        s[8] -= a2.x * xj; s[9] -= a2.y * xj; s[10] -= a2.z * xj; s[11] -= a2.w * xj;
        s[12] -= a3.x * xj; s[13] -= a3.y * xj; s[14] -= a3.z * xj; s[15] -= a3.w * xj;
      }
#pragma unroll
      for (int rp = 0; rp < 16; rp++) {
        u16 xb = f2bf(s[rp]);
        float xj = bf2f(xb);
        wu[(16 * b + rp) * 64 + e] = xb;
#pragma unroll
        for (int r = rp + 1; r < 16; r++) s[r] -= AT[(16 * b + rp) * AST + 16 * b + r] * xj;
      }
    }
  }
}

__device__ __forceinline__ void gdn_chain(char* smraw, const Params& p, int chain) {
  int tid = threadIdx.x; asm volatile("" : "+v"(tid)); const int _tid_pad = 0, lane = tid & 63, w = tid >> 6, fr = lane & 15, fq = lane >> 4;
  const int d = chain & 1, h = (chain >> 1) & 3, seq = chain >> 3;
  int c0, nc;
  if (seq < 8) { c0 = seq * 32; nc = 32; } else { c0 = 256 + (seq - 8) * 64; nc = 64; }
  u16* qs = (u16*)smraw;
  u16* qd = qs + 64 * 72;
  u16* ks_ = qd + 64 * 72;
  u16* kdT = ks_ + 64 * 72;
  u16* at = kdT + 64 * 72;
  u16* ST = at + 64 * 72;
  u16* VT = ST + 4 * 16 * 72;
  float* sgc = (float*)(VT + 4 * 16 * 72);
  const u16* qg = (const u16*)(p.ws + O_XN);
  const u16* kg = qg + (size_t)T_ALL * 256;
  const float* gcg = (const float*)(p.ws + O_GC);
  u16* og = (u16*)(p.ws + O_OD) + (size_t)d * T_ALL * 256;
  u16* STw = ST + w * 16 * 72;
  u16* VTw = VT + w * 16 * 72;
  f32x4 accS[4];
#pragma unroll
  for (int mt = 0; mt < 4; mt++) accS[mt] = (f32x4){0, 0, 0, 0};
  __syncthreads();
  for (int e = lane; e < 16 * 72; e += 64) STw[e] = 0;
  for (int it = 0; it < nc; it++) {
    const int ck = d == 0 ? c0 + it : c0 + nc - 1 - it;
    const int t0 = ck * 64;
    const u16* wch = (const u16*)(p.ws + O_WU) + ((size_t)(ck * 4 + h) * 2 + d) * 8192;
    const u16* uch = wch + 4096;
    const int tok_last = d == 0 ? t0 + 63 : t0;
    const float gl = gcg[(size_t)(h * 2 + d) * T_ALL + tok_last];
    {
      int row = tid >> 2, seg = tid & 3;
      int tok = d == 0 ? t0 + row : t0 + 63 - row;
      float gcv = gcg[(size_t)(h * 2 + d) * T_ALL + tok];
      if (seg == 0) sgc[row] = gcv;
      float eq = expf(gcv), ek = expf(gl - gcv);
      const u16* qr = qg + (size_t)tok * 256 + h * 64 + seg * 16;
      const u16* kr = kg + (size_t)tok * 256 + h * 64 + seg * 16;
      uint4 q0 = *(const uint4*)qr, q1 = *(const uint4*)(qr + 8);
      uint4 k0 = *(const uint4*)kr, k1 = *(const uint4*)(kr + 8);
      *(uint4*)(qs + row * 72 + seg * 16) = q0; *(uint4*)(qs + row * 72 + seg * 16 + 8) = q1;
      *(uint4*)(ks_ + row * 72 + seg * 16) = k0; *(uint4*)(ks_ + row * 72 + seg * 16 + 8) = k1;
      unsigned qa[8] = {q0.x, q0.y, q0.z, q0.w, q1.x, q1.y, q1.z, q1.w};
      unsigned ka[8] = {k0.x, k0.y, k0.z, k0.w, k1.x, k1.y, k1.z, k1.w};
#pragma unroll
      for (int i = 0; i < 8; i++) {
        float qa0 = bf2f((u16)(qa[i] & 0xffff)) * eq, qa1 = bf2f((u16)(qa[i] >> 16)) * eq;
        *(unsigned*)(qd + row * 72 + seg * 16 + 2 * i) = f2bf(qa0) | ((unsigned)f2bf(qa1) << 16);
        float kb0 = bf2f((u16)(ka[i] & 0xffff)) * ek, kb1 = bf2f((u16)(ka[i] >> 16)) * ek;
        kdT[(seg * 16 + 2 * i) * 72 + row] = f2bf(kb0);
        kdT[(seg * 16 + 2 * i + 1) * 72 + row] = f2bf(kb1);
      }
    }
    __syncthreads();
    {
      f32x4 acc[4];
#pragma unroll
      for (int nt = 0; nt < 4; nt++) acc[nt] = (f32x4){0, 0, 0, 0};
#pragma unroll
      for (int ks = 0; ks < 2; ks++) {
        bf16x8 af = *(const bf16x8*)(qs + (16 * w + fr) * 72 + ks * 32 + fq * 8);
#pragma unroll
        for (int nt = 0; nt < 4; nt++) {
          bf16x8 bfm = *(const bf16x8*)(ks_ + (16 * nt + fr) * 72 + ks * 32 + fq * 8);
          acc[nt] = __builtin_amdgcn_mfma_f32_16x16x32_bf16(af, bfm, acc[nt], 0, 0, 0);
        }
      }
#pragma unroll
      for (int nt = 0; nt < 4; nt++)
#pragma unroll
        for (int e = 0; e < 4; e++) {
          int c = 16 * w + 4 * fq + e, m = 16 * nt + fr;
          float v = c >= m ? acc[nt][e] * expf(sgc[c] - sgc[m]) : 0.f;
          at[c * 72 + m] = f2bf(v);
        }
    }
    __syncthreads();
    {
      const int e0 = 16 * w;
      f32x4 av[4];
#pragma unroll
      for (int mt = 0; mt < 4; mt++) av[mt] = (f32x4){0, 0, 0, 0};
#pragma unroll
      for (int ks = 0; ks < 2; ks++) {
        bf16x8 bS = *(const bf16x8*)(STw + fr * 72 + ks * 32 + fq * 8);
#pragma unroll
        for (int mt = 0; mt < 4; mt++) {
          bf16x8 aw = *(const bf16x8*)(wch + (16 * mt + fr) * 64 + ks * 32 + fq * 8);
          av[mt] = __builtin_amdgcn_mfma_f32_16x16x32_bf16(aw, bS, av[mt], 0, 0, 0);
        }
      }
#pragma unroll
      for (int mt = 0; mt < 4; mt++) {
        u16 hv[4];
#pragma unroll
        for (int e = 0; e < 4; e++) {
          int c = 16 * mt + 4 * fq + e;
          float vn = bf2f(uch[c * 64 + e0 + fr]) - av[mt][e];
          hv[e] = f2bf(vn);
        }
        uint2 pk; pk.x = hv[0] | ((unsigned)hv[1] << 16); pk.y = hv[2] | ((unsigned)hv[3] << 16);
        *(uint2*)(VTw + fr * 72 + 16 * mt + 4 * fq) = pk;
      }
      __builtin_amdgcn_wave_barrier();
      f32x4 ao[4];
#pragma unroll
      for (int mt = 0; mt < 4; mt++) ao[mt] = (f32x4){0, 0, 0, 0};
#pragma unroll
      for (int ks = 0; ks < 2; ks++) {
        bf16x8 bS = *(const bf16x8*)(STw + fr * 72 + ks * 32 + fq * 8);
        bf16x8 bV = *(const bf16x8*)(VTw + fr * 72 + ks * 32 + fq * 8);
#pragma unroll
        for (int mt = 0; mt < 4; mt++) {
          bf16x8 aq = *(const bf16x8*)(qd + (16 * mt + fr) * 72 + ks * 32 + fq * 8);
          bf16x8 aa = *(const bf16x8*)(at + (16 * mt + fr) * 72 + ks * 32 + fq * 8);
          ao[mt] = __builtin_amdgcn_mfma_f32_16x16x32_bf16(aq, bS, ao[mt], 0, 0, 0);
          ao[mt] = __builtin_amdgcn_mfma_f32_16x16x32_bf16(aa, bV, ao[mt], 0, 0, 0);
        }
      }
#pragma unroll
      for (int mt = 0; mt < 4; mt++)
#pragma unroll
        for (int e = 0; e < 4; e++) {
          int c = 16 * mt + 4 * fq + e;
          int tok = d == 0 ? t0 + c : t0 + 63 - c;
          og[(size_t)tok * 256 + h * 64 + e0 + fr] = f2bf(ao[mt][e]);
        }
      float egl = expf(gl);
#pragma unroll
      for (int mt = 0; mt < 4; mt++) accS[mt] = accS[mt] * egl;
#pragma unroll
      for (int ks = 0; ks < 2; ks++) {
        bf16x8 bV = *(const bf16x8*)(VTw + fr * 72 + ks * 32 + fq * 8);
#pragma unroll
        for (int mt = 0; mt < 4; mt++) {
          bf16x8 ak = *(const bf16x8*)(kdT + (16 * mt + fr) * 72 + ks * 32 + fq * 8);
          accS[mt] = __builtin_amdgcn_mfma_f32_16x16x32_bf16(ak, bV, accS[mt], 0, 0, 0);
        }
      }
      __builtin_amdgcn_wave_barrier();
#pragma unroll
      for (int mt = 0; mt < 4; mt++) {
        uint2 pk;
        pk.x = f2bf(accS[mt][0]) | ((unsigned)f2bf(accS[mt][1]) << 16);
        pk.y = f2bf(accS[mt][2]) | ((unsigned)f2bf(accS[mt][3]) << 16);
        *(uint2*)(STw + fr * 72 + 16 * mt + 4 * fq) = pk;
      }
    }
    __syncthreads();
  }
}
__device__ __forceinline__ void gdn_final_rows(const Params& p, int l, int rowblk) {
  int tid_ = threadIdx.x; asm volatile("" : "+v"(tid_));
  const int lane = tid_ & 63, w = tid_ >> 6;
  int tok = rowblk * 4 + w;
  const u16* o0 = (const u16*)(p.ws + O_OD) + (size_t)tok * 256 + lane * 4;
  const u16* o1 = o0 + (size_t)T_ALL * 256;
  const u16* zg = (const u16*)(p.ws + O_ZC) + (size_t)tok * 1024 + 768 + lane * 4;
  uint2 a = *(const uint2*)o0, b = *(const uint2*)o1, g = *(const uint2*)zg;
  float o[4], gt[4];
  o[0] = bf2f(a.x & 0xffff) + bf2f(b.x & 0xffff); o[1] = bf2f(a.x >> 16) + bf2f(b.x >> 16);
  o[2] = bf2f(a.y & 0xffff) + bf2f(b.y & 0xffff); o[3] = bf2f(a.y >> 16) + bf2f(b.y >> 16);
  gt[0] = bf2f(g.x & 0xffff); gt[1] = bf2f(g.x >> 16); gt[2] = bf2f(g.y & 0xffff); gt[3] = bf2f(g.y >> 16);
  float ss = o[0] * o[0] + o[1] * o[1] + o[2] * o[2] + o[3] * o[3];
#pragma unroll
  for (int m = 8; m > 0; m >>= 1) ss += __shfl_xor(ss, m);
  float rs = rsqrtf(ss * (1.f / 64.f) + EPSF);
  if (!(MIXMASK & 4)) rs = 0.f;
  const float* nw = p.in[24] + l * 64 + (lane & 15) * 4;
  u16 r[4];
#pragma unroll
  for (int e = 0; e < 4; e++) r[e] = f2bf(o[e] * rs * nw[e] * siluf_(gt[e]));
  uint2 pk; pk.x = r[0] | ((unsigned)r[1] << 16); pk.y = r[2] | ((unsigned)r[3] << 16);
  *(uint2*)((u16*)(p.ws + O_XN) + (size_t)2 * T_ALL * 256 + (size_t)tok * 256 + lane * 4) = pk;
}
__device__ __forceinline__ void grpnorm_rows(const Params& p, int l, int which, int rowblk) {
  int tid_ = threadIdx.x; asm volatile("" : "+v"(tid_));
  const int lane = tid_ & 63, w = tid_ >> 6;
  int tok = rowblk * 4 + w;
  u16* m = (u16*)(p.ws + O_XN) + (size_t)which * T_ALL * 256 + (size_t)tok * 256 + lane * 4;
  uint2 a = *(const uint2*)m;
  float v[4] = {bf2f(a.x & 0xffff), bf2f(a.x >> 16), bf2f(a.y & 0xffff), bf2f(a.y >> 16)};
  float ss = wave_sum(v[0] * v[0] + v[1] * v[1] + v[2] * v[2] + v[3] * v[3]);
  float rs = rsqrtf(ss * (1.f / 256.f) + EPSF);
  if (!((MIXMASK >> which) & 1)) rs = 0.f;
  const float* gn = p.in[34] + (l * 3 + which) * 256 + lane * 4;
  uint2 pk;
  pk.x = f2bf(v[0] * rs * gn[0]) | ((unsigned)f2bf(v[1] * rs * gn[1]) << 16);
  pk.y = f2bf(v[2] * rs * gn[2]) | ((unsigned)f2bf(v[3] * rs * gn[3]) << 16);
  *(uint2*)m = pk;
}

#define WST 1296
#define UST 264
__device__ __forceinline__ float hy_conv3(const u16* __restrict__ raw, int t, int L, float w0, float w1, float w2, float b) {
  float xm = t > 0 ? bf2f(raw[t - 1]) : 0.f;
  float x0 = bf2f(raw[t]);
  float xp = t + 1 < L ? bf2f(raw[t + 1]) : 0.f;
  return w0 * xm + w1 * x0 + w2 * xp + b;
}
__device__ __forceinline__ void hy_conv_item(char* smraw, const Params& p, int l, int stage, int set, int c, int tb) {
  int tid = threadIdx.x; asm volatile("" : "+v"(tid)); const int _tid_pad = 0, lane = tid & 63, w = tid >> 6, fr = lane & 15, fq = lane >> 4;
  const int L = 2048 << set, nb = 8 << set, base = set ? T_P : 0;
  const int T0 = tb * 1024;
  u16* win = (u16*)smraw;
  u16* su = win + 8 * WST;
  float* sinv = (float*)(su + 16 * UST);
  const u16* dt = (const u16*)(p.ws + O_DT);
  const u16* rawv = dt + (size_t)c * T_ALL + base;
  const u16* rawx = dt + (size_t)((stage + 1) * 256 + c) * T_ALL + base;
  const u16* y1 = (const u16*)(p.ws + O_Y1) + (size_t)c * T_ALL + base;
  u16* outp = stage == 0 ? (u16*)(p.ws + O_Y1) + (size_t)c * T_ALL + base
                         : (u16*)(p.ws + O_DT) + (size_t)(256 + c) * T_ALL + base;
  const u16* kr = (const u16*)(p.ws + O_HYKR) + (set ? HYKR1 : 0) + ((size_t)stage * 256 + c) * (2 * L);
  const float* cw = p.in[25] + (size_t)l * 3 * 768;
  const float* cb = p.in[26] + (size_t)l * 768;
  const float v0 = cw[c], v1 = cw[768 + c], v2 = cw[1536 + c], vb = cb[c];
  const int xc_ = (stage + 1) * 256 + c;
  const float x0w = cw[xc_], x1w = cw[768 + xc_], x2w = cw[1536 + xc_], xbw = cb[xc_];
  __syncthreads();
  if (tid < 64) {
    const float* ps = (const float*)(p.ws + O_HYPS) + (size_t)(set ? 32 * 512 : 0);
    int ntb = L / 64;
    float s = 0.f;
    for (int i = lane; i < ntb; i += 64) s += ps[(size_t)i * 512 + stage * 256 + c];
    s = wave_sum(s);
    if (lane == 0) sinv[0] = 1.f / s;
  }
  f32x4 acc[16];
#pragma unroll
  for (int i = 0; i < 16; i++) acc[i] = (f32x4){0, 0, 0, 0};
  for (int S0 = 0; S0 < L; S0 += 256) {
    __syncthreads();
    const int B0 = S0 - T0;
    for (int idx = tid; idx < 8 * 160; idx += 256) {
      int rho = idx / 160, gi = idx % 160;
      int ybase = B0 - 1016 + 8 * gi - rho + L;
      u16 hh[8];
#pragma unroll
      for (int e = 0; e < 8; e++) { int yy = ybase + e; hh[e] = (yy >= 0 && yy < 2 * L) ? kr[yy] : (u16)0; }
      uint4 pk;
      pk.x = hh[0] | ((unsigned)hh[1] << 16); pk.y = hh[2] | ((unsigned)hh[3] << 16);
      pk.z = hh[4] | ((unsigned)hh[5] << 16); pk.w = hh[6] | ((unsigned)hh[7] << 16);
      *(uint4*)(win + rho * WST + 8 * gi) = pk;
    }
    {
      int b = tid >> 4, seg = tid & 15;
      u16 hh[16];
      if (b < nb) {
        const u16* src = (stage == 0 ? rawv : y1) + (size_t)b * L;
#pragma unroll
        for (int e = 0; e < 16; e++) {
          int s = S0 + seg * 16 + e;
          hh[e] = stage == 0 ? f2bf(hy_conv3(src, s, L, v0, v1, v2, vb)) : src[s];
        }
      } else {
#pragma unroll
        for (int e = 0; e < 16; e++) hh[e] = 0;
      }
      uint4 p0, p1;
      p0.x = hh[0] | ((unsigned)hh[1] << 16); p0.y = hh[2] | ((unsigned)hh[3] << 16);
      p0.z = hh[4] | ((unsigned)hh[5] << 16); p0.w = hh[6] | ((unsigned)hh[7] << 16);
      p1.x = hh[8] | ((unsigned)hh[9] << 16); p1.y = hh[10] | ((unsigned)hh[11] << 16);
      p1.z = hh[12] | ((unsigned)hh[13] << 16); p1.w = hh[14] | ((unsigned)hh[15] << 16);
      *(uint4*)(su + b * UST + seg * 16) = p0;
      *(uint4*)(su + b * UST + seg * 16 + 8) = p1;
    }
    __syncthreads();
    bf16x8 bfr[8];
#pragma unroll
    for (int j = 0; j < 8; j++) bfr[j] = *(const bf16x8*)(su + fr * UST + 32 * j + 8 * fq);
    const u16* wbase = win + (fr & 7) * WST + (8 * fq - 256 * w - 8 * (fr >> 3) + 1016);
#pragma unroll
    for (int dd = 0; dd < 30; dd++) {
      bf16x8 af = *(const bf16x8*)(wbase + 16 * (dd - 15));
#pragma unroll
      for (int j = 0; j < 8; j++) {
        const int i = 2 * j - (dd - 15);
        if (i >= 0 && i < 16) acc[i] = __builtin_amdgcn_mfma_f32_16x16x32_bf16(af, bfr[j], acc[i], 0, 0, 0);
      }
    }
  }
  __syncthreads();
  const float inv = sinv[0];
  const float bias = p.in[33][(size_t)(l * 2 + stage) * 256 + c];
  if (fr < nb) {
#pragma unroll
    for (int i = 0; i < 16; i++) {
      u16 r[4];
#pragma unroll
      for (int e = 0; e < 4; e++) {
        int t = T0 + 256 * w + 16 * i + 4 * fq + e;
        float uval = stage == 0 ? hy_conv3(rawv + (size_t)fr * L, t, L, v0, v1, v2, vb) : bf2f(y1[(size_t)fr * L + t]);
        float xg = hy_conv3(rawx + (size_t)fr * L, t, L, x0w, x1w, x2w, xbw);
        r[e] = f2bf(xg * (acc[i][e] * inv + bias * uval));
      }
      uint2 pk; pk.x = r[0] | ((unsigned)r[1] << 16); pk.y = r[2] | ((unsigned)r[3] << 16);
      *(uint2*)(outp + (size_t)fr * L + T0 + 256 * w + 16 * i + 4 * fq) = pk;
    }
  }
}
__device__ __forceinline__ void hy_final_item(char* smraw, const Params& p, int l, int ck) {
  int tid = threadIdx.x; asm volatile("" : "+v"(tid)); const int _tid_pad = 0, lane = tid & 63, w = tid >> 6;
  float* s = (float*)smraw;
  const u16* yd = (const u16*)(p.ws + O_DT) + (size_t)256 * T_ALL;
  const int t0 = ck * 64;
  __syncthreads();
  for (int i = 0; i < 64; i++) {
    int c = w * 64 + i;
    s[lane * 257 + c] = bf2f(yd[(size_t)c * T_ALL + t0 + lane]);
  }
  __syncthreads();
  const float* gn = p.in[34] + (l * 3 + 2) * 256;
  u16* mixD = (u16*)(p.ws + O_XN) + (size_t)3 * T_ALL * 256;
  for (int i = 0; i < 16; i++) {
    int tt = w * 16 + i;
    float v[4];
#pragma unroll
    for (int e = 0; e < 4; e++) v[e] = s[tt * 257 + lane * 4 + e];
    float ss = wave_sum(v[0] * v[0] + v[1] * v[1] + v[2] * v[2] + v[3] * v[3]);
    float rs = rsqrtf(ss * (1.f / 256.f) + EPSF);
    if (!(MIXMASK & 8)) rs = 0.f;
    uint2 pk;
    pk.x = f2bf(v[0] * rs * gn[lane * 4]) | ((unsigned)f2bf(v[1] * rs * gn[lane * 4 + 1]) << 16);
    pk.y = f2bf(v[2] * rs * gn[lane * 4 + 2]) | ((unsigned)f2bf(v[3] * rs * gn[lane * 4 + 3]) << 16);
    *(uint2*)(mixD + (size_t)(t0 + tt) * 256 + lane * 4) = pk;
  }
}

#define GRID_SYNC() do {                                                                                   \
    __builtin_amdgcn_fence(__ATOMIC_RELEASE, "agent");                                                     \
    asm volatile("s_waitcnt vmcnt(0) lgkmcnt(0)" ::: "memory");                                            \
    __syncthreads();                                                                                       \
    bar_target += (unsigned)nblk;                                                                          \
    if (threadIdx.x == 0) {                                                                                \
      __hip_atomic_fetch_add(bar_ctr, 1u, __ATOMIC_RELAXED, __HIP_MEMORY_SCOPE_AGENT);                     \
      while (__hip_atomic_load(bar_ctr, __ATOMIC_RELAXED, __HIP_MEMORY_SCOPE_AGENT) < bar_target)          \
        __builtin_amdgcn_s_sleep(2);                                                                       \
    }                                                                                                      \
    __syncthreads();                                                                                       \
    __builtin_amdgcn_fence(__ATOMIC_ACQUIRE, "agent");                                                     \
    asm volatile("s_waitcnt vmcnt(0)" ::: "memory");                                                       \
  } while (0)

__global__ void __launch_bounds__(256, 2) mega(Params p) {
  cg::grid_group grid = cg::this_grid();
  __shared__ __attribute__((aligned(16))) char smraw[SMEM_BYTES];
  u16* smem = (u16*)smraw;
  float* smf = (float*)smraw;
  const int bid = blockIdx.x, nblk = gridDim.x, tid = threadIdx.x;
  const int rbid = nblk - 1 - bid;
  const int lane = tid & 63;
  char* const ws = p.ws;
  unsigned* const bar_ctr = (unsigned*)(ws + O_BAR);
  unsigned bar_target = 0;
  grid.sync();

#ifdef NANFILL
  {
    uint4 nanv = make_uint4(0x7FC07FC0u, 0x7FC07FC0u, 0x7FC07FC0u, 0x7FC07FC0u);
    uint4* w4 = (uint4*)ws;
    for (size_t i = (size_t)bid * 256 + tid; i < WS_TOTAL / 16; i += (size_t)nblk * 256) w4[i] = nanv;
    uint4* o4 = (uint4*)p.out;
    for (size_t i = (size_t)bid * 256 + tid; i < (size_t)T_ALL * DM / 4; i += (size_t)nblk * 256) o4[i] = nanv;
    __threadfence(); grid.sync(); __threadfence();
  }
#endif
#pragma unroll 1
  for (int lay = 0; lay < 2; lay++) {
    {
      int l = lay; asm volatile("" : "+s"(l));
#pragma unroll 1
      for (int i = bid; i < 42 * 16; i += nblk) transpose_tile(smf, p.in[3] + (size_t)l * 1024 * 2576, 2576, p.in[2] + l * 1024, (u16*)(ws + O_WIN), 1024, 0, (i / 16) * 64, (i % 16) * 64);
#pragma unroll 1
      for (int i = rbid; i < 16 * 16; i += nblk) transpose_tile(smf, p.in[35] + (size_t)l * 1024 * 1024, 1024, nullptr, (u16*)(ws + O_WOUT), 1024, 1, (i / 16) * 64, (i % 16) * 64);
#pragma unroll 1
      for (int i = bid; i < 88 * 16; i += nblk) transpose_tile(smf, p.in[37] + (size_t)l * 1024 * 5632, 5632, p.in[36] + l * 1024, (u16*)(ws + O_WUP), 1024, 2, (i / 16) * 64, (i % 16) * 64);
#pragma unroll 1
      for (int i = rbid; i < 16 * 44; i += nblk) transpose_tile(smf, p.in[40] + (size_t)l * 2816 * 1024, 1024, nullptr, (u16*)(ws + O_WDN), 2816, 3, (i / 44) * 64, (i % 44) * 64);
#pragma unroll 1
      for (int i = bid; i < 16; i += nblk) transpose_tile(smf, p.in[19] + (size_t)l * 256 * 256, 256, nullptr, (u16*)(ws + O_WGLU), 256, 4, (i / 4) * 64, (i % 4) * 64);
#pragma unroll 1
      for (int i = rbid; i < 64; i += nblk) {
        u16* wl = (u16*)(ws + O_WLRU);
        for (int e = i * 1024 + tid; e < (i + 1) * 1024; e += 256) {
          int k = e & 63, n = (e >> 6) & 255, head = e >> 14;
          int d = n >> 7, gate = (n >> 6) & 1, j = n & 63;
          const float* wr_ = p.in[6]; const float* wi_ = p.in[8];
          size_t off_ = ((size_t)((l * 2 + d) * 4 + head) * 64 + k) * 64 + j;
          float vr_ = wr_[off_], vi_ = wi_[off_];
          wl[e] = f2bf(gate ? vi_ : vr_);
        }
      }
#pragma unroll 1
      for (int i = bid; i < 16 * 2 * 65; i += nblk) s5_prep_item(smf, p, l, i);
#pragma unroll 1
      for (int i = rbid; i < 16 * 2 * 64; i += nblk) s5_bts_item(p, l, i);
#pragma unroll 1
      for (int i = rbid; i < 96; i += nblk) hy_filter_item(smf, p, l, i < 32 ? 0 : 1, i < 32 ? i : i - 32);
#pragma unroll 1
      for (int i = bid; i < T_ALL / 4; i += nblk) rms_rows_to_bf16(p, l, i);
    }
    GRID_SYNC();
    {
      int l = lay; asm volatile("" : "+s"(l));
#pragma unroll 1
      for (int it = bid; it < 640 * 21; it += nblk) {
        const int mt = it / 21, nt = it % 21;
        { const float* H = gemm_tile(smem, (const u16*)(ws + O_XN), 1024, mt * 128, 0, T_ALL, 1024, 0, (const u16*)(ws + O_WIN) + (size_t)nt * 128 * 1024, 1024, 1024);
            const int tok0 = mt * 128;
            if (nt < 4) {
              u16* zA = (u16*)(ws + O_ZA) + (size_t)tok0 * 512 + nt * 128;
              EPI_ROWS(H, { *(uint2*)(zA + (size_t)r * 512 + c) = pack4(v.x, v.y, v.z, v.w); })
            } else if (nt < 6) {
              u16* uh = (u16*)(ws + O_UH);
              EPI_ROWS(H, {
                int tok = tok0 + r, ch = (nt - 4) * 128 + c;
                *(uint2*)(uh + ((size_t)(ch >> 4) * 1280 + (tok >> 6)) * 1280 + (tok & 63) * 16 + (ch & 15)) = pack4(v.x, v.y, v.z, v.w); })
            } else if (nt < 14) {
              u16* zC = (u16*)(ws + O_ZC) + (size_t)tok0 * 1024 + (nt - 6) * 128;
              EPI_ROWS(H, { *(uint2*)(zC + (size_t)r * 1024 + c) = pack4(v.x, v.y, v.z, v.w); })
            } else if (nt < 20) {
              u16* dt = (u16*)(ws + O_DT) + (size_t)((nt - 14) * 128 + (tid & 127)) * T_ALL + tok0 + (tid >> 7) * 64;
              const float* Hc = H + (tid >> 7) * 64 * HST + (tid & 127);
#pragma unroll 2
              for (int k = 0; k < 8; k++) {
                uint2 a = pack4(Hc[(8 * k) * HST], Hc[(8 * k + 1) * HST], Hc[(8 * k + 2) * HST], Hc[(8 * k + 3) * HST]);
                uint2 b = pack4(Hc[(8 * k + 4) * HST], Hc[(8 * k + 5) * HST], Hc[(8 * k + 6) * HST], Hc[(8 * k + 7) * HST]);
                uint4 pk; pk.x = a.x; pk.y = a.y; pk.z = b.x; pk.w = b.y;
                *(uint4*)(dt + 8 * k) = pk;
              }
            } else {
              float* ba = (float*)(ws + O_BA) + (size_t)tok0 * 16;
#pragma unroll 2
              for (int k = 0; k < 8; k++) { int idx = tid + 256 * k; ba[idx] = H[(idx >> 4) * HST + (idx & 15)]; }
            }
          }
      }
#pragma unroll 1
      for (int it = rbid; it < 16 * 1024; it += nblk) s5_expand_item(p, l, it);
    }
    GRID_SYNC();
    {
      int l = lay; asm volatile("" : "+s"(l));
#pragma unroll 1
      for (int it = bid; it < NCH64 * 4; it += nblk) gdn_g1_item(smraw, p, l, it);
#pragma unroll 1
      for (int it = rbid; it < 16 * 10 * 2; it += nblk) {
        const int g = it / 20, mt = (it % 20) >> 1, nt = it & 1;
        { const float* H = gemm_tile(smem, (const u16*)(ws + O_UH) + (size_t)g * 1280 * 1280, 1280, mt * 128, 0, 1280, 1024, 0,
                  (const u16*)(ws + O_BTS) + (size_t)g * 256 * 1024 + (size_t)nt * 128 * 1024, 1024, 1024);
            float* send = (float*)(ws + O_SEND) + (size_t)g * 1280 * 256 + (size_t)mt * 128 * 256 + nt * 128;
            EPI_ROWS(H, { *(float4*)(send + (size_t)r * 256 + c) = v; })
          }
      }
#pragma unroll 1
      for (int it = bid; it < NCH32 * 4; it += nblk) lru_item(smraw, p, l, it, 0);
    }
    GRID_SYNC();
    {
      int l = lay; asm volatile("" : "+s"(l));
#pragma unroll 1
      for (int it = bid; it < 192; it += nblk) gdn_chain(smraw, p, it);
#pragma unroll 1
      for (int it = rbid; it < 48; it += nblk) lru_propagate(p, it * 256 + tid);
#pragma unroll 1
      for (int it = rbid - 48; it < 192; it += nblk) { if (it >= 0) s5_propagate(p, l, it * 256 + tid); }
#pragma unroll 1
      for (int it = rbid; it < 1536; it += nblk) {
        if (it < 1024) hy_conv_item(smraw, p, l, 0, 1, it >> 2, it & 3);
        else hy_conv_item(smraw, p, l, 0, 0, (it - 1024) >> 1, it & 1);
      }
    }
    GRID_SYNC();
    {
      int l = lay; asm volatile("" : "+s"(l));
#pragma unroll 1
      for (int it = bid; it < 1536; it += nblk) {
        if (it < 1024) hy_conv_item(smraw, p, l, 1, 1, it >> 2, it & 3);
        else hy_conv_item(smraw, p, l, 1, 0, (it - 1024) >> 1, it & 1);
      }
#pragma unroll 1
      for (int it = rbid; it < 16 * 10 * 8; it += nblk) {
        const int g = it / 80, mt = (it % 80) >> 3, nt = it & 7;
        { const float* H = gemm_tile(smem, (const u16*)(ws + O_UH) + (size_t)g * 1280 * 1280, 1280, mt * 128, 0, 1280, 1280, 0,
                  (const u16*)(ws + O_BTY) + (size_t)g * 1024 * 1280 + (size_t)nt * 128 * 1280, 1280, 1280);
            u16* zb = (u16*)(ws + O_XN) + (size_t)3 * T_ALL * 256;
            EPI_ROWS(H, {
              int ck = mt * 128 + r, n = nt * 128 + c;
              *(uint2*)(zb + ((size_t)g * T_ALL + ck * 64 + (n >> 4)) * 16 + (n & 15)) = pack4(geluf_(v.x), geluf_(v.y), geluf_(v.z), geluf_(v.w)); })
          }
      }
#pragma unroll 1
      for (int it = bid; it < NCH32 * 4; it += nblk) lru_item(smraw, p, l, it, 1);
#pragma unroll 1
      for (int it = rbid; it < T_ALL / 4; it += nblk) gdn_final_rows(p, l, it);
    }
    GRID_SYNC();
    {
      int l = lay; asm volatile("" : "+s"(l));
#pragma unroll 1
      for (int it = bid; it < 640 * 2; it += nblk) {
        const int mt = it >> 1, nt = it & 1;
        const u16* zb = (const u16*)(ws + O_XN) + (size_t)3 * T_ALL * 256;
        { const float* H = gemm_tile(smem, zb, 16, mt * 128, 0, T_ALL, 16, (size_t)T_ALL * 16, (const u16*)(ws + O_WGLU) + (size_t)nt * 128 * 256, 256, 256);
            u16* mixB = (u16*)(ws + O_XN) + (size_t)T_ALL * 256 + (size_t)mt * 128 * 256 + nt * 128;
            const u16* zr = zb + (size_t)mt * 128 * 16;
            const float* gb = p.in[20] + l * 256 + nt * 128;
            EPI_ROWS(H, {
              uint2 zz = *(const uint2*)(zr + ((size_t)((nt * 128 + c) >> 4) * T_ALL + r) * 16 + (c & 15));
              float4 g4 = *(const float4*)(gb + c);
              float z0 = bf2f(zz.x & 0xffff), z1 = bf2f(zz.x >> 16), z2 = bf2f(zz.y & 0xffff), z3 = bf2f(zz.y >> 16);
              *(uint2*)(mixB + (size_t)r * 256 + c) = pack4(z0 * sigmoidf_(v.x + g4.x), z1 * sigmoidf_(v.y + g4.y), z2 * sigmoidf_(v.z + g4.z), z3 * sigmoidf_(v.w + g4.w)); })
          }
      }
#pragma unroll 1
      for (int it = rbid; it < T_ALL / 4; it += nblk) grpnorm_rows(p, l, 0, it);
    }
    GRID_SYNC();
    {
      int l = lay; asm volatile("" : "+s"(l));
#pragma unroll 1
      for (int it = bid; it < NCH64; it += nblk) hy_final_item(smraw, p, l, it);
#pragma unroll 1
      for (int it = rbid; it < T_ALL / 4; it += nblk) grpnorm_rows(p, l, 1, it);
    }
    GRID_SYNC();
    {
      int l = lay; asm volatile("" : "+s"(l));
#pragma unroll 1
      for (int it = bid; it < 640 * 8; it += nblk) {
        const int mt = it >> 3, nt = it & 7;
        { const float* H = gemm_tile(smem, (const u16*)(ws + O_XN), 256, mt * 128, 0, T_ALL, 256, (size_t)T_ALL * 256,
                  (const u16*)(ws + O_WOUT) + (size_t)nt * 128 * 1024, 1024, 1024);
            float* o = p.out + (size_t)mt * 128 * DM + nt * 128;
            EPI_ROWS(H, {
              float4 b4 = *(const float4*)(xrow(p, l, mt * 128 + r) + nt * 128 + c);
              float4 o4; o4.x = b4.x + v.x; o4.y = b4.y + v.y; o4.z = b4.z + v.z; o4.w = b4.w + v.w;
              *(float4*)(o + (size_t)r * DM + c) = o4; })
          }
      }
    }
    GRID_SYNC();
    {
      int l = lay; asm volatile("" : "+s"(l));
#pragma unroll 1
      for (int it = bid; it < T_ALL / 4; it += nblk) rms_rows_to_bf16(p, 1, it);
    }
    GRID_SYNC();
    {
      int l = lay; asm volatile("" : "+s"(l));
      const int nM = 8 * 17 + 16 * 33;
#pragma unroll 1
      for (int it = bid; it < nM * 44; it += nblk) {
        const int mi = it / 44, nt = it % 44;
        int seq, ti, L;
        if (mi < 136) { seq = mi / 17; ti = mi % 17; L = 2048; }
        else { seq = 8 + (mi - 136) / 33; ti = (mi - 136) % 33; L = 4096; }
        const int s0 = seq < 8 ? seq * 2048 : T_P + (seq - 8) * 4096;
        const int arow0 = s0 + 126 * ti - 1;
        const int nvalid = min(126, L - 126 * ti);
        { const float* H = gemm_tile(smem, (const u16*)(ws + O_XN), 1024, arow0, s0, s0 + L, 1024, 0, (const u16*)(ws + O_WUP) + (size_t)nt * 128 * 1024, 1024, 1024);
            const int j = tid & 63, rg = tid >> 6;
            const float* cw = p.in[38] + (size_t)l * 3 * 5632;
            const float* cb = p.in[39] + (size_t)l * 5632;
            const int cg_ = nt * 64 + j, cv_ = DFF + nt * 64 + j;
            const float g0 = cw[cg_], g1 = cw[5632 + cg_], g2 = cw[2 * 5632 + cg_], gb = cb[cg_];
            const float u0 = cw[cv_], u1 = cw[5632 + cv_], u2 = cw[2 * 5632 + cv_], ub = cb[cv_];
            u16* hm = (u16*)(ws + O_HMID) + (size_t)arow0 * DFF + nt * 64 + j;
#pragma unroll 2
            for (int r = 1 + rg; r <= nvalid; r += 4) {
              float gate = g0 * H[(r - 1) * HST + j] + g1 * H[r * HST + j] + g2 * H[(r + 1) * HST + j] + gb;
              float val = u0 * H[(r - 1) * HST + 64 + j] + u1 * H[r * HST + 64 + j] + u2 * H[(r + 1) * HST + 64 + j] + ub;
              hm[(size_t)r * DFF] = f2bf(siluf_(gate) * val);
            }
          }
      }
    }
    GRID_SYNC();
    {
      int l = lay; asm volatile("" : "+s"(l));
#pragma unroll 1
      for (int it = bid; it < 640 * 8; it += nblk) {
        const int mt = it >> 3, nt = it & 7;
        { const float* H = gemm_tile(smem, (const u16*)(ws + O_HMID), DFF, mt * 128, 0, T_ALL, DFF, 0, (const u16*)(ws + O_WDN) + (size_t)nt * 128 * DFF, DFF, DFF);
            float* o = p.out + (size_t)mt * 128 * DM + nt * 128;
            EPI_ROWS(H, {
              float4 b4 = *(const float4*)(o + (size_t)r * DM + c);
              b4.x += v.x; b4.y += v.y; b4.z += v.z; b4.w += v.w;
              *(float4*)(o + (size_t)r * DM + c) = b4; })
          }
      }
    }
    GRID_SYNC();
  }
  {
    const int w = tid >> 6;
    const float* fn = p.in[41];
#pragma unroll 1
    for (int it = bid; it < T_ALL / 4; it += nblk) {
      int tok = it * 4 + w;
      float* x = p.out + (size_t)tok * DM;
      float4 v[4];
      float ss = 0.f;
#pragma unroll
      for (int i = 0; i < 4; i++) {
        v[i] = *(const float4*)(x + i * 256 + lane * 4);
        ss += v[i].x * v[i].x + v[i].y * v[i].y + v[i].z * v[i].z + v[i].w * v[i].w;
      }
      ss = wave_sum(ss);
      float rs = rsqrtf(ss * (1.f / 1024.f) + EPSF);
#pragma unroll
      for (int i = 0; i < 4; i++) {
        float4 g = *(const float4*)(fn + i * 256 + lane * 4);
        float4 o; o.x = v[i].x * rs * g.x; o.y = v[i].y * rs * g.y; o.z = v[i].z * rs * g.z; o.w = v[i].w * rs * g.w;
        *(float4*)(x + i * 256 + lane * 4) = o;
      }
    }
  }
}

extern "C" void kernel_launch(void* const* d_in, const int* in_sizes, int n_in,
                              void* d_out, int out_size, void* d_ws, size_t ws_size,
                              hipStream_t stream) {
  static int grid_blocks = 0;
  if (!grid_blocks) {
    int dev = 0, cus = 0, per_cu = 0;
    (void)hipGetDevice(&dev);
    (void)hipDeviceGetAttribute(&cus, hipDeviceAttributeMultiprocessorCount, dev);
    (void)hipOccupancyMaxActiveBlocksPerMultiprocessor(&per_cu, mega, 256, 0);
    if (per_cu > 2) per_cu = 2;
    if (per_cu < 1) per_cu = 1;
    grid_blocks = cus * per_cu;
  }
  if (ws_size < WS_TOTAL) fprintf(stderr, "workspace too small: %zu < %zu\n", ws_size, (size_t)WS_TOTAL);
  Params p{};
  for (int i = 0; i < 42; i++) p.in[i] = (const float*)d_in[i];
  p.out = (float*)d_out;
  p.ws = (char*)d_ws;
  (void)hipMemsetAsync((char*)d_ws + O_BAR, 0, 256, stream);
  void* args[] = {&p};
  hipError_t e = hipLaunchCooperativeKernel((void*)mega, dim3(grid_blocks), dim3(256), args, 0, stream);
  if (e != hipSuccess) fprintf(stderr, "coop launch failed: %s (grid %d)\n", hipGetErrorString(e), grid_blocks);
}
```

```cpp
#include <hip/hip_runtime.h>
#include <hip/hip_bf16.h>
#include <hip/hip_cooperative_groups.h>
#include <cstdio>
namespace cg = cooperative_groups;

typedef unsigned short u16;
using bf16x8 = __attribute__((ext_vector_type(8))) short;
using f32x4 = __attribute__((ext_vector_type(4))) float;

#define T_ALL 81920
#define T_P 16384
#define DM 1024
#define NZ 2688
#define DFF 2816
#define NCH32 2560
#define NCH64 1280
#define EPSF 1e-6f

constexpr size_t al(size_t x) { return (x + 255) & ~(size_t)255; }
constexpr size_t O_WIN = 0;
constexpr size_t O_WOUT = O_WIN + al((size_t)NZ * 1024 * 2);
constexpr size_t O_WUP = O_WOUT + al((size_t)1024 * 1024 * 2);
constexpr size_t O_WDN = O_WUP + al((size_t)5632 * 1024 * 2);
constexpr size_t O_WLRU = O_WDN + al((size_t)1024 * 2816 * 2);
constexpr size_t O_WGLU = O_WLRU + al((size_t)4 * 256 * 64 * 2);
constexpr size_t O_AB64 = O_WGLU + al((size_t)256 * 256 * 2);
constexpr size_t O_KTAB = O_AB64 + 2 * al((size_t)2 * 16 * 64 * 2 * 4);
constexpr size_t O_BTY = O_KTAB + al((size_t)16 * 2 * 64 * 256 * 4);
constexpr size_t O_BTS = O_BTY + al((size_t)16 * 1024 * 1280 * 2);
constexpr size_t O_HYKR = O_BTS + al((size_t)16 * 256 * 1024 * 2);
constexpr size_t HYKR1 = (size_t)2 * 256 * 4096;
constexpr size_t O_HYPS = O_HYKR + al((size_t)2 * 256 * (4096 + 8192) * 2);
constexpr size_t O_XN = O_HYPS + al((size_t)(32 + 64) * 512 * 4);
constexpr size_t O_ZA = O_XN + al((size_t)T_ALL * 1024 * 2);
constexpr size_t O_UH = O_ZA + al((size_t)T_ALL * 512 * 2);
constexpr size_t O_ZC = O_UH + al((size_t)16 * 1280 * 1280 * 2);
constexpr size_t O_BA = O_ZC + al((size_t)T_ALL * 1024 * 2);
constexpr size_t O_DT = O_BA + al((size_t)T_ALL * 16 * 4);
constexpr size_t O_WU = O_DT + al((size_t)768 * T_ALL * 2);
constexpr size_t O_GC = O_WU + al((size_t)NCH64 * 4 * 2 * 2 * 4096 * 2);
constexpr size_t O_OD = O_GC + al((size_t)T_ALL * 8 * 4);
constexpr size_t O_Y1 = O_OD + al((size_t)2 * T_ALL * 256 * 2);
constexpr size_t O_SEND = O_Y1 + al((size_t)256 * T_ALL * 2);
constexpr size_t O_LCAR = O_SEND + al((size_t)16 * 1280 * 256 * 4);
constexpr size_t O_LHIN = O_LCAR + al((size_t)NCH32 * 512 * 8);
constexpr size_t O_BAR = O_LHIN + al((size_t)NCH32 * 512 * 4);
constexpr size_t WS_TOTAL = O_BAR + 256;
static_assert(WS_TOTAL <= (size_t)1073741824, "ws");
constexpr size_t O_HMID = O_ZA;
static_assert(O_HMID + (size_t)T_ALL * DFF * 2 <= O_GC, "hmid alias");

struct Params {
  const float* in[42];
  float* out;
  char* ws;
};

#define SMEM_BYTES 73728
#ifndef MIXMASK
#define MIXMASK 15
#endif

__device__ __forceinline__ u16 f2bf(float f) {
  unsigned u = __float_as_uint(f);
  u += 0x7fffu + ((u >> 16) & 1u);
  return (u16)(u >> 16);
}
__device__ __forceinline__ float bf2f(u16 h) { return __uint_as_float(((unsigned)h) << 16); }
__device__ __forceinline__ float sigmoidf_(float x) { return 1.f / (1.f + __expf(-x)); }
__device__ __forceinline__ float siluf_(float x) { return x / (1.f + __expf(-x)); }
__device__ __forceinline__ float softplusf_(float x) { return x > 20.f ? x : log1pf(expf(x)); }
__device__ __forceinline__ float geluf_(float x) {
  float t = tanhf(0.7978845608028654f * (x + 0.044715f * x * x * x));
  return 0.5f * x * (1.f + t);
}
__device__ __forceinline__ float wave_sum(float v) {
#pragma unroll
  for (int o = 32; o > 0; o >>= 1) v += __shfl_xor(v, o);
  return v;
}
__device__ __forceinline__ const float* xrow(const Params& p, int l, int tok) {
  const float* a = p.in[0]; const float* b = p.in[1]; const float* o = p.out;
  const float* r0 = a + (size_t)tok * DM;
  const float* r1 = b + (size_t)(tok - T_P) * DM;
  const float* r2 = o + (size_t)tok * DM;
  return l == 0 ? (tok < T_P ? r0 : r1) : r2;
}
__device__ __forceinline__ void seq_bounds(int tok, int& lo, int& hi) {
  if (tok < T_P) { lo = tok & ~2047; hi = lo + 2048; }
  else { lo = T_P + ((tok - T_P) & ~4095); hi = lo + 4096; }
}

#define GST 72
#define HST 132
__device__ __forceinline__ const float* gemm_tile(u16* smem, const u16* __restrict__ A, long lda, int arow0, int alo, int ahi,
                                          int segShift, size_t segStride,
                                          const u16* __restrict__ Bt, long ldb, int K) {
  u16* sA = smem;
  u16* sB = smem + 2 * 128 * GST;
  int tid = threadIdx.x; asm volatile("" : "+v"(tid)); const int _tid_pad = 0, lane = tid & 63, w = tid >> 6;
  const int wm = w >> 1, wn = w & 1, fr = lane & 15, fq = lane >> 4;
  const int cc = tid & 7, r0 = tid >> 3;
  f32x4 acc[4][4];
#pragma unroll
  for (int i = 0; i < 4; i++)
#pragma unroll
    for (int j = 0; j < 4; j++) acc[i][j] = (f32x4){0.f, 0.f, 0.f, 0.f};
  uint4 ra0x, ra1x, ra2x, ra3x, rb0x, rb1x, rb2x, rb3x, ra0y, ra1y, ra2y, ra3y, rb0y, rb1y, rb2y, rb3y;
  const int nk = K >> 6;
#define GROW(i_, AP, BP, OK) const bool OK = (arow0 + r0 + 32 * i_) >= alo && (arow0 + r0 + 32 * i_) < ahi;        \
    const u16* AP = A + (long)(OK ? (arow0 + r0 + 32 * i_) : alo) * lda;                                             \
    const u16* BP = Bt + (long)(r0 + 32 * i_) * ldb + cc * 8;
  GROW(0, ap0, bp0, ok0) GROW(1, ap1, bp1, ok1) GROW(2, ap2, bp2, ok2) GROW(3, ap3, bp3, ok3)
#define GLOAD1(AP, BP, OK, RA, RB) {                                                \
      uint4 t_ = *(const uint4*)(AP + aoff_);                                         \
      RA = OK ? t_ : make_uint4(0, 0, 0, 0);                                          \
      RB = *(const uint4*)(BP + k0_); }
#define GLOAD(kt_, S) do {                                                         \
    const int k0_ = (kt_) << 6;                                                       \
    const int kk_ = k0_ + cc * 8;                                                     \
    const int sg_ = kk_ >> segShift;                                                  \
    const size_t aoff_ = (size_t)sg_ * segStride + (kk_ - (sg_ << segShift));         \
    GLOAD1(ap0, bp0, ok0, ra0##S, rb0##S) GLOAD1(ap1, bp1, ok1, ra1##S, rb1##S)       \
    GLOAD1(ap2, bp2, ok2, ra2##S, rb2##S) GLOAD1(ap3, bp3, ok3, ra3##S, rb3##S)       \
    } while (0)
#define SWRITE1(buf_, i_, RA, RB) {                                                 \
      *(uint4*)(sA + (buf_) * 128 * GST + (r0 + 32 * i_) * GST + cc * 8) = RA;        \
      *(uint4*)(sB + (buf_) * 128 * GST + (r0 + 32 * i_) * GST + cc * 8) = RB; }
#define SWRITE(buf_, S) do {                                                        \
    SWRITE1(buf_, 0, ra0##S, rb0##S) SWRITE1(buf_, 1, ra1##S, rb1##S) SWRITE1(buf_, 2, ra2##S, rb2##S) SWRITE1(buf_, 3, ra3##S, rb3##S) \
    } while (0)
#define GCOMPUTE(buf_) do {                                                         \
    const u16* a = sA + (buf_) * 128 * GST;                                           \
    const u16* b = sB + (buf_) * 128 * GST;                                           \
    _Pragma("unroll") for (int ks = 0; ks < 2; ks++) {                                \
      bf16x8 af[4], bfr[4];                                                           \
      _Pragma("unroll") for (int i = 0; i < 4; i++) {                                 \
        af[i] = *(const bf16x8*)(a + (64 * wm + 16 * i + fr) * GST + ks * 32 + fq * 8);   \
        bfr[i] = *(const bf16x8*)(b + (64 * wn + 16 * i + fr) * GST + ks * 32 + fq * 8);  \
      }                                                                               \
      _Pragma("unroll") for (int i = 0; i < 4; i++)                                   \
      _Pragma("unroll") for (int j = 0; j < 4; j++)                                   \
        acc[i][j] = __builtin_amdgcn_mfma_f32_16x16x32_bf16(af[i], bfr[j], acc[i][j], 0, 0, 0); \
    } } while (0)
#define LDS_BARRIER() asm volatile("s_waitcnt lgkmcnt(0)\n\ts_barrier" ::: "memory")
  __syncthreads();
  GLOAD(0, x);
  SWRITE(0, x);
  if (nk > 1) GLOAD(1, y);
  LDS_BARRIER();
#pragma unroll 1
  for (int kt = 0; kt < nk; kt += 2) {
    if (kt + 2 < nk) GLOAD(kt + 2, x);
    GCOMPUTE(0);
    if (kt + 1 < nk) SWRITE(1, y);
    LDS_BARRIER();
    if (kt + 1 >= nk) break;
    if (kt + 3 < nk) GLOAD(kt + 3, y);
    GCOMPUTE(1);
    if (kt + 2 < nk) SWRITE(0, x);
    LDS_BARRIER();
  }
  float* H = (float*)smem;
#pragma unroll
  for (int i = 0; i < 4; i++)
#pragma unroll
    for (int j = 0; j < 4; j++)
#pragma unroll
      for (int e = 0; e < 4; e++) H[(64 * wm + 16 * i + 4 * fq + e) * HST + 64 * wn + 16 * j + fr] = acc[i][j][e];
  __syncthreads();
  return H;
}
__device__ __forceinline__ uint2 pack4(float a, float b, float c, float d) {
  uint2 pk; pk.x = f2bf(a) | ((unsigned)f2bf(b) << 16); pk.y = f2bf(c) | ((unsigned)f2bf(d) << 16); return pk;
}
#define EPI_ROWS(H, BODY...)                                                     \
  _Pragma("unroll 2") for (int _it = 0; _it < 16; _it++) {                       \
    const int r = (tid_o >> 5) + 8 * _it, c = (tid_o & 31) * 4;      \
    const float4 v = *(const float4*)((H) + r * HST + c); BODY }

__device__ __forceinline__ int colmap(int mode, int n) {
  if (mode == 0) {
    if (n < 1792) return n;
    if (n < 2560) return n + 16;
    if (n < 2576) return 1792 + (n - 2560);
    return -1;
  }
  if (mode == 2) { int nt = n >> 7, c = n & 127; return c < 64 ? nt * 64 + c : DFF + nt * 64 + (c - 64); }
  return n;
}
__device__ __forceinline__ void transpose_tile(float* sm, const float* __restrict__ src, int ldsrc, const float* __restrict__ gain,
                               u16* __restrict__ dst, int K, int mode, int n0, int k0) {
  int tid = threadIdx.x; asm volatile("" : "+v"(tid)); const int _tid_pad = 0;
  __syncthreads();
  {
    int nn = tid & 63;
    int sc = colmap(mode, n0 + nn);
#pragma unroll
    for (int i = 0; i < 16; i++) {
      int kk = (tid >> 6) + 4 * i;
      float v = 0.f;
      if (sc >= 0) { v = src[(size_t)(k0 + kk) * ldsrc + sc]; if (gain) v *= gain[k0 + kk]; }
      sm[kk * 65 + nn] = v;
    }
  }
  __syncthreads();
  {
    int c = tid & 7;
#pragma unroll
    for (int i = 0; i < 2; i++) {
      int nn = (tid >> 3) + 32 * i;
      u16 h[8];
#pragma unroll
      for (int e = 0; e < 8; e++) h[e] = f2bf(sm[(c * 8 + e) * 65 + nn]);
      uint4 pk;
      pk.x = h[0] | ((unsigned)h[1] << 16); pk.y = h[2] | ((unsigned)h[3] << 16);
      pk.z = h[4] | ((unsigned)h[5] << 16); pk.w = h[6] | ((unsigned)h[7] << 16);
      *(uint4*)(dst + (size_t)(n0 + nn) * K + k0 + c * 8) = pk;
    }
  }
}

__device__ __forceinline__ void s5_prep_item(float* sm, const Params& p, int l, int item) {
  int tid = threadIdx.x; asm volatile("" : "+v"(tid)); const int _tid_pad = 0;
  const int m = item % 65, d = (item / 65) & 1, g = item / 130;
  float* s_abm = sm;
  float* s_q = sm + 128;
  const int ldg = (l * 2 + d) * 16 + g;
  __syncthreads();
  if (tid < 64) {
    int pi = ldg * 64 + tid;
    float dt = expf(p.in[13][ldg]);
    float are = p.in[11][pi], aim = p.in[12][pi];
    float mag = expf(dt * are), ang = dt * aim;
    float abr = mag * cosf(ang), abi = mag * sinf(ang);
    float den = are * are + aim * aim;
    float nre = abr - 1.f;
    s_q[tid * 2] = (nre * are + abi * aim) / den;
    s_q[tid * 2 + 1] = (abi * are - nre * aim) / den;
    float mm = expf((float)m * dt * are), am = (float)m * ang;
    float pr = mm * cosf(am), pim = mm * sinf(am);
    s_abm[tid * 2] = pr; s_abm[tid * 2 + 1] = pim;
    if (m == 64) {
      float* ab64 = (float*)(p.ws + O_AB64) + (size_t)l * 2 * 16 * 64 * 2;
      ab64[((d * 16 + g) * 64 + tid) * 2] = pr;
      ab64[((d * 16 + g) * 64 + tid) * 2 + 1] = pim;
    }
  }
  __syncthreads();
  const float* bre = p.in[14] + (size_t)ldg * 64 * 16;
  const float* bim = p.in[15] + (size_t)ldg * 64 * 16;
  const float* cre = p.in[16] + (size_t)ldg * 16 * 64;
  const float* cim = p.in[17] + (size_t)ldg * 16 * 64;
  u16* bty = (u16*)(p.ws + O_BTY) + (size_t)g * 1024 * 1280;
  u16* bts = (u16*)(p.ws + O_BTS) + (size_t)g * 256 * 1024;
  if (m <= 63) {
    int ho = tid >> 4, hi = tid & 15;
    float acc = 0.f;
    for (int pp = 0; pp < 64; pp++) {
      float cr = cre[ho * 64 + pp], ci = cim[ho * 64 + pp];
      float ar = s_abm[pp * 2], ai = s_abm[pp * 2 + 1];
      float t1r = cr * ar - ci * ai, t1i = cr * ai + ci * ar;
      float qr = s_q[pp * 2], qi = s_q[pp * 2 + 1];
      float br = bre[pp * 16 + hi], bi = bim[pp * 16 + hi];
      float bbr = qr * br - qi * bi, bbi = qr * bi + qi * br;
      acc += t1r * bbr - t1i * bbi;
    }
    float* kt = (float*)(p.ws + O_KTAB);
    kt[((size_t)((g * 2 + d) * 64 + m)) * 256 + ho * 16 + hi] = acc;
  }
  if (m >= 1) {
    int t = d == 0 ? m - 1 : 64 - m;
    for (int e = tid; e < 1024; e += 256) {
      int ho = e >> 6, pp = e & 63;
      float cr = cre[ho * 64 + pp], ci = cim[ho * 64 + pp];
      float ar = s_abm[pp * 2], ai = s_abm[pp * 2 + 1];
      float xr = cr * ar - ci * ai, xi = cr * ai + ci * ar;
      size_t o = (size_t)(t * 16 + ho) * 1280 + 1024 + d * 128 + pp * 2;
      bty[o] = f2bf(xr);
      bty[o + 1] = f2bf(-xi);
    }
  }
}
__device__ __forceinline__ void s5_bts_item(const Params& p, int l, int item) {
  int tid = threadIdx.x; asm volatile("" : "+v"(tid));
  const int pp = item & 63, d = (item >> 6) & 1, g = item >> 7;
  const int sp = tid >> 2, hq = tid & 3;
  const int ldg = (l * 2 + d) * 16 + g;
  const int pi = ldg * 64 + pp;
  float dt = expf(p.in[13][ldg]);
  float are = p.in[11][pi], aim = p.in[12][pi];
  float mag = expf(dt * are), ang = dt * aim;
  float abr = mag * cosf(ang), abi = mag * sinf(ang);
  float den = are * are + aim * aim;
  float nre = abr - 1.f;
  float qr = (nre * are + abi * aim) / den, qi = (abi * are - nre * aim) / den;
  const int f = d == 0 ? 63 - sp : sp;
  float mm = expf((float)f * dt * are), am = (float)f * ang;
  float ar = mm * cosf(am), ai = mm * sinf(am);
  const float* bre = p.in[14] + (size_t)ldg * 64 * 16 + pp * 16 + hq * 4;
  const float* bim = p.in[15] + (size_t)ldg * 64 * 16 + pp * 16 + hq * 4;
  float fr_[4], fi_[4];
#pragma unroll
  for (int e = 0; e < 4; e++) {
    float br = bre[e], bi = bim[e];
    float bbr = qr * br - qi * bi, bbi = qr * bi + qi * br;
    fr_[e] = ar * bbr - ai * bbi; fi_[e] = ar * bbi + ai * bbr;
  }
  u16* bts = (u16*)(p.ws + O_BTS) + (size_t)g * 256 * 1024 + (size_t)(d * 128 + pp * 2) * 1024 + sp * 16 + hq * 4;
  *(uint2*)bts = pack4(fr_[0], fr_[1], fr_[2], fr_[3]);
  *(uint2*)(bts + 1024) = pack4(fi_[0], fi_[1], fi_[2], fi_[3]);
}
__device__ __forceinline__ void s5_expand_item(const Params& p, int l, int item) {
  int tid = threadIdx.x; asm volatile("" : "+v"(tid)); const int _tid_pad = 0;
  int g = item >> 10, n = item & 1023, t = n >> 4, ho = n & 15;
  int sp = tid >> 2, hi0 = (tid & 3) * 4;
  const float* kt = (const float*)(p.ws + O_KTAB);
  float v[4] = {0.f, 0.f, 0.f, 0.f};
  if (t >= sp) {
    const float* k0 = kt + ((size_t)((g * 2 + 0) * 64 + (t - sp))) * 256 + ho * 16 + hi0;
#pragma unroll
    for (int e = 0; e < 4; e++) v[e] += k0[e];
  }
  if (sp >= t) {
    const float* k1 = kt + ((size_t)((g * 2 + 1) * 64 + (sp - t))) * 256 + ho * 16 + hi0;
#pragma unroll
    for (int e = 0; e < 4; e++) v[e] += k1[e];
  }
  if (t == sp && ho >= hi0 && ho < hi0 + 4) v[ho - hi0] += p.in[18][l * 256 + g * 16 + ho];
  u16* bty = (u16*)(p.ws + O_BTY) + (size_t)g * 1024 * 1280 + (size_t)n * 1280 + sp * 16 + hi0;
  uint2 pk;
  pk.x = f2bf(v[0]) | ((unsigned)f2bf(v[1]) << 16);
  pk.y = f2bf(v[2]) | ((unsigned)f2bf(v[3]) << 16);
  *(uint2*)bty = pk;
}

__device__ __forceinline__ void hy_filter_item(float* sm, const Params& p, int l, int set, int tb) {
  int tid = threadIdx.x; asm volatile("" : "+v"(tid));
  const int L = 2048 << set;
  float* sz = sm;
  float* h1 = sm + 65 * 33;
  float* h2 = h1 + 65 * 64;
  const float* w1 = p.in[27] + (size_t)l * 33 * 64;
  const float* b1 = p.in[28] + l * 64;
  const float* fq_ = p.in[29] + l * 64;
  const float* w2 = p.in[30] + (size_t)l * 64 * 64;
  const float* b2 = p.in[31] + l * 64;
  const float* w3 = p.in[32] + (size_t)l * 64 * 1024;
  __syncthreads();
  for (int e = tid; e < 65 * 33; e += 256) {
    int tt = e / 33, i = e % 33;
    int t = tb * 64 + tt;
    float val;
    if (i == 0) val = (float)t / (float)(L - 1);
    else {
      int b = (i - 1) & 15;
      float f = 1e-4f + (float)b * ((15.f - 1e-4f) / 15.f);
      float wang = 6.283185307179586f * (float)t / (float)L;
      val = i <= 16 ? cosf(f * wang) : -sinf(f * wang);
    }
    sz[e] = val;
  }
  __syncthreads();
  {
    int j = tid & 63;
    float fj = fq_[j], bj = b1[j];
#pragma unroll 1
    for (int i = 0; i < 17; i++) {
      int tt = (tid >> 6) + 4 * i;
      if (tt < 65) {
        float a = bj;
        for (int k = 0; k < 33; k++) a += sz[tt * 33 + k] * w1[k * 64 + j];
        h1[tt * 64 + j] = sinf(fj * a);
      }
    }
  }
  __syncthreads();
  {
    int j = tid & 63;
    float fj = fq_[j], bj = b2[j];
#pragma unroll 1
    for (int i = 0; i < 17; i++) {
      int tt = (tid >> 6) + 4 * i;
      if (tt < 65) {
        float a = bj;
        for (int k = 0; k < 64; k++) a += h1[tt * 64 + k] * w2[k * 64 + j];
        h2[tt * 64 + j] = sinf(fj * a);
      }
    }
  }
  __syncthreads();
  const int c = tid;
  const float mind = -3.0701134573253943f, maxd = -15.350567286626972f;
  float delta = fabsf(mind + (float)c * ((maxd - mind) / 255.f));
  u16* kr = (u16*)(p.ws + O_HYKR) + (set ? HYKR1 : 0);
  float* ps = (float*)(p.ws + O_HYPS) + (size_t)(set ? 32 * 512 : 0) + (size_t)tb * 512;
#pragma unroll 1
  for (int order = 0; order < 2; order++) {
    u16* krc = kr + ((size_t)order * 256 + c) * (2 * L);
    float asum = 0.f, v00 = 0.f;
#pragma unroll 1
    for (int dir = 0; dir < 2; dir++) {
      float wc[64];
#pragma unroll
      for (int k = 0; k < 64; k++) wc[k] = w3[k * 1024 + order * 512 + dir * 256 + c];
      float hold = 0.f;
      const int ntt = dir == 0 ? 65 : 64;
#pragma unroll 1
      for (int tt = 0; tt < ntt; tt++) {
        float a = 0.f;
#pragma unroll
        for (int k = 0; k < 64; k++) a += h2[tt * 64 + k] * wc[k];
        int t = tb * 64 + tt;
        float tl = (float)t / (float)(L - 1);
        a *= expf(-tl * delta);
        if (t >= L) a = 0.f;
        if (tt < 64) asum += fabsf(a);
        if (dir == 0) {
          if (tt == 0) { if (tb == 0) v00 = a; }
          else if (tt & 1) hold = a;
          else *(unsigned*)(krc + (L - t)) = f2bf(a) | ((unsigned)f2bf(hold) << 16);
        } else {
          if (!(tt & 1)) hold = (t == 0) ? v00 + a : a;
          else *(unsigned*)(krc + (L + t - 1)) = f2bf(hold) | ((unsigned)f2bf(a) << 16);
        }
      }
    }
    ps[order * 256 + c] = asum;
  }
}

__device__ __forceinline__ void rms_rows_to_bf16(const Params& p, int l, int rowblk) {
  int tid_ = threadIdx.x; asm volatile("" : "+v"(tid_));
  const int lane = tid_ & 63, w = tid_ >> 6;
  int tok = rowblk * 4 + w;
  const float* x = xrow(p, l, tok);
  float4 v[4];
  float ss = 0.f;
#pragma unroll
  for (int i = 0; i < 4; i++) {
    v[i] = *(const float4*)(x + i * 256 + lane * 4);
    ss += v[i].x * v[i].x + v[i].y * v[i].y + v[i].z * v[i].z + v[i].w * v[i].w;
  }
  ss = wave_sum(ss);
  float rs = rsqrtf(ss * (1.f / 1024.f) + EPSF);
  u16* xn = (u16*)(p.ws + O_XN) + (size_t)tok * 1024;
#pragma unroll
  for (int i = 0; i < 4; i++) {
    uint2 pk;
    pk.x = f2bf(v[i].x * rs) | ((unsigned)f2bf(v[i].y * rs) << 16);
    pk.y = f2bf(v[i].z * rs) | ((unsigned)f2bf(v[i].w * rs) << 16);
    *(uint2*)(xn + i * 256 + lane * 4) = pk;
  }
}

__device__ __forceinline__ void lru_item(char* smraw, const Params& p, int l, int item, int mode) {
  int tid = threadIdx.x; asm volatile("" : "+v"(tid)); const int _tid_pad = 0, lane = tid & 63, w = tid >> 6, fr = lane & 15, fq = lane >> 4;
  const int cki = item >> 2, head = item & 3;
  const int t0 = cki * 32;
  int lo, hi; seq_bounds(t0, lo, hi);
  float* xc = (float*)smraw;
  u16* xcb = (u16*)(smraw + 8192);
  float* sa = (float*)(smraw + 8192 + 4608);
  float* su = sa + 2 * 32 * 64;
  float* sx = su + 2 * 32 * 64;
  const u16* zA = (const u16*)(p.ws + O_ZA);
  __syncthreads();
  {
    int ch = tid & 63, tq = tid >> 6;
    int gch = head * 64 + ch;
    const float* cw = p.in[4] + l * 4 * 256;
    float w0 = cw[gch], w1 = cw[256 + gch], w2 = cw[512 + gch], w3 = cw[768 + gch];
    float cb = p.in[5][l * 256 + gch];
    float win[11];
#pragma unroll
    for (int i = 0; i < 11; i++) {
      int tok = t0 + tq * 8 + i - 2;
      win[i] = (tok >= lo && tok < hi) ? bf2f(zA[(size_t)tok * 512 + gch]) : 0.f;
    }
#pragma unroll
    for (int i = 0; i < 8; i++) {
      float v = w0 * win[i] + w1 * win[i + 1] + w2 * win[i + 2] + w3 * win[i + 3] + cb;
      int tt = tq * 8 + i;
      xc[tt * 64 + ch] = v;
      xcb[tt * 72 + ch] = f2bf(v);
    }
  }
  __syncthreads();
  {
    const int d = w >> 1, half = w & 1;
    const u16* wl = (const u16*)(p.ws + O_WLRU) + (size_t)head * 256 * 64;
    f32x4 accr[2][2], acci[2][2];
#pragma unroll
    for (int a = 0; a < 2; a++)
#pragma unroll
      for (int b = 0; b < 2; b++) { accr[a][b] = (f32x4){0, 0, 0, 0}; acci[a][b] = (f32x4){0, 0, 0, 0}; }
#pragma unroll
    for (int ks = 0; ks < 2; ks++) {
      bf16x8 af[2], br[2], bi[2];
#pragma unroll
      for (int mt = 0; mt < 2; mt++) af[mt] = *(const bf16x8*)(xcb + (16 * mt + fr) * 72 + ks * 32 + fq * 8);
#pragma unroll
      for (int nt = 0; nt < 2; nt++) {
        int nr = d * 128 + 32 * half + 16 * nt + fr;
        br[nt] = *(const bf16x8*)(wl + (size_t)nr * 64 + ks * 32 + fq * 8);
        bi[nt] = *(const bf16x8*)(wl + (size_t)(nr + 64) * 64 + ks * 32 + fq * 8);
      }
#pragma unroll
      for (int mt = 0; mt < 2; mt++)
#pragma unroll
        for (int nt = 0; nt < 2; nt++) {
          accr[mt][nt] = __builtin_amdgcn_mfma_f32_16x16x32_bf16(af[mt], br[nt], accr[mt][nt], 0, 0, 0);
          acci[mt][nt] = __builtin_amdgcn_mfma_f32_16x16x32_bf16(af[mt], bi[nt], acci[mt][nt], 0, 0, 0);
        }
    }
#pragma unroll
    for (int nt = 0; nt < 2; nt++) {
      int ch = 32 * half + 16 * nt + fr;
      int gch = head * 64 + ch;
      float brr = p.in[7][(l * 2 + d) * 256 + gch], bii = p.in[9][(l * 2 + d) * 256 + gch];
      float sp = softplusf_(-p.in[10][(l * 2 + d) * 256 + gch]);
#pragma unroll
      for (int mt = 0; mt < 2; mt++)
#pragma unroll
        for (int e = 0; e < 4; e++) {
          int tt = 16 * mt + 4 * fq + e;
          float r = 1.f / (1.f + expf(-(accr[mt][nt][e] + brr)));
          float ig = 1.f / (1.f + expf(-(acci[mt][nt][e] + bii)));
          float la = -8.f * r * sp;
          float a = expf(la);
          float u = sqrtf(-expm1f(2.f * la)) * (ig * xc[tt * 64 + ch]);
          sa[(d * 32 + tt) * 64 + ch] = a;
          su[(d * 32 + tt) * 64 + ch] = u;
        }
    }
  }
  __syncthreads();
  {
    const int ch = tid & 63, d = (tid >> 6) & 1, half = tid >> 7;
    float A = 1.f, B = 0.f;
#pragma unroll
    for (int i = 0; i < 16; i++) {
      int tt = d == 0 ? half * 16 + i : half * 16 + 15 - i;
      float a = sa[(d * 32 + tt) * 64 + ch], u = su[(d * 32 + tt) * 64 + ch];
      A = a * A; B = a * B + u;
    }
    sx[((d * 2 + half) * 64 + ch) * 2] = A;
    sx[((d * 2 + half) * 64 + ch) * 2 + 1] = B;
  }
  __syncthreads();
  if (mode == 0) {
    if (tid < 128) {
      int ch = tid & 63, d = tid >> 6;
      int first = d == 0 ? 0 : 1, second = 1 - first;
      float A1 = sx[((d * 2 + first) * 64 + ch) * 2], B1 = sx[((d * 2 + first) * 64 + ch) * 2 + 1];
      float A2 = sx[((d * 2 + second) * 64 + ch) * 2], B2 = sx[((d * 2 + second) * 64 + ch) * 2 + 1];
      float2 cr; cr.x = A2 * A1; cr.y = A2 * B1 + B2;
      ((float2*)(p.ws + O_LCAR))[((size_t)cki * 2 + d) * 256 + head * 64 + ch] = cr;
    }
    return;
  }
  {
    const int ch = tid & 63, d = (tid >> 6) & 1, half = tid >> 7;
    float h = ((const float*)(p.ws + O_LHIN))[((size_t)cki * 2 + d) * 256 + head * 64 + ch];
    int first = d == 0 ? 0 : 1;
    if (half != first) h = sx[((d * 2 + first) * 64 + ch) * 2] * h + sx[((d * 2 + first) * 64 + ch) * 2 + 1];
#pragma unroll
    for (int i = 0; i < 16; i++) {
      int tt = d == 0 ? half * 16 + i : half * 16 + 15 - i;
      float a = sa[(d * 32 + tt) * 64 + ch], u = su[(d * 32 + tt) * 64 + ch];
      h = a * h + u;
      su[(d * 32 + tt) * 64 + ch] = h;
    }
  }
  __syncthreads();
  {
    int ch = tid & 63, tq = tid >> 6;
    u16* mixA = (u16*)(p.ws + O_XN);
#pragma unroll
    for (int i = 0; i < 8; i++) {
      int tt = tq * 8 + i, tok = t0 + tt;
      float hsum = su[tt * 64 + ch] + su[(32 + tt) * 64 + ch];
      float gate = bf2f(zA[(size_t)tok * 512 + 256 + head * 64 + ch]);
      mixA[(size_t)tok * 256 + head * 64 + ch] = f2bf(hsum * geluf_(gate));
    }
  }
}
__device__ __forceinline__ void lru_propagate(const Params& p, int idx) {
  int seq = idx >> 9, d = (idx >> 8) & 1, ch = idx & 255;
  int c0, nc;
  if (seq < 8) { c0 = seq * 64; nc = 64; } else { c0 = 512 + (seq - 8) * 128; nc = 128; }
  const float2* car = (const float2*)(p.ws + O_LCAR);
  float* hin = (float*)(p.ws + O_LHIN);
  float h = 0.f;
  for (int i = 0; i < nc; i++) {
    int ck = d == 0 ? c0 + i : c0 + nc - 1 - i;
    size_t o = ((size_t)ck * 2 + d) * 256 + ch;
    hin[o] = h;
    float2 ab = car[o];
    h = ab.x * h + ab.y;
  }
}
__device__ __forceinline__ void s5_propagate(const Params& p, int l, int idx) {
  int pp = idx & 63, d = (idx >> 6) & 1, g = (idx >> 7) & 15, seq = idx >> 11;
  int c0, nc;
  if (seq < 8) { c0 = seq * 32; nc = 32; } else { c0 = 256 + (seq - 8) * 64; nc = 64; }
  const float* ab64 = (const float*)(p.ws + O_AB64) + (size_t)l * 2 * 16 * 64 * 2;
  float ar = ab64[((d * 16 + g) * 64 + pp) * 2], ai = ab64[((d * 16 + g) * 64 + pp) * 2 + 1];
  const float* send = (const float*)(p.ws + O_SEND) + (size_t)g * 1280 * 256;
  u16* uh = (u16*)(p.ws + O_UH) + (size_t)g * 1280 * 1280;
  float hr = 0.f, hi = 0.f;
  for (int i = 0; i < nc; i++) {
    int ck = d == 0 ? c0 + i : c0 + nc - 1 - i;
    *(unsigned*)(uh + (size_t)ck * 1280 + 1024 + d * 128 + pp * 2) = f2bf(hr) | ((unsigned)f2bf(hi) << 16);
    float2 s = *(const float2*)(send + (size_t)ck * 256 + d * 128 + pp * 2);
    float nr = __fmaf_rn(ar, hr, __fmaf_rn(-ai, hi, s.x));
    float ni = __fmaf_rn(ar, hi, __fmaf_rn(ai, hr, s.y));
    asm volatile("" : "+v"(nr));
    asm volatile("" : "+v"(ni));
    hr = nr; hi = ni;
  }
}

#define AST 68
__device__ __forceinline__ void gdn_g1_item(char* smraw, const Params& p, int l, int item) {
  int tid = threadIdx.x; asm volatile("" : "+v"(tid)); const int _tid_pad = 0, lane = tid & 63, w = tid >> 6, fr = lane & 15, fq = lane >> 4;
  const int ck = item >> 2, h = item & 3;
  const int t0 = ck * 64;
  int lo, hi; seq_bounds(t0, lo, hi);
  u16* sk = (u16*)smraw;
  u16* sv = sk + 64 * 72;
  u16* Am = (u16*)(smraw + 2 * 64 * 72 * 2);
  float* sgc = (float*)(Am + 2 * 64 * 72);
  float* sbeta = sgc + 128;
  u16* Xs = (u16*)(sbeta + 128);
  const u16* zC = (const u16*)(p.ws + O_ZC);
  const float* ba = (const float*)(p.ws + O_BA);
  u16* qg = (u16*)(p.ws + O_XN);
  u16* kg = qg + (size_t)T_ALL * 256;
  u16* vg = kg + (size_t)T_ALL * 256;
  __syncthreads();
  {
    const float* cw = p.in[21] + (size_t)l * 4 * 768;
    float wq[4], wk[4], wv[4];
#pragma unroll
    for (int j = 0; j < 4; j++) {
      wq[j] = cw[j * 768 + h * 64 + lane];
      wk[j] = cw[j * 768 + 256 + h * 64 + lane];
      wv[j] = cw[j * 768 + 512 + h * 64 + lane];
    }
    for (int rr = 0; rr < 16; rr++) {
      int c = w * 16 + rr, tok = t0 + c;
      float q = 0.f, k = 0.f, v = 0.f;
#pragma unroll
      for (int j = 0; j < 4; j++) {
        int tk = tok + j - 2;
        if (tk >= lo && tk < hi) {
          const u16* zr = zC + (size_t)tk * 1024 + h * 64 + lane;
          q += wq[j] * bf2f(zr[0]); k += wk[j] * bf2f(zr[256]); v += wv[j] * bf2f(zr[512]);
        }
      }
      q = siluf_(q); k = siluf_(k); v = siluf_(v);
      float sq = wave_sum(q * q), skk = wave_sum(k * k);
      q = q * rsqrtf(sq + EPSF) * 0.125f;
      k = k * rsqrtf(skk + EPSF);
      u16 kb = f2bf(k), vb = f2bf(v);
      sk[c * 72 + lane] = kb; sv[c * 72 + lane] = vb;
      qg[(size_t)tok * 256 + h * 64 + lane] = f2bf(q);
      kg[(size_t)tok * 256 + h * 64 + lane] = kb;
      vg[(size_t)tok * 256 + h * 64 + lane] = vb;
    }
  }
  if (tid < 128) {
    int d = tid >> 6, c = tid & 63;
    int tok = d == 0 ? t0 + c : t0 + 63 - c;
    float alog = p.in[22][(l * 2 + d) * 4 + h], dtb = p.in[23][(l * 2 + d) * 4 + h];
    float g = -expf(alog) * softplusf_(ba[(size_t)tok * 16 + 8 + d * 4 + h] + dtb);
    float beta = 1.f / (1.f + expf(-ba[(size_t)tok * 16 + d * 4 + h]));
    float s = g;
#pragma unroll
    for (int o = 1; o < 64; o <<= 1) { float t = __shfl_up(s, o); if (c >= o) s += t; }
    sgc[d * 64 + c] = s; sbeta[d * 64 + c] = beta;
    ((float*)(p.ws + O_GC))[(size_t)(h * 2 + d) * T_ALL + tok] = s;
  }
  __syncthreads();
  {
    f32x4 acc[4];
#pragma unroll
    for (int nt = 0; nt < 4; nt++) acc[nt] = (f32x4){0, 0, 0, 0};
#pragma unroll
    for (int ks = 0; ks < 2; ks++) {
      bf16x8 af = *(const bf16x8*)(sk + (16 * w + fr) * 72 + ks * 32 + fq * 8);
#pragma unroll
      for (int nt = 0; nt < 4; nt++) {
        bf16x8 bfm = *(const bf16x8*)(sk + (16 * nt + fr) * 72 + ks * 32 + fq * 8);
        acc[nt] = __builtin_amdgcn_mfma_f32_16x16x32_bf16(af, bfm, acc[nt], 0, 0, 0);
      }
    }
#pragma unroll
    for (int nt = 0; nt < 4; nt++)
#pragma unroll
      for (int e = 0; e < 4; e++) {
        int c = 16 * w + 4 * fq + e, m = 16 * nt + fr;
        float gm = acc[nt][e];
        float a0 = c > m ? sbeta[c] * gm * expf(sgc[c] - sgc[m]) : 0.f;
        Am[m * 72 + c] = f2bf(a0);
        int c1 = 63 - c, m1 = 63 - m;
        float a1 = c1 > m1 ? sbeta[64 + c1] * gm * expf(sgc[64 + c1] - sgc[64 + m1]) : 0.f;
        Am[64 * 72 + m1 * 72 + c1] = f2bf(a1);
      }
  }
  __syncthreads();
  {
    const int d = tid >> 7, col = tid & 127;
    const u16* AT = Am + d * 64 * 72;
    u16* Xd = Xs + d * 48 * 128;
    const u16* src = col < 64 ? sk : sv;
    const int e = col & 63;
    u16* wu = (u16*)(p.ws + O_WU) + ((size_t)(ck * 4 + h) * 2 + d) * 8192 + (col < 64 ? 0 : 4096);
#pragma unroll 1
    for (int b = 0; b < 4; b++) {
      float s[16];
#pragma unroll
      for (int r = 0; r < 16; r++) {
        int i = 16 * b + r;
        int tokr = d == 0 ? i : 63 - i;
        float rv = bf2f(src[tokr * 72 + e]) * sbeta[d * 64 + i];
        if (col < 64) rv *= expf(sgc[d * 64 + i]);
        s[r] = rv;
      }
#pragma unroll 4
      for (int j = 0; j < 16 * b; j++) {
        float xj = bf2f(Xd[j * 128 + col]);
        const uint4* ar = (const uint4*)(AT + j * 72 + 16 * b);
        uint4 a0 = ar[0], a1 = ar[1];
        unsigned aw[8] = {a0.x, a0.y, a0.z, a0.w, a1.x, a1.y, a1.z, a1.w};
#pragma unroll
        for (int q = 0; q < 8; q++) {
          s[2 * q] -= __uint_as_float(aw[q] << 16) * xj;
          s[2 * q + 1] -= __uint_as_float(aw[q] & 0xffff0000u) * xj;
        }
      }
#pragma unroll
      for (int rp = 0; rp < 16; rp++) {
        u16 xb = f2bf(s[rp]);
        float xj = bf2f(xb);
        wu[(16 * b + rp) * 64 + e] = xb;
        if (b < 3) Xd[(16 * b + rp) * 128 + col] = xb;
        const uint4* ar = (const uint4*)(AT + (16 * b + rp) * 72 + 16 * b);
        uint4 a0 = ar[0], a1 = ar[1];
        unsigned aw[8] = {a0.x, a0.y, a0.z, a0.w, a1.x, a1.y, a1.z, a1.w};
#pragma unroll
        for (int r = rp + 1; r < 16; r++) {
          float av = (r & 1) ? __uint_as_float(aw[r >> 1] & 0xffff0000u) : __uint_as_float(aw[r >> 1] << 16);
          s[r] -= av * xj;
        }
      }
    }
  }
}

__device__ __forceinline__ void gdn_chain(char* smraw, const Params& p, int chain) {
  int tid = threadIdx.x; asm volatile("" : "+v"(tid)); const int _tid_pad = 0, lane = tid & 63, w = tid >> 6, fr = lane & 15, fq = lane >> 4;
  const int d = chain & 1, h = (chain >> 1) & 3, seq = chain >> 3;
  int c0, nc;
  if (seq < 8) { c0 = seq * 32; nc = 32; } else { c0 = 256 + (seq - 8) * 64; nc = 64; }
  u16* qs = (u16*)smraw;
  u16* qd = qs + 64 * 72;
  u16* ks_ = qd + 64 * 72;
  u16* kdT = ks_ + 64 * 72;
  u16* at = kdT + 64 * 72;
  u16* ST = at + 64 * 72;
  u16* VT = ST + 4 * 16 * 72;
  float* sgc = (float*)(VT + 4 * 16 * 72);
  const u16* qg = (const u16*)(p.ws + O_XN);
  const u16* kg = qg + (size_t)T_ALL * 256;
  const float* gcg = (const float*)(p.ws + O_GC);
  u16* og = (u16*)(p.ws + O_OD) + (size_t)d * T_ALL * 256;
  u16* STw = ST + w * 16 * 72;
  u16* VTw = VT + w * 16 * 72;
  f32x4 accS[4];
#pragma unroll
  for (int mt = 0; mt < 4; mt++) accS[mt] = (f32x4){0, 0, 0, 0};
  __syncthreads();
  for (int e = lane; e < 16 * 72; e += 64) STw[e] = 0;
  for (int it = 0; it < nc; it++) {
    const int ck = d == 0 ? c0 + it : c0 + nc - 1 - it;
    const int t0 = ck * 64;
    const u16* wch = (const u16*)(p.ws + O_WU) + ((size_t)(ck * 4 + h) * 2 + d) * 8192;
    const u16* uch = wch + 4096;
    const int tok_last = d == 0 ? t0 + 63 : t0;
    const float gl = gcg[(size_t)(h * 2 + d) * T_ALL + tok_last];
    {
      int row = tid >> 2, seg = tid & 3;
      int tok = d == 0 ? t0 + row : t0 + 63 - row;
      float gcv = gcg[(size_t)(h * 2 + d) * T_ALL + tok];
      if (seg == 0) sgc[row] = gcv;
      float eq = expf(gcv), ek = expf(gl - gcv);
      const u16* qr = qg + (size_t)tok * 256 + h * 64 + seg * 16;
      const u16* kr = kg + (size_t)tok * 256 + h * 64 + seg * 16;
      uint4 q0 = *(const uint4*)qr, q1 = *(const uint4*)(qr + 8);
      uint4 k0 = *(const uint4*)kr, k1 = *(const uint4*)(kr + 8);
      *(uint4*)(qs + row * 72 + seg * 16) = q0; *(uint4*)(qs + row * 72 + seg * 16 + 8) = q1;
      *(uint4*)(ks_ + row * 72 + seg * 16) = k0; *(uint4*)(ks_ + row * 72 + seg * 16 + 8) = k1;
      unsigned qa[8] = {q0.x, q0.y, q0.z, q0.w, q1.x, q1.y, q1.z, q1.w};
      unsigned ka[8] = {k0.x, k0.y, k0.z, k0.w, k1.x, k1.y, k1.z, k1.w};
#pragma unroll
      for (int i = 0; i < 8; i++) {
        float qa0 = bf2f((u16)(qa[i] & 0xffff)) * eq, qa1 = bf2f((u16)(qa[i] >> 16)) * eq;
        *(unsigned*)(qd + row * 72 + seg * 16 + 2 * i) = f2bf(qa0) | ((unsigned)f2bf(qa1) << 16);
        float kb0 = bf2f((u16)(ka[i] & 0xffff)) * ek, kb1 = bf2f((u16)(ka[i] >> 16)) * ek;
        kdT[(seg * 16 + 2 * i) * 72 + row] = f2bf(kb0);
        kdT[(seg * 16 + 2 * i + 1) * 72 + row] = f2bf(kb1);
      }
    }
    __syncthreads();
    {
      f32x4 acc[4];
#pragma unroll
      for (int nt = 0; nt < 4; nt++) acc[nt] = (f32x4){0, 0, 0, 0};
#pragma unroll
      for (int ks = 0; ks < 2; ks++) {
        bf16x8 af = *(const bf16x8*)(qs + (16 * w + fr) * 72 + ks * 32 + fq * 8);
#pragma unroll
        for (int nt = 0; nt < 4; nt++) {
          bf16x8 bfm = *(const bf16x8*)(ks_ + (16 * nt + fr) * 72 + ks * 32 + fq * 8);
          acc[nt] = __builtin_amdgcn_mfma_f32_16x16x32_bf16(af, bfm, acc[nt], 0, 0, 0);
        }
      }
#pragma unroll
      for (int nt = 0; nt < 4; nt++)
#pragma unroll
        for (int e = 0; e < 4; e++) {
          int c = 16 * w + 4 * fq + e, m = 16 * nt + fr;
          float v = c >= m ? acc[nt][e] * expf(sgc[c] - sgc[m]) : 0.f;
          at[c * 72 + m] = f2bf(v);
        }
    }
    __syncthreads();
    {
      const int e0 = 16 * w;
      f32x4 av[4];
#pragma unroll
      for (int mt = 0; mt < 4; mt++) av[mt] = (f32x4){0, 0, 0, 0};
#pragma unroll
      for (int ks = 0; ks < 2; ks++) {
        bf16x8 bS = *(const bf16x8*)(STw + fr * 72 + ks * 32 + fq * 8);
#pragma unroll
        for (int mt = 0; mt < 4; mt++) {
          bf16x8 aw = *(const bf16x8*)(wch + (16 * mt + fr) * 64 + ks * 32 + fq * 8);
          av[mt] = __builtin_amdgcn_mfma_f32_16x16x32_bf16(aw, bS, av[mt], 0, 0, 0);
        }
      }
#pragma unroll
      for (int mt = 0; mt < 4; mt++) {
        u16 hv[4];
#pragma unroll
        for (int e = 0; e < 4; e++) {
          int c = 16 * mt + 4 * fq + e;
          float vn = bf2f(uch[c * 64 + e0 + fr]) - av[mt][e];
          hv[e] = f2bf(vn);
        }
        uint2 pk; pk.x = hv[0] | ((unsigned)hv[1] << 16); pk.y = hv[2] | ((unsigned)hv[3] << 16);
        *(uint2*)(VTw + fr * 72 + 16 * mt + 4 * fq) = pk;
      }
      __builtin_amdgcn_wave_barrier();
      f32x4 ao[4];
#pragma unroll
      for (int mt = 0; mt < 4; mt++) ao[mt] = (f32x4){0, 0, 0, 0};
#pragma unroll
      for (int ks = 0; ks < 2; ks++) {
        bf16x8 bS = *(const bf16x8*)(STw + fr * 72 + ks * 32 + fq * 8);
        bf16x8 bV = *(const bf16x8*)(VTw + fr * 72 + ks * 32 + fq * 8);
#pragma unroll
        for (int mt = 0; mt < 4; mt++) {
          bf16x8 aq = *(const bf16x8*)(qd + (16 * mt + fr) * 72 + ks * 32 + fq * 8);
          bf16x8 aa = *(const bf16x8*)(at + (16 * mt + fr) * 72 + ks * 32 + fq * 8);
          ao[mt] = __builtin_amdgcn_mfma_f32_16x16x32_bf16(aq, bS, ao[mt], 0, 0, 0);
          ao[mt] = __builtin_amdgcn_mfma_f32_16x16x32_bf16(aa, bV, ao[mt], 0, 0, 0);
        }
      }
#pragma unroll
      for (int mt = 0; mt < 4; mt++)
#pragma unroll
        for (int e = 0; e < 4; e++) {
          int c = 16 * mt + 4 * fq + e;
          int tok = d == 0 ? t0 + c : t0 + 63 - c;
          og[(size_t)tok * 256 + h * 64 + e0 + fr] = f2bf(ao[mt][e]);
        }
      float egl = expf(gl);
#pragma unroll
      for (int mt = 0; mt < 4; mt++) accS[mt] = accS[mt] * egl;
#pragma unroll
      for (int ks = 0; ks < 2; ks++) {
        bf16x8 bV = *(const bf16x8*)(VTw + fr * 72 + ks * 32 + fq * 8);
#pragma unroll
        for (int mt = 0; mt < 4; mt++) {
          bf16x8 ak = *(const bf16x8*)(kdT + (16 * mt + fr) * 72 + ks * 32 + fq * 8);
          accS[mt] = __builtin_amdgcn_mfma_f32_16x16x32_bf16(ak, bV, accS[mt], 0, 0, 0);
        }
      }
      __builtin_amdgcn_wave_barrier();
#pragma unroll
      for (int mt = 0; mt < 4; mt++) {
        uint2 pk;
        pk.x = f2bf(accS[mt][0]) | ((unsigned)f2bf(accS[mt][1]) << 16);
        pk.y = f2bf(accS[mt][2]) | ((unsigned)f2bf(accS[mt][3]) << 16);
        *(uint2*)(STw + fr * 72 + 16 * mt + 4 * fq) = pk;
      }
    }
    __syncthreads();
  }
}
__device__ __forceinline__ void gdn_final_rows(const Params& p, int l, int rowblk) {
  int tid_ = threadIdx.x; asm volatile("" : "+v"(tid_));
  const int lane = tid_ & 63, w = tid_ >> 6;
  int tok = rowblk * 4 + w;
  const u16* o0 = (const u16*)(p.ws + O_OD) + (size_t)tok * 256 + lane * 4;
  const u16* o1 = o0 + (size_t)T_ALL * 256;
  const u16* zg = (const u16*)(p.ws + O_ZC) + (size_t)tok * 1024 + 768 + lane * 4;
  uint2 a = *(const uint2*)o0, b = *(const uint2*)o1, g = *(const uint2*)zg;
  float o[4], gt[4];
  o[0] = bf2f(a.x & 0xffff) + bf2f(b.x & 0xffff); o[1] = bf2f(a.x >> 16) + bf2f(b.x >> 16);
  o[2] = bf2f(a.y & 0xffff) + bf2f(b.y & 0xffff); o[3] = bf2f(a.y >> 16) + bf2f(b.y >> 16);
  gt[0] = bf2f(g.x & 0xffff); gt[1] = bf2f(g.x >> 16); gt[2] = bf2f(g.y & 0xffff); gt[3] = bf2f(g.y >> 16);
  float ss = o[0] * o[0] + o[1] * o[1] + o[2] * o[2] + o[3] * o[3];
#pragma unroll
  for (int m = 8; m > 0; m >>= 1) ss += __shfl_xor(ss, m);
  float rs = rsqrtf(ss * (1.f / 64.f) + EPSF);
  if (!(MIXMASK & 4)) rs = 0.f;
  const float* nw = p.in[24] + l * 64 + (lane & 15) * 4;
  u16 r[4];
#pragma unroll
  for (int e = 0; e < 4; e++) r[e] = f2bf(o[e] * rs * nw[e] * siluf_(gt[e]));
  uint2 pk; pk.x = r[0] | ((unsigned)r[1] << 16); pk.y = r[2] | ((unsigned)r[3] << 16);
  *(uint2*)((u16*)(p.ws + O_XN) + (size_t)2 * T_ALL * 256 + (size_t)tok * 256 + lane * 4) = pk;
}
__device__ __forceinline__ void grpnorm_rows(const Params& p, int l, int which, int rowblk) {
  int tid_ = threadIdx.x; asm volatile("" : "+v"(tid_));
  const int lane = tid_ & 63, w = tid_ >> 6;
  int tok = rowblk * 4 + w;
  u16* m = (u16*)(p.ws + O_XN) + (size_t)which * T_ALL * 256 + (size_t)tok * 256 + lane * 4;
  uint2 a = *(const uint2*)m;
  float v[4] = {bf2f(a.x & 0xffff), bf2f(a.x >> 16), bf2f(a.y & 0xffff), bf2f(a.y >> 16)};
  float ss = wave_sum(v[0] * v[0] + v[1] * v[1] + v[2] * v[2] + v[3] * v[3]);
  float rs = rsqrtf(ss * (1.f / 256.f) + EPSF);
  if (!((MIXMASK >> which) & 1)) rs = 0.f;
  const float* gn = p.in[34] + (l * 3 + which) * 256 + lane * 4;
  uint2 pk;
  pk.x = f2bf(v[0] * rs * gn[0]) | ((unsigned)f2bf(v[1] * rs * gn[1]) << 16);
  pk.y = f2bf(v[2] * rs * gn[2]) | ((unsigned)f2bf(v[3] * rs * gn[3]) << 16);
  *(uint2*)m = pk;
}

#define WST 1296
#define UST 264
__device__ __forceinline__ float hy_conv3(const u16* __restrict__ raw, int t, int L, float w0, float w1, float w2, float b) {
  float xm = t > 0 ? bf2f(raw[t - 1]) : 0.f;
  float x0 = bf2f(raw[t]);
  float xp = t + 1 < L ? bf2f(raw[t + 1]) : 0.f;
  return w0 * xm + w1 * x0 + w2 * xp + b;
}
__device__ __forceinline__ void hy_conv_item(char* smraw, const Params& p, int l, int stage, int set, int c, int tb) {
  int tid = threadIdx.x; asm volatile("" : "+v"(tid)); const int _tid_pad = 0, lane = tid & 63, w = tid >> 6, fr = lane & 15, fq = lane >> 4;
  const int L = 2048 << set, nb = 8 << set, base = set ? T_P : 0;
  const int T0 = tb * 1024;
  u16* win = (u16*)smraw;
  u16* su = win + 8 * WST;
  float* sinv = (float*)(su + 16 * UST);
  const u16* dt = (const u16*)(p.ws + O_DT);
  const u16* rawv = dt + (size_t)c * T_ALL + base;
  const u16* rawx = dt + (size_t)((stage + 1) * 256 + c) * T_ALL + base;
  const u16* y1 = (const u16*)(p.ws + O_Y1) + (size_t)c * T_ALL + base;
  u16* outp = stage == 0 ? (u16*)(p.ws + O_Y1) + (size_t)c * T_ALL + base
                         : (u16*)(p.ws + O_DT) + (size_t)(256 + c) * T_ALL + base;
  const u16* kr = (const u16*)(p.ws + O_HYKR) + (set ? HYKR1 : 0) + ((size_t)stage * 256 + c) * (2 * L);
  const float* cw = p.in[25] + (size_t)l * 3 * 768;
  const float* cb = p.in[26] + (size_t)l * 768;
  const float v0 = cw[c], v1 = cw[768 + c], v2 = cw[1536 + c], vb = cb[c];
  const int xc_ = (stage + 1) * 256 + c;
  const float x0w = cw[xc_], x1w = cw[768 + xc_], x2w = cw[1536 + xc_], xbw = cb[xc_];
  __syncthreads();
  if (tid < 64) {
    const float* ps = (const float*)(p.ws + O_HYPS) + (size_t)(set ? 32 * 512 : 0);
    int ntb = L / 64;
    float s = 0.f;
    for (int i = lane; i < ntb; i += 64) s += ps[(size_t)i * 512 + stage * 256 + c];
    s = wave_sum(s);
    if (lane == 0) sinv[0] = 1.f / s;
  }
  f32x4 acc[16];
#pragma unroll
  for (int i = 0; i < 16; i++) acc[i] = (f32x4){0, 0, 0, 0};
  for (int S0 = 0; S0 < L; S0 += 256) {
    __syncthreads();
    const int B0 = S0 - T0;
    for (int idx = tid; idx < 8 * 160; idx += 256) {
      int rho = idx / 160, gi = idx % 160;
      int ybase = B0 - 1016 + 8 * gi - rho + L;
      u16 hh[8];
#pragma unroll
      for (int e = 0; e < 8; e++) { int yy = ybase + e; hh[e] = (yy >= 0 && yy < 2 * L) ? kr[yy] : (u16)0; }
      uint4 pk;
      pk.x = hh[0] | ((unsigned)hh[1] << 16); pk.y = hh[2] | ((unsigned)hh[3] << 16);
      pk.z = hh[4] | ((unsigned)hh[5] << 16); pk.w = hh[6] | ((unsigned)hh[7] << 16);
      *(uint4*)(win + rho * WST + 8 * gi) = pk;
    }
    {
      int b = tid >> 4, seg = tid & 15;
      u16 hh[16];
      if (b < nb) {
        const u16* src = (stage == 0 ? rawv : y1) + (size_t)b * L;
#pragma unroll
        for (int e = 0; e < 16; e++) {
          int s = S0 + seg * 16 + e;
          hh[e] = stage == 0 ? f2bf(hy_conv3(src, s, L, v0, v1, v2, vb)) : src[s];
        }
      } else {
#pragma unroll
        for (int e = 0; e < 16; e++) hh[e] = 0;
      }
      uint4 p0, p1;
      p0.x = hh[0] | ((unsigned)hh[1] << 16); p0.y = hh[2] | ((unsigned)hh[3] << 16);
      p0.z = hh[4] | ((unsigned)hh[5] << 16); p0.w = hh[6] | ((unsigned)hh[7] << 16);
      p1.x = hh[8] | ((unsigned)hh[9] << 16); p1.y = hh[10] | ((unsigned)hh[11] << 16);
      p1.z = hh[12] | ((unsigned)hh[13] << 16); p1.w = hh[14] | ((unsigned)hh[15] << 16);
      *(uint4*)(su + b * UST + seg * 16) = p0;
      *(uint4*)(su + b * UST + seg * 16 + 8) = p1;
    }
    __syncthreads();
    bf16x8 bfr[8];
#pragma unroll
    for (int j = 0; j < 8; j++) bfr[j] = *(const bf16x8*)(su + fr * UST + 32 * j + 8 * fq);
    const u16* wbase = win + (fr & 7) * WST + (8 * fq - 256 * w - 8 * (fr >> 3) + 1016);
#pragma unroll
    for (int dd = 0; dd < 30; dd++) {
      bf16x8 af = *(const bf16x8*)(wbase + 16 * (dd - 15));
#pragma unroll
      for (int j = 0; j < 8; j++) {
        const int i = 2 * j - (dd - 15);
        if (i >= 0 && i < 16) acc[i] = __builtin_amdgcn_mfma_f32_16x16x32_bf16(af, bfr[j], acc[i], 0, 0, 0);
      }
    }
  }
  __syncthreads();
  const float inv = sinv[0];
  const float bias = p.in[33][(size_t)(l * 2 + stage) * 256 + c];
  if (fr < nb) {
#pragma unroll
    for (int i = 0; i < 16; i++) {
      u16 r[4];
#pragma unroll
      for (int e = 0; e < 4; e++) {
        int t = T0 + 256 * w + 16 * i + 4 * fq + e;
        float uval = stage == 0 ? hy_conv3(rawv + (size_t)fr * L, t, L, v0, v1, v2, vb) : bf2f(y1[(size_t)fr * L + t]);
        float xg = hy_conv3(rawx + (size_t)fr * L, t, L, x0w, x1w, x2w, xbw);
        r[e] = f2bf(xg * (acc[i][e] * inv + bias * uval));
      }
      uint2 pk; pk.x = r[0] | ((unsigned)r[1] << 16); pk.y = r[2] | ((unsigned)r[3] << 16);
      *(uint2*)(outp + (size_t)fr * L + T0 + 256 * w + 16 * i + 4 * fq) = pk;
    }
  }
}
__device__ __forceinline__ void hy_final_item(char* smraw, const Params& p, int l, int ck) {
  int tid = threadIdx.x; asm volatile("" : "+v"(tid)); const int _tid_pad = 0, lane = tid & 63, w = tid >> 6;
  float* s = (float*)smraw;
  const u16* yd = (const u16*)(p.ws + O_DT) + (size_t)256 * T_ALL;
  const int t0 = ck * 64;
  __syncthreads();
  for (int i = 0; i < 64; i++) {
    int c = w * 64 + i;
    s[lane * 257 + c] = bf2f(yd[(size_t)c * T_ALL + t0 + lane]);
  }
  __syncthreads();
  const float* gn = p.in[34] + (l * 3 + 2) * 256;
  u16* mixD = (u16*)(p.ws + O_XN) + (size_t)3 * T_ALL * 256;
  for (int i = 0; i < 16; i++) {
    int tt = w * 16 + i;
    float v[4];
#pragma unroll
    for (int e = 0; e < 4; e++) v[e] = s[tt * 257 + lane * 4 + e];
    float ss = wave_sum(v[0] * v[0] + v[1] * v[1] + v[2] * v[2] + v[3] * v[3]);
    float rs = rsqrtf(ss * (1.f / 256.f) + EPSF);
    if (!(MIXMASK & 8)) rs = 0.f;
    uint2 pk;
    pk.x = f2bf(v[0] * rs * gn[lane * 4]) | ((unsigned)f2bf(v[1] * rs * gn[lane * 4 + 1]) << 16);
    pk.y = f2bf(v[2] * rs * gn[lane * 4 + 2]) | ((unsigned)f2bf(v[3] * rs * gn[lane * 4 + 3]) << 16);
    *(uint2*)(mixD + (size_t)(t0 + tt) * 256 + lane * 4) = pk;
  }
}

#define GRID_SYNC() do {                                                                                   \
    __builtin_amdgcn_fence(__ATOMIC_RELEASE, "agent");                                                     \
    asm volatile("s_waitcnt vmcnt(0) lgkmcnt(0)" ::: "memory");                                            \
    __syncthreads();                                                                                       \
    bar_target += (unsigned)nblk;                                                                          \
    if (threadIdx.x == 0) {                                                                                \
      __hip_atomic_fetch_add(bar_ctr, 1u, __ATOMIC_RELAXED, __HIP_MEMORY_SCOPE_AGENT);                     \
      while (__hip_atomic_load(bar_ctr, __ATOMIC_RELAXED, __HIP_MEMORY_SCOPE_AGENT) < bar_target)          \
        __builtin_amdgcn_s_sleep(2);                                                                       \
    }                                                                                                      \
    __syncthreads();                                                                                       \
    __builtin_amdgcn_fence(__ATOMIC_ACQUIRE, "agent");                                                     \
    asm volatile("s_waitcnt vmcnt(0)" ::: "memory");                                                       \
  } while (0)

#define TILE_LOOP(nM_, nN_, MT, NT)                                                                  \
  const int nSN_ = ((nN_) + 7) >> 3, nS_ = (((nM_) + 7) >> 3) * nSN_, P_ = nblk >> 3;                 \
  _Pragma("unroll 1") for (int S_ = (bid & 7); S_ < nS_ && (bid >> 3) < P_; S_ += 8)                 \
  _Pragma("unroll 1") for (int q_ = (bid >> 3); q_ < 64; q_ += P_)                                   \
    for (int MT = (S_ / nSN_) * 8 + (q_ >> 3), NT = (S_ % nSN_) * 8 + (q_ & 7), once_ = 1; once_ && MT < (nM_) && NT < (nN_); once_ = 0)

__global__ void __launch_bounds__(256, 2) mega(Params p) {
  cg::grid_group grid = cg::this_grid();
  __shared__ __attribute__((aligned(16))) char smraw[SMEM_BYTES];
  u16* smem = (u16*)smraw;
  float* smf = (float*)smraw;
  const int bid = blockIdx.x, nblk = gridDim.x, tid = threadIdx.x;
  const int rbid = nblk - 1 - bid;
  const int lane = tid & 63;
  char* const ws = p.ws;
  unsigned* const bar_ctr = (unsigned*)(ws + O_BAR);
  unsigned bar_target = 0;
  grid.sync();

#ifdef NANFILL
  {
    uint4 nanv = make_uint4(0x7FC07FC0u, 0x7FC07FC0u, 0x7FC07FC0u, 0x7FC07FC0u);
    uint4* w4 = (uint4*)ws;
    for (size_t i = (size_t)bid * 256 + tid; i < WS_TOTAL / 16; i += (size_t)nblk * 256) w4[i] = nanv;
    uint4* o4 = (uint4*)p.out;
    for (size_t i = (size_t)bid * 256 + tid; i < (size_t)T_ALL * DM / 4; i += (size_t)nblk * 256) o4[i] = nanv;
    __threadfence(); grid.sync(); __threadfence();
  }
#endif
#pragma unroll 1
  for (int lay = 0; lay < 2; lay++) {
    {
      int l = lay; asm volatile("" : "+s"(l));
#pragma unroll 1
      for (int i = bid; i < 42 * 16; i += nblk) transpose_tile(smf, p.in[3] + (size_t)l * 1024 * 2576, 2576, p.in[2] + l * 1024, (u16*)(ws + O_WIN), 1024, 0, (i / 16) * 64, (i % 16) * 64);
#pragma unroll 1
      for (int i = rbid; i < 16 * 16; i += nblk) transpose_tile(smf, p.in[35] + (size_t)l * 1024 * 1024, 1024, nullptr, (u16*)(ws + O_WOUT), 1024, 1, (i / 16) * 64, (i % 16) * 64);
#pragma unroll 1
      for (int i = bid; i < 88 * 16; i += nblk) transpose_tile(smf, p.in[37] + (size_t)l * 1024 * 5632, 5632, p.in[36] + l * 1024, (u16*)(ws + O_WUP), 1024, 2, (i / 16) * 64, (i % 16) * 64);
#pragma unroll 1
      for (int i = rbid; i < 16 * 44; i += nblk) transpose_tile(smf, p.in[40] + (size_t)l * 2816 * 1024, 1024, nullptr, (u16*)(ws + O_WDN), 2816, 3, (i / 44) * 64, (i % 44) * 64);
#pragma unroll 1
      for (int i = bid; i < 16; i += nblk) transpose_tile(smf, p.in[19] + (size_t)l * 256 * 256, 256, nullptr, (u16*)(ws + O_WGLU), 256, 4, (i / 4) * 64, (i % 4) * 64);
#pragma unroll 1
      for (int i = rbid; i < 64; i += nblk) {
        u16* wl = (u16*)(ws + O_WLRU);
        for (int e = i * 1024 + tid; e < (i + 1) * 1024; e += 256) {
          int k = e & 63, n = (e >> 6) & 255, head = e >> 14;
          int d = n >> 7, gate = (n >> 6) & 1, j = n & 63;
          const float* wr_ = p.in[6]; const float* wi_ = p.in[8];
          size_t off_ = ((size_t)((l * 2 + d) * 4 + head) * 64 + k) * 64 + j;
          float vr_ = wr_[off_], vi_ = wi_[off_];
          wl[e] = f2bf(gate ? vi_ : vr_);
        }
      }
#pragma unroll 1
      for (int i = bid; i < 16 * 2 * 65; i += nblk) s5_prep_item(smf, p, l, i);
#pragma unroll 1
      for (int i = rbid; i < 16 * 2 * 64; i += nblk) s5_bts_item(p, l, i);
#pragma unroll 1
      for (int i = rbid; i < 96; i += nblk) hy_filter_item(smf, p, l, i < 32 ? 0 : 1, i < 32 ? i : i - 32);
#pragma unroll 1
      for (int i = bid; i < T_ALL / 4; i += nblk) rms_rows_to_bf16(p, l, i);
    }
    GRID_SYNC();
    {
      int l = lay; asm volatile("" : "+s"(l));
      TILE_LOOP(640, 21, mt, nt) {
        { const float* H = gemm_tile(smem, (const u16*)(ws + O_XN), 1024, mt * 128, 0, T_ALL, 30, 0, (const u16*)(ws + O_WIN) + (size_t)nt * 128 * 1024, 1024, 1024);
            int tid_o = threadIdx.x; asm volatile("" : "+v"(tid_o));
            const int tok0 = mt * 128;
            if (nt < 4) {
              u16* zA = (u16*)(ws + O_ZA) + (size_t)tok0 * 512 + nt * 128;
              EPI_ROWS(H, { *(uint2*)(zA + (size_t)r * 512 + c) = pack4(v.x, v.y, v.z, v.w); })
            } else if (nt < 6) {
              u16* uh = (u16*)(ws + O_UH);
              EPI_ROWS(H, {
                int tok = tok0 + r, ch = (nt - 4) * 128 + c;
                *(uint2*)(uh + ((size_t)(ch >> 4) * 1280 + (tok >> 6)) * 1280 + (tok & 63) * 16 + (ch & 15)) = pack4(v.x, v.y, v.z, v.w); })
            } else if (nt < 14) {
              u16* zC = (u16*)(ws + O_ZC) + (size_t)tok0 * 1024 + (nt - 6) * 128;
              EPI_ROWS(H, { *(uint2*)(zC + (size_t)r * 1024 + c) = pack4(v.x, v.y, v.z, v.w); })
            } else if (nt < 20) {
              u16* dt = (u16*)(ws + O_DT) + (size_t)((nt - 14) * 128 + (tid_o & 127)) * T_ALL + tok0 + (tid_o >> 7) * 64;
              const float* Hc = H + (tid_o >> 7) * 64 * HST + (tid_o & 127);
#pragma unroll 2
              for (int k = 0; k < 8; k++) {
                uint2 a = pack4(Hc[(8 * k) * HST], Hc[(8 * k + 1) * HST], Hc[(8 * k + 2) * HST], Hc[(8 * k + 3) * HST]);
                uint2 b = pack4(Hc[(8 * k + 4) * HST], Hc[(8 * k + 5) * HST], Hc[(8 * k + 6) * HST], Hc[(8 * k + 7) * HST]);
                uint4 pk; pk.x = a.x; pk.y = a.y; pk.z = b.x; pk.w = b.y;
                *(uint4*)(dt + 8 * k) = pk;
              }
            } else {
              float* ba = (float*)(ws + O_BA) + (size_t)tok0 * 16;
#pragma unroll 2
              for (int k = 0; k < 8; k++) { int idx = tid_o + 256 * k; ba[idx] = H[(idx >> 4) * HST + (idx & 15)]; }
            }
          }
      }
#pragma unroll 1
      for (int it = rbid; it < 16 * 1024; it += nblk) s5_expand_item(p, l, it);
    }
    GRID_SYNC();
    {
      int l = lay; asm volatile("" : "+s"(l));
#pragma unroll 1
      for (int it = bid; it < NCH64 * 4; it += nblk) gdn_g1_item(smraw, p, l, it);
#pragma unroll 1
      for (int it = rbid; it < 16 * 10 * 2; it += nblk) {
        const int g = it / 20, mt = (it % 20) >> 1, nt = it & 1;
        { const float* H = gemm_tile(smem, (const u16*)(ws + O_UH) + (size_t)g * 1280 * 1280, 1280, mt * 128, 0, 1280, 30, 0,
                  (const u16*)(ws + O_BTS) + (size_t)g * 256 * 1024 + (size_t)nt * 128 * 1024, 1024, 1024);
            int tid_o = threadIdx.x; asm volatile("" : "+v"(tid_o));
            float* send = (float*)(ws + O_SEND) + (size_t)g * 1280 * 256 + (size_t)mt * 128 * 256 + nt * 128;
            EPI_ROWS(H, { *(float4*)(send + (size_t)r * 256 + c) = v; })
          }
      }
#pragma unroll 1
      for (int it = bid; it < NCH32 * 4; it += nblk) lru_item(smraw, p, l, it, 0);
    }
    GRID_SYNC();
    {
      int l = lay; asm volatile("" : "+s"(l));
#pragma unroll 1
      for (int it = bid; it < 192; it += nblk) gdn_chain(smraw, p, it);
#pragma unroll 1
      for (int it = rbid; it < 48; it += nblk) lru_propagate(p, it * 256 + tid);
#pragma unroll 1
      for (int it = rbid - 48; it < 192; it += nblk) { if (it >= 0) s5_propagate(p, l, it * 256 + tid); }
      unsigned* hq = (unsigned*)(ws + O_BAR + 192) + l;
      int* hslot = (int*)(smraw + SMEM_BYTES - 16);
#pragma unroll 1
      for (;;) {
        __syncthreads();
        if (tid == 0) *hslot = (int)atomicAdd(hq, 1u);
        __syncthreads();
        const int item = *hslot;
        if (item >= 512) break;
        const int set = item < 256 ? 1 : 0, c = item & 255, ntb = set ? 4 : 2;
#pragma unroll 1
        for (int tb = 0; tb < ntb; tb++) hy_conv_item(smraw, p, l, 0, set, c, tb);
        __threadfence();
        __syncthreads();
#pragma unroll 1
        for (int tb = 0; tb < ntb; tb++) hy_conv_item(smraw, p, l, 1, set, c, tb);
      }
    }
    GRID_SYNC();
    {
      int l = lay; asm volatile("" : "+s"(l));
#pragma unroll 1
      for (int it = rbid; it < 16 * 10 * 8; it += nblk) {
        const int g = it / 80, mt = (it % 80) >> 3, nt = it & 7;
        { const float* H = gemm_tile(smem, (const u16*)(ws + O_UH) + (size_t)g * 1280 * 1280, 1280, mt * 128, 0, 1280, 30, 0,
                  (const u16*)(ws + O_BTY) + (size_t)g * 1024 * 1280 + (size_t)nt * 128 * 1280, 1280, 1280);
            int tid_o = threadIdx.x; asm volatile("" : "+v"(tid_o));
            u16* zb = (u16*)(ws + O_XN) + (size_t)3 * T_ALL * 256;
            EPI_ROWS(H, {
              int ck = mt * 128 + r, n = nt * 128 + c;
              *(uint2*)(zb + ((size_t)g * T_ALL + ck * 64 + (n >> 4)) * 16 + (n & 15)) = pack4(geluf_(v.x), geluf_(v.y), geluf_(v.z), geluf_(v.w)); })
          }
      }
#pragma unroll 1
      for (int it = bid; it < NCH32 * 4; it += nblk) lru_item(smraw, p, l, it, 1);
#pragma unroll 1
      for (int it = rbid; it < T_ALL / 4; it += nblk) gdn_final_rows(p, l, it);
    }
    GRID_SYNC();
    {
      int l = lay; asm volatile("" : "+s"(l));
#pragma unroll 1
      for (int it = bid; it < 640 * 2; it += nblk) {
        const int mt = it >> 1, nt = it & 1;
        const u16* zb = (const u16*)(ws + O_XN) + (size_t)3 * T_ALL * 256;
        { const float* H = gemm_tile(smem, zb, 16, mt * 128, 0, T_ALL, 4, (size_t)T_ALL * 16, (const u16*)(ws + O_WGLU) + (size_t)nt * 128 * 256, 256, 256);
            int tid_o = threadIdx.x; asm volatile("" : "+v"(tid_o));
            u16* mixB = (u16*)(ws + O_XN) + (size_t)T_ALL * 256 + (size_t)mt * 128 * 256 + nt * 128;
            const u16* zr = zb + (size_t)mt * 128 * 16;
            const float* gb = p.in[20] + l * 256 + nt * 128;
            EPI_ROWS(H, {
              uint2 zz = *(const uint2*)(zr + ((size_t)((nt * 128 + c) >> 4) * T_ALL + r) * 16 + (c & 15));
              float4 g4 = *(const float4*)(gb + c);
              float z0 = bf2f(zz.x & 0xffff), z1 = bf2f(zz.x >> 16), z2 = bf2f(zz.y & 0xffff), z3 = bf2f(zz.y >> 16);
              *(uint2*)(mixB + (size_t)r * 256 + c) = pack4(z0 * sigmoidf_(v.x + g4.x), z1 * sigmoidf_(v.y + g4.y), z2 * sigmoidf_(v.z + g4.z), z3 * sigmoidf_(v.w + g4.w)); })
          }
      }
#pragma unroll 1
      for (int it = rbid; it < T_ALL / 4; it += nblk) grpnorm_rows(p, l, 0, it);
    }
    GRID_SYNC();
    {
      int l = lay; asm volatile("" : "+s"(l));
#pragma unroll 1
      for (int it = bid; it < NCH64; it += nblk) hy_final_item(smraw, p, l, it);
#pragma unroll 1
      for (int it = rbid; it < T_ALL / 4; it += nblk) grpnorm_rows(p, l, 1, it);
    }
    GRID_SYNC();
    {
      int l = lay; asm volatile("" : "+s"(l));
      TILE_LOOP(640, 8, mt, nt) {
        { const float* H = gemm_tile(smem, (const u16*)(ws + O_XN), 256, mt * 128, 0, T_ALL, 8, (size_t)T_ALL * 256,
                  (const u16*)(ws + O_WOUT) + (size_t)nt * 128 * 1024, 1024, 1024);
            int tid_o = threadIdx.x; asm volatile("" : "+v"(tid_o));
            float* o = p.out + (size_t)mt * 128 * DM + nt * 128;
            EPI_ROWS(H, {
              float4 b4 = *(const float4*)(xrow(p, l, mt * 128 + r) + nt * 128 + c);
              float4 o4; o4.x = b4.x + v.x; o4.y = b4.y + v.y; o4.z = b4.z + v.z; o4.w = b4.w + v.w;
              *(float4*)(o + (size_t)r * DM + c) = o4; })
          }
      }
    }
    GRID_SYNC();
    {
      int l = lay; asm volatile("" : "+s"(l));
#pragma unroll 1
      for (int it = bid; it < T_ALL / 4; it += nblk) rms_rows_to_bf16(p, 1, it);
    }
    GRID_SYNC();
    {
      int l = lay; asm volatile("" : "+s"(l));
      const int nM = 8 * 17 + 16 * 33;
      TILE_LOOP(nM, 44, mi, nt) {
        int seq, ti, L;
        if (mi < 136) { seq = mi / 17; ti = mi % 17; L = 2048; }
        else { seq = 8 + (mi - 136) / 33; ti = (mi - 136) % 33; L = 4096; }
        const int s0 = seq < 8 ? seq * 2048 : T_P + (seq - 8) * 4096;
        const int arow0 = s0 + 126 * ti - 1;
        const int nvalid = min(126, L - 126 * ti);
        { const float* H = gemm_tile(smem, (const u16*)(ws + O_XN), 1024, arow0, s0, s0 + L, 30, 0, (const u16*)(ws + O_WUP) + (size_t)nt * 128 * 1024, 1024, 1024);
            int tid_o = threadIdx.x; asm volatile("" : "+v"(tid_o));
            const int j = tid_o & 63, rg = tid_o >> 6;
            const float* cw = p.in[38] + (size_t)l * 3 * 5632;
            const float* cb = p.in[39] + (size_t)l * 5632;
            const int cg_ = nt * 64 + j, cv_ = DFF + nt * 64 + j;
            const float g0 = cw[cg_], g1 = cw[5632 + cg_], g2 = cw[2 * 5632 + cg_], gb = cb[cg_];
            const float u0 = cw[cv_], u1 = cw[5632 + cv_], u2 = cw[2 * 5632 + cv_], ub = cb[cv_];
            u16* hm = (u16*)(ws + O_HMID) + (size_t)arow0 * DFF + nt * 64 + j;
#pragma unroll 2
            for (int r = 1 + rg; r <= nvalid; r += 4) {
              float gate = g0 * H[(r - 1) * HST + j] + g1 * H[r * HST + j] + g2 * H[(r + 1) * HST + j] + gb;
              float val = u0 * H[(r - 1) * HST + 64 + j] + u1 * H[r * HST + 64 + j] + u2 * H[(r + 1) * HST + 64 + j] + ub;
              hm[(size_t)r * DFF] = f2bf(siluf_(gate) * val);
            }
          }
      }
    }
    GRID_SYNC();
    {
      int l = lay; asm volatile("" : "+s"(l));
      TILE_LOOP(640, 8, mt, nt) {
        { const float* H = gemm_tile(smem, (const u16*)(ws + O_HMID), DFF, mt * 128, 0, T_ALL, 30, 0, (const u16*)(ws + O_WDN) + (size_t)nt * 128 * DFF, DFF, DFF);
            int tid_o = threadIdx.x; asm volatile("" : "+v"(tid_o));
            float* o = p.out + (size_t)mt * 128 * DM + nt * 128;
            EPI_ROWS(H, {
              float4 b4 = *(const float4*)(o + (size_t)r * DM + c);
              b4.x += v.x; b4.y += v.y; b4.z += v.z; b4.w += v.w;
              *(float4*)(o + (size_t)r * DM + c) = b4; })
          }
      }
    }
    GRID_SYNC();
  }
  {
    const int w = tid >> 6;
    const float* fn = p.in[41];
#pragma unroll 1
    for (int it = bid; it < T_ALL / 4; it += nblk) {
      int tok = it * 4 + w;
      float* x = p.out + (size_t)tok * DM;
      float4 v[4];
      float ss = 0.f;
#pragma unroll
      for (int i = 0; i < 4; i++) {
        v[i] = *(const float4*)(x + i * 256 + lane * 4);
        ss += v[i].x * v[i].x + v[i].y * v[i].y + v[i].z * v[i].z + v[i].w * v[i].w;
      }
      ss = wave_sum(ss);
      float rs = rsqrtf(ss * (1.f / 1024.f) + EPSF);
#pragma unroll
      for (int i = 0; i < 4; i++) {
        float4 g = *(const float4*)(fn + i * 256 + lane * 4);
        float4 o; o.x = v[i].x * rs * g.x; o.y = v[i].y * rs * g.y; o.z = v[i].z * rs * g.z; o.w = v[i].w * rs * g.w;
        *(float4*)(x + i * 256 + lane * 4) = o;
      }
    }
  }
}

extern "C" void kernel_launch(void* const* d_in, const int* in_sizes, int n_in,
                              void* d_out, int out_size, void* d_ws, size_t ws_size,
                              hipStream_t stream) {
  static int grid_blocks = 0;
  if (!grid_blocks) {
    int dev = 0, cus = 0, per_cu = 0;
    (void)hipGetDevice(&dev);
    (void)hipDeviceGetAttribute(&cus, hipDeviceAttributeMultiprocessorCount, dev);
    (void)hipOccupancyMaxActiveBlocksPerMultiprocessor(&per_cu, mega, 256, 0);
    if (per_cu > 2) per_cu = 2;
    if (per_cu < 1) per_cu = 1;
    grid_blocks = cus * per_cu;
  }
  if (ws_size < WS_TOTAL) fprintf(stderr, "workspace too small: %zu < %zu\n", ws_size, (size_t)WS_TOTAL);
  Params p{};
  for (int i = 0; i < 42; i++) p.in[i] = (const float*)d_in[i];
  p.out = (float*)d_out;
  p.ws = (char*)d_ws;
  (void)hipMemsetAsync((char*)d_ws + O_BAR, 0, 256, stream);
  void* args[] = {&p};
  hipError_t e = hipLaunchCooperativeKernel((void*)mega, dim3(grid_blocks), dim3(256), args, 0, stream);
  if (e != hipSuccess) fprintf(stderr, "coop launch failed: %s (grid %d)\n", hipGetErrorString(e), grid_blocks);
}
```

```cpp
#include <hip/hip_runtime.h>
#include <hip/hip_bf16.h>
#include <hip/hip_cooperative_groups.h>
#include <cstdio>
namespace cg = cooperative_groups;

typedef unsigned short u16;
using bf16x8 = __attribute__((ext_vector_type(8))) short;
using f32x4 = __attribute__((ext_vector_type(4))) float;

#define T_ALL 81920
#define T_P 16384
#define DM 1024
#define NZ 2688
#define DFF 2816
#define NCH32 2560
#define NCH64 1280
#define EPSF 1e-6f

constexpr size_t al(size_t x) { return (x + 255) & ~(size_t)255; }
constexpr size_t O_WIN = 0;
constexpr size_t O_WOUT = O_WIN + al((size_t)NZ * 1024 * 2);
constexpr size_t O_WUP = O_WOUT + al((size_t)1024 * 1024 * 2);
constexpr size_t O_WDN = O_WUP + al((size_t)5632 * 1024 * 2);
constexpr size_t O_WLRU = O_WDN + al((size_t)1024 * 2816 * 2);
constexpr size_t O_WGLU = O_WLRU + al((size_t)4 * 256 * 64 * 2);
constexpr size_t O_AB64 = O_WGLU + al((size_t)256 * 256 * 2);
constexpr size_t O_KTAB = O_AB64 + 2 * al((size_t)2 * 16 * 64 * 2 * 4);
constexpr size_t O_BTY = O_KTAB + al((size_t)16 * 2 * 64 * 256 * 4);
constexpr size_t O_BTS = O_BTY + al((size_t)16 * 1024 * 1280 * 2);
constexpr size_t O_HYKR = O_BTS + al((size_t)16 * 256 * 1024 * 2);
constexpr size_t HYKR1 = (size_t)2 * 256 * 4096;
constexpr size_t O_HYPS = O_HYKR + al((size_t)2 * 256 * (4096 + 8192) * 2);
constexpr size_t O_XN = O_HYPS + al((size_t)(32 + 64) * 512 * 4);
constexpr size_t O_ZA = O_XN + al((size_t)T_ALL * 1024 * 2);
constexpr size_t O_UH = O_ZA + al((size_t)T_ALL * 512 * 2);
constexpr size_t O_ZC = O_UH + al((size_t)16 * 1280 * 1280 * 2);
constexpr size_t O_BA = O_ZC + al((size_t)T_ALL * 1024 * 2);
constexpr size_t O_DT = O_BA + al((size_t)T_ALL * 16 * 4);
constexpr size_t O_WU = O_DT + al((size_t)768 * T_ALL * 2);
constexpr size_t O_GC = O_WU + al((size_t)NCH64 * 4 * 2 * 2 * 4096 * 2);
constexpr size_t O_OD = O_GC + al((size_t)T_ALL * 8 * 4);
constexpr size_t O_Y1 = O_OD + al((size_t)2 * T_ALL * 256 * 2);
constexpr size_t O_SEND = O_Y1 + al((size_t)256 * T_ALL * 2);
constexpr size_t O_LCAR = O_SEND + al((size_t)16 * 1280 * 256 * 4);
constexpr size_t O_LHIN = O_LCAR + al((size_t)NCH32 * 512 * 8);
constexpr size_t O_BAR = O_LHIN + al((size_t)NCH32 * 512 * 4);
constexpr size_t WS_TOTAL = O_BAR + 16384;
static_assert(WS_TOTAL <= (size_t)1073741824, "ws");
constexpr size_t O_HMID = O_ZA;
static_assert(O_HMID + (size_t)T_ALL * DFF * 2 <= O_GC, "hmid alias");

struct Params {
  const float* in[42];
  float* out;
  char* ws;
};

#define SMEM_BYTES 73728
#ifndef MIXMASK
#define MIXMASK 15
#endif

__device__ __forceinline__ u16 f2bf(float f) {
  unsigned u = __float_as_uint(f);
  u += 0x7fffu + ((u >> 16) & 1u);
  return (u16)(u >> 16);
}
__device__ __forceinline__ float bf2f(u16 h) { return __uint_as_float(((unsigned)h) << 16); }
__device__ __forceinline__ float sigmoidf_(float x) { return 1.f / (1.f + __expf(-x)); }
__device__ __forceinline__ float siluf_(float x) { return x / (1.f + __expf(-x)); }
__device__ __forceinline__ float softplusf_(float x) { return x > 20.f ? x : log1pf(expf(x)); }
__device__ __forceinline__ float geluf_(float x) {
  float t = tanhf(0.7978845608028654f * (x + 0.044715f * x * x * x));
  return 0.5f * x * (1.f + t);
}
__device__ __forceinline__ float wave_sum(float v) {
#pragma unroll
  for (int o = 32; o > 0; o >>= 1) v += __shfl_xor(v, o);
  return v;
}
__device__ __forceinline__ const float* xrow(const Params& p, int l, int tok) {
  const float* a = p.in[0]; const float* b = p.in[1]; const float* o = p.out;
  const float* r0 = a + (size_t)tok * DM;
  const float* r1 = b + (size_t)(tok - T_P) * DM;
  const float* r2 = o + (size_t)tok * DM;
  return l == 0 ? (tok < T_P ? r0 : r1) : r2;
}
__device__ __forceinline__ void seq_bounds(int tok, int& lo, int& hi) {
  if (tok < T_P) { lo = tok & ~2047; hi = lo + 2048; }
  else { lo = T_P + ((tok - T_P) & ~4095); hi = lo + 4096; }
}

#define GST 72
#define HST 132
__device__ __forceinline__ const float* gemm_tile(u16* smem, const u16* __restrict__ A, long lda, int arow0, int alo, int ahi,
                                          int segShift, size_t segStride,
                                          const u16* __restrict__ Bt, long ldb, int K) {
  u16* sA = smem;
  u16* sB = smem + 2 * 128 * GST;
  int tid = threadIdx.x; asm volatile("" : "+v"(tid)); const int _tid_pad = 0, lane = tid & 63, w = tid >> 6;
  const int wm = w >> 1, wn = w & 1, fr = lane & 15, fq = lane >> 4;
  const int cc = tid & 7, r0 = tid >> 3;
  f32x4 acc[4][4];
#pragma unroll
  for (int i = 0; i < 4; i++)
#pragma unroll
    for (int j = 0; j < 4; j++) acc[i][j] = (f32x4){0.f, 0.f, 0.f, 0.f};
  uint4 ra0x, ra1x, ra2x, ra3x, rb0x, rb1x, rb2x, rb3x;
  const int nk = K >> 6;
#define GROW(i_, AP, BP, OK) const bool OK = (arow0 + r0 + 32 * i_) >= alo && (arow0 + r0 + 32 * i_) < ahi;        \
    const u16* AP = A + (long)(OK ? (arow0 + r0 + 32 * i_) : alo) * lda;                                             \
    const u16* BP = Bt + (long)(r0 + 32 * i_) * ldb + cc * 8;
  GROW(0, ap0, bp0, ok0) GROW(1, ap1, bp1, ok1) GROW(2, ap2, bp2, ok2) GROW(3, ap3, bp3, ok3)
#define GLOAD1(AP, BP, OK, RA, RB) {                                                \
      uint4 t_ = *(const uint4*)(AP + aoff_);                                         \
      RA = OK ? t_ : make_uint4(0, 0, 0, 0);                                          \
      RB = *(const uint4*)(BP + k0_); }
#define GLOAD(kt_, S) do {                                                         \
    const int k0_ = (kt_) << 6;                                                       \
    const int kk_ = k0_ + cc * 8;                                                     \
    const int sg_ = kk_ >> segShift;                                                  \
    const size_t aoff_ = (size_t)sg_ * segStride + (kk_ - (sg_ << segShift));         \
    GLOAD1(ap0, bp0, ok0, ra0##S, rb0##S) GLOAD1(ap1, bp1, ok1, ra1##S, rb1##S)       \
    GLOAD1(ap2, bp2, ok2, ra2##S, rb2##S) GLOAD1(ap3, bp3, ok3, ra3##S, rb3##S)       \
    } while (0)
#define SWRITE1(buf_, i_, RA, RB) {                                                 \
      *(uint4*)(sA + (buf_) * 128 * GST + (r0 + 32 * i_) * GST + cc * 8) = RA;        \
      *(uint4*)(sB + (buf_) * 128 * GST + (r0 + 32 * i_) * GST + cc * 8) = RB; }
#define SWRITE(buf_, S) do {                                                        \
    SWRITE1(buf_, 0, ra0##S, rb0##S) SWRITE1(buf_, 1, ra1##S, rb1##S) SWRITE1(buf_, 2, ra2##S, rb2##S) SWRITE1(buf_, 3, ra3##S, rb3##S) \
    } while (0)
#define GCOMPUTE(buf_) do {                                                         \
    const u16* a = sA + (buf_) * 128 * GST;                                           \
    const u16* b = sB + (buf_) * 128 * GST;                                           \
    _Pragma("unroll") for (int ks = 0; ks < 2; ks++) {                                \
      bf16x8 af[4], bfr[4];                                                           \
      _Pragma("unroll") for (int i = 0; i < 4; i++) {                                 \
        af[i] = *(const bf16x8*)(a + (64 * wm + 16 * i + fr) * GST + ks * 32 + fq * 8);   \
        bfr[i] = *(const bf16x8*)(b + (64 * wn + 16 * i + fr) * GST + ks * 32 + fq * 8);  \
      }                                                                               \
      _Pragma("unroll") for (int i = 0; i < 4; i++)                                   \
      _Pragma("unroll") for (int j = 0; j < 4; j++)                                   \
        acc[i][j] = __builtin_amdgcn_mfma_f32_16x16x32_bf16(af[i], bfr[j], acc[i][j], 0, 0, 0); \
    } } while (0)
#define LDS_BARRIER() asm volatile("s_waitcnt lgkmcnt(0)\n\ts_barrier" ::: "memory")
  __syncthreads();
  GLOAD(0, x);
  SWRITE(0, x);
  LDS_BARRIER();
#pragma unroll 1
  for (int kt = 0; kt < nk; kt += 2) {
    if (kt + 1 < nk) GLOAD(kt + 1, x);
    GCOMPUTE(0);
    if (kt + 1 < nk) SWRITE(1, x);
    LDS_BARRIER();
    if (kt + 1 >= nk) break;
    if (kt + 2 < nk) GLOAD(kt + 2, x);
    GCOMPUTE(1);
    if (kt + 2 < nk) SWRITE(0, x);
    LDS_BARRIER();
  }
  float* H = (float*)smem;
#pragma unroll
  for (int i = 0; i < 4; i++)
#pragma unroll
    for (int j = 0; j < 4; j++)
#pragma unroll
      for (int e = 0; e < 4; e++) H[(64 * wm + 16 * i + 4 * fq + e) * HST + 64 * wn + 16 * j + fr] = acc[i][j][e];
  __syncthreads();
  return H;
}
__device__ __forceinline__ uint2 pack4(float a, float b, float c, float d) {
  uint2 pk; pk.x = f2bf(a) | ((unsigned)f2bf(b) << 16); pk.y = f2bf(c) | ((unsigned)f2bf(d) << 16); return pk;
}
#define EPI_ROWS(H, BODY...)                                                     \
  _Pragma("unroll 2") for (int _it = 0; _it < 16; _it++) {                       \
    const int r = (tid_o >> 5) + 8 * _it, c = (tid_o & 31) * 4;      \
    const float4 v = *(const float4*)((H) + r * HST + c); BODY }

__device__ __forceinline__ int colmap(int mode, int n) {
  if (mode == 0) {
    if (n < 1792) return n;
    if (n < 2560) return n + 16;
    if (n < 2576) return 1792 + (n - 2560);
    return -1;
  }
  if (mode == 2) { int nt = n >> 7, c = n & 127; return c < 64 ? nt * 64 + c : DFF + nt * 64 + (c - 64); }
  return n;
}
__device__ __forceinline__ void transpose_tile(float* sm, const float* __restrict__ src, int ldsrc, const float* __restrict__ gain,
                               u16* __restrict__ dst, int K, int mode, int n0, int k0) {
  int tid = threadIdx.x; asm volatile("" : "+v"(tid)); const int _tid_pad = 0;
  __syncthreads();
  {
    int nn = tid & 63;
    int sc = colmap(mode, n0 + nn);
#pragma unroll
    for (int i = 0; i < 16; i++) {
      int kk = (tid >> 6) + 4 * i;
      float v = 0.f;
      if (sc >= 0) { v = src[(size_t)(k0 + kk) * ldsrc + sc]; if (gain) v *= gain[k0 + kk]; }
      sm[kk * 65 + nn] = v;
    }
  }
  __syncthreads();
  {
    int c = tid & 7;
#pragma unroll
    for (int i = 0; i < 2; i++) {
      int nn = (tid >> 3) + 32 * i;
      u16 h[8];
#pragma unroll
      for (int e = 0; e < 8; e++) h[e] = f2bf(sm[(c * 8 + e) * 65 + nn]);
      uint4 pk;
      pk.x = h[0] | ((unsigned)h[1] << 16); pk.y = h[2] | ((unsigned)h[3] << 16);
      pk.z = h[4] | ((unsigned)h[5] << 16); pk.w = h[6] | ((unsigned)h[7] << 16);
      *(uint4*)(dst + (size_t)(n0 + nn) * K + k0 + c * 8) = pk;
    }
  }
}

__device__ __forceinline__ void s5_prep_item(float* sm, const Params& p, int l, int item) {
  int tid = threadIdx.x; asm volatile("" : "+v"(tid)); const int _tid_pad = 0;
  const int m = item % 65, d = (item / 65) & 1, g = item / 130;
  float* s_abm = sm;
  float* s_q = sm + 128;
  const int ldg = (l * 2 + d) * 16 + g;
  __syncthreads();
  if (tid < 64) {
    int pi = ldg * 64 + tid;
    float dt = expf(p.in[13][ldg]);
    float are = p.in[11][pi], aim = p.in[12][pi];
    float mag = expf(dt * are), ang = dt * aim;
    float abr = mag * cosf(ang), abi = mag * sinf(ang);
    float den = are * are + aim * aim;
    float nre = abr - 1.f;
    s_q[tid * 2] = (nre * are + abi * aim) / den;
    s_q[tid * 2 + 1] = (abi * are - nre * aim) / den;
    float mm = expf((float)m * dt * are), am = (float)m * ang;
    float pr = mm * cosf(am), pim = mm * sinf(am);
    s_abm[tid * 2] = pr; s_abm[tid * 2 + 1] = pim;
    if (m == 64) {
      float* ab64 = (float*)(p.ws + O_AB64) + (size_t)l * 2 * 16 * 64 * 2;
      ab64[((d * 16 + g) * 64 + tid) * 2] = pr;
      ab64[((d * 16 + g) * 64 + tid) * 2 + 1] = pim;
    }
  }
  __syncthreads();
  const float* bre = p.in[14] + (size_t)ldg * 64 * 16;
  const float* bim = p.in[15] + (size_t)ldg * 64 * 16;
  const float* cre = p.in[16] + (size_t)ldg * 16 * 64;
  const float* cim = p.in[17] + (size_t)ldg * 16 * 64;
  u16* bty = (u16*)(p.ws + O_BTY) + (size_t)g * 1024 * 1280;
  u16* bts = (u16*)(p.ws + O_BTS) + (size_t)g * 256 * 1024;
  if (m <= 63) {
    int ho = tid >> 4, hi = tid & 15;
    float acc = 0.f;
    for (int pp = 0; pp < 64; pp++) {
      float cr = cre[ho * 64 + pp], ci = cim[ho * 64 + pp];
      float ar = s_abm[pp * 2], ai = s_abm[pp * 2 + 1];
      float t1r = cr * ar - ci * ai, t1i = cr * ai + ci * ar;
      float qr = s_q[pp * 2], qi = s_q[pp * 2 + 1];
      float br = bre[pp * 16 + hi], bi = bim[pp * 16 + hi];
      float bbr = qr * br - qi * bi, bbi = qr * bi + qi * br;
      acc += t1r * bbr - t1i * bbi;
    }
    float* kt = (float*)(p.ws + O_KTAB);
    kt[((size_t)((g * 2 + d) * 64 + m)) * 256 + ho * 16 + hi] = acc;
  }
  if (m >= 1) {
    int t = d == 0 ? m - 1 : 64 - m;
    for (int e = tid; e < 1024; e += 256) {
      int ho = e >> 6, pp = e & 63;
      float cr = cre[ho * 64 + pp], ci = cim[ho * 64 + pp];
      float ar = s_abm[pp * 2], ai = s_abm[pp * 2 + 1];
      float xr = cr * ar - ci * ai, xi = cr * ai + ci * ar;
      size_t o = (size_t)(t * 16 + ho) * 1280 + 1024 + d * 128 + pp * 2;
      bty[o] = f2bf(xr);
      bty[o + 1] = f2bf(-xi);
    }
  }
}
__device__ __forceinline__ void s5_bts_item(const Params& p, int l, int item) {
  int tid = threadIdx.x; asm volatile("" : "+v"(tid));
  const int pp = item & 63, d = (item >> 6) & 1, g = item >> 7;
  const int sp = tid >> 2, hq = tid & 3;
  const int ldg = (l * 2 + d) * 16 + g;
  const int pi = ldg * 64 + pp;
  float dt = expf(p.in[13][ldg]);
  float are = p.in[11][pi], aim = p.in[12][pi];
  float mag = expf(dt * are), ang = dt * aim;
  float abr = mag * cosf(ang), abi = mag * sinf(ang);
  float den = are * are + aim * aim;
  float nre = abr - 1.f;
  float qr = (nre * are + abi * aim) / den, qi = (abi * are - nre * aim) / den;
  const int f = d == 0 ? 63 - sp : sp;
  float mm = expf((float)f * dt * are), am = (float)f * ang;
  float ar = mm * cosf(am), ai = mm * sinf(am);
  const float* bre = p.in[14] + (size_t)ldg * 64 * 16 + pp * 16 + hq * 4;
  const float* bim = p.in[15] + (size_t)ldg * 64 * 16 + pp * 16 + hq * 4;
  float fr_[4], fi_[4];
#pragma unroll
  for (int e = 0; e < 4; e++) {
    float br = bre[e], bi = bim[e];
    float bbr = qr * br - qi * bi, bbi = qr * bi + qi * br;
    fr_[e] = ar * bbr - ai * bbi; fi_[e] = ar * bbi + ai * bbr;
  }
  u16* bts = (u16*)(p.ws + O_BTS) + (size_t)g * 256 * 1024 + (size_t)(d * 128 + pp * 2) * 1024 + sp * 16 + hq * 4;
  *(uint2*)bts = pack4(fr_[0], fr_[1], fr_[2], fr_[3]);
  *(uint2*)(bts + 1024) = pack4(fi_[0], fi_[1], fi_[2], fi_[3]);
}
__device__ __forceinline__ void s5_expand_item(const Params& p, int l, int item) {
  int tid = threadIdx.x; asm volatile("" : "+v"(tid)); const int _tid_pad = 0;
  int g = item >> 10, n = item & 1023, t = n >> 4, ho = n & 15;
  int sp = tid >> 2, hi0 = (tid & 3) * 4;
  const float* kt = (const float*)(p.ws + O_KTAB);
  float v[4] = {0.f, 0.f, 0.f, 0.f};
  if (t >= sp) {
    const float* k0 = kt + ((size_t)((g * 2 + 0) * 64 + (t - sp))) * 256 + ho * 16 + hi0;
#pragma unroll
    for (int e = 0; e < 4; e++) v[e] += k0[e];
  }
  if (sp >= t) {
    const float* k1 = kt + ((size_t)((g * 2 + 1) * 64 + (sp - t))) * 256 + ho * 16 + hi0;
#pragma unroll
    for (int e = 0; e < 4; e++) v[e] += k1[e];
  }
  if (t == sp && ho >= hi0 && ho < hi0 + 4) v[ho - hi0] += p.in[18][l * 256 + g * 16 + ho];
  u16* bty = (u16*)(p.ws + O_BTY) + (size_t)g * 1024 * 1280 + (size_t)n * 1280 + sp * 16 + hi0;
  uint2 pk;
  pk.x = f2bf(v[0]) | ((unsigned)f2bf(v[1]) << 16);
  pk.y = f2bf(v[2]) | ((unsigned)f2bf(v[3]) << 16);
  *(uint2*)bty = pk;
}

__device__ __forceinline__ void hy_filter_item(float* sm, const Params& p, int l, int set, int tb) {
  int tid = threadIdx.x; asm volatile("" : "+v"(tid));
  const int L = 2048 << set;
  float* sz = sm;
  float* h1 = sm + 65 * 33;
  float* h2 = h1 + 65 * 64;
  const float* w1 = p.in[27] + (size_t)l * 33 * 64;
  const float* b1 = p.in[28] + l * 64;
  const float* fq_ = p.in[29] + l * 64;
  const float* w2 = p.in[30] + (size_t)l * 64 * 64;
  const float* b2 = p.in[31] + l * 64;
  const float* w3 = p.in[32] + (size_t)l * 64 * 1024;
  __syncthreads();
  for (int e = tid; e < 65 * 33; e += 256) {
    int tt = e / 33, i = e % 33;
    int t = tb * 64 + tt;
    float val;
    if (i == 0) val = (float)t / (float)(L - 1);
    else {
      int b = (i - 1) & 15;
      float f = 1e-4f + (float)b * ((15.f - 1e-4f) / 15.f);
      float wang = 6.283185307179586f * (float)t / (float)L;
      val = i <= 16 ? cosf(f * wang) : -sinf(f * wang);
    }
    sz[e] = val;
  }
  __syncthreads();
  {
    int j = tid & 63;
    float fj = fq_[j], bj = b1[j];
#pragma unroll 1
    for (int i = 0; i < 17; i++) {
      int tt = (tid >> 6) + 4 * i;
      if (tt < 65) {
        float a = bj;
        for (int k = 0; k < 33; k++) a += sz[tt * 33 + k] * w1[k * 64 + j];
        h1[tt * 64 + j] = sinf(fj * a);
      }
    }
  }
  __syncthreads();
  {
    int j = tid & 63;
    float fj = fq_[j], bj = b2[j];
#pragma unroll 1
    for (int i = 0; i < 17; i++) {
      int tt = (tid >> 6) + 4 * i;
      if (tt < 65) {
        float a = bj;
        for (int k = 0; k < 64; k++) a += h1[tt * 64 + k] * w2[k * 64 + j];
        h2[tt * 64 + j] = sinf(fj * a);
      }
    }
  }
  __syncthreads();
  const int c = tid;
  const float mind = -3.0701134573253943f, maxd = -15.350567286626972f;
  float delta = fabsf(mind + (float)c * ((maxd - mind) / 255.f));
  u16* kr = (u16*)(p.ws + O_HYKR) + (set ? HYKR1 : 0);
  float* ps = (float*)(p.ws + O_HYPS) + (size_t)(set ? 32 * 512 : 0) + (size_t)tb * 512;
#pragma unroll 1
  for (int order = 0; order < 2; order++) {
    u16* krc = kr + ((size_t)order * 256 + c) * (2 * L);
    float asum = 0.f, v00 = 0.f;
#pragma unroll 1
    for (int dir = 0; dir < 2; dir++) {
      float wc[64];
#pragma unroll
      for (int k = 0; k < 64; k++) wc[k] = w3[k * 1024 + order * 512 + dir * 256 + c];
      float hold = 0.f;
      const int ntt = dir == 0 ? 65 : 64;
#pragma unroll 1
      for (int tt = 0; tt < ntt; tt++) {
        float a = 0.f;
#pragma unroll
        for (int k = 0; k < 64; k++) a += h2[tt * 64 + k] * wc[k];
        int t = tb * 64 + tt;
        float tl = (float)t / (float)(L - 1);
        a *= expf(-tl * delta);
        if (t >= L) a = 0.f;
        if (tt < 64) asum += fabsf(a);
        if (dir == 0) {
          if (tt == 0) { if (tb == 0) v00 = a; }
          else if (tt & 1) hold = a;
          else *(unsigned*)(krc + (L - t)) = f2bf(a) | ((unsigned)f2bf(hold) << 16);
        } else {
          if (!(tt & 1)) hold = (t == 0) ? v00 + a : a;
          else *(unsigned*)(krc + (L + t - 1)) = f2bf(hold) | ((unsigned)f2bf(a) << 16);
        }
      }
    }
    ps[order * 256 + c] = asum;
  }
}

__device__ __forceinline__ void rms_rows_to_bf16(const Params& p, int l, int rowblk) {
  int tid_ = threadIdx.x; asm volatile("" : "+v"(tid_));
  const int lane = tid_ & 63, w = tid_ >> 6;
  int tok = rowblk * 4 + w;
  const float* x = xrow(p, l, tok);
  float4 v[4];
  float ss = 0.f;
#pragma unroll
  for (int i = 0; i < 4; i++) {
    v[i] = *(const float4*)(x + i * 256 + lane * 4);
    ss += v[i].x * v[i].x + v[i].y * v[i].y + v[i].z * v[i].z + v[i].w * v[i].w;
  }
  ss = wave_sum(ss);
  float rs = rsqrtf(ss * (1.f / 1024.f) + EPSF);
  u16* xn = (u16*)(p.ws + O_XN) + (size_t)tok * 1024;
#pragma unroll
  for (int i = 0; i < 4; i++) {
    uint2 pk;
    pk.x = f2bf(v[i].x * rs) | ((unsigned)f2bf(v[i].y * rs) << 16);
    pk.y = f2bf(v[i].z * rs) | ((unsigned)f2bf(v[i].w * rs) << 16);
    *(uint2*)(xn + i * 256 + lane * 4) = pk;
  }
}

__device__ __forceinline__ void lru_item(char* smraw, const Params& p, int l, int item, int mode) {
  int tid = threadIdx.x; asm volatile("" : "+v"(tid)); const int _tid_pad = 0, lane = tid & 63, w = tid >> 6, fr = lane & 15, fq = lane >> 4;
  const int cki = item >> 2, head = item & 3;
  const int t0 = cki * 32;
  int lo, hi; seq_bounds(t0, lo, hi);
  float* xc = (float*)smraw;
  u16* xcb = (u16*)(smraw + 8192);
  float* sa = (float*)(smraw + 8192 + 4608);
  float* su = sa + 2 * 32 * 64;
  float* sx = su + 2 * 32 * 64;
  const u16* zA = (const u16*)(p.ws + O_ZA);
  __syncthreads();
  {
    int ch = tid & 63, tq = tid >> 6;
    int gch = head * 64 + ch;
    const float* cw = p.in[4] + l * 4 * 256;
    float w0 = cw[gch], w1 = cw[256 + gch], w2 = cw[512 + gch], w3 = cw[768 + gch];
    float cb = p.in[5][l * 256 + gch];
    float win[11];
#pragma unroll
    for (int i = 0; i < 11; i++) {
      int tok = t0 + tq * 8 + i - 2;
      win[i] = (tok >= lo && tok < hi) ? bf2f(zA[(size_t)tok * 512 + gch]) : 0.f;
    }
#pragma unroll
    for (int i = 0; i < 8; i++) {
      float v = w0 * win[i] + w1 * win[i + 1] + w2 * win[i + 2] + w3 * win[i + 3] + cb;
      int tt = tq * 8 + i;
      xc[tt * 64 + ch] = v;
      xcb[tt * 72 + ch] = f2bf(v);
    }
  }
  __syncthreads();
  {
    const int d = w >> 1, half = w & 1;
    const u16* wl = (const u16*)(p.ws + O_WLRU) + (size_t)head * 256 * 64;
    f32x4 accr[2][2], acci[2][2];
#pragma unroll
    for (int a = 0; a < 2; a++)
#pragma unroll
      for (int b = 0; b < 2; b++) { accr[a][b] = (f32x4){0, 0, 0, 0}; acci[a][b] = (f32x4){0, 0, 0, 0}; }
#pragma unroll
    for (int ks = 0; ks < 2; ks++) {
      bf16x8 af[2], br[2], bi[2];
#pragma unroll
      for (int mt = 0; mt < 2; mt++) af[mt] = *(const bf16x8*)(xcb + (16 * mt + fr) * 72 + ks * 32 + fq * 8);
#pragma unroll
      for (int nt = 0; nt < 2; nt++) {
        int nr = d * 128 + 32 * half + 16 * nt + fr;
        br[nt] = *(const bf16x8*)(wl + (size_t)nr * 64 + ks * 32 + fq * 8);
        bi[nt] = *(const bf16x8*)(wl + (size_t)(nr + 64) * 64 + ks * 32 + fq * 8);
      }
#pragma unroll
      for (int mt = 0; mt < 2; mt++)
#pragma unroll
        for (int nt = 0; nt < 2; nt++) {
          accr[mt][nt] = __builtin_amdgcn_mfma_f32_16x16x32_bf16(af[mt], br[nt], accr[mt][nt], 0, 0, 0);
          acci[mt][nt] = __builtin_amdgcn_mfma_f32_16x16x32_bf16(af[mt], bi[nt], acci[mt][nt], 0, 0, 0);
        }
    }
#pragma unroll
    for (int nt = 0; nt < 2; nt++) {
      int ch = 32 * half + 16 * nt + fr;
      int gch = head * 64 + ch;
      float brr = p.in[7][(l * 2 + d) * 256 + gch], bii = p.in[9][(l * 2 + d) * 256 + gch];
      float sp = softplusf_(-p.in[10][(l * 2 + d) * 256 + gch]);
#pragma unroll
      for (int mt = 0; mt < 2; mt++)
#pragma unroll
        for (int e = 0; e < 4; e++) {
          int tt = 16 * mt + 4 * fq + e;
          float r = 1.f / (1.f + expf(-(accr[mt][nt][e] + brr)));
          float ig = 1.f / (1.f + expf(-(acci[mt][nt][e] + bii)));
          float la = -8.f * r * sp;
          float a = expf(la);
          float u = sqrtf(-expm1f(2.f * la)) * (ig * xc[tt * 64 + ch]);
          sa[(d * 32 + tt) * 64 + ch] = a;
          su[(d * 32 + tt) * 64 + ch] = u;
        }
    }
  }
  __syncthreads();
  {
    const int ch = tid & 63, d = (tid >> 6) & 1, half = tid >> 7;
    float A = 1.f, B = 0.f;
#pragma unroll
    for (int i = 0; i < 16; i++) {
      int tt = d == 0 ? half * 16 + i : half * 16 + 15 - i;
      float a = sa[(d * 32 + tt) * 64 + ch], u = su[(d * 32 + tt) * 64 + ch];
      A = a * A; B = a * B + u;
    }
    sx[((d * 2 + half) * 64 + ch) * 2] = A;
    sx[((d * 2 + half) * 64 + ch) * 2 + 1] = B;
  }
  __syncthreads();
  if (mode == 0) {
    if (tid < 128) {
      int ch = tid & 63, d = tid >> 6;
      int first = d == 0 ? 0 : 1, second = 1 - first;
      float A1 = sx[((d * 2 + first) * 64 + ch) * 2], B1 = sx[((d * 2 + first) * 64 + ch) * 2 + 1];
      float A2 = sx[((d * 2 + second) * 64 + ch) * 2], B2 = sx[((d * 2 + second) * 64 + ch) * 2 + 1];
      float2 cr; cr.x = A2 * A1; cr.y = A2 * B1 + B2;
      ((float2*)(p.ws + O_LCAR))[((size_t)cki * 2 + d) * 256 + head * 64 + ch] = cr;
    }
    return;
  }
  {
    const int ch = tid & 63, d = (tid >> 6) & 1, half = tid >> 7;
    float h = ((const float*)(p.ws + O_LHIN))[((size_t)cki * 2 + d) * 256 + head * 64 + ch];
    int first = d == 0 ? 0 : 1;
    if (half != first) h = sx[((d * 2 + first) * 64 + ch) * 2] * h + sx[((d * 2 + first) * 64 + ch) * 2 + 1];
#pragma unroll
    for (int i = 0; i < 16; i++) {
      int tt = d == 0 ? half * 16 + i : half * 16 + 15 - i;
      float a = sa[(d * 32 + tt) * 64 + ch], u = su[(d * 32 + tt) * 64 + ch];
      h = a * h + u;
      su[(d * 32 + tt) * 64 + ch] = h;
    }
  }
  __syncthreads();
  {
    int ch = tid & 63, tq = tid >> 6;
    u16* mixA = (u16*)(p.ws + O_XN);
#pragma unroll
    for (int i = 0; i < 8; i++) {
      int tt = tq * 8 + i, tok = t0 + tt;
      float hsum = su[tt * 64 + ch] + su[(32 + tt) * 64 + ch];
      float gate = bf2f(zA[(size_t)tok * 512 + 256 + head * 64 + ch]);
      mixA[(size_t)tok * 256 + head * 64 + ch] = f2bf(hsum * geluf_(gate));
    }
  }
}
__device__ __forceinline__ void lru_propagate(const Params& p, int idx) {
  int seq = idx >> 9, d = (idx >> 8) & 1, ch = idx & 255;
  int c0, nc;
  if (seq < 8) { c0 = seq * 64; nc = 64; } else { c0 = 512 + (seq - 8) * 128; nc = 128; }
  const float2* car = (const float2*)(p.ws + O_LCAR);
  float* hin = (float*)(p.ws + O_LHIN);
  float h = 0.f;
  for (int i = 0; i < nc; i++) {
    int ck = d == 0 ? c0 + i : c0 + nc - 1 - i;
    size_t o = ((size_t)ck * 2 + d) * 256 + ch;
    hin[o] = h;
    float2 ab = car[o];
    h = ab.x * h + ab.y;
  }
}
__device__ __forceinline__ void s5_propagate(const Params& p, int l, int idx) {
  int pp = idx & 63, d = (idx >> 6) & 1, g = (idx >> 7) & 15, seq = idx >> 11;
  int c0, nc;
  if (seq < 8) { c0 = seq * 32; nc = 32; } else { c0 = 256 + (seq - 8) * 64; nc = 64; }
  const float* ab64 = (const float*)(p.ws + O_AB64) + (size_t)l * 2 * 16 * 64 * 2;
  float ar = ab64[((d * 16 + g) * 64 + pp) * 2], ai = ab64[((d * 16 + g) * 64 + pp) * 2 + 1];
  const float* send = (const float*)(p.ws + O_SEND) + (size_t)g * 1280 * 256;
  u16* uh = (u16*)(p.ws + O_UH) + (size_t)g * 1280 * 1280;
  float hr = 0.f, hi = 0.f;
  for (int i = 0; i < nc; i++) {
    int ck = d == 0 ? c0 + i : c0 + nc - 1 - i;
    *(unsigned*)(uh + (size_t)ck * 1280 + 1024 + d * 128 + pp * 2) = f2bf(hr) | ((unsigned)f2bf(hi) << 16);
    float2 s = *(const float2*)(send + (size_t)ck * 256 + d * 128 + pp * 2);
    float nr = __fmaf_rn(ar, hr, __fmaf_rn(-ai, hi, s.x));
    float ni = __fmaf_rn(ar, hi, __fmaf_rn(ai, hr, s.y));
    asm volatile("" : "+v"(nr));
    asm volatile("" : "+v"(ni));
    hr = nr; hi = ni;
  }
}

#define AST 68
__device__ __forceinline__ void gdn_g1_item(char* smraw, const Params& p, int l, int item) {
  int tid = threadIdx.x; asm volatile("" : "+v"(tid)); const int _tid_pad = 0, lane = tid & 63, w = tid >> 6, fr = lane & 15, fq = lane >> 4;
  const int ck = item >> 2, h = item & 3;
  const int t0 = ck * 64;
  int lo, hi; seq_bounds(t0, lo, hi);
  u16* sk = (u16*)smraw;
  u16* sv = sk + 64 * 72;
  u16* Am = (u16*)(smraw + 2 * 64 * 72 * 2);
  float* sgc = (float*)(Am + 2 * 64 * 72);
  float* sbeta = sgc + 128;
  u16* Xs = (u16*)(sbeta + 128);
  const u16* zC = (const u16*)(p.ws + O_ZC);
  const float* ba = (const float*)(p.ws + O_BA);
  u16* qg = (u16*)(p.ws + O_XN);
  u16* kg = qg + (size_t)T_ALL * 256;
  u16* vg = kg + (size_t)T_ALL * 256;
  __syncthreads();
  {
    const float* cw = p.in[21] + (size_t)l * 4 * 768;
    float wq[4], wk[4], wv[4];
#pragma unroll
    for (int j = 0; j < 4; j++) {
      wq[j] = cw[j * 768 + h * 64 + lane];
      wk[j] = cw[j * 768 + 256 + h * 64 + lane];
      wv[j] = cw[j * 768 + 512 + h * 64 + lane];
    }
    for (int rr = 0; rr < 16; rr++) {
      int c = w * 16 + rr, tok = t0 + c;
      float q = 0.f, k = 0.f, v = 0.f;
#pragma unroll
      for (int j = 0; j < 4; j++) {
        int tk = tok + j - 2;
        if (tk >= lo && tk < hi) {
          const u16* zr = zC + (size_t)tk * 1024 + h * 64 + lane;
          q += wq[j] * bf2f(zr[0]); k += wk[j] * bf2f(zr[256]); v += wv[j] * bf2f(zr[512]);
        }
      }
      q = siluf_(q); k = siluf_(k); v = siluf_(v);
      float sq = wave_sum(q * q), skk = wave_sum(k * k);
      q = q * rsqrtf(sq + EPSF) * 0.125f;
      k = k * rsqrtf(skk + EPSF);
      u16 kb = f2bf(k), vb = f2bf(v);
      sk[c * 72 + lane] = kb; sv[c * 72 + lane] = vb;
      qg[(size_t)tok * 256 + h * 64 + lane] = f2bf(q);
      kg[(size_t)tok * 256 + h * 64 + lane] = kb;
      vg[(size_t)tok * 256 + h * 64 + lane] = vb;
    }
  }
  if (tid < 128) {
    int d = tid >> 6, c = tid & 63;
    int tok = d == 0 ? t0 + c : t0 + 63 - c;
    float alog = p.in[22][(l * 2 + d) * 4 + h], dtb = p.in[23][(l * 2 + d) * 4 + h];
    float g = -expf(alog) * softplusf_(ba[(size_t)tok * 16 + 8 + d * 4 + h] + dtb);
    float beta = 1.f / (1.f + expf(-ba[(size_t)tok * 16 + d * 4 + h]));
    float s = g;
#pragma unroll
    for (int o = 1; o < 64; o <<= 1) { float t = __shfl_up(s, o); if (c >= o) s += t; }
    sgc[d * 64 + c] = s; sbeta[d * 64 + c] = beta;
    ((float*)(p.ws + O_GC))[(size_t)(h * 2 + d) * T_ALL + tok] = s;
  }
  __syncthreads();
  {
    f32x4 acc[4];
#pragma unroll
    for (int nt = 0; nt < 4; nt++) acc[nt] = (f32x4){0, 0, 0, 0};
#pragma unroll
    for (int ks = 0; ks < 2; ks++) {
      bf16x8 af = *(const bf16x8*)(sk + (16 * w + fr) * 72 + ks * 32 + fq * 8);
#pragma unroll
      for (int nt = 0; nt < 4; nt++) {
        bf16x8 bfm = *(const bf16x8*)(sk + (16 * nt + fr) * 72 + ks * 32 + fq * 8);
        acc[nt] = __builtin_amdgcn_mfma_f32_16x16x32_bf16(af, bfm, acc[nt], 0, 0, 0);
      }
    }
#pragma unroll
    for (int nt = 0; nt < 4; nt++)
#pragma unroll
      for (int e = 0; e < 4; e++) {
        int c = 16 * w + 4 * fq + e, m = 16 * nt + fr;
        float gm = acc[nt][e];
        float a0 = c > m ? sbeta[c] * gm * expf(sgc[c] - sgc[m]) : 0.f;
        Am[m * 72 + c] = f2bf(a0);
        int c1 = 63 - c, m1 = 63 - m;
        float a1 = c1 > m1 ? sbeta[64 + c1] * gm * expf(sgc[64 + c1] - sgc[64 + m1]) : 0.f;
        Am[64 * 72 + m1 * 72 + c1] = f2bf(a1);
      }
  }
  __syncthreads();
  {
    const int d = tid >> 7, col = tid & 127;
    const u16* AT = Am + d * 64 * 72;
    u16* Xd = Xs + d * 48 * 128;
    const u16* src = col < 64 ? sk : sv;
    const int e = col & 63;
    u16* wu = (u16*)(p.ws + O_WU) + ((size_t)(ck * 4 + h) * 2 + d) * 8192 + (col < 64 ? 0 : 4096);
#pragma unroll 1
    for (int b = 0; b < 4; b++) {
      float s[16];
#pragma unroll
      for (int r = 0; r < 16; r++) {
        int i = 16 * b + r;
        int tokr = d == 0 ? i : 63 - i;
        float rv = bf2f(src[tokr * 72 + e]) * sbeta[d * 64 + i];
        if (col < 64) rv *= expf(sgc[d * 64 + i]);
        s[r] = rv;
      }
#pragma unroll 4
      for (int j = 0; j < 16 * b; j++) {
        float xj = bf2f(Xd[j * 128 + col]);
        const uint4* ar = (const uint4*)(AT + j * 72 + 16 * b);
        uint4 a0 = ar[0], a1 = ar[1];
        unsigned aw[8] = {a0.x, a0.y, a0.z, a0.w, a1.x, a1.y, a1.z, a1.w};
#pragma unroll
        for (int q = 0; q < 8; q++) {
          s[2 * q] -= __uint_as_float(aw[q] << 16) * xj;
          s[2 * q + 1] -= __uint_as_float(aw[q] & 0xffff0000u) * xj;
        }
      }
#pragma unroll
      for (int rp = 0; rp < 16; rp++) {
        u16 xb = f2bf(s[rp]);
        float xj = bf2f(xb);
        wu[(16 * b + rp) * 64 + e] = xb;
        if (b < 3) Xd[(16 * b + rp) * 128 + col] = xb;
        const uint4* ar = (const uint4*)(AT + (16 * b + rp) * 72 + 16 * b);
        uint4 a0 = ar[0], a1 = ar[1];
        unsigned aw[8] = {a0.x, a0.y, a0.z, a0.w, a1.x, a1.y, a1.z, a1.w};
#pragma unroll
        for (int r = rp + 1; r < 16; r++) {
          float av = (r & 1) ? __uint_as_float(aw[r >> 1] & 0xffff0000u) : __uint_as_float(aw[r >> 1] << 16);
          s[r] -= av * xj;
        }
      }
    }
  }
}

__device__ __forceinline__ void gdn_chain(char* smraw, const Params& p, int chain) {
  int tid = threadIdx.x; asm volatile("" : "+v"(tid)); const int _tid_pad = 0, lane = tid & 63, w = tid >> 6, fr = lane & 15, fq = lane >> 4;
  const int d = chain & 1, h = (chain >> 1) & 3, seq = chain >> 3;
  int c0, nc;
  if (seq < 8) { c0 = seq * 32; nc = 32; } else { c0 = 256 + (seq - 8) * 64; nc = 64; }
  u16* qs = (u16*)smraw;
  u16* qd = qs + 64 * 72;
  u16* ks_ = qd + 64 * 72;
  u16* kdT = ks_ + 64 * 72;
  u16* at = kdT + 64 * 72;
  u16* ST = at + 64 * 72;
  u16* VT = ST + 4 * 16 * 72;
  float* sgc = (float*)(VT + 4 * 16 * 72);
  const u16* qg = (const u16*)(p.ws + O_XN);
  const u16* kg = qg + (size_t)T_ALL * 256;
  const float* gcg = (const float*)(p.ws + O_GC);
  u16* og = (u16*)(p.ws + O_OD) + (size_t)d * T_ALL * 256;
  u16* STw = ST + w * 16 * 72;
  u16* VTw = VT + w * 16 * 72;
  f32x4 accS[4];
#pragma unroll
  for (int mt = 0; mt < 4; mt++) accS[mt] = (f32x4){0, 0, 0, 0};
  __syncthreads();
  for (int e = lane; e < 16 * 72; e += 64) STw[e] = 0;
  for (int it = 0; it < nc; it++) {
    const int ck = d == 0 ? c0 + it : c0 + nc - 1 - it;
    const int t0 = ck * 64;
    const u16* wch = (const u16*)(p.ws + O_WU) + ((size_t)(ck * 4 + h) * 2 + d) * 8192;
    const u16* uch = wch + 4096;
    const int tok_last = d == 0 ? t0 + 63 : t0;
    const float gl = gcg[(size_t)(h * 2 + d) * T_ALL + tok_last];
    {
      int row = tid >> 2, seg = tid & 3;
      int tok = d == 0 ? t0 + row : t0 + 63 - row;
      float gcv = gcg[(size_t)(h * 2 + d) * T_ALL + tok];
      if (seg == 0) sgc[row] = gcv;
      float eq = expf(gcv), ek = expf(gl - gcv);
      const u16* qr = qg + (size_t)tok * 256 + h * 64 + seg * 16;
      const u16* kr = kg + (size_t)tok * 256 + h * 64 + seg * 16;
      uint4 q0 = *(const uint4*)qr, q1 = *(const uint4*)(qr + 8);
      uint4 k0 = *(const uint4*)kr, k1 = *(const uint4*)(kr + 8);
      *(uint4*)(qs + row * 72 + seg * 16) = q0; *(uint4*)(qs + row * 72 + seg * 16 + 8) = q1;
      *(uint4*)(ks_ + row * 72 + seg * 16) = k0; *(uint4*)(ks_ + row * 72 + seg * 16 + 8) = k1;
      unsigned qa[8] = {q0.x, q0.y, q0.z, q0.w, q1.x, q1.y, q1.z, q1.w};
      unsigned ka[8] = {k0.x, k0.y, k0.z, k0.w, k1.x, k1.y, k1.z, k1.w};
#pragma unroll
      for (int i = 0; i < 8; i++) {
        float qa0 = bf2f((u16)(qa[i] & 0xffff)) * eq, qa1 = bf2f((u16)(qa[i] >> 16)) * eq;
        *(unsigned*)(qd + row * 72 + seg * 16 + 2 * i) = f2bf(qa0) | ((unsigned)f2bf(qa1) << 16);
        float kb0 = bf2f((u16)(ka[i] & 0xffff)) * ek, kb1 = bf2f((u16)(ka[i] >> 16)) * ek;
        kdT[(seg * 16 + 2 * i) * 72 + row] = f2bf(kb0);
        kdT[(seg * 16 + 2 * i + 1) * 72 + row] = f2bf(kb1);
      }
    }
    __syncthreads();
    {
      f32x4 acc[4];
#pragma unroll
      for (int nt = 0; nt < 4; nt++) acc[nt] = (f32x4){0, 0, 0, 0};
#pragma unroll
      for (int ks = 0; ks < 2; ks++) {
        bf16x8 af = *(const bf16x8*)(qs + (16 * w + fr) * 72 + ks * 32 + fq * 8);
#pragma unroll
        for (int nt = 0; nt < 4; nt++) {
          bf16x8 bfm = *(const bf16x8*)(ks_ + (16 * nt + fr) * 72 + ks * 32 + fq * 8);
          acc[nt] = __builtin_amdgcn_mfma_f32_16x16x32_bf16(af, bfm, acc[nt], 0, 0, 0);
        }
      }
#pragma unroll
      for (int nt = 0; nt < 4; nt++)
#pragma unroll
        for (int e = 0; e < 4; e++) {
          int c = 16 * w + 4 * fq + e, m = 16 * nt + fr;
          float v = c >= m ? acc[nt][e] * expf(sgc[c] - sgc[m]) : 0.f;
          at[c * 72 + m] = f2bf(v);
        }
    }
    __syncthreads();
    {
      const int e0 = 16 * w;
      f32x4 av[4];
#pragma unroll
      for (int mt = 0; mt < 4; mt++) av[mt] = (f32x4){0, 0, 0, 0};
#pragma unroll
      for (int ks = 0; ks < 2; ks++) {
        bf16x8 bS = *(const bf16x8*)(STw + fr * 72 + ks * 32 + fq * 8);
#pragma unroll
        for (int mt = 0; mt < 4; mt++) {
          bf16x8 aw = *(const bf16x8*)(wch + (16 * mt + fr) * 64 + ks * 32 + fq * 8);
          av[mt] = __builtin_amdgcn_mfma_f32_16x16x32_bf16(aw, bS, av[mt], 0, 0, 0);
        }
      }
#pragma unroll
      for (int mt = 0; mt < 4; mt++) {
        u16 hv[4];
#pragma unroll
        for (int e = 0; e < 4; e++) {
          int c = 16 * mt + 4 * fq + e;
          float vn = bf2f(uch[c * 64 + e0 + fr]) - av[mt][e];
          hv[e] = f2bf(vn);
        }
        uint2 pk; pk.x = hv[0] | ((unsigned)hv[1] << 16); pk.y = hv[2] | ((unsigned)hv[3] << 16);
        *(uint2*)(VTw + fr * 72 + 16 * mt + 4 * fq) = pk;
      }
      __builtin_amdgcn_wave_barrier();
      f32x4 ao[4];
#pragma unroll
      for (int mt = 0; mt < 4; mt++) ao[mt] = (f32x4){0, 0, 0, 0};
#pragma unroll
      for (int ks = 0; ks < 2; ks++) {
        bf16x8 bS = *(const bf16x8*)(STw + fr * 72 + ks * 32 + fq * 8);
        bf16x8 bV = *(const bf16x8*)(VTw + fr * 72 + ks * 32 + fq * 8);
#pragma unroll
        for (int mt = 0; mt < 4; mt++) {
          bf16x8 aq = *(const bf16x8*)(qd + (16 * mt + fr) * 72 + ks * 32 + fq * 8);
          bf16x8 aa = *(const bf16x8*)(at + (16 * mt + fr) * 72 + ks * 32 + fq * 8);
          ao[mt] = __builtin_amdgcn_mfma_f32_16x16x32_bf16(aq, bS, ao[mt], 0, 0, 0);
          ao[mt] = __builtin_amdgcn_mfma_f32_16x16x32_bf16(aa, bV, ao[mt], 0, 0, 0);
        }
      }
#pragma unroll
      for (int mt = 0; mt < 4; mt++)
#pragma unroll
        for (int e = 0; e < 4; e++) {
          int c = 16 * mt + 4 * fq + e;
          int tok = d == 0 ? t0 + c : t0 + 63 - c;
          og[(size_t)tok * 256 + h * 64 + e0 + fr] = f2bf(ao[mt][e]);
        }
      float egl = expf(gl);
#pragma unroll
      for (int mt = 0; mt < 4; mt++) accS[mt] = accS[mt] * egl;
#pragma unroll
      for (int ks = 0; ks < 2; ks++) {
        bf16x8 bV = *(const bf16x8*)(VTw + fr * 72 + ks * 32 + fq * 8);
#pragma unroll
        for (int mt = 0; mt < 4; mt++) {
          bf16x8 ak = *(const bf16x8*)(kdT + (16 * mt + fr) * 72 + ks * 32 + fq * 8);
          accS[mt] = __builtin_amdgcn_mfma_f32_16x16x32_bf16(ak, bV, accS[mt], 0, 0, 0);
        }
      }
      __builtin_amdgcn_wave_barrier();
#pragma unroll
      for (int mt = 0; mt < 4; mt++) {
        uint2 pk;
        pk.x = f2bf(accS[mt][0]) | ((unsigned)f2bf(accS[mt][1]) << 16);
        pk.y = f2bf(accS[mt][2]) | ((unsigned)f2bf(accS[mt][3]) << 16);
        *(uint2*)(STw + fr * 72 + 16 * mt + 4 * fq) = pk;
      }
    }
    __syncthreads();
  }
}
__device__ __forceinline__ void gdn_final_rows(const Params& p, int l, int rowblk) {
  int tid_ = threadIdx.x; asm volatile("" : "+v"(tid_));
  const int lane = tid_ & 63, w = tid_ >> 6;
  int tok = rowblk * 4 + w;
  const u16* o0 = (const u16*)(p.ws + O_OD) + (size_t)tok * 256 + lane * 4;
  const u16* o1 = o0 + (size_t)T_ALL * 256;
  const u16* zg = (const u16*)(p.ws + O_ZC) + (size_t)tok * 1024 + 768 + lane * 4;
  uint2 a = *(const uint2*)o0, b = *(const uint2*)o1, g = *(const uint2*)zg;
  float o[4], gt[4];
  o[0] = bf2f(a.x & 0xffff) + bf2f(b.x & 0xffff); o[1] = bf2f(a.x >> 16) + bf2f(b.x >> 16);
  o[2] = bf2f(a.y & 0xffff) + bf2f(b.y & 0xffff); o[3] = bf2f(a.y >> 16) + bf2f(b.y >> 16);
  gt[0] = bf2f(g.x & 0xffff); gt[1] = bf2f(g.x >> 16); gt[2] = bf2f(g.y & 0xffff); gt[3] = bf2f(g.y >> 16);
  float ss = o[0] * o[0] + o[1] * o[1] + o[2] * o[2] + o[3] * o[3];
#pragma unroll
  for (int m = 8; m > 0; m >>= 1) ss += __shfl_xor(ss, m);
  float rs = rsqrtf(ss * (1.f / 64.f) + EPSF);
  if (!(MIXMASK & 4)) rs = 0.f;
  const float* nw = p.in[24] + l * 64 + (lane & 15) * 4;
  u16 r[4];
#pragma unroll
  for (int e = 0; e < 4; e++) r[e] = f2bf(o[e] * rs * nw[e] * siluf_(gt[e]));
  uint2 pk; pk.x = r[0] | ((unsigned)r[1] << 16); pk.y = r[2] | ((unsigned)r[3] << 16);
  *(uint2*)((u16*)(p.ws + O_XN) + (size_t)2 * T_ALL * 256 + (size_t)tok * 256 + lane * 4) = pk;
}
__device__ __forceinline__ void grpnorm_rows(const Params& p, int l, int which, int rowblk) {
  int tid_ = threadIdx.x; asm volatile("" : "+v"(tid_));
  const int lane = tid_ & 63, w = tid_ >> 6;
  int tok = rowblk * 4 + w;
  u16* m = (u16*)(p.ws + O_XN) + (size_t)which * T_ALL * 256 + (size_t)tok * 256 + lane * 4;
  uint2 a = *(const uint2*)m;
  float v[4] = {bf2f(a.x & 0xffff), bf2f(a.x >> 16), bf2f(a.y & 0xffff), bf2f(a.y >> 16)};
  float ss = wave_sum(v[0] * v[0] + v[1] * v[1] + v[2] * v[2] + v[3] * v[3]);
  float rs = rsqrtf(ss * (1.f / 256.f) + EPSF);
  if (!((MIXMASK >> which) & 1)) rs = 0.f;
  const float* gn = p.in[34] + (l * 3 + which) * 256 + lane * 4;
  uint2 pk;
  pk.x = f2bf(v[0] * rs * gn[0]) | ((unsigned)f2bf(v[1] * rs * gn[1]) << 16);
  pk.y = f2bf(v[2] * rs * gn[2]) | ((unsigned)f2bf(v[3] * rs * gn[3]) << 16);
  *(uint2*)m = pk;
}

#define WST 1296
#define UST 264
__device__ __forceinline__ float hy_conv3(const u16* __restrict__ raw, int t, int L, float w0, float w1, float w2, float b) {
  float xm = t > 0 ? bf2f(raw[t - 1]) : 0.f;
  float x0 = bf2f(raw[t]);
  float xp = t + 1 < L ? bf2f(raw[t + 1]) : 0.f;
  return w0 * xm + w1 * x0 + w2 * xp + b;
}
__device__ __forceinline__ void hy_conv_item(char* smraw, const Params& p, int l, int stage, int set, int c, int tb) {
  int tid = threadIdx.x; asm volatile("" : "+v"(tid)); const int _tid_pad = 0, lane = tid & 63, w = tid >> 6, fr = lane & 15, fq = lane >> 4;
  const int L = 2048 << set, nb = 8 << set, base = set ? T_P : 0;
  const int T0 = tb * 1024;
  u16* win = (u16*)smraw;
  u16* su = win + 8 * WST;
  float* sinv = (float*)(su + 16 * UST);
  const u16* dt = (const u16*)(p.ws + O_DT);
  const u16* rawv = dt + (size_t)c * T_ALL + base;
  const u16* rawx = dt + (size_t)((stage + 1) * 256 + c) * T_ALL + base;
  const u16* y1 = (const u16*)(p.ws + O_Y1) + (size_t)c * T_ALL + base;
  u16* outp = stage == 0 ? (u16*)(p.ws + O_Y1) + (size_t)c * T_ALL + base
                         : (u16*)(p.ws + O_DT) + (size_t)(256 + c) * T_ALL + base;
  const u16* kr = (const u16*)(p.ws + O_HYKR) + (set ? HYKR1 : 0) + ((size_t)stage * 256 + c) * (2 * L);
  const float* cw = p.in[25] + (size_t)l * 3 * 768;
  const float* cb = p.in[26] + (size_t)l * 768;
  const float v0 = cw[c], v1 = cw[768 + c], v2 = cw[1536 + c], vb = cb[c];
  const int xc_ = (stage + 1) * 256 + c;
  const float x0w = cw[xc_], x1w = cw[768 + xc_], x2w = cw[1536 + xc_], xbw = cb[xc_];
  __syncthreads();
  if (tid < 64) {
    const float* ps = (const float*)(p.ws + O_HYPS) + (size_t)(set ? 32 * 512 : 0);
    int ntb = L / 64;
    float s = 0.f;
    for (int i = lane; i < ntb; i += 64) s += ps[(size_t)i * 512 + stage * 256 + c];
    s = wave_sum(s);
    if (lane == 0) sinv[0] = 1.f / s;
  }
  f32x4 acc[16];
#pragma unroll
  for (int i = 0; i < 16; i++) acc[i] = (f32x4){0, 0, 0, 0};
  for (int S0 = 0; S0 < L; S0 += 256) {
    __syncthreads();
    const int B0 = S0 - T0;
    for (int idx = tid; idx < 8 * 160; idx += 256) {
      int rho = idx / 160, gi = idx % 160;
      int ybase = B0 - 1016 + 8 * gi - rho + L;
      u16 hh[8];
#pragma unroll
      for (int e = 0; e < 8; e++) { int yy = ybase + e; hh[e] = (yy >= 0 && yy < 2 * L) ? kr[yy] : (u16)0; }
      uint4 pk;
      pk.x = hh[0] | ((unsigned)hh[1] << 16); pk.y = hh[2] | ((unsigned)hh[3] << 16);
      pk.z = hh[4] | ((unsigned)hh[5] << 16); pk.w = hh[6] | ((unsigned)hh[7] << 16);
      *(uint4*)(win + rho * WST + 8 * gi) = pk;
    }
    {
      int b = tid >> 4, seg = tid & 15;
      u16 hh[16];
      if (b < nb) {
        const u16* src = (stage == 0 ? rawv : y1) + (size_t)b * L;
#pragma unroll
        for (int e = 0; e < 16; e++) {
          int s = S0 + seg * 16 + e;
          hh[e] = stage == 0 ? f2bf(hy_conv3(src, s, L, v0, v1, v2, vb)) : src[s];
        }
      } else {
#pragma unroll
        for (int e = 0; e < 16; e++) hh[e] = 0;
      }
      uint4 p0, p1;
      p0.x = hh[0] | ((unsigned)hh[1] << 16); p0.y = hh[2] | ((unsigned)hh[3] << 16);
      p0.z = hh[4] | ((unsigned)hh[5] << 16); p0.w = hh[6] | ((unsigned)hh[7] << 16);
      p1.x = hh[8] | ((unsigned)hh[9] << 16); p1.y = hh[10] | ((unsigned)hh[11] << 16);
      p1.z = hh[12] | ((unsigned)hh[13] << 16); p1.w = hh[14] | ((unsigned)hh[15] << 16);
      *(uint4*)(su + b * UST + seg * 16) = p0;
      *(uint4*)(su + b * UST + seg * 16 + 8) = p1;
    }
    __syncthreads();
    bf16x8 bfr[8];
#pragma unroll
    for (int j = 0; j < 8; j++) bfr[j] = *(const bf16x8*)(su + fr * UST + 32 * j + 8 * fq);
    const u16* wbase = win + (fr & 7) * WST + (8 * fq - 256 * w - 8 * (fr >> 3) + 1016);
#pragma unroll
    for (int dd = 0; dd < 30; dd++) {
      bf16x8 af = *(const bf16x8*)(wbase + 16 * (dd - 15));
#pragma unroll
      for (int j = 0; j < 8; j++) {
        const int i = 2 * j - (dd - 15);
        if (i >= 0 && i < 16) acc[i] = __builtin_amdgcn_mfma_f32_16x16x32_bf16(af, bfr[j], acc[i], 0, 0, 0);
      }
    }
  }
  __syncthreads();
  const float inv = sinv[0];
  const float bias = p.in[33][(size_t)(l * 2 + stage) * 256 + c];
  if (fr < nb) {
#pragma unroll
    for (int i = 0; i < 16; i++) {
      u16 r[4];
#pragma unroll
      for (int e = 0; e < 4; e++) {
        int t = T0 + 256 * w + 16 * i + 4 * fq + e;
        float uval = stage == 0 ? hy_conv3(rawv + (size_t)fr * L, t, L, v0, v1, v2, vb) : bf2f(y1[(size_t)fr * L + t]);
        float xg = hy_conv3(rawx + (size_t)fr * L, t, L, x0w, x1w, x2w, xbw);
        r[e] = f2bf(xg * (acc[i][e] * inv + bias * uval));
      }
      uint2 pk; pk.x = r[0] | ((unsigned)r[1] << 16); pk.y = r[2] | ((unsigned)r[3] << 16);
      *(uint2*)(outp + (size_t)fr * L + T0 + 256 * w + 16 * i + 4 * fq) = pk;
    }
  }
}
__device__ __forceinline__ void hy_final_item(char* smraw, const Params& p, int l, int ck) {
  int tid = threadIdx.x; asm volatile("" : "+v"(tid)); const int _tid_pad = 0, lane = tid & 63, w = tid >> 6;
  float* s = (float*)smraw;
  const u16* yd = (const u16*)(p.ws + O_DT) + (size_t)256 * T_ALL;
  const int t0 = ck * 64;
  __syncthreads();
  for (int i = 0; i < 64; i++) {
    int c = w * 64 + i;
    s[lane * 257 + c] = bf2f(yd[(size_t)c * T_ALL + t0 + lane]);
  }
  __syncthreads();
  const float* gn = p.in[34] + (l * 3 + 2) * 256;
  u16* mixD = (u16*)(p.ws + O_XN) + (size_t)3 * T_ALL * 256;
  for (int i = 0; i < 16; i++) {
    int tt = w * 16 + i;
    float v[4];
#pragma unroll
    for (int e = 0; e < 4; e++) v[e] = s[tt * 257 + lane * 4 + e];
    float ss = wave_sum(v[0] * v[0] + v[1] * v[1] + v[2] * v[2] + v[3] * v[3]);
    float rs = rsqrtf(ss * (1.f / 256.f) + EPSF);
    if (!(MIXMASK & 8)) rs = 0.f;
    uint2 pk;
    pk.x = f2bf(v[0] * rs * gn[lane * 4]) | ((unsigned)f2bf(v[1] * rs * gn[lane * 4 + 1]) << 16);
    pk.y = f2bf(v[2] * rs * gn[lane * 4 + 2]) | ((unsigned)f2bf(v[3] * rs * gn[lane * 4 + 3]) << 16);
    *(uint2*)(mixD + (size_t)(t0 + tt) * 256 + lane * 4) = pk;
  }
}

#define XB_CENS(j) (64 + 64 * (j))
#define XB_XSUB(j) (1088 + 64 * (j))
#define XB_XGEN(j) (2112 + 64 * (j))
#define XB_TOP 3136
#define XB_TOPGEN 3200
__device__ __forceinline__ unsigned xb_ld(unsigned* p) { return __hip_atomic_load(p, __ATOMIC_RELAXED, __HIP_MEMORY_SCOPE_AGENT); }
__device__ __forceinline__ unsigned xb_add(unsigned* p, unsigned v) { return __hip_atomic_fetch_add(p, v, __ATOMIC_RELAXED, __HIP_MEMORY_SCOPE_AGENT); }
__device__ __forceinline__ void xcd_barrier(unsigned* bar, unsigned x, unsigned nloc, unsigned nx, unsigned k) {
  asm volatile("s_waitcnt vmcnt(0) lgkmcnt(0)" ::: "memory");
  __syncthreads();
  if (threadIdx.x == 0) {
    const unsigned old = xb_add(&bar[XB_XSUB(x)], 1u);
    if (old + 1u == k * nloc) {
      __builtin_amdgcn_fence(__ATOMIC_RELEASE, "agent");
      asm volatile("s_waitcnt vmcnt(0)" ::: "memory");
      const unsigned og = xb_add(&bar[XB_TOP], 1u);
      if (og + 1u == k * nx) xb_add(&bar[XB_TOPGEN], 1u);
      else while (xb_ld(&bar[XB_TOPGEN]) < k) __builtin_amdgcn_s_sleep(1);
      __builtin_amdgcn_fence(__ATOMIC_ACQUIRE, "agent");
      xb_add(&bar[XB_XGEN(x)], 1u);
      asm volatile("s_waitcnt vmcnt(0)" ::: "memory");
    } else {
      while (xb_ld(&bar[XB_XGEN(x)]) < k) __builtin_amdgcn_s_sleep(1);
      __builtin_amdgcn_fence(__ATOMIC_ACQUIRE, "agent");
      asm volatile("s_waitcnt vmcnt(0)" ::: "memory");
    }
  }
  __syncthreads();
}
#define GRID_SYNC() do { ++bar_k; xcd_barrier(bar, bst[0], bst[1], bst[2], bar_k); } while (0)

#define TILE_LOOP(nM_, nN_, MT, NT)                                                                  \
  const int nSN_ = ((nN_) + 7) >> 3, nS_ = (((nM_) + 7) >> 3) * nSN_, P_ = nblk >> 3;                 \
  _Pragma("unroll 1") for (int S_ = (bid & 7); S_ < nS_ && (bid >> 3) < P_; S_ += 8)                 \
  _Pragma("unroll 1") for (int q_ = (bid >> 3); q_ < 64; q_ += P_)                                   \
    for (int MT = (S_ / nSN_) * 8 + (q_ >> 3), NT = (S_ % nSN_) * 8 + (q_ & 7), once_ = 1; once_ && MT < (nM_) && NT < (nN_); once_ = 0)

__global__ void __launch_bounds__(256, 2) mega(Params p) {
  cg::grid_group grid = cg::this_grid();
  __shared__ __attribute__((aligned(16))) char smraw[SMEM_BYTES];
  u16* smem = (u16*)smraw;
  float* smf = (float*)smraw;
  const int bid = blockIdx.x, nblk = gridDim.x, tid = threadIdx.x;
  const int rbid = nblk - 1 - bid;
  const int lane = tid & 63;
  char* const ws = p.ws;
  unsigned* const bar = (unsigned*)(ws + O_BAR);
  __shared__ unsigned bst[4];
  unsigned bar_k = 0;
  if (tid == 0) { bst[0] = (unsigned)__builtin_amdgcn_s_getreg((3 << 11) | 20) & 0xFu; xb_add(&bar[XB_CENS(bst[0])], 1u); }
  __threadfence();
  grid.sync();
  if (tid == 0) {
    unsigned mine = 0, cnt = 0;
    for (unsigned j = 0; j < 16; j++) { unsigned c = xb_ld(&bar[XB_CENS(j)]); cnt += c > 0u ? 1u : 0u; if (j == bst[0]) mine = c; }
    bst[1] = mine; bst[2] = cnt;
  }
  __syncthreads();

#ifdef NANFILL
  {
    uint4 nanv = make_uint4(0x7FC07FC0u, 0x7FC07FC0u, 0x7FC07FC0u, 0x7FC07FC0u);
    uint4* w4 = (uint4*)ws;
    for (size_t i = (size_t)bid * 256 + tid; i < WS_TOTAL / 16; i += (size_t)nblk * 256) w4[i] = nanv;
    uint4* o4 = (uint4*)p.out;
    for (size_t i = (size_t)bid * 256 + tid; i < (size_t)T_ALL * DM / 4; i += (size_t)nblk * 256) o4[i] = nanv;
    __threadfence(); grid.sync(); __threadfence();
  }
#endif
#pragma unroll 1
  for (int lay = 0; lay < 2; lay++) {
    {
      int l = lay; asm volatile("" : "+s"(l));
#pragma unroll 1
      for (int i = bid; i < 42 * 16; i += nblk) transpose_tile(smf, p.in[3] + (size_t)l * 1024 * 2576, 2576, p.in[2] + l * 1024, (u16*)(ws + O_WIN), 1024, 0, (i / 16) * 64, (i % 16) * 64);
#pragma unroll 1
      for (int i = rbid; i < 16 * 16; i += nblk) transpose_tile(smf, p.in[35] + (size_t)l * 1024 * 1024, 1024, nullptr, (u16*)(ws + O_WOUT), 1024, 1, (i / 16) * 64, (i % 16) * 64);
#pragma unroll 1
      for (int i = bid; i < 88 * 16; i += nblk) transpose_tile(smf, p.in[37] + (size_t)l * 1024 * 5632, 5632, p.in[36] + l * 1024, (u16*)(ws + O_WUP), 1024, 2, (i / 16) * 64, (i % 16) * 64);
#pragma unroll 1
      for (int i = rbid; i < 16 * 44; i += nblk) transpose_tile(smf, p.in[40] + (size_t)l * 2816 * 1024, 1024, nullptr, (u16*)(ws + O_WDN), 2816, 3, (i / 44) * 64, (i % 44) * 64);
#pragma unroll 1
      for (int i = bid; i < 16; i += nblk) transpose_tile(smf, p.in[19] + (size_t)l * 256 * 256, 256, nullptr, (u16*)(ws + O_WGLU), 256, 4, (i / 4) * 64, (i % 4) * 64);
#pragma unroll 1
      for (int i = rbid; i < 64; i += nblk) {
        u16* wl = (u16*)(ws + O_WLRU);
        for (int e = i * 1024 + tid; e < (i + 1) * 1024; e += 256) {
          int k = e & 63, n = (e >> 6) & 255, head = e >> 14;
          int d = n >> 7, gate = (n >> 6) & 1, j = n & 63;
          const float* wr_ = p.in[6]; const float* wi_ = p.in[8];
          size_t off_ = ((size_t)((l * 2 + d) * 4 + head) * 64 + k) * 64 + j;
          float vr_ = wr_[off_], vi_ = wi_[off_];
          wl[e] = f2bf(gate ? vi_ : vr_);
        }
      }
#pragma unroll 1
      for (int i = bid; i < 16 * 2 * 65; i += nblk) s5_prep_item(smf, p, l, i);
#pragma unroll 1
      for (int i = rbid; i < 16 * 2 * 64; i += nblk) s5_bts_item(p, l, i);
#pragma unroll 1
      for (int i = rbid; i < 96; i += nblk) hy_filter_item(smf, p, l, i < 32 ? 0 : 1, i < 32 ? i : i - 32);
#pragma unroll 1
      for (int i = bid; i < T_ALL / 4; i += nblk) rms_rows_to_bf16(p, l, i);
    }
    GRID_SYNC();
    {
      int l = lay; asm volatile("" : "+s"(l));
      TILE_LOOP(640, 21, mt, nt) {
        { const float* H = gemm_tile(smem, (const u16*)(ws + O_XN), 1024, mt * 128, 0, T_ALL, 30, 0, (const u16*)(ws + O_WIN) + (size_t)nt * 128 * 1024, 1024, 1024);
            int tid_o = threadIdx.x; asm volatile("" : "+v"(tid_o));
            const int tok0 = mt * 128;
            if (nt < 4) {
              u16* zA = (u16*)(ws + O_ZA) + (size_t)tok0 * 512 + nt * 128;
              EPI_ROWS(H, { *(uint2*)(zA + (size_t)r * 512 + c) = pack4(v.x, v.y, v.z, v.w); })
            } else if (nt < 6) {
              u16* uh = (u16*)(ws + O_UH);
              EPI_ROWS(H, {
                int tok = tok0 + r, ch = (nt - 4) * 128 + c;
                *(uint2*)(uh + ((size_t)(ch >> 4) * 1280 + (tok >> 6)) * 1280 + (tok & 63) * 16 + (ch & 15)) = pack4(v.x, v.y, v.z, v.w); })
            } else if (nt < 14) {
              u16* zC = (u16*)(ws + O_ZC) + (size_t)tok0 * 1024 + (nt - 6) * 128;
              EPI_ROWS(H, { *(uint2*)(zC + (size_t)r * 1024 + c) = pack4(v.x, v.y, v.z, v.w); })
            } else if (nt < 20) {
              u16* dt = (u16*)(ws + O_DT) + (size_t)((nt - 14) * 128 + (tid_o & 127)) * T_ALL + tok0 + (tid_o >> 7) * 64;
              const float* Hc = H + (tid_o >> 7) * 64 * HST + (tid_o & 127);
#pragma unroll 2
              for (int k = 0; k < 8; k++) {
                uint2 a = pack4(Hc[(8 * k) * HST], Hc[(8 * k + 1) * HST], Hc[(8 * k + 2) * HST], Hc[(8 * k + 3) * HST]);
                uint2 b = pack4(Hc[(8 * k + 4) * HST], Hc[(8 * k + 5) * HST], Hc[(8 * k + 6) * HST], Hc[(8 * k + 7) * HST]);
                uint4 pk; pk.x = a.x; pk.y = a.y; pk.z = b.x; pk.w = b.y;
                *(uint4*)(dt + 8 * k) = pk;
              }
            } else {
              float* ba = (float*)(ws + O_BA) + (size_t)tok0 * 16;
#pragma unroll 2
              for (int k = 0; k < 8; k++) { int idx = tid_o + 256 * k; ba[idx] = H[(idx >> 4) * HST + (idx & 15)]; }
            }
          }
      }
#pragma unroll 1
      for (int it = rbid; it < 16 * 1024; it += nblk) s5_expand_item(p, l, it);
    }
    GRID_SYNC();
    {
      int l = lay; asm volatile("" : "+s"(l));
#pragma unroll 1
      for (int it = bid; it < NCH64 * 4; it += nblk) gdn_g1_item(smraw, p, l, it);
#pragma unroll 1
      for (int it = rbid; it < 16 * 10 * 2; it += nblk) {
        const int g = it / 20, mt = (it % 20) >> 1, nt = it & 1;
        { const float* H = gemm_tile(smem, (const u16*)(ws + O_UH) + (size_t)g * 1280 * 1280, 1280, mt * 128, 0, 1280, 30, 0,
                  (const u16*)(ws + O_BTS) + (size_t)g * 256 * 1024 + (size_t)nt * 128 * 1024, 1024, 1024);
            int tid_o = threadIdx.x; asm volatile("" : "+v"(tid_o));
            float* send = (float*)(ws + O_SEND) + (size_t)g * 1280 * 256 + (size_t)mt * 128 * 256 + nt * 128;
            EPI_ROWS(H, { *(float4*)(send + (size_t)r * 256 + c) = v; })
          }
      }
#pragma unroll 1
      for (int it = bid; it < NCH32 * 4; it += nblk) lru_item(smraw, p, l, it, 0);
    }
    GRID_SYNC();
    {
      int l = lay; asm volatile("" : "+s"(l));
#pragma unroll 1
      for (int it = bid; it < 192; it += nblk) gdn_chain(smraw, p, it);
#pragma unroll 1
      for (int it = rbid; it < 48; it += nblk) lru_propagate(p, it * 256 + tid);
#pragma unroll 1
      for (int it = rbid - 48; it < 192; it += nblk) { if (it >= 0) s5_propagate(p, l, it * 256 + tid); }
      unsigned* hq = (unsigned*)(ws + O_BAR + 192) + l;
      int* hslot = (int*)(smraw + SMEM_BYTES - 16);
#pragma unroll 1
      for (;;) {
        __syncthreads();
        if (tid == 0) *hslot = (int)atomicAdd(hq, 1u);
        __syncthreads();
        const int item = *hslot;
        if (item >= 512) break;
        const int set = item < 256 ? 1 : 0, c = item & 255, ntb = set ? 4 : 2;
#pragma unroll 1
        for (int tb = 0; tb < ntb; tb++) hy_conv_item(smraw, p, l, 0, set, c, tb);
        __threadfence();
        __syncthreads();
#pragma unroll 1
        for (int tb = 0; tb < ntb; tb++) hy_conv_item(smraw, p, l, 1, set, c, tb);
      }
    }
    GRID_SYNC();
    {
      int l = lay; asm volatile("" : "+s"(l));
#pragma unroll 1
      for (int it = rbid; it < 16 * 10 * 8; it += nblk) {
        const int g = it / 80, mt = (it % 80) >> 3, nt = it & 7;
        { const float* H = gemm_tile(smem, (const u16*)(ws + O_UH) + (size_t)g * 1280 * 1280, 1280, mt * 128, 0, 1280, 30, 0,
                  (const u16*)(ws + O_BTY) + (size_t)g * 1024 * 1280 + (size_t)nt * 128 * 1280, 1280, 1280);
            int tid_o = threadIdx.x; asm volatile("" : "+v"(tid_o));
            u16* zb = (u16*)(ws + O_XN) + (size_t)3 * T_ALL * 256;
            EPI_ROWS(H, {
              int ck = mt * 128 + r, n = nt * 128 + c;
              *(uint2*)(zb + ((size_t)g * T_ALL + ck * 64 + (n >> 4)) * 16 + (n & 15)) = pack4(geluf_(v.x), geluf_(v.y), geluf_(v.z), geluf_(v.w)); })
          }
      }
#pragma unroll 1
      for (int it = bid; it < NCH32 * 4; it += nblk) lru_item(smraw, p, l, it, 1);
#pragma unroll 1
      for (int it = rbid; it < T_ALL / 4; it += nblk) gdn_final_rows(p, l, it);
    }
    GRID_SYNC();
    {
      int l = lay; asm volatile("" : "+s"(l));
#pragma unroll 1
      for (int it = bid; it < 640 * 2; it += nblk) {
        const int mt = it >> 1, nt = it & 1;
        const u16* zb = (const u16*)(ws + O_XN) + (size_t)3 * T_ALL * 256;
        { const float* H = gemm_tile(smem, zb, 16, mt * 128, 0, T_ALL, 4, (size_t)T_ALL * 16, (const u16*)(ws + O_WGLU) + (size_t)nt * 128 * 256, 256, 256);
            int tid_o = threadIdx.x; asm volatile("" : "+v"(tid_o));
            u16* mixB = (u16*)(ws + O_XN) + (size_t)T_ALL * 256 + (size_t)mt * 128 * 256 + nt * 128;
            const u16* zr = zb + (size_t)mt * 128 * 16;
            const float* gb = p.in[20] + l * 256 + nt * 128;
            EPI_ROWS(H, {
              uint2 zz = *(const uint2*)(zr + ((size_t)((nt * 128 + c) >> 4) * T_ALL + r) * 16 + (c & 15));
              float4 g4 = *(const float4*)(gb + c);
              float z0 = bf2f(zz.x & 0xffff), z1 = bf2f(zz.x >> 16), z2 = bf2f(zz.y & 0xffff), z3 = bf2f(zz.y >> 16);
              *(uint2*)(mixB + (size_t)r * 256 + c) = pack4(z0 * sigmoidf_(v.x + g4.x), z1 * sigmoidf_(v.y + g4.y), z2 * sigmoidf_(v.z + g4.z), z3 * sigmoidf_(v.w + g4.w)); })
          }
      }
#pragma unroll 1
      for (int it = rbid; it < T_ALL / 4; it += nblk) grpnorm_rows(p, l, 0, it);
    }
    GRID_SYNC();
    {
      int l = lay; asm volatile("" : "+s"(l));
#pragma unroll 1
      for (int it = bid; it < NCH64; it += nblk) hy_final_item(smraw, p, l, it);
#pragma unroll 1
      for (int it = rbid; it < T_ALL / 4; it += nblk) grpnorm_rows(p, l, 1, it);
    }
    GRID_SYNC();
    {
      int l = lay; asm volatile("" : "+s"(l));
      TILE_LOOP(640, 8, mt, nt) {
        { const float* H = gemm_tile(smem, (const u16*)(ws + O_XN), 256, mt * 128, 0, T_ALL, 8, (size_t)T_ALL * 256,
                  (const u16*)(ws + O_WOUT) + (size_t)nt * 128 * 1024, 1024, 1024);
            int tid_o = threadIdx.x; asm volatile("" : "+v"(tid_o));
            float* o = p.out + (size_t)mt * 128 * DM + nt * 128;
            EPI_ROWS(H, {
              float4 b4 = *(const float4*)(xrow(p, l, mt * 128 + r) + nt * 128 + c);
              float4 o4; o4.x = b4.x + v.x; o4.y = b4.y + v.y; o4.z = b4.z + v.z; o4.w = b4.w + v.w;
              *(float4*)(o + (size_t)r * DM + c) = o4; })
          }
      }
    }
    GRID_SYNC();
    {
      int l = lay; asm volatile("" : "+s"(l));
#pragma unroll 1
      for (int it = bid; it < T_ALL / 4; it += nblk) rms_rows_to_bf16(p, 1, it);
    }
    GRID_SYNC();
    {
      int l = lay; asm volatile("" : "+s"(l));
      const int nM = 8 * 17 + 16 * 33;
      TILE_LOOP(nM, 44, mi, nt) {
        int seq, ti, L;
        if (mi < 136) { seq = mi / 17; ti = mi % 17; L = 2048; }
        else { seq = 8 + (mi - 136) / 33; ti = (mi - 136) % 33; L = 4096; }
        const int s0 = seq < 8 ? seq * 2048 : T_P + (seq - 8) * 4096;
        const int arow0 = s0 + 126 * ti - 1;
        const int nvalid = min(126, L - 126 * ti);
        { const float* H = gemm_tile(smem, (const u16*)(ws + O_XN), 1024, arow0, s0, s0 + L, 30, 0, (const u16*)(ws + O_WUP) + (size_t)nt * 128 * 1024, 1024, 1024);
            int tid_o = threadIdx.x; asm volatile("" : "+v"(tid_o));
            const int j = tid_o & 63, rg = tid_o >> 6;
            const float* cw = p.in[38] + (size_t)l * 3 * 5632;
            const float* cb = p.in[39] + (size_t)l * 5632;
            const int cg_ = nt * 64 + j, cv_ = DFF + nt * 64 + j;
            const float g0 = cw[cg_], g1 = cw[5632 + cg_], g2 = cw[2 * 5632 + cg_], gb = cb[cg_];
            const float u0 = cw[cv_], u1 = cw[5632 + cv_], u2 = cw[2 * 5632 + cv_], ub = cb[cv_];
            u16* hm = (u16*)(ws + O_HMID) + (size_t)arow0 * DFF + nt * 64 + j;
#pragma unroll 2
            for (int r = 1 + rg; r <= nvalid; r += 4) {
              float gate = g0 * H[(r - 1) * HST + j] + g1 * H[r * HST + j] + g2 * H[(r + 1) * HST + j] + gb;
              float val = u0 * H[(r - 1) * HST + 64 + j] + u1 * H[r * HST + 64 + j] + u2 * H[(r + 1) * HST + 64 + j] + ub;
              hm[(size_t)r * DFF] = f2bf(siluf_(gate) * val);
            }
          }
      }
    }
    GRID_SYNC();
    {
      int l = lay; asm volatile("" : "+s"(l));
      TILE_LOOP(640, 8, mt, nt) {
        { const float* H = gemm_tile(smem, (const u16*)(ws + O_HMID), DFF, mt * 128, 0, T_ALL, 30, 0, (const u16*)(ws + O_WDN) + (size_t)nt * 128 * DFF, DFF, DFF);
            int tid_o = threadIdx.x; asm volatile("" : "+v"(tid_o));
            float* o = p.out + (size_t)mt * 128 * DM + nt * 128;
            EPI_ROWS(H, {
              float4 b4 = *(const float4*)(o + (size_t)r * DM + c);
              b4.x += v.x; b4.y += v.y; b4.z += v.z; b4.w += v.w;
              *(float4*)(o + (size_t)r * DM + c) = b4; })
          }
      }
    }
    GRID_SYNC();
  }
  {
    const int w = tid >> 6;
    const float* fn = p.in[41];
#pragma unroll 1
    for (int it = bid; it < T_ALL / 4; it += nblk) {
      int tok = it * 4 + w;
      float* x = p.out + (size_t)tok * DM;
      float4 v[4];
      float ss = 0.f;
#pragma unroll
      for (int i = 0; i < 4; i++) {
        v[i] = *(const float4*)(x + i * 256 + lane * 4);
        ss += v[i].x * v[i].x + v[i].y * v[i].y + v[i].z * v[i].z + v[i].w * v[i].w;
      }
      ss = wave_sum(ss);
      float rs = rsqrtf(ss * (1.f / 1024.f) + EPSF);
#pragma unroll
      for (int i = 0; i < 4; i++) {
        float4 g = *(const float4*)(fn + i * 256 + lane * 4);
        float4 o; o.x = v[i].x * rs * g.x; o.y = v[i].y * rs * g.y; o.z = v[i].z * rs * g.z; o.w = v[i].w * rs * g.w;
        *(float4*)(x + i * 256 + lane * 4) = o;
      }
    }
  }
}

extern "C" void kernel_launch(void* const* d_in, const int* in_sizes, int n_in,
                              void* d_out, int out_size, void* d_ws, size_t ws_size,
                              hipStream_t stream) {
  static int grid_blocks = 0;
  if (!grid_blocks) {
    int dev = 0, cus = 0, per_cu = 0;
    (void)hipGetDevice(&dev);
    (void)hipDeviceGetAttribute(&cus, hipDeviceAttributeMultiprocessorCount, dev);
    (void)hipOccupancyMaxActiveBlocksPerMultiprocessor(&per_cu, mega, 256, 0);
    if (per_cu > 2) per_cu = 2;
    if (per_cu < 1) per_cu = 1;
    grid_blocks = cus * per_cu;
  }
  if (ws_size < WS_TOTAL) fprintf(stderr, "workspace too small: %zu < %zu\n", ws_size, (size_t)WS_TOTAL);
  Params p{};
  for (int i = 0; i < 42; i++) p.in[i] = (const float*)d_in[i];
  p.out = (float*)d_out;
  p.ws = (char*)d_ws;
  (void)hipMemsetAsync((char*)d_ws + O_BAR, 0, 16384, stream);
  void* args[] = {&p};
  hipError_t e = hipLaunchCooperativeKernel((void*)mega, dim3(grid_blocks), dim3(256), args, 0, stream);
  if (e != hipSuccess) fprintf(stderr, "coop launch failed: %s (grid %d)\n", hipGetErrorString(e), grid_blocks);
}
```

```cpp
#include <hip/hip_runtime.h>
#include <hip/hip_bf16.h>
#include <hip/hip_cooperative_groups.h>
#include <cstdio>
namespace cg = cooperative_groups;

typedef unsigned short u16;
using bf16x8 = __attribute__((ext_vector_type(8))) short;
using f32x4 = __attribute__((ext_vector_type(4))) float;

#define T_ALL 81920
#define T_P 16384
#define DM 1024
#define NZ 2688
#define DFF 2816
#define NCH32 2560
#define NCH64 1280
#define EPSF 1e-6f

constexpr size_t al(size_t x) { return (x + 255) & ~(size_t)255; }
constexpr size_t O_WIN = 0;
constexpr size_t O_WOUT = O_WIN + al((size_t)NZ * 1024 * 2);
constexpr size_t O_WUP = O_WOUT + al((size_t)1024 * 1024 * 2);
constexpr size_t O_WDN = O_WUP + al((size_t)5632 * 1024 * 2);
constexpr size_t O_WLRU = O_WDN + al((size_t)1024 * 2816 * 2);
constexpr size_t O_WGLU = O_WLRU + al((size_t)4 * 256 * 64 * 2);
constexpr size_t O_AB64 = O_WGLU + al((size_t)256 * 256 * 2);
constexpr size_t O_KTAB = O_AB64 + 2 * al((size_t)2 * 16 * 64 * 2 * 4);
constexpr size_t O_BTY = O_KTAB + al((size_t)16 * 2 * 64 * 256 * 4);
constexpr size_t O_BTS = O_BTY + al((size_t)16 * 1024 * 1280 * 2);
constexpr size_t O_HYKR = O_BTS + al((size_t)16 * 256 * 1024 * 2);
constexpr size_t HYKR1 = (size_t)2 * 256 * 4096;
constexpr size_t O_HYPS = O_HYKR + al((size_t)2 * 256 * (4096 + 8192) * 2);
constexpr size_t O_XN = O_HYPS + al((size_t)(32 + 64) * 512 * 4);
constexpr size_t O_ZA = O_XN + al((size_t)T_ALL * 1024 * 2);
constexpr size_t O_UH = O_ZA + al((size_t)T_ALL * 512 * 2);
constexpr size_t O_ZC = O_UH + al((size_t)16 * 1280 * 1280 * 2);
constexpr size_t O_BA = O_ZC + al((size_t)T_ALL * 1024 * 2);
constexpr size_t O_DT = O_BA + al((size_t)T_ALL * 16 * 4);
constexpr size_t O_WU = O_DT + al((size_t)768 * T_ALL * 2);
constexpr size_t O_GC = O_WU + al((size_t)NCH64 * 4 * 2 * 2 * 4096 * 2);
constexpr size_t O_OD = O_GC + al((size_t)T_ALL * 8 * 4);
constexpr size_t O_Y1 = O_OD + al((size_t)2 * T_ALL * 256 * 2);
constexpr size_t O_SEND = O_Y1 + al((size_t)256 * T_ALL * 2);
constexpr size_t O_LCAR = O_SEND + al((size_t)16 * 1280 * 256 * 4);
constexpr size_t O_LHIN = O_LCAR + al((size_t)NCH32 * 512 * 8);
constexpr size_t O_BAR = O_LHIN + al((size_t)NCH32 * 512 * 4);
constexpr size_t WS_TOTAL = O_BAR + 16384;
static_assert(WS_TOTAL <= (size_t)1073741824, "ws");
constexpr size_t O_HMID = O_ZA;
static_assert(O_HMID + (size_t)T_ALL * DFF * 2 <= O_GC, "hmid alias");

struct Params {
  const float* in[42];
  float* out;
  char* ws;
};

#define SMEM_BYTES 73728
#ifndef MIXMASK
#define MIXMASK 15
#endif

__device__ __forceinline__ u16 f2bf(float f) {
  unsigned u = __float_as_uint(f);
  u += 0x7fffu + ((u >> 16) & 1u);
  return (u16)(u >> 16);
}
__device__ __forceinline__ float bf2f(u16 h) { return __uint_as_float(((unsigned)h) << 16); }
__device__ __forceinline__ float sigmoidf_(float x) { return 1.f / (1.f + __expf(-x)); }
__device__ __forceinline__ float siluf_(float x) { return x / (1.f + __expf(-x)); }
__device__ __forceinline__ float softplusf_(float x) { return x > 20.f ? x : log1pf(expf(x)); }
__device__ __forceinline__ float geluf_(float x) {
  float t = tanhf(0.7978845608028654f * (x + 0.044715f * x * x * x));
  return 0.5f * x * (1.f + t);
}
__device__ __forceinline__ float wave_sum(float v) {
#pragma unroll
  for (int o = 32; o > 0; o >>= 1) v += __shfl_xor(v, o);
  return v;
}
__device__ __forceinline__ const float* xrow(const Params& p, int l, int tok) {
  const float* a = p.in[0]; const float* b = p.in[1]; const float* o = p.out;
  const float* r0 = a + (size_t)tok * DM;
  const float* r1 = b + (size_t)(tok - T_P) * DM;
  const float* r2 = o + (size_t)tok * DM;
  return l == 0 ? (tok < T_P ? r0 : r1) : r2;
}
__device__ __forceinline__ void seq_bounds(int tok, int& lo, int& hi) {
  if (tok < T_P) { lo = tok & ~2047; hi = lo + 2048; }
  else { lo = T_P + ((tok - T_P) & ~4095); hi = lo + 4096; }
}

#define GST 72
#define HST 132
__device__ __forceinline__ const float* gemm_tile(u16* smem, const u16* __restrict__ A, long lda, int arow0, int alo, int ahi,
                                          int segShift, size_t segStride,
                                          const u16* __restrict__ Bt, long ldb, int K) {
  u16* sA = smem;
  u16* sB = smem + 2 * 128 * GST;
  int tid = threadIdx.x; asm volatile("" : "+v"(tid)); const int _tid_pad = 0, lane = tid & 63, w = tid >> 6;
  const int wm = w >> 1, wn = w & 1, fr = lane & 15, fq = lane >> 4;
  const int cc = tid & 7, r0 = tid >> 3;
  f32x4 acc[4][4];
#pragma unroll
  for (int i = 0; i < 4; i++)
#pragma unroll
    for (int j = 0; j < 4; j++) acc[i][j] = (f32x4){0.f, 0.f, 0.f, 0.f};
  uint4 ra0x, ra1x, ra2x, ra3x, rb0x, rb1x, rb2x, rb3x;
  const int nk = K >> 6;
#define GROW(i_, AP, BP, OK) const bool OK = (arow0 + r0 + 32 * i_) >= alo && (arow0 + r0 + 32 * i_) < ahi;        \
    const u16* AP = A + (long)(OK ? (arow0 + r0 + 32 * i_) : alo) * lda;                                             \
    const u16* BP = Bt + (long)(r0 + 32 * i_) * ldb + cc * 8;
  GROW(0, ap0, bp0, ok0) GROW(1, ap1, bp1, ok1) GROW(2, ap2, bp2, ok2) GROW(3, ap3, bp3, ok3)
#define GLOAD1(AP, BP, OK, RA, RB) {                                                \
      uint4 t_ = *(const uint4*)(AP + aoff_);                                         \
      RA = OK ? t_ : make_uint4(0, 0, 0, 0);                                          \
      RB = *(const uint4*)(BP + k0_); }
#define GLOAD(kt_, S) do {                                                         \
    const int k0_ = (kt_) << 6;                                                       \
    const int kk_ = k0_ + cc * 8;                                                     \
    const int sg_ = kk_ >> segShift;                                                  \
    const size_t aoff_ = (size_t)sg_ * segStride + (kk_ - (sg_ << segShift));         \
    GLOAD1(ap0, bp0, ok0, ra0##S, rb0##S) GLOAD1(ap1, bp1, ok1, ra1##S, rb1##S)       \
    GLOAD1(ap2, bp2, ok2, ra2##S, rb2##S) GLOAD1(ap3, bp3, ok3, ra3##S, rb3##S)       \
    } while (0)
#define SWRITE1(buf_, i_, RA, RB) {                                                 \
      *(uint4*)(sA + (buf_) * 128 * GST + (r0 + 32 * i_) * GST + cc * 8) = RA;        \
      *(uint4*)(sB + (buf_) * 128 * GST + (r0 + 32 * i_) * GST + cc * 8) = RB; }
#define SWRITE(buf_, S) do {                                                        \
    SWRITE1(buf_, 0, ra0##S, rb0##S) SWRITE1(buf_, 1, ra1##S, rb1##S) SWRITE1(buf_, 2, ra2##S, rb2##S) SWRITE1(buf_, 3, ra3##S, rb3##S) \
    } while (0)
#define GCOMPUTE(buf_) do {                                                         \
    const u16* a = sA + (buf_) * 128 * GST;                                           \
    const u16* b = sB + (buf_) * 128 * GST;                                           \
    _Pragma("unroll") for (int ks = 0; ks < 2; ks++) {                                \
      bf16x8 af[4], bfr[4];                                                           \
      _Pragma("unroll") for (int i = 0; i < 4; i++) {                                 \
        af[i] = *(const bf16x8*)(a + (64 * wm + 16 * i + fr) * GST + ks * 32 + fq * 8);   \
        bfr[i] = *(const bf16x8*)(b + (64 * wn + 16 * i + fr) * GST + ks * 32 + fq * 8);  \
      }                                                                               \
      _Pragma("unroll") for (int i = 0; i < 4; i++)                                   \
      _Pragma("unroll") for (int j = 0; j < 4; j++)                                   \
        acc[i][j] = __builtin_amdgcn_mfma_f32_16x16x32_bf16(af[i], bfr[j], acc[i][j], 0, 0, 0); \
    } } while (0)
#define LDS_BARRIER() asm volatile("s_waitcnt lgkmcnt(0)\n\ts_barrier" ::: "memory")
  __syncthreads();
  GLOAD(0, x);
  SWRITE(0, x);
  LDS_BARRIER();
#pragma unroll 1
  for (int kt = 0; kt < nk; kt += 2) {
    if (kt + 1 < nk) GLOAD(kt + 1, x);
    GCOMPUTE(0);
    if (kt + 1 < nk) SWRITE(1, x);
    LDS_BARRIER();
    if (kt + 1 >= nk) break;
    if (kt + 2 < nk) GLOAD(kt + 2, x);
    GCOMPUTE(1);
    if (kt + 2 < nk) SWRITE(0, x);
    LDS_BARRIER();
  }
  float* H = (float*)smem;
#pragma unroll
  for (int i = 0; i < 4; i++)
#pragma unroll
    for (int j = 0; j < 4; j++)
#pragma unroll
      for (int e = 0; e < 4; e++) H[(64 * wm + 16 * i + 4 * fq + e) * HST + 64 * wn + 16 * j + fr] = acc[i][j][e];
  __syncthreads();
  return H;
}
__device__ __forceinline__ uint2 pack4(float a, float b, float c, float d) {
  uint2 pk; pk.x = f2bf(a) | ((unsigned)f2bf(b) << 16); pk.y = f2bf(c) | ((unsigned)f2bf(d) << 16); return pk;
}
#define EPI_ROWS(H, BODY...)                                                     \
  _Pragma("unroll 2") for (int _it = 0; _it < 16; _it++) {                       \
    const int r = (tid_o >> 5) + 8 * _it, c = (tid_o & 31) * 4;      \
    const float4 v = *(const float4*)((H) + r * HST + c); BODY }

__device__ __forceinline__ int colmap(int mode, int n) {
  if (mode == 0) {
    if (n < 1792) return n;
    if (n < 2560) return n + 16;
    if (n < 2576) return 1792 + (n - 2560);
    return -1;
  }
  if (mode == 2) { int nt = n >> 7, c = n & 127; return c < 64 ? nt * 64 + c : DFF + nt * 64 + (c - 64); }
  return n;
}
__device__ __forceinline__ void transpose_tile(float* sm, const float* __restrict__ src, int ldsrc, const float* __restrict__ gain,
                               u16* __restrict__ dst, int K, int mode, int n0, int k0) {
  int tid = threadIdx.x; asm volatile("" : "+v"(tid)); const int _tid_pad = 0;
  __syncthreads();
  {
    int nn = tid & 63;
    int sc = colmap(mode, n0 + nn);
#pragma unroll
    for (int i = 0; i < 16; i++) {
      int kk = (tid >> 6) + 4 * i;
      float v = 0.f;
      if (sc >= 0) { v = src[(size_t)(k0 + kk) * ldsrc + sc]; if (gain) v *= gain[k0 + kk]; }
      sm[kk * 65 + nn] = v;
    }
  }
  __syncthreads();
  {
    int c = tid & 7;
#pragma unroll
    for (int i = 0; i < 2; i++) {
      int nn = (tid >> 3) + 32 * i;
      u16 h[8];
#pragma unroll
      for (int e = 0; e < 8; e++) h[e] = f2bf(sm[(c * 8 + e) * 65 + nn]);
      uint4 pk;
      pk.x = h[0] | ((unsigned)h[1] << 16); pk.y = h[2] | ((unsigned)h[3] << 16);
      pk.z = h[4] | ((unsigned)h[5] << 16); pk.w = h[6] | ((unsigned)h[7] << 16);
      *(uint4*)(dst + (size_t)(n0 + nn) * K + k0 + c * 8) = pk;
    }
  }
}

__device__ __forceinline__ void s5_prep_item(float* sm, const Params& p, int l, int item) {
  int tid = threadIdx.x; asm volatile("" : "+v"(tid)); const int _tid_pad = 0;
  const int m = item % 65, d = (item / 65) & 1, g = item / 130;
  float* s_abm = sm;
  float* s_q = sm + 128;
  const int ldg = (l * 2 + d) * 16 + g;
  __syncthreads();
  if (tid < 64) {
    int pi = ldg * 64 + tid;
    float dt = expf(p.in[13][ldg]);
    float are = p.in[11][pi], aim = p.in[12][pi];
    float mag = expf(dt * are), ang = dt * aim;
    float abr = mag * cosf(ang), abi = mag * sinf(ang);
    float den = are * are + aim * aim;
    float nre = abr - 1.f;
    s_q[tid * 2] = (nre * are + abi * aim) / den;
    s_q[tid * 2 + 1] = (abi * are - nre * aim) / den;
    float mm = expf((float)m * dt * are), am = (float)m * ang;
    float pr = mm * cosf(am), pim = mm * sinf(am);
    s_abm[tid * 2] = pr; s_abm[tid * 2 + 1] = pim;
    if (m == 64) {
      float* ab64 = (float*)(p.ws + O_AB64) + (size_t)l * 2 * 16 * 64 * 2;
      ab64[((d * 16 + g) * 64 + tid) * 2] = pr;
      ab64[((d * 16 + g) * 64 + tid) * 2 + 1] = pim;
    }
  }
  __syncthreads();
  const float* bre = p.in[14] + (size_t)ldg * 64 * 16;
  const float* bim = p.in[15] + (size_t)ldg * 64 * 16;
  const float* cre = p.in[16] + (size_t)ldg * 16 * 64;
  const float* cim = p.in[17] + (size_t)ldg * 16 * 64;
  u16* bty = (u16*)(p.ws + O_BTY) + (size_t)g * 1024 * 1280;
  u16* bts = (u16*)(p.ws + O_BTS) + (size_t)g * 256 * 1024;
  if (m <= 63) {
    int ho = tid >> 4, hi = tid & 15;
    float acc = 0.f;
    for (int pp = 0; pp < 64; pp++) {
      float cr = cre[ho * 64 + pp], ci = cim[ho * 64 + pp];
      float ar = s_abm[pp * 2], ai = s_abm[pp * 2 + 1];
      float t1r = cr * ar - ci * ai, t1i = cr * ai + ci * ar;
      float qr = s_q[pp * 2], qi = s_q[pp * 2 + 1];
      float br = bre[pp * 16 + hi], bi = bim[pp * 16 + hi];
      float bbr = qr * br - qi * bi, bbi = qr * bi + qi * br;
      acc += t1r * bbr - t1i * bbi;
    }
    float* kt = (float*)(p.ws + O_KTAB);
    kt[((size_t)((g * 2 + d) * 64 + m)) * 256 + ho * 16 + hi] = acc;
  }
  if (m >= 1) {
    int t = d == 0 ? m - 1 : 64 - m;
    for (int e = tid; e < 1024; e += 256) {
      int ho = e >> 6, pp = e & 63;
      float cr = cre[ho * 64 + pp], ci = cim[ho * 64 + pp];
      float ar = s_abm[pp * 2], ai = s_abm[pp * 2 + 1];
      float xr = cr * ar - ci * ai, xi = cr * ai + ci * ar;
      size_t o = (size_t)(t * 16 + ho) * 1280 + 1024 + d * 128 + pp * 2;
      bty[o] = f2bf(xr);
      bty[o + 1] = f2bf(-xi);
    }
  }
}
__device__ __forceinline__ void s5_bts_item(const Params& p, int l, int item) {
  int tid = threadIdx.x; asm volatile("" : "+v"(tid));
  const int pp = item & 63, d = (item >> 6) & 1, g = item >> 7;
  const int sp = tid >> 2, hq = tid & 3;
  const int ldg = (l * 2 + d) * 16 + g;
  const int pi = ldg * 64 + pp;
  float dt = expf(p.in[13][ldg]);
  float are = p.in[11][pi], aim = p.in[12][pi];
  float mag = expf(dt * are), ang = dt * aim;
  float abr = mag * cosf(ang), abi = mag * sinf(ang);
  float den = are * are + aim * aim;
  float nre = abr - 1.f;
  float qr = (nre * are + abi * aim) / den, qi = (abi * are - nre * aim) / den;
  const int f = d == 0 ? 63 - sp : sp;
  float mm = expf((float)f * dt * are), am = (float)f * ang;
  float ar = mm * cosf(am), ai = mm * sinf(am);
  const float* bre = p.in[14] + (size_t)ldg * 64 * 16 + pp * 16 + hq * 4;
  const float* bim = p.in[15] + (size_t)ldg * 64 * 16 + pp * 16 + hq * 4;
  float fr_[4], fi_[4];
#pragma unroll
  for (int e = 0; e < 4; e++) {
    float br = bre[e], bi = bim[e];
    float bbr = qr * br - qi * bi, bbi = qr * bi + qi * br;
    fr_[e] = ar * bbr - ai * bbi; fi_[e] = ar * bbi + ai * bbr;
  }
  u16* bts = (u16*)(p.ws + O_BTS) + (size_t)g * 256 * 1024 + (size_t)(d * 128 + pp * 2) * 1024 + sp * 16 + hq * 4;
  *(uint2*)bts = pack4(fr_[0], fr_[1], fr_[2], fr_[3]);
  *(uint2*)(bts + 1024) = pack4(fi_[0], fi_[1], fi_[2], fi_[3]);
}
__device__ __forceinline__ void s5_expand_item(const Params& p, int l, int item) {
  int tid = threadIdx.x; asm volatile("" : "+v"(tid)); const int _tid_pad = 0;
  int g = item >> 10, n = item & 1023, t = n >> 4, ho = n & 15;
  int sp = tid >> 2, hi0 = (tid & 3) * 4;
  const float* kt = (const float*)(p.ws + O_KTAB);
  float v[4] = {0.f, 0.f, 0.f, 0.f};
  if (t >= sp) {
    const float* k0 = kt + ((size_t)((g * 2 + 0) * 64 + (t - sp))) * 256 + ho * 16 + hi0;
#pragma unroll
    for (int e = 0; e < 4; e++) v[e] += k0[e];
  }
  if (sp >= t) {
    const float* k1 = kt + ((size_t)((g * 2 + 1) * 64 + (sp - t))) * 256 + ho * 16 + hi0;
#pragma unroll
    for (int e = 0; e < 4; e++) v[e] += k1[e];
  }
  if (t == sp && ho >= hi0 && ho < hi0 + 4) v[ho - hi0] += p.in[18][l * 256 + g * 16 + ho];
  u16* bty = (u16*)(p.ws + O_BTY) + (size_t)g * 1024 * 1280 + (size_t)n * 1280 + sp * 16 + hi0;
  uint2 pk;
  pk.x = f2bf(v[0]) | ((unsigned)f2bf(v[1]) << 16);
  pk.y = f2bf(v[2]) | ((unsigned)f2bf(v[3]) << 16);
  *(uint2*)bty = pk;
}

__device__ __forceinline__ void hy_filter_item(float* sm, const Params& p, int l, int set, int tb) {
  int tid = threadIdx.x; asm volatile("" : "+v"(tid));
  const int L = 2048 << set;
  float* sz = sm;
  float* h1 = sm + 65 * 33;
  float* h2 = h1 + 65 * 64;
  const float* w1 = p.in[27] + (size_t)l * 33 * 64;
  const float* b1 = p.in[28] + l * 64;
  const float* fq_ = p.in[29] + l * 64;
  const float* w2 = p.in[30] + (size_t)l * 64 * 64;
  const float* b2 = p.in[31] + l * 64;
  const float* w3 = p.in[32] + (size_t)l * 64 * 1024;
  __syncthreads();
  for (int e = tid; e < 65 * 33; e += 256) {
    int tt = e / 33, i = e % 33;
    int t = tb * 64 + tt;
    float val;
    if (i == 0) val = (float)t / (float)(L - 1);
    else {
      int b = (i - 1) & 15;
      float f = 1e-4f + (float)b * ((15.f - 1e-4f) / 15.f);
      float wang = 6.283185307179586f * (float)t / (float)L;
      val = i <= 16 ? cosf(f * wang) : -sinf(f * wang);
    }
    sz[e] = val;
  }
  __syncthreads();
  {
    int j = tid & 63;
    float fj = fq_[j], bj = b1[j];
#pragma unroll 1
    for (int i = 0; i < 17; i++) {
      int tt = (tid >> 6) + 4 * i;
      if (tt < 65) {
        float a = bj;
        for (int k = 0; k < 33; k++) a += sz[tt * 33 + k] * w1[k * 64 + j];
        h1[tt * 64 + j] = sinf(fj * a);
      }
    }
  }
  __syncthreads();
  {
    int j = tid & 63;
    float fj = fq_[j], bj = b2[j];
#pragma unroll 1
    for (int i = 0; i < 17; i++) {
      int tt = (tid >> 6) + 4 * i;
      if (tt < 65) {
        float a = bj;
        for (int k = 0; k < 64; k++) a += h1[tt * 64 + k] * w2[k * 64 + j];
        h2[tt * 64 + j] = sinf(fj * a);
      }
    }
  }
  __syncthreads();
  const int c = tid;
  const float mind = -3.0701134573253943f, maxd = -15.350567286626972f;
  float delta = fabsf(mind + (float)c * ((maxd - mind) / 255.f));
  u16* kr = (u16*)(p.ws + O_HYKR) + (set ? HYKR1 : 0);
  float* ps = (float*)(p.ws + O_HYPS) + (size_t)(set ? 32 * 512 : 0) + (size_t)tb * 512;
#pragma unroll 1
  for (int order = 0; order < 2; order++) {
    u16* krc = kr + ((size_t)order * 256 + c) * (2 * L);
    float asum = 0.f, v00 = 0.f;
#pragma unroll 1
    for (int dir = 0; dir < 2; dir++) {
      float wc[64];
#pragma unroll
      for (int k = 0; k < 64; k++) wc[k] = w3[k * 1024 + order * 512 + dir * 256 + c];
      float hold = 0.f;
      const int ntt = dir == 0 ? 65 : 64;
#pragma unroll 1
      for (int tt = 0; tt < ntt; tt++) {
        float a = 0.f;
#pragma unroll
        for (int k = 0; k < 64; k++) a += h2[tt * 64 + k] * wc[k];
        int t = tb * 64 + tt;
        float tl = (float)t / (float)(L - 1);
        a *= expf(-tl * delta);
        if (t >= L) a = 0.f;
        if (tt < 64) asum += fabsf(a);
        if (dir == 0) {
          if (tt == 0) { if (tb == 0) v00 = a; }
          else if (tt & 1) hold = a;
          else *(unsigned*)(krc + (L - t)) = f2bf(a) | ((unsigned)f2bf(hold) << 16);
        } else {
          if (!(tt & 1)) hold = (t == 0) ? v00 + a : a;
          else *(unsigned*)(krc + (L + t - 1)) = f2bf(hold) | ((unsigned)f2bf(a) << 16);
        }
      }
    }
    ps[order * 256 + c] = asum;
  }
}

__device__ __forceinline__ void rms_rows_to_bf16(const Params& p, int l, int rowblk) {
  int tid_ = threadIdx.x; asm volatile("" : "+v"(tid_));
  const int lane = tid_ & 63, w = tid_ >> 6;
  int tok = rowblk * 4 + w;
  const float* x = xrow(p, l, tok);
  float4 v[4];
  float ss = 0.f;
#pragma unroll
  for (int i = 0; i < 4; i++) {
    v[i] = *(const float4*)(x + i * 256 + lane * 4);
    ss += v[i].x * v[i].x + v[i].y * v[i].y + v[i].z * v[i].z + v[i].w * v[i].w;
  }
  ss = wave_sum(ss);
  float rs = rsqrtf(ss * (1.f / 1024.f) + EPSF);
  u16* xn = (u16*)(p.ws + O_XN) + (size_t)tok * 1024;
#pragma unroll
  for (int i = 0; i < 4; i++) {
    uint2 pk;
    pk.x = f2bf(v[i].x * rs) | ((unsigned)f2bf(v[i].y * rs) << 16);
    pk.y = f2bf(v[i].z * rs) | ((unsigned)f2bf(v[i].w * rs) << 16);
    *(uint2*)(xn + i * 256 + lane * 4) = pk;
  }
}

__device__ __forceinline__ void lru_item(char* smraw, const Params& p, int l, int item, int mode) {
  int tid = threadIdx.x; asm volatile("" : "+v"(tid)); const int _tid_pad = 0, lane = tid & 63, w = tid >> 6, fr = lane & 15, fq = lane >> 4;
  const int cki = item >> 2, head = item & 3;
  const int t0 = cki * 32;
  int lo, hi; seq_bounds(t0, lo, hi);
  float* xc = (float*)smraw;
  u16* xcb = (u16*)(smraw + 8192);
  float* sa = (float*)(smraw + 8192 + 4608);
  float* su = sa + 2 * 32 * 64;
  float* sx = su + 2 * 32 * 64;
  const u16* zA = (const u16*)(p.ws + O_ZA);
  __syncthreads();
  {
    int ch = tid & 63, tq = tid >> 6;
    int gch = head * 64 + ch;
    const float* cw = p.in[4] + l * 4 * 256;
    float w0 = cw[gch], w1 = cw[256 + gch], w2 = cw[512 + gch], w3 = cw[768 + gch];
    float cb = p.in[5][l * 256 + gch];
    float win[11];
#pragma unroll
    for (int i = 0; i < 11; i++) {
      int tok = t0 + tq * 8 + i - 2;
      win[i] = (tok >= lo && tok < hi) ? bf2f(zA[(size_t)tok * 512 + gch]) : 0.f;
    }
#pragma unroll
    for (int i = 0; i < 8; i++) {
      float v = w0 * win[i] + w1 * win[i + 1] + w2 * win[i + 2] + w3 * win[i + 3] + cb;
      int tt = tq * 8 + i;
      xc[tt * 64 + ch] = v;
      xcb[tt * 72 + ch] = f2bf(v);
    }
  }
  __syncthreads();
  {
    const int d = w >> 1, half = w & 1;
    const u16* wl = (const u16*)(p.ws + O_WLRU) + (size_t)head * 256 * 64;
    f32x4 accr[2][2], acci[2][2];
#pragma unroll
    for (int a = 0; a < 2; a++)
#pragma unroll
      for (int b = 0; b < 2; b++) { accr[a][b] = (f32x4){0, 0, 0, 0}; acci[a][b] = (f32x4){0, 0, 0, 0}; }
#pragma unroll
    for (int ks = 0; ks < 2; ks++) {
      bf16x8 af[2], br[2], bi[2];
#pragma unroll
      for (int mt = 0; mt < 2; mt++) af[mt] = *(const bf16x8*)(xcb + (16 * mt + fr) * 72 + ks * 32 + fq * 8);
#pragma unroll
      for (int nt = 0; nt < 2; nt++) {
        int nr = d * 128 + 32 * half + 16 * nt + fr;
        br[nt] = *(const bf16x8*)(wl + (size_t)nr * 64 + ks * 32 + fq * 8);
        bi[nt] = *(const bf16x8*)(wl + (size_t)(nr + 64) * 64 + ks * 32 + fq * 8);
      }
#pragma unroll
      for (int mt = 0; mt < 2; mt++)
#pragma unroll
        for (int nt = 0; nt < 2; nt++) {
          accr[mt][nt] = __builtin_amdgcn_mfma_f32_16x16x32_bf16(af[mt], br[nt], accr[mt][nt], 0, 0, 0);
          acci[mt][nt] = __builtin_amdgcn_mfma_f32_16x16x32_bf16(af[mt], bi[nt], acci[mt][nt], 0, 0, 0);
        }
    }
#pragma unroll
    for (int nt = 0; nt < 2; nt++) {
      int ch = 32 * half + 16 * nt + fr;
      int gch = head * 64 + ch;
      float brr = p.in[7][(l * 2 + d) * 256 + gch], bii = p.in[9][(l * 2 + d) * 256 + gch];
      float sp = softplusf_(-p.in[10][(l * 2 + d) * 256 + gch]);
#pragma unroll
      for (int mt = 0; mt < 2; mt++)
#pragma unroll
        for (int e = 0; e < 4; e++) {
          int tt = 16 * mt + 4 * fq + e;
          float r = 1.f / (1.f + expf(-(accr[mt][nt][e] + brr)));
          float ig = 1.f / (1.f + expf(-(acci[mt][nt][e] + bii)));
          float la = -8.f * r * sp;
          float a = expf(la);
          float u = sqrtf(-expm1f(2.f * la)) * (ig * xc[tt * 64 + ch]);
          sa[(d * 32 + tt) * 64 + ch] = a;
          su[(d * 32 + tt) * 64 + ch] = u;
        }
    }
  }
  __syncthreads();
  {
    const int ch = tid & 63, d = (tid >> 6) & 1, half = tid >> 7;
    float A = 1.f, B = 0.f;
#pragma unroll
    for (int i = 0; i < 16; i++) {
      int tt = d == 0 ? half * 16 + i : half * 16 + 15 - i;
      float a = sa[(d * 32 + tt) * 64 + ch], u = su[(d * 32 + tt) * 64 + ch];
      A = a * A; B = a * B + u;
    }
    sx[((d * 2 + half) * 64 + ch) * 2] = A;
    sx[((d * 2 + half) * 64 + ch) * 2 + 1] = B;
  }
  __syncthreads();
  if (mode == 0) {
    if (tid < 128) {
      int ch = tid & 63, d = tid >> 6;
      int first = d == 0 ? 0 : 1, second = 1 - first;
      float A1 = sx[((d * 2 + first) * 64 + ch) * 2], B1 = sx[((d * 2 + first) * 64 + ch) * 2 + 1];
      float A2 = sx[((d * 2 + second) * 64 + ch) * 2], B2 = sx[((d * 2 + second) * 64 + ch) * 2 + 1];
      float2 cr; cr.x = A2 * A1; cr.y = A2 * B1 + B2;
      ((float2*)(p.ws + O_LCAR))[((size_t)cki * 2 + d) * 256 + head * 64 + ch] = cr;
    }
    return;
  }
  {
    const int ch = tid & 63, d = (tid >> 6) & 1, half = tid >> 7;
    float h = ((const float*)(p.ws + O_LHIN))[((size_t)cki * 2 + d) * 256 + head * 64 + ch];
    int first = d == 0 ? 0 : 1;
    if (half != first) h = sx[((d * 2 + first) * 64 + ch) * 2] * h + sx[((d * 2 + first) * 64 + ch) * 2 + 1];
#pragma unroll
    for (int i = 0; i < 16; i++) {
      int tt = d == 0 ? half * 16 + i : half * 16 + 15 - i;
      float a = sa[(d * 32 + tt) * 64 + ch], u = su[(d * 32 + tt) * 64 + ch];
      h = a * h + u;
      su[(d * 32 + tt) * 64 + ch] = h;
    }
  }
  __syncthreads();
  {
    int ch = tid & 63, tq = tid >> 6;
    u16* mixA = (u16*)(p.ws + O_XN);
#pragma unroll
    for (int i = 0; i < 8; i++) {
      int tt = tq * 8 + i, tok = t0 + tt;
      float hsum = su[tt * 64 + ch] + su[(32 + tt) * 64 + ch];
      float gate = bf2f(zA[(size_t)tok * 512 + 256 + head * 64 + ch]);
      mixA[(size_t)tok * 256 + head * 64 + ch] = f2bf(hsum * geluf_(gate));
    }
  }
}
__device__ __forceinline__ void lru_propagate(const Params& p, int idx) {
  int seq = idx >> 9, d = (idx >> 8) & 1, ch = idx & 255;
  int c0, nc;
  if (seq < 8) { c0 = seq * 64; nc = 64; } else { c0 = 512 + (seq - 8) * 128; nc = 128; }
  const float2* car = (const float2*)(p.ws + O_LCAR);
  float* hin = (float*)(p.ws + O_LHIN);
  float h = 0.f;
  for (int i = 0; i < nc; i++) {
    int ck = d == 0 ? c0 + i : c0 + nc - 1 - i;
    size_t o = ((size_t)ck * 2 + d) * 256 + ch;
    hin[o] = h;
    float2 ab = car[o];
    h = ab.x * h + ab.y;
  }
}
__device__ __forceinline__ void s5_propagate(const Params& p, int l, int idx) {
  int pp = idx & 63, d = (idx >> 6) & 1, g = (idx >> 7) & 15, seq = idx >> 11;
  int c0, nc;
  if (seq < 8) { c0 = seq * 32; nc = 32; } else { c0 = 256 + (seq - 8) * 64; nc = 64; }
  const float* ab64 = (const float*)(p.ws + O_AB64) + (size_t)l * 2 * 16 * 64 * 2;
  float ar = ab64[((d * 16 + g) * 64 + pp) * 2], ai = ab64[((d * 16 + g) * 64 + pp) * 2 + 1];
  const float* send = (const float*)(p.ws + O_SEND) + (size_t)g * 1280 * 256;
  u16* uh = (u16*)(p.ws + O_UH) + (size_t)g * 1280 * 1280;
  float hr = 0.f, hi = 0.f;
  for (int i = 0; i < nc; i++) {
    int ck = d == 0 ? c0 + i : c0 + nc - 1 - i;
    *(unsigned*)(uh + (size_t)ck * 1280 + 1024 + d * 128 + pp * 2) = f2bf(hr) | ((unsigned)f2bf(hi) << 16);
    float2 s = *(const float2*)(send + (size_t)ck * 256 + d * 128 + pp * 2);
    float nr = __fmaf_rn(ar, hr, __fmaf_rn(-ai, hi, s.x));
    float ni = __fmaf_rn(ar, hi, __fmaf_rn(ai, hr, s.y));
    asm volatile("" : "+v"(nr));
    asm volatile("" : "+v"(ni));
    hr = nr; hi = ni;
  }
}

#define AST 68
__device__ __forceinline__ void gdn_g1_item(char* smraw, const Params& p, int l, int item) {
  int tid = threadIdx.x; asm volatile("" : "+v"(tid)); const int _tid_pad = 0, lane = tid & 63, w = tid >> 6, fr = lane & 15, fq = lane >> 4;
  const int ck = item >> 2, h = item & 3;
  const int t0 = ck * 64;
  int lo, hi; seq_bounds(t0, lo, hi);
  u16* sk = (u16*)smraw;
  u16* sv = sk + 64 * 72;
  u16* Am = (u16*)(smraw + 2 * 64 * 72 * 2);
  float* sgc = (float*)(Am + 2 * 64 * 72);
  float* sbeta = sgc + 128;
  u16* Xs = (u16*)(sbeta + 128);
  const u16* zC = (const u16*)(p.ws + O_ZC);
  const float* ba = (const float*)(p.ws + O_BA);
  u16* qg = (u16*)(p.ws + O_XN);
  u16* kg = qg + (size_t)T_ALL * 256;
  u16* vg = kg + (size_t)T_ALL * 256;
  __syncthreads();
  {
    const float* cw = p.in[21] + (size_t)l * 4 * 768;
    float wq[4], wk[4], wv[4];
#pragma unroll
    for (int j = 0; j < 4; j++) {
      wq[j] = cw[j * 768 + h * 64 + lane];
      wk[j] = cw[j * 768 + 256 + h * 64 + lane];
      wv[j] = cw[j * 768 + 512 + h * 64 + lane];
    }
    for (int rr = 0; rr < 16; rr++) {
      int c = w * 16 + rr, tok = t0 + c;
      float q = 0.f, k = 0.f, v = 0.f;
#pragma unroll
      for (int j = 0; j < 4; j++) {
        int tk = tok + j - 2;
        if (tk >= lo && tk < hi) {
          const u16* zr = zC + (size_t)tk * 1024 + h * 64 + lane;
          q += wq[j] * bf2f(zr[0]); k += wk[j] * bf2f(zr[256]); v += wv[j] * bf2f(zr[512]);
        }
      }
      q = siluf_(q); k = siluf_(k); v = siluf_(v);
      float sq = wave_sum(q * q), skk = wave_sum(k * k);
      q = q * rsqrtf(sq + EPSF) * 0.125f;
      k = k * rsqrtf(skk + EPSF);
      u16 kb = f2bf(k), vb = f2bf(v);
      sk[c * 72 + lane] = kb; sv[c * 72 + lane] = vb;
      qg[(size_t)tok * 256 + h * 64 + lane] = f2bf(q);
      kg[(size_t)tok * 256 + h * 64 + lane] = kb;
      vg[(size_t)tok * 256 + h * 64 + lane] = vb;
    }
  }
  if (tid < 128) {
    int d = tid >> 6, c = tid & 63;
    int tok = d == 0 ? t0 + c : t0 + 63 - c;
    float alog = p.in[22][(l * 2 + d) * 4 + h], dtb = p.in[23][(l * 2 + d) * 4 + h];
    float g = -expf(alog) * softplusf_(ba[(size_t)tok * 16 + 8 + d * 4 + h] + dtb);
    float beta = 1.f / (1.f + expf(-ba[(size_t)tok * 16 + d * 4 + h]));
    float s = g;
#pragma unroll
    for (int o = 1; o < 64; o <<= 1) { float t = __shfl_up(s, o); if (c >= o) s += t; }
    sgc[d * 64 + c] = s; sbeta[d * 64 + c] = beta;
    ((float*)(p.ws + O_GC))[(size_t)(h * 2 + d) * T_ALL + tok] = s;
  }
  __syncthreads();
  {
    f32x4 acc[4];
#pragma unroll
    for (int nt = 0; nt < 4; nt++) acc[nt] = (f32x4){0, 0, 0, 0};
#pragma unroll
    for (int ks = 0; ks < 2; ks++) {
      bf16x8 af = *(const bf16x8*)(sk + (16 * w + fr) * 72 + ks * 32 + fq * 8);
#pragma unroll
      for (int nt = 0; nt < 4; nt++) {
        bf16x8 bfm = *(const bf16x8*)(sk + (16 * nt + fr) * 72 + ks * 32 + fq * 8);
        acc[nt] = __builtin_amdgcn_mfma_f32_16x16x32_bf16(af, bfm, acc[nt], 0, 0, 0);
      }
    }
#pragma unroll
    for (int nt = 0; nt < 4; nt++)
#pragma unroll
      for (int e = 0; e < 4; e++) {
        int c = 16 * w + 4 * fq + e, m = 16 * nt + fr;
        float gm = acc[nt][e];
        float a0 = c > m ? sbeta[c] * gm * expf(sgc[c] - sgc[m]) : 0.f;
        Am[m * 72 + c] = f2bf(a0);
        int c1 = 63 - c, m1 = 63 - m;
        float a1 = c1 > m1 ? sbeta[64 + c1] * gm * expf(sgc[64 + c1] - sgc[64 + m1]) : 0.f;
        Am[64 * 72 + m1 * 72 + c1] = f2bf(a1);
      }
  }
  __syncthreads();
  {
    const int d = tid >> 7, col = tid & 127;
    const u16* AT = Am + d * 64 * 72;
    u16* Xd = Xs + d * 48 * 128;
    const u16* src = col < 64 ? sk : sv;
    const int e = col & 63;
    u16* wu = (u16*)(p.ws + O_WU) + ((size_t)(ck * 4 + h) * 2 + d) * 8192 + (col < 64 ? 0 : 4096);
#pragma unroll 1
    for (int b = 0; b < 4; b++) {
      float s[16];
#pragma unroll
      for (int r = 0; r < 16; r++) {
        int i = 16 * b + r;
        int tokr = d == 0 ? i : 63 - i;
        float rv = bf2f(src[tokr * 72 + e]) * sbeta[d * 64 + i];
        if (col < 64) rv *= expf(sgc[d * 64 + i]);
        s[r] = rv;
      }
#pragma unroll 4
      for (int j = 0; j < 16 * b; j++) {
        float xj = bf2f(Xd[j * 128 + col]);
        const uint4* ar = (const uint4*)(AT + j * 72 + 16 * b);
        uint4 a0 = ar[0], a1 = ar[1];
        unsigned aw[8] = {a0.x, a0.y, a0.z, a0.w, a1.x, a1.y, a1.z, a1.w};
#pragma unroll
        for (int q = 0; q < 8; q++) {
          s[2 * q] -= __uint_as_float(aw[q] << 16) * xj;
          s[2 * q + 1] -= __uint_as_float(aw[q] & 0xffff0000u) * xj;
        }
      }
#pragma unroll
      for (int rp = 0; rp < 16; rp++) {
        u16 xb = f2bf(s[rp]);
        float xj = bf2f(xb);
        wu[(16 * b + rp) * 64 + e] = xb;
        if (b < 3) Xd[(16 * b + rp) * 128 + col] = xb;
        const uint4* ar = (const uint4*)(AT + (16 * b + rp) * 72 + 16 * b);
        uint4 a0 = ar[0], a1 = ar[1];
        unsigned aw[8] = {a0.x, a0.y, a0.z, a0.w, a1.x, a1.y, a1.z, a1.w};
#pragma unroll
        for (int r = rp + 1; r < 16; r++) {
          float av = (r & 1) ? __uint_as_float(aw[r >> 1] & 0xffff0000u) : __uint_as_float(aw[r >> 1] << 16);
          s[r] -= av * xj;
        }
      }
    }
  }
}

__device__ __forceinline__ void gdn_chain(char* smraw, const Params& p, int chain) {
  int tid = threadIdx.x; asm volatile("" : "+v"(tid)); const int _tid_pad = 0, lane = tid & 63, w = tid >> 6, fr = lane & 15, fq = lane >> 4;
  const int d = chain & 1, h = (chain >> 1) & 3, seq = chain >> 3;
  int c0, nc;
  if (seq < 8) { c0 = seq * 32; nc = 32; } else { c0 = 256 + (seq - 8) * 64; nc = 64; }
  u16* qs = (u16*)smraw;
  u16* qd = qs + 64 * 72;
  u16* ks_ = qd + 64 * 72;
  u16* kdT = ks_ + 64 * 72;
  u16* at = kdT + 64 * 72;
  u16* ST = at + 64 * 72;
  u16* VT = ST + 4 * 16 * 72;
  float* sgc = (float*)(VT + 4 * 16 * 72);
  const u16* qg = (const u16*)(p.ws + O_XN);
  const u16* kg = qg + (size_t)T_ALL * 256;
  const float* gcg = (const float*)(p.ws + O_GC);
  u16* og = (u16*)(p.ws + O_OD) + (size_t)d * T_ALL * 256;
  u16* STw = ST + w * 16 * 72;
  u16* VTw = VT + w * 16 * 72;
  f32x4 accS[4];
#pragma unroll
  for (int mt = 0; mt < 4; mt++) accS[mt] = (f32x4){0, 0, 0, 0};
  __syncthreads();
  for (int e = lane; e < 16 * 72; e += 64) STw[e] = 0;
  for (int it = 0; it < nc; it++) {
    const int ck = d == 0 ? c0 + it : c0 + nc - 1 - it;
    const int t0 = ck * 64;
    const u16* wch = (const u16*)(p.ws + O_WU) + ((size_t)(ck * 4 + h) * 2 + d) * 8192;
    const u16* uch = wch + 4096;
    const int tok_last = d == 0 ? t0 + 63 : t0;
    const float gl = gcg[(size_t)(h * 2 + d) * T_ALL + tok_last];
    {
      int row = tid >> 2, seg = tid & 3;
      int tok = d == 0 ? t0 + row : t0 + 63 - row;
      float gcv = gcg[(size_t)(h * 2 + d) * T_ALL + tok];
      if (seg == 0) sgc[row] = gcv;
      float eq = expf(gcv), ek = expf(gl - gcv);
      const u16* qr = qg + (size_t)tok * 256 + h * 64 + seg * 16;
      const u16* kr = kg + (size_t)tok * 256 + h * 64 + seg * 16;
      uint4 q0 = *(const uint4*)qr, q1 = *(const uint4*)(qr + 8);
      uint4 k0 = *(const uint4*)kr, k1 = *(const uint4*)(kr + 8);
      *(uint4*)(qs + row * 72 + seg * 16) = q0; *(uint4*)(qs + row * 72 + seg * 16 + 8) = q1;
      *(uint4*)(ks_ + row * 72 + seg * 16) = k0; *(uint4*)(ks_ + row * 72 + seg * 16 + 8) = k1;
      unsigned qa[8] = {q0.x, q0.y, q0.z, q0.w, q1.x, q1.y, q1.z, q1.w};
      unsigned ka[8] = {k0.x, k0.y, k0.z, k0.w, k1.x, k1.y, k1.z, k1.w};
#pragma unroll
      for (int i = 0; i < 8; i++) {
        float qa0 = bf2f((u16)(qa[i] & 0xffff)) * eq, qa1 = bf2f((u16)(qa[i] >> 16)) * eq;
        *(unsigned*)(qd + row * 72 + seg * 16 + 2 * i) = f2bf(qa0) | ((unsigned)f2bf(qa1) << 16);
        float kb0 = bf2f((u16)(ka[i] & 0xffff)) * ek, kb1 = bf2f((u16)(ka[i] >> 16)) * ek;
        kdT[(seg * 16 + 2 * i) * 72 + row] = f2bf(kb0);
        kdT[(seg * 16 + 2 * i + 1) * 72 + row] = f2bf(kb1);
      }
    }
    LDS_BARRIER();
    {
      f32x4 acc[4];
#pragma unroll
      for (int nt = 0; nt < 4; nt++) acc[nt] = (f32x4){0, 0, 0, 0};
#pragma unroll
      for (int ks = 0; ks < 2; ks++) {
        bf16x8 af = *(const bf16x8*)(qs + (16 * w + fr) * 72 + ks * 32 + fq * 8);
#pragma unroll
        for (int nt = 0; nt < 4; nt++) {
          bf16x8 bfm = *(const bf16x8*)(ks_ + (16 * nt + fr) * 72 + ks * 32 + fq * 8);
          acc[nt] = __builtin_amdgcn_mfma_f32_16x16x32_bf16(af, bfm, acc[nt], 0, 0, 0);
        }
      }
#pragma unroll
      for (int nt = 0; nt < 4; nt++)
#pragma unroll
        for (int e = 0; e < 4; e++) {
          int c = 16 * w + 4 * fq + e, m = 16 * nt + fr;
          float v = c >= m ? acc[nt][e] * expf(sgc[c] - sgc[m]) : 0.f;
          at[c * 72 + m] = f2bf(v);
        }
    }
    LDS_BARRIER();
    {
      const int e0 = 16 * w;
      f32x4 av[4];
#pragma unroll
      for (int mt = 0; mt < 4; mt++) av[mt] = (f32x4){0, 0, 0, 0};
#pragma unroll
      for (int ks = 0; ks < 2; ks++) {
        bf16x8 bS = *(const bf16x8*)(STw + fr * 72 + ks * 32 + fq * 8);
#pragma unroll
        for (int mt = 0; mt < 4; mt++) {
          bf16x8 aw = *(const bf16x8*)(wch + (16 * mt + fr) * 64 + ks * 32 + fq * 8);
          av[mt] = __builtin_amdgcn_mfma_f32_16x16x32_bf16(aw, bS, av[mt], 0, 0, 0);
        }
      }
#pragma unroll
      for (int mt = 0; mt < 4; mt++) {
        u16 hv[4];
#pragma unroll
        for (int e = 0; e < 4; e++) {
          int c = 16 * mt + 4 * fq + e;
          float vn = bf2f(uch[c * 64 + e0 + fr]) - av[mt][e];
          hv[e] = f2bf(vn);
        }
        uint2 pk; pk.x = hv[0] | ((unsigned)hv[1] << 16); pk.y = hv[2] | ((unsigned)hv[3] << 16);
        *(uint2*)(VTw + fr * 72 + 16 * mt + 4 * fq) = pk;
      }
      __builtin_amdgcn_wave_barrier();
      f32x4 ao[4];
#pragma unroll
      for (int mt = 0; mt < 4; mt++) ao[mt] = (f32x4){0, 0, 0, 0};
#pragma unroll
      for (int ks = 0; ks < 2; ks++) {
        bf16x8 bS = *(const bf16x8*)(STw + fr * 72 + ks * 32 + fq * 8);
        bf16x8 bV = *(const bf16x8*)(VTw + fr * 72 + ks * 32 + fq * 8);
#pragma unroll
        for (int mt = 0; mt < 4; mt++) {
          bf16x8 aq = *(const bf16x8*)(qd + (16 * mt + fr) * 72 + ks * 32 + fq * 8);
          bf16x8 aa = *(const bf16x8*)(at + (16 * mt + fr) * 72 + ks * 32 + fq * 8);
          ao[mt] = __builtin_amdgcn_mfma_f32_16x16x32_bf16(aq, bS, ao[mt], 0, 0, 0);
          ao[mt] = __builtin_amdgcn_mfma_f32_16x16x32_bf16(aa, bV, ao[mt], 0, 0, 0);
        }
      }
#pragma unroll
      for (int mt = 0; mt < 4; mt++)
#pragma unroll
        for (int e = 0; e < 4; e++) {
          int c = 16 * mt + 4 * fq + e;
          int tok = d == 0 ? t0 + c : t0 + 63 - c;
          og[(size_t)tok * 256 + h * 64 + e0 + fr] = f2bf(ao[mt][e]);
        }
      float egl = expf(gl);
#pragma unroll
      for (int mt = 0; mt < 4; mt++) accS[mt] = accS[mt] * egl;
#pragma unroll
      for (int ks = 0; ks < 2; ks++) {
        bf16x8 bV = *(const bf16x8*)(VTw + fr * 72 + ks * 32 + fq * 8);
#pragma unroll
        for (int mt = 0; mt < 4; mt++) {
          bf16x8 ak = *(const bf16x8*)(kdT + (16 * mt + fr) * 72 + ks * 32 + fq * 8);
          accS[mt] = __builtin_amdgcn_mfma_f32_16x16x32_bf16(ak, bV, accS[mt], 0, 0, 0);
        }
      }
      __builtin_amdgcn_wave_barrier();
#pragma unroll
      for (int mt = 0; mt < 4; mt++) {
        uint2 pk;
        pk.x = f2bf(accS[mt][0]) | ((unsigned)f2bf(accS[mt][1]) << 16);
        pk.y = f2bf(accS[mt][2]) | ((unsigned)f2bf(accS[mt][3]) << 16);
        *(uint2*)(STw + fr * 72 + 16 * mt + 4 * fq) = pk;
      }
    }
    LDS_BARRIER();
  }
}
__device__ __forceinline__ void gdn_final_rows(const Params& p, int l, int rowblk) {
  int tid_ = threadIdx.x; asm volatile("" : "+v"(tid_));
  const int lane = tid_ & 63, w = tid_ >> 6;
  int tok = rowblk * 4 + w;
  const u16* o0 = (const u16*)(p.ws + O_OD) + (size_t)tok * 256 + lane * 4;
  const u16* o1 = o0 + (size_t)T_ALL * 256;
  const u16* zg = (const u16*)(p.ws + O_ZC) + (size_t)tok * 1024 + 768 + lane * 4;
  uint2 a = *(const uint2*)o0, b = *(const uint2*)o1, g = *(const uint2*)zg;
  float o[4], gt[4];
  o[0] = bf2f(a.x & 0xffff) + bf2f(b.x & 0xffff); o[1] = bf2f(a.x >> 16) + bf2f(b.x >> 16);
  o[2] = bf2f(a.y & 0xffff) + bf2f(b.y & 0xffff); o[3] = bf2f(a.y >> 16) + bf2f(b.y >> 16);
  gt[0] = bf2f(g.x & 0xffff); gt[1] = bf2f(g.x >> 16); gt[2] = bf2f(g.y & 0xffff); gt[3] = bf2f(g.y >> 16);
  float ss = o[0] * o[0] + o[1] * o[1] + o[2] * o[2] + o[3] * o[3];
#pragma unroll
  for (int m = 8; m > 0; m >>= 1) ss += __shfl_xor(ss, m);
  float rs = rsqrtf(ss * (1.f / 64.f) + EPSF);
  if (!(MIXMASK & 4)) rs = 0.f;
  const float* nw = p.in[24] + l * 64 + (lane & 15) * 4;
  u16 r[4];
#pragma unroll
  for (int e = 0; e < 4; e++) r[e] = f2bf(o[e] * rs * nw[e] * siluf_(gt[e]));
  uint2 pk; pk.x = r[0] | ((unsigned)r[1] << 16); pk.y = r[2] | ((unsigned)r[3] << 16);
  *(uint2*)((u16*)(p.ws + O_XN) + (size_t)2 * T_ALL * 256 + (size_t)tok * 256 + lane * 4) = pk;
}
__device__ __forceinline__ void grpnorm_rows(const Params& p, int l, int which, int rowblk) {
  int tid_ = threadIdx.x; asm volatile("" : "+v"(tid_));
  const int lane = tid_ & 63, w = tid_ >> 6;
  int tok = rowblk * 4 + w;
  u16* m = (u16*)(p.ws + O_XN) + (size_t)which * T_ALL * 256 + (size_t)tok * 256 + lane * 4;
  uint2 a = *(const uint2*)m;
  float v[4] = {bf2f(a.x & 0xffff), bf2f(a.x >> 16), bf2f(a.y & 0xffff), bf2f(a.y >> 16)};
  float ss = wave_sum(v[0] * v[0] + v[1] * v[1] + v[2] * v[2] + v[3] * v[3]);
  float rs = rsqrtf(ss * (1.f / 256.f) + EPSF);
  if (!((MIXMASK >> which) & 1)) rs = 0.f;
  const float* gn = p.in[34] + (l * 3 + which) * 256 + lane * 4;
  uint2 pk;
  pk.x = f2bf(v[0] * rs * gn[0]) | ((unsigned)f2bf(v[1] * rs * gn[1]) << 16);
  pk.y = f2bf(v[2] * rs * gn[2]) | ((unsigned)f2bf(v[3] * rs * gn[3]) << 16);
  *(uint2*)m = pk;
}

#define WST 1296
#define UST 264
__device__ __forceinline__ float hy_conv3(const u16* __restrict__ raw, int t, int L, float w0, float w1, float w2, float b) {
  float xm = t > 0 ? bf2f(raw[t - 1]) : 0.f;
  float x0 = bf2f(raw[t]);
  float xp = t + 1 < L ? bf2f(raw[t + 1]) : 0.f;
  return w0 * xm + w1 * x0 + w2 * xp + b;
}
__device__ __forceinline__ void hy_conv_item(char* smraw, const Params& p, int l, int stage, int set, int c, int tb) {
  int tid = threadIdx.x; asm volatile("" : "+v"(tid)); const int _tid_pad = 0, lane = tid & 63, w = tid >> 6, fr = lane & 15, fq = lane >> 4;
  const int L = 2048 << set, nb = 8 << set, base = set ? T_P : 0;
  const int T0 = tb * 1024;
  u16* win = (u16*)smraw;
  u16* su = win + 8 * WST;
  float* sinv = (float*)(su + 16 * UST);
  const u16* dt = (const u16*)(p.ws + O_DT);
  const u16* rawv = dt + (size_t)c * T_ALL + base;
  const u16* rawx = dt + (size_t)((stage + 1) * 256 + c) * T_ALL + base;
  const u16* y1 = (const u16*)(p.ws + O_Y1) + (size_t)c * T_ALL + base;
  u16* outp = stage == 0 ? (u16*)(p.ws + O_Y1) + (size_t)c * T_ALL + base
                         : (u16*)(p.ws + O_DT) + (size_t)(256 + c) * T_ALL + base;
  const u16* kr = (const u16*)(p.ws + O_HYKR) + (set ? HYKR1 : 0) + ((size_t)stage * 256 + c) * (2 * L);
  const float* cw = p.in[25] + (size_t)l * 3 * 768;
  const float* cb = p.in[26] + (size_t)l * 768;
  const float v0 = cw[c], v1 = cw[768 + c], v2 = cw[1536 + c], vb = cb[c];
  const int xc_ = (stage + 1) * 256 + c;
  const float x0w = cw[xc_], x1w = cw[768 + xc_], x2w = cw[1536 + xc_], xbw = cb[xc_];
  __syncthreads();
  if (tid < 64) {
    const float* ps = (const float*)(p.ws + O_HYPS) + (size_t)(set ? 32 * 512 : 0);
    int ntb = L / 64;
    float s = 0.f;
    for (int i = lane; i < ntb; i += 64) s += ps[(size_t)i * 512 + stage * 256 + c];
    s = wave_sum(s);
    if (lane == 0) sinv[0] = 1.f / s;
  }
  f32x4 acc[16];
#pragma unroll
  for (int i = 0; i < 16; i++) acc[i] = (f32x4){0, 0, 0, 0};
  for (int S0 = 0; S0 < L; S0 += 256) {
    __syncthreads();
    const int B0 = S0 - T0;
    for (int idx = tid; idx < 8 * 160; idx += 256) {
      int rho = idx / 160, gi = idx % 160;
      int ybase = B0 - 1016 + 8 * gi - rho + L;
      int a = ybase & ~1;
      uint4 pk;
      if (a >= 0 && a + 10 <= 2 * L) {
        const unsigned* kd = (const unsigned*)(kr + a);
        unsigned d0 = kd[0], d1 = kd[1], d2 = kd[2], d3 = kd[3], d4 = kd[4];
        if (ybase & 1) {
          pk.x = __builtin_amdgcn_alignbit(d1, d0, 16); pk.y = __builtin_amdgcn_alignbit(d2, d1, 16);
          pk.z = __builtin_amdgcn_alignbit(d3, d2, 16); pk.w = __builtin_amdgcn_alignbit(d4, d3, 16);
        } else { pk.x = d0; pk.y = d1; pk.z = d2; pk.w = d3; }
      } else {
        u16 hh[8];
#pragma unroll
        for (int e = 0; e < 8; e++) { int yy = ybase + e; hh[e] = (yy >= 0 && yy < 2 * L) ? kr[yy] : (u16)0; }
        pk.x = hh[0] | ((unsigned)hh[1] << 16); pk.y = hh[2] | ((unsigned)hh[3] << 16);
        pk.z = hh[4] | ((unsigned)hh[5] << 16); pk.w = hh[6] | ((unsigned)hh[7] << 16);
      }
      *(uint4*)(win + rho * WST + 8 * gi) = pk;
    }
    {
      int b = tid >> 4, seg = tid & 15;
      uint4 p0 = make_uint4(0, 0, 0, 0), p1 = make_uint4(0, 0, 0, 0);
      if (b < nb) {
        const u16* src = (stage == 0 ? rawv : y1) + (size_t)b * L;
        const int s0 = S0 + seg * 16;
        uint4 r0 = *(const uint4*)(src + s0), r1 = *(const uint4*)(src + s0 + 8);
        if (stage == 0) {
          unsigned w[8] = {r0.x, r0.y, r0.z, r0.w, r1.x, r1.y, r1.z, r1.w};
          float x[18];
          x[0] = s0 > 0 ? bf2f(src[s0 - 1]) : 0.f;
          x[17] = s0 + 16 < L ? bf2f(src[s0 + 16]) : 0.f;
#pragma unroll
          for (int q = 0; q < 8; q++) { x[1 + 2 * q] = __uint_as_float(w[q] << 16); x[2 + 2 * q] = __uint_as_float(w[q] & 0xffff0000u); }
          unsigned o[8];
#pragma unroll
          for (int q = 0; q < 8; q++) {
            float c0 = v0 * x[2 * q] + v1 * x[2 * q + 1] + v2 * x[2 * q + 2] + vb;
            float c1 = v0 * x[2 * q + 1] + v1 * x[2 * q + 2] + v2 * x[2 * q + 3] + vb;
            o[q] = f2bf(c0) | ((unsigned)f2bf(c1) << 16);
          }
          p0 = make_uint4(o[0], o[1], o[2], o[3]); p1 = make_uint4(o[4], o[5], o[6], o[7]);
        } else { p0 = r0; p1 = r1; }
      }
      *(uint4*)(su + b * UST + seg * 16) = p0;
      *(uint4*)(su + b * UST + seg * 16 + 8) = p1;
    }
    __syncthreads();
    bf16x8 bfr[8];
#pragma unroll
    for (int j = 0; j < 8; j++) bfr[j] = *(const bf16x8*)(su + fr * UST + 32 * j + 8 * fq);
    const u16* wbase = win + (fr & 7) * WST + (8 * fq - 256 * w - 8 * (fr >> 3) + 1016);
#pragma unroll
    for (int dd = 0; dd < 30; dd++) {
      bf16x8 af = *(const bf16x8*)(wbase + 16 * (dd - 15));
#pragma unroll
      for (int j = 0; j < 8; j++) {
        const int i = 2 * j - (dd - 15);
        if (i >= 0 && i < 16) acc[i] = __builtin_amdgcn_mfma_f32_16x16x32_bf16(af, bfr[j], acc[i], 0, 0, 0);
      }
    }
  }
  __syncthreads();
  const float inv = sinv[0];
  const float bias = p.in[33][(size_t)(l * 2 + stage) * 256 + c];
  if (fr < nb) {
#pragma unroll
    for (int i = 0; i < 16; i++) {
      u16 r[4];
#pragma unroll
      for (int e = 0; e < 4; e++) {
        int t = T0 + 256 * w + 16 * i + 4 * fq + e;
        float uval = stage == 0 ? hy_conv3(rawv + (size_t)fr * L, t, L, v0, v1, v2, vb) : bf2f(y1[(size_t)fr * L + t]);
        float xg = hy_conv3(rawx + (size_t)fr * L, t, L, x0w, x1w, x2w, xbw);
        r[e] = f2bf(xg * (acc[i][e] * inv + bias * uval));
      }
      uint2 pk; pk.x = r[0] | ((unsigned)r[1] << 16); pk.y = r[2] | ((unsigned)r[3] << 16);
      *(uint2*)(outp + (size_t)fr * L + T0 + 256 * w + 16 * i + 4 * fq) = pk;
    }
  }
}
__device__ __forceinline__ void hy_final_item(char* smraw, const Params& p, int l, int ck) {
  int tid = threadIdx.x; asm volatile("" : "+v"(tid)); const int _tid_pad = 0, lane = tid & 63, w = tid >> 6;
  float* s = (float*)smraw;
  const u16* yd = (const u16*)(p.ws + O_DT) + (size_t)256 * T_ALL;
  const int t0 = ck * 64;
  __syncthreads();
  for (int i = 0; i < 64; i++) {
    int c = w * 64 + i;
    s[lane * 257 + c] = bf2f(yd[(size_t)c * T_ALL + t0 + lane]);
  }
  __syncthreads();
  const float* gn = p.in[34] + (l * 3 + 2) * 256;
  u16* mixD = (u16*)(p.ws + O_XN) + (size_t)3 * T_ALL * 256;
  for (int i = 0; i < 16; i++) {
    int tt = w * 16 + i;
    float v[4];
#pragma unroll
    for (int e = 0; e < 4; e++) v[e] = s[tt * 257 + lane * 4 + e];
    float ss = wave_sum(v[0] * v[0] + v[1] * v[1] + v[2] * v[2] + v[3] * v[3]);
    float rs = rsqrtf(ss * (1.f / 256.f) + EPSF);
    if (!(MIXMASK & 8)) rs = 0.f;
    uint2 pk;
    pk.x = f2bf(v[0] * rs * gn[lane * 4]) | ((unsigned)f2bf(v[1] * rs * gn[lane * 4 + 1]) << 16);
    pk.y = f2bf(v[2] * rs * gn[lane * 4 + 2]) | ((unsigned)f2bf(v[3] * rs * gn[lane * 4 + 3]) << 16);
    *(uint2*)(mixD + (size_t)(t0 + tt) * 256 + lane * 4) = pk;
  }
}

#define XB_CENS(j) (64 + 64 * (j))
#define XB_XSUB(j) (1088 + 64 * (j))
#define XB_XGEN(j) (2112 + 64 * (j))
#define XB_TOP 3136
#define XB_TOPGEN 3200
__device__ __forceinline__ unsigned xb_ld(unsigned* p) { return __hip_atomic_load(p, __ATOMIC_RELAXED, __HIP_MEMORY_SCOPE_AGENT); }
__device__ __forceinline__ unsigned xb_add(unsigned* p, unsigned v) { return __hip_atomic_fetch_add(p, v, __ATOMIC_RELAXED, __HIP_MEMORY_SCOPE_AGENT); }
__device__ __forceinline__ void xcd_barrier(unsigned* bar, unsigned x, unsigned nloc, unsigned nx, unsigned k) {
  asm volatile("s_waitcnt vmcnt(0) lgkmcnt(0)" ::: "memory");
  __syncthreads();
  if (threadIdx.x == 0) {
    const unsigned old = xb_add(&bar[XB_XSUB(x)], 1u);
    if (old + 1u == k * nloc) {
      __builtin_amdgcn_fence(__ATOMIC_RELEASE, "agent");
      asm volatile("s_waitcnt vmcnt(0)" ::: "memory");
      const unsigned og = xb_add(&bar[XB_TOP], 1u);
      if (og + 1u == k * nx) xb_add(&bar[XB_TOPGEN], 1u);
      else while (xb_ld(&bar[XB_TOPGEN]) < k) __builtin_amdgcn_s_sleep(1);
      __builtin_amdgcn_fence(__ATOMIC_ACQUIRE, "agent");
      xb_add(&bar[XB_XGEN(x)], 1u);
      asm volatile("s_waitcnt vmcnt(0)" ::: "memory");
    } else {
      while (xb_ld(&bar[XB_XGEN(x)]) < k) __builtin_amdgcn_s_sleep(1);
      __builtin_amdgcn_fence(__ATOMIC_ACQUIRE, "agent");
      asm volatile("s_waitcnt vmcnt(0)" ::: "memory");
    }
  }
  __syncthreads();
}
#define GRID_SYNC() do { ++bar_k; xcd_barrier(bar, bst[0], bst[1], bst[2], bar_k); } while (0)

#define TILE_LOOP(nM_, nN_, MT, NT)                                                                  \
  const int nSN_ = ((nN_) + 7) >> 3, nS_ = (((nM_) + 7) >> 3) * nSN_, P_ = nblk >> 3;                 \
  _Pragma("unroll 1") for (int S_ = (bid & 7); S_ < nS_ && (bid >> 3) < P_; S_ += 8)                 \
  _Pragma("unroll 1") for (int q_ = (bid >> 3); q_ < 64; q_ += P_)                                   \
    for (int MT = (S_ / nSN_) * 8 + (q_ >> 3), NT = (S_ % nSN_) * 8 + (q_ & 7), once_ = 1; once_ && MT < (nM_) && NT < (nN_); once_ = 0)

__global__ void __launch_bounds__(256, 2) mega(Params p) {
  cg::grid_group grid = cg::this_grid();
  __shared__ __attribute__((aligned(16))) char smraw[SMEM_BYTES];
  u16* smem = (u16*)smraw;
  float* smf = (float*)smraw;
  const int bid = blockIdx.x, nblk = gridDim.x, tid = threadIdx.x;
  const int rbid = nblk - 1 - bid;
  const int lane = tid & 63;
  char* const ws = p.ws;
  unsigned* const bar = (unsigned*)(ws + O_BAR);
  __shared__ unsigned bst[4];
  unsigned bar_k = 0;
  if (tid == 0) { bst[0] = (unsigned)__builtin_amdgcn_s_getreg((3 << 11) | 20) & 0xFu; xb_add(&bar[XB_CENS(bst[0])], 1u); }
  __threadfence();
  grid.sync();
  if (tid == 0) {
    unsigned mine = 0, cnt = 0;
    for (unsigned j = 0; j < 16; j++) { unsigned c = xb_ld(&bar[XB_CENS(j)]); cnt += c > 0u ? 1u : 0u; if (j == bst[0]) mine = c; }
    bst[1] = mine; bst[2] = cnt;
  }
  __syncthreads();

#ifdef NANFILL
  {
    uint4 nanv = make_uint4(0x7FC07FC0u, 0x7FC07FC0u, 0x7FC07FC0u, 0x7FC07FC0u);
    uint4* w4 = (uint4*)ws;
    for (size_t i = (size_t)bid * 256 + tid; i < WS_TOTAL / 16; i += (size_t)nblk * 256) w4[i] = nanv;
    uint4* o4 = (uint4*)p.out;
    for (size_t i = (size_t)bid * 256 + tid; i < (size_t)T_ALL * DM / 4; i += (size_t)nblk * 256) o4[i] = nanv;
    __threadfence(); grid.sync(); __threadfence();
  }
#endif
#pragma unroll 1
  for (int lay = 0; lay < 2; lay++) {
    {
      int l = lay; asm volatile("" : "+s"(l));
#pragma unroll 1
      for (int i = bid; i < 42 * 16; i += nblk) transpose_tile(smf, p.in[3] + (size_t)l * 1024 * 2576, 2576, p.in[2] + l * 1024, (u16*)(ws + O_WIN), 1024, 0, (i / 16) * 64, (i % 16) * 64);
#pragma unroll 1
      for (int i = rbid; i < 16 * 16; i += nblk) transpose_tile(smf, p.in[35] + (size_t)l * 1024 * 1024, 1024, nullptr, (u16*)(ws + O_WOUT), 1024, 1, (i / 16) * 64, (i % 16) * 64);
#pragma unroll 1
      for (int i = bid; i < 88 * 16; i += nblk) transpose_tile(smf, p.in[37] + (size_t)l * 1024 * 5632, 5632, p.in[36] + l * 1024, (u16*)(ws + O_WUP), 1024, 2, (i / 16) * 64, (i % 16) * 64);
#pragma unroll 1
      for (int i = rbid; i < 16 * 44; i += nblk) transpose_tile(smf, p.in[40] + (size_t)l * 2816 * 1024, 1024, nullptr, (u16*)(ws + O_WDN), 2816, 3, (i / 44) * 64, (i % 44) * 64);
#pragma unroll 1
      for (int i = bid; i < 16; i += nblk) transpose_tile(smf, p.in[19] + (size_t)l * 256 * 256, 256, nullptr, (u16*)(ws + O_WGLU), 256, 4, (i / 4) * 64, (i % 4) * 64);
#pragma unroll 1
      for (int i = rbid; i < 64; i += nblk) {
        u16* wl = (u16*)(ws + O_WLRU);
        for (int e = i * 1024 + tid; e < (i + 1) * 1024; e += 256) {
          int k = e & 63, n = (e >> 6) & 255, head = e >> 14;
          int d = n >> 7, gate = (n >> 6) & 1, j = n & 63;
          const float* wr_ = p.in[6]; const float* wi_ = p.in[8];
          size_t off_ = ((size_t)((l * 2 + d) * 4 + head) * 64 + k) * 64 + j;
          float vr_ = wr_[off_], vi_ = wi_[off_];
          wl[e] = f2bf(gate ? vi_ : vr_);
        }
      }
#pragma unroll 1
      for (int i = bid; i < 16 * 2 * 65; i += nblk) s5_prep_item(smf, p, l, i);
#pragma unroll 1
      for (int i = rbid; i < 16 * 2 * 64; i += nblk) s5_bts_item(p, l, i);
#pragma unroll 1
      for (int i = rbid; i < 96; i += nblk) hy_filter_item(smf, p, l, i < 32 ? 0 : 1, i < 32 ? i : i - 32);
      {
        unsigned* rq = (unsigned*)(ws + O_BAR + 208) + l;
        int* rslot = (int*)(smraw + SMEM_BYTES - 16);
#pragma unroll 1
        for (;;) {
          __syncthreads();
          if (tid == 0) *rslot = (int)atomicAdd(rq, 1u);
          __syncthreads();
          const int c0 = *rslot * 16;
          if (c0 >= T_ALL / 4) break;
#pragma unroll 1
          for (int i = c0; i < c0 + 16; i++) rms_rows_to_bf16(p, l, i);
        }
      }
    }
    GRID_SYNC();
    {
      int l = lay; asm volatile("" : "+s"(l));
      TILE_LOOP(640, 21, mt, nt) {
        { const float* H = gemm_tile(smem, (const u16*)(ws + O_XN), 1024, mt * 128, 0, T_ALL, 30, 0, (const u16*)(ws + O_WIN) + (size_t)nt * 128 * 1024, 1024, 1024);
            int tid_o = threadIdx.x; asm volatile("" : "+v"(tid_o));
            const int tok0 = mt * 128;
            if (nt < 4) {
              u16* zA = (u16*)(ws + O_ZA) + (size_t)tok0 * 512 + nt * 128;
              EPI_ROWS(H, { *(uint2*)(zA + (size_t)r * 512 + c) = pack4(v.x, v.y, v.z, v.w); })
            } else if (nt < 6) {
              u16* uh = (u16*)(ws + O_UH);
              EPI_ROWS(H, {
                int tok = tok0 + r, ch = (nt - 4) * 128 + c;
                *(uint2*)(uh + ((size_t)(ch >> 4) * 1280 + (tok >> 6)) * 1280 + (tok & 63) * 16 + (ch & 15)) = pack4(v.x, v.y, v.z, v.w); })
            } else if (nt < 14) {
              u16* zC = (u16*)(ws + O_ZC) + (size_t)tok0 * 1024 + (nt - 6) * 128;
              EPI_ROWS(H, { *(uint2*)(zC + (size_t)r * 1024 + c) = pack4(v.x, v.y, v.z, v.w); })
            } else if (nt < 20) {
              u16* dt = (u16*)(ws + O_DT) + (size_t)((nt - 14) * 128 + (tid_o & 127)) * T_ALL + tok0 + (tid_o >> 7) * 64;
              const float* Hc = H + (tid_o >> 7) * 64 * HST + (tid_o & 127);
#pragma unroll 2
              for (int k = 0; k < 8; k++) {
                uint2 a = pack4(Hc[(8 * k) * HST], Hc[(8 * k + 1) * HST], Hc[(8 * k + 2) * HST], Hc[(8 * k + 3) * HST]);
                uint2 b = pack4(Hc[(8 * k + 4) * HST], Hc[(8 * k + 5) * HST], Hc[(8 * k + 6) * HST], Hc[(8 * k + 7) * HST]);
                uint4 pk; pk.x = a.x; pk.y = a.y; pk.z = b.x; pk.w = b.y;
                *(uint4*)(dt + 8 * k) = pk;
              }
            } else {
              float* ba = (float*)(ws + O_BA) + (size_t)tok0 * 16;
#pragma unroll 2
              for (int k = 0; k < 8; k++) { int idx = tid_o + 256 * k; ba[idx] = H[(idx >> 4) * HST + (idx & 15)]; }
            }
          }
      }
#pragma unroll 1
      for (int it = rbid; it < 16 * 1024; it += nblk) s5_expand_item(p, l, it);
    }
    GRID_SYNC();
    {
      int l = lay; asm volatile("" : "+s"(l));
#pragma unroll 1
      for (int it = bid; it < NCH64 * 4; it += nblk) gdn_g1_item(smraw, p, l, it);
#pragma unroll 1
      for (int it = rbid; it < 16 * 10 * 2; it += nblk) {
        const int g = it / 20, mt = (it % 20) >> 1, nt = it & 1;
        { const float* H = gemm_tile(smem, (const u16*)(ws + O_UH) + (size_t)g * 1280 * 1280, 1280, mt * 128, 0, 1280, 30, 0,
                  (const u16*)(ws + O_BTS) + (size_t)g * 256 * 1024 + (size_t)nt * 128 * 1024, 1024, 1024);
            int tid_o = threadIdx.x; asm volatile("" : "+v"(tid_o));
            float* send = (float*)(ws + O_SEND) + (size_t)g * 1280 * 256 + (size_t)mt * 128 * 256 + nt * 128;
            EPI_ROWS(H, { *(float4*)(send + (size_t)r * 256 + c) = v; })
          }
      }
#pragma unroll 1
      for (int it = bid; it < NCH32 * 4; it += nblk) lru_item(smraw, p, l, it, 0);
    }
    GRID_SYNC();
    {
      int l = lay; asm volatile("" : "+s"(l));
#pragma unroll 1
      for (int it = bid; it < 192; it += nblk) gdn_chain(smraw, p, it);
#pragma unroll 1
      for (int it = rbid; it < 48; it += nblk) lru_propagate(p, it * 256 + tid);
#pragma unroll 1
      for (int it = rbid - 48; it < 192; it += nblk) { if (it >= 0) s5_propagate(p, l, it * 256 + tid); }
      unsigned* hq = (unsigned*)(ws + O_BAR + 192) + l;
      int* hslot = (int*)(smraw + SMEM_BYTES - 16);
#pragma unroll 1
      for (;;) {
        __syncthreads();
        if (tid == 0) *hslot = (int)atomicAdd(hq, 1u);
        __syncthreads();
        const int item = *hslot;
        if (item >= 512) break;
        const int set = item < 256 ? 1 : 0, c = item & 255, ntb = set ? 4 : 2;
#pragma unroll 1
        for (int tb = 0; tb < ntb; tb++) hy_conv_item(smraw, p, l, 0, set, c, tb);
        __threadfence();
        __syncthreads();
#pragma unroll 1
        for (int tb = 0; tb < ntb; tb++) hy_conv_item(smraw, p, l, 1, set, c, tb);
      }
    }
    GRID_SYNC();
    {
      int l = lay; asm volatile("" : "+s"(l));
#pragma unroll 1
      for (int it = rbid; it < 16 * 10 * 8; it += nblk) {
        const int g = it / 80, mt = (it % 80) >> 3, nt = it & 7;
        { const float* H = gemm_tile(smem, (const u16*)(ws + O_UH) + (size_t)g * 1280 * 1280, 1280, mt * 128, 0, 1280, 30, 0,
                  (const u16*)(ws + O_BTY) + (size_t)g * 1024 * 1280 + (size_t)nt * 128 * 1280, 1280, 1280);
            int tid_o = threadIdx.x; asm volatile("" : "+v"(tid_o));
            u16* zb = (u16*)(ws + O_XN) + (size_t)3 * T_ALL * 256;
            EPI_ROWS(H, {
              int ck = mt * 128 + r, n = nt * 128 + c;
              *(uint2*)(zb + ((size_t)g * T_ALL + ck * 64 + (n >> 4)) * 16 + (n & 15)) = pack4(geluf_(v.x), geluf_(v.y), geluf_(v.z), geluf_(v.w)); })
          }
      }
#pragma unroll 1
      for (int it = bid; it < NCH32 * 4; it += nblk) lru_item(smraw, p, l, it, 1);
#pragma unroll 1
      for (int it = rbid; it < T_ALL / 4; it += nblk) gdn_final_rows(p, l, it);
    }
    GRID_SYNC();
    {
      int l = lay; asm volatile("" : "+s"(l));
#pragma unroll 1
      for (int it = bid; it < 640 * 2; it += nblk) {
        const int mt = it >> 1, nt = it & 1;
        const u16* zb = (const u16*)(ws + O_XN) + (size_t)3 * T_ALL * 256;
        { const float* H = gemm_tile(smem, zb, 16, mt * 128, 0, T_ALL, 4, (size_t)T_ALL * 16, (const u16*)(ws + O_WGLU) + (size_t)nt * 128 * 256, 256, 256);
            int tid_o = threadIdx.x; asm volatile("" : "+v"(tid_o));
            u16* mixB = (u16*)(ws + O_XN) + (size_t)T_ALL * 256 + (size_t)mt * 128 * 256 + nt * 128;
            const u16* zr = zb + (size_t)mt * 128 * 16;
            const float* gb = p.in[20] + l * 256 + nt * 128;
            EPI_ROWS(H, {
              uint2 zz = *(const uint2*)(zr + ((size_t)((nt * 128 + c) >> 4) * T_ALL + r) * 16 + (c & 15));
              float4 g4 = *(const float4*)(gb + c);
              float z0 = bf2f(zz.x & 0xffff), z1 = bf2f(zz.x >> 16), z2 = bf2f(zz.y & 0xffff), z3 = bf2f(zz.y >> 16);
              *(uint2*)(mixB + (size_t)r * 256 + c) = pack4(z0 * sigmoidf_(v.x + g4.x), z1 * sigmoidf_(v.y + g4.y), z2 * sigmoidf_(v.z + g4.z), z3 * sigmoidf_(v.w + g4.w)); })
          }
      }
#pragma unroll 1
      for (int it = rbid; it < T_ALL / 4; it += nblk) grpnorm_rows(p, l, 0, it);
    }
    GRID_SYNC();
    {
      int l = lay; asm volatile("" : "+s"(l));
#pragma unroll 1
      for (int it = bid; it < NCH64; it += nblk) hy_final_item(smraw, p, l, it);
#pragma unroll 1
      for (int it = rbid; it < T_ALL / 4; it += nblk) grpnorm_rows(p, l, 1, it);
    }
    GRID_SYNC();
    {
      int l = lay; asm volatile("" : "+s"(l));
      TILE_LOOP(640, 8, mt, nt) {
        { const float* H = gemm_tile(smem, (const u16*)(ws + O_XN), 256, mt * 128, 0, T_ALL, 8, (size_t)T_ALL * 256,
                  (const u16*)(ws + O_WOUT) + (size_t)nt * 128 * 1024, 1024, 1024);
            int tid_o = threadIdx.x; asm volatile("" : "+v"(tid_o));
            float* o = p.out + (size_t)mt * 128 * DM + nt * 128;
            EPI_ROWS(H, {
              float4 b4 = *(const float4*)(xrow(p, l, mt * 128 + r) + nt * 128 + c);
              float4 o4; o4.x = b4.x + v.x; o4.y = b4.y + v.y; o4.z = b4.z + v.z; o4.w = b4.w + v.w;
              *(float4*)(o + (size_t)r * DM + c) = o4; })
          }
      }
    }
    GRID_SYNC();
    {
      int l = lay; asm volatile("" : "+s"(l));
#pragma unroll 1
      for (int it = bid; it < T_ALL / 4; it += nblk) rms_rows_to_bf16(p, 1, it);
    }
    GRID_SYNC();
    {
      int l = lay; asm volatile("" : "+s"(l));
      const int nM = 8 * 17 + 16 * 33;
      TILE_LOOP(nM, 44, mi, nt) {
        int seq, ti, L;
        if (mi < 136) { seq = mi / 17; ti = mi % 17; L = 2048; }
        else { seq = 8 + (mi - 136) / 33; ti = (mi - 136) % 33; L = 4096; }
        const int s0 = seq < 8 ? seq * 2048 : T_P + (seq - 8) * 4096;
        const int arow0 = s0 + 126 * ti - 1;
        const int nvalid = min(126, L - 126 * ti);
        { const float* H = gemm_tile(smem, (const u16*)(ws + O_XN), 1024, arow0, s0, s0 + L, 30, 0, (const u16*)(ws + O_WUP) + (size_t)nt * 128 * 1024, 1024, 1024);
            int tid_o = threadIdx.x; asm volatile("" : "+v"(tid_o));
            const int j = tid_o & 63, rg = tid_o >> 6;
            const float* cw = p.in[38] + (size_t)l * 3 * 5632;
            const float* cb = p.in[39] + (size_t)l * 5632;
            const int cg_ = nt * 64 + j, cv_ = DFF + nt * 64 + j;
            const float g0 = cw[cg_], g1 = cw[5632 + cg_], g2 = cw[2 * 5632 + cg_], gb = cb[cg_];
            const float u0 = cw[cv_], u1 = cw[5632 + cv_], u2 = cw[2 * 5632 + cv_], ub = cb[cv_];
            u16* hm = (u16*)(ws + O_HMID) + (size_t)arow0 * DFF + nt * 64 + j;
#pragma unroll 2
            for (int r = 1 + rg; r <= nvalid; r += 4) {
              float gate = g0 * H[(r - 1) * HST + j] + g1 * H[r * HST + j] + g2 * H[(r + 1) * HST + j] + gb;
              float val = u0 * H[(r - 1) * HST + 64 + j] + u1 * H[r * HST + 64 + j] + u2 * H[(r + 1) * HST + 64 + j] + ub;
              hm[(size_t)r * DFF] = f2bf(siluf_(gate) * val);
            }
          }
      }
    }
    GRID_SYNC();
    {
      int l = lay; asm volatile("" : "+s"(l));
      TILE_LOOP(640, 8, mt, nt) {
        { const float* H = gemm_tile(smem, (const u16*)(ws + O_HMID), DFF, mt * 128, 0, T_ALL, 30, 0, (const u16*)(ws + O_WDN) + (size_t)nt * 128 * DFF, DFF, DFF);
            int tid_o = threadIdx.x; asm volatile("" : "+v"(tid_o));
            float* o = p.out + (size_t)mt * 128 * DM + nt * 128;
            EPI_ROWS(H, {
              float4 b4 = *(const float4*)(o + (size_t)r * DM + c);
              b4.x += v.x; b4.y += v.y; b4.z += v.z; b4.w += v.w;
              *(float4*)(o + (size_t)r * DM + c) = b4; })
          }
      }
    }
    GRID_SYNC();
  }
  {
    const int w = tid >> 6;
    const float* fn = p.in[41];
#pragma unroll 1
    for (int it = bid; it < T_ALL / 4; it += nblk) {
      int tok = it * 4 + w;
      float* x = p.out + (size_t)tok * DM;
      float4 v[4];
      float ss = 0.f;
#pragma unroll
      for (int i = 0; i < 4; i++) {
        v[i] = *(const float4*)(x + i * 256 + lane * 4);
        ss += v[i].x * v[i].x + v[i].y * v[i].y + v[i].z * v[i].z + v[i].w * v[i].w;
      }
      ss = wave_sum(ss);
      float rs = rsqrtf(ss * (1.f / 1024.f) + EPSF);
#pragma unroll
      for (int i = 0; i < 4; i++) {
        float4 g = *(const float4*)(fn + i * 256 + lane * 4);
        float4 o; o.x = v[i].x * rs * g.x; o.y = v[i].y * rs * g.y; o.z = v[i].z * rs * g.z; o.w = v[i].w * rs * g.w;
        *(float4*)(x + i * 256 + lane * 4) = o;
      }
    }
  }
}

extern "C" void kernel_launch(void* const* d_in, const int* in_sizes, int n_in,
                              void* d_out, int out_size, void* d_ws, size_t ws_size,
                              hipStream_t stream) {
  static int grid_blocks = 0;
  if (!grid_blocks) {
    int dev = 0, cus = 0, per_cu = 0;
    (void)hipGetDevice(&dev);
    (void)hipDeviceGetAttribute(&cus, hipDeviceAttributeMultiprocessorCount, dev);
    (void)hipOccupancyMaxActiveBlocksPerMultiprocessor(&per_cu, mega, 256, 0);
    if (per_cu > 2) per_cu = 2;
    if (per_cu < 1) per_cu = 1;
    grid_blocks = cus * per_cu;
  }
  if (ws_size < WS_TOTAL) fprintf(stderr, "workspace too small: %zu < %zu\n", ws_size, (size_t)WS_TOTAL);
  Params p{};
  for (int i = 0; i < 42; i++) p.in[i] = (const float*)d_in[i];
  p.out = (float*)d_out;
  p.ws = (char*)d_ws;
  (void)hipMemsetAsync((char*)d_ws + O_BAR, 0, 16384, stream);
  void* args[] = {&p};
  hipError_t e = hipLaunchCooperativeKernel((void*)mega, dim3(grid_blocks), dim3(256), args, 0, stream);
  if (e != hipSuccess) fprintf(stderr, "coop launch failed: %s (grid %d)\n", hipGetErrorString(e), grid_blocks);
}
```

```cpp
#include <hip/hip_runtime.h>
#include <hip/hip_bf16.h>
#include <hip/hip_cooperative_groups.h>
#include <cstdio>
namespace cg = cooperative_groups;

typedef unsigned short u16;
using bf16x8 = __attribute__((ext_vector_type(8))) short;
using f32x4 = __attribute__((ext_vector_type(4))) float;

#define T_ALL 81920
#define T_P 16384
#define DM 1024
#define NZ 2688
#define DFF 2816
#define NCH32 2560
#define NCH64 1280
#define EPSF 1e-6f

constexpr size_t al(size_t x) { return (x + 255) & ~(size_t)255; }
constexpr size_t O_WIN = 0;
constexpr size_t O_WOUT = O_WIN + al((size_t)NZ * 1024 * 2);
constexpr size_t O_WUP = O_WOUT + al((size_t)1024 * 1024 * 2);
constexpr size_t O_WDN = O_WUP + al((size_t)5632 * 1024 * 2);
constexpr size_t O_WLRU = O_WDN + al((size_t)1024 * 2816 * 2);
constexpr size_t O_WGLU = O_WLRU + al((size_t)4 * 256 * 64 * 2);
constexpr size_t O_AB64 = O_WGLU + al((size_t)256 * 256 * 2);
constexpr size_t O_KTAB = O_AB64 + 2 * al((size_t)2 * 16 * 64 * 2 * 4);
constexpr size_t O_BTY = O_KTAB + al((size_t)16 * 2 * 64 * 256 * 4);
constexpr size_t O_BTS = O_BTY + al((size_t)16 * 1024 * 1280 * 2);
constexpr size_t O_HYKR = O_BTS + al((size_t)16 * 256 * 1024 * 2);
constexpr size_t HYKR1 = (size_t)2 * 256 * 4096;
constexpr size_t O_HYPS = O_HYKR + al((size_t)2 * 256 * (4096 + 8192) * 2);
constexpr size_t O_XN = O_HYPS + al((size_t)(32 + 64) * 512 * 4);
constexpr size_t O_ZA = O_XN + al((size_t)T_ALL * 1024 * 2);
constexpr size_t O_UH = O_ZA + al((size_t)T_ALL * 512 * 2);
constexpr size_t O_ZC = O_UH + al((size_t)16 * 1280 * 1280 * 2);
constexpr size_t O_BA = O_ZC + al((size_t)T_ALL * 1024 * 2);
constexpr size_t O_DT = O_BA + al((size_t)T_ALL * 16 * 4);
constexpr size_t O_WU = O_DT + al((size_t)768 * T_ALL * 2);
constexpr size_t O_GC = O_WU + al((size_t)NCH64 * 4 * 2 * 2 * 4096 * 2);
constexpr size_t O_OD = O_GC + al((size_t)T_ALL * 8 * 4);
constexpr size_t O_Y1 = O_OD + al((size_t)2 * T_ALL * 256 * 2);
constexpr size_t O_SEND = O_Y1 + al((size_t)256 * T_ALL * 2);
constexpr size_t O_LCAR = O_SEND + al((size_t)16 * 1280 * 256 * 4);
constexpr size_t O_LHIN = O_LCAR + al((size_t)NCH32 * 512 * 8);
constexpr size_t O_BAR = O_LHIN + al((size_t)NCH32 * 512 * 4);
constexpr size_t WS_TOTAL = O_BAR + 16384;
static_assert(WS_TOTAL <= (size_t)1073741824, "ws");
constexpr size_t O_HMID = O_ZA;
static_assert(O_HMID + (size_t)T_ALL * DFF * 2 <= O_GC, "hmid alias");

struct Params {
  const float* in[42];
  float* out;
  char* ws;
};

#define SMEM_BYTES 73728
#ifndef MIXMASK
#define MIXMASK 15
#endif

__device__ __forceinline__ u16 f2bf(float f) {
  unsigned u = __float_as_uint(f);
  u += 0x7fffu + ((u >> 16) & 1u);
  return (u16)(u >> 16);
}
__device__ __forceinline__ float bf2f(u16 h) { return __uint_as_float(((unsigned)h) << 16); }
__device__ __forceinline__ float sigmoidf_(float x) { return 1.f / (1.f + __expf(-x)); }
__device__ __forceinline__ float siluf_(float x) { return x / (1.f + __expf(-x)); }
__device__ __forceinline__ float softplusf_(float x) { return x > 20.f ? x : log1pf(expf(x)); }
__device__ __forceinline__ float geluf_(float x) {
  float t = tanhf(0.7978845608028654f * (x + 0.044715f * x * x * x));
  return 0.5f * x * (1.f + t);
}
__device__ __forceinline__ float wave_sum(float v) {
#pragma unroll
  for (int o = 32; o > 0; o >>= 1) v += __shfl_xor(v, o);
  return v;
}
__device__ __forceinline__ const float* xrow(const Params& p, int l, int tok) {
  const float* a = p.in[0]; const float* b = p.in[1]; const float* o = p.out;
  const float* r0 = a + (size_t)tok * DM;
  const float* r1 = b + (size_t)(tok - T_P) * DM;
  const float* r2 = o + (size_t)tok * DM;
  return l == 0 ? (tok < T_P ? r0 : r1) : r2;
}
__device__ __forceinline__ void seq_bounds(int tok, int& lo, int& hi) {
  if (tok < T_P) { lo = tok & ~2047; hi = lo + 2048; }
  else { lo = T_P + ((tok - T_P) & ~4095); hi = lo + 4096; }
}

#define LDS_BARRIER() asm volatile("s_waitcnt lgkmcnt(0)\n\ts_barrier" ::: "memory")

#define GST 72
#define HST 132
__device__ __forceinline__ const float* gemm_tile(u16* smem, const u16* __restrict__ A, long lda, int arow0, int alo, int ahi,
                                          int segShift, size_t segStride,
                                          const u16* __restrict__ Bt, long ldb, int K) {
  u16* sA = smem;
  u16* sB = smem + 2 * 128 * GST;
  int tid = threadIdx.x; asm volatile("" : "+v"(tid)); const int _tid_pad = 0, lane = tid & 63, w = tid >> 6;
  const int wm = w >> 1, wn = w & 1, fr = lane & 15, fq = lane >> 4;
  const int cc = tid & 7, r0 = tid >> 3;
  f32x4 acc[4][4];
#pragma unroll
  for (int i = 0; i < 4; i++)
#pragma unroll
    for (int j = 0; j < 4; j++) acc[i][j] = (f32x4){0.f, 0.f, 0.f, 0.f};
  uint4 ra0x, ra1x, ra2x, ra3x, rb0x, rb1x, rb2x, rb3x;
  const int nk = K >> 6;
#define GROW(i_, AP, BP, OK) const bool OK = (arow0 + r0 + 32 * i_) >= alo && (arow0 + r0 + 32 * i_) < ahi;        \
    const u16* AP = A + (long)(OK ? (arow0 + r0 + 32 * i_) : alo) * lda;                                             \
    const u16* BP = Bt + (long)(r0 + 32 * i_) * ldb + cc * 8;
  GROW(0, ap0, bp0, ok0) GROW(1, ap1, bp1, ok1) GROW(2, ap2, bp2, ok2) GROW(3, ap3, bp3, ok3)
#define GLOAD1(AP, BP, OK, RA, RB) {                                                \
      uint4 t_ = *(const uint4*)(AP + aoff_);                                         \
      RA = OK ? t_ : make_uint4(0, 0, 0, 0);                                          \
      RB = *(const uint4*)(BP + k0_); }
#define GLOAD(kt_, S) do {                                                         \
    const int k0_ = (kt_) << 6;                                                       \
    const int kk_ = k0_ + cc * 8;                                                     \
    const int sg_ = kk_ >> segShift;                                                  \
    const size_t aoff_ = (size_t)sg_ * segStride + (kk_ - (sg_ << segShift));         \
    GLOAD1(ap0, bp0, ok0, ra0##S, rb0##S) GLOAD1(ap1, bp1, ok1, ra1##S, rb1##S)       \
    GLOAD1(ap2, bp2, ok2, ra2##S, rb2##S) GLOAD1(ap3, bp3, ok3, ra3##S, rb3##S)       \
    } while (0)
#define SWRITE1(buf_, i_, RA, RB) {                                                 \
      *(uint4*)(sA + (buf_) * 128 * GST + (r0 + 32 * i_) * GST + cc * 8) = RA;        \
      *(uint4*)(sB + (buf_) * 128 * GST + (r0 + 32 * i_) * GST + cc * 8) = RB; }
#define SWRITE(buf_, S) do {                                                        \
    SWRITE1(buf_, 0, ra0##S, rb0##S) SWRITE1(buf_, 1, ra1##S, rb1##S) SWRITE1(buf_, 2, ra2##S, rb2##S) SWRITE1(buf_, 3, ra3##S, rb3##S) \
    } while (0)
#define GCOMPUTE(buf_) do {                                                         \
    const u16* a = sA + (buf_) * 128 * GST;                                           \
    const u16* b = sB + (buf_) * 128 * GST;                                           \
    _Pragma("unroll") for (int ks = 0; ks < 2; ks++) {                                \
      bf16x8 af[4], bfr[4];                                                           \
      _Pragma("unroll") for (int i = 0; i < 4; i++) {                                 \
        af[i] = *(const bf16x8*)(a + (64 * wm + 16 * i + fr) * GST + ks * 32 + fq * 8);   \
        bfr[i] = *(const bf16x8*)(b + (64 * wn + 16 * i + fr) * GST + ks * 32 + fq * 8);  \
      }                                                                               \
      _Pragma("unroll") for (int i = 0; i < 4; i++)                                   \
      _Pragma("unroll") for (int j = 0; j < 4; j++)                                   \
        acc[i][j] = __builtin_amdgcn_mfma_f32_16x16x32_bf16(af[i], bfr[j], acc[i][j], 0, 0, 0); \
    } } while (0)
  LDS_BARRIER();
  GLOAD(0, x);
  SWRITE(0, x);
  LDS_BARRIER();
#pragma unroll 1
  for (int kt = 0; kt < nk; kt += 2) {
    if (kt + 1 < nk) GLOAD(kt + 1, x);
    GCOMPUTE(0);
    if (kt + 1 < nk) SWRITE(1, x);
    LDS_BARRIER();
    if (kt + 1 >= nk) break;
    if (kt + 2 < nk) GLOAD(kt + 2, x);
    GCOMPUTE(1);
    if (kt + 2 < nk) SWRITE(0, x);
    LDS_BARRIER();
  }
  float* H = (float*)smem;
#pragma unroll
  for (int i = 0; i < 4; i++)
#pragma unroll
    for (int j = 0; j < 4; j++)
#pragma unroll
      for (int e = 0; e < 4; e++) H[(64 * wm + 16 * i + 4 * fq + e) * HST + 64 * wn + 16 * j + fr] = acc[i][j][e];
  LDS_BARRIER();
  return H;
}
__device__ __forceinline__ uint2 pack4(float a, float b, float c, float d) {
  uint2 pk; pk.x = f2bf(a) | ((unsigned)f2bf(b) << 16); pk.y = f2bf(c) | ((unsigned)f2bf(d) << 16); return pk;
}
#define EPI_ROWS(H, BODY...)                                                     \
  _Pragma("unroll 4") for (int _it = 0; _it < 16; _it++) {                       \
    const int r = (tid_o >> 5) + 8 * _it, c = (tid_o & 31) * 4;      \
    const float4 v = *(const float4*)((H) + r * HST + c); BODY }

__device__ __forceinline__ int colmap(int mode, int n) {
  if (mode == 0) {
    if (n < 1792) return n;
    if (n < 2560) return n + 16;
    if (n < 2576) return 1792 + (n - 2560);
    return -1;
  }
  if (mode == 2) { int nt = n >> 7, c = n & 127; return c < 64 ? nt * 64 + c : DFF + nt * 64 + (c - 64); }
  return n;
}
__device__ __forceinline__ void transpose_tile(float* sm, const float* __restrict__ src, int ldsrc, const float* __restrict__ gain,
                               u16* __restrict__ dst, int K, int mode, int n0, int k0) {
  int tid = threadIdx.x; asm volatile("" : "+v"(tid)); const int _tid_pad = 0;
  LDS_BARRIER();
  {
    int nn = tid & 63;
    int sc = colmap(mode, n0 + nn);
#pragma unroll
    for (int i = 0; i < 16; i++) {
      int kk = (tid >> 6) + 4 * i;
      float v = 0.f;
      if (sc >= 0) { v = src[(size_t)(k0 + kk) * ldsrc + sc]; if (gain) v *= gain[k0 + kk]; }
      sm[kk * 65 + nn] = v;
    }
  }
  LDS_BARRIER();
  {
    int c = tid & 7;
#pragma unroll
    for (int i = 0; i < 2; i++) {
      int nn = (tid >> 3) + 32 * i;
      u16 h[8];
#pragma unroll
      for (int e = 0; e < 8; e++) h[e] = f2bf(sm[(c * 8 + e) * 65 + nn]);
      uint4 pk;
      pk.x = h[0] | ((unsigned)h[1] << 16); pk.y = h[2] | ((unsigned)h[3] << 16);
      pk.z = h[4] | ((unsigned)h[5] << 16); pk.w = h[6] | ((unsigned)h[7] << 16);
      *(uint4*)(dst + (size_t)(n0 + nn) * K + k0 + c * 8) = pk;
    }
  }
}

__device__ __forceinline__ void s5_prep_item(float* sm, const Params& p, int l, int item) {
  int tid = threadIdx.x; asm volatile("" : "+v"(tid)); const int _tid_pad = 0;
  const int m = item % 65, d = (item / 65) & 1, g = item / 130;
  float* s_abm = sm;
  float* s_q = sm + 128;
  const int ldg = (l * 2 + d) * 16 + g;
  LDS_BARRIER();
  if (tid < 64) {
    int pi = ldg * 64 + tid;
    float dt = expf(p.in[13][ldg]);
    float are = p.in[11][pi], aim = p.in[12][pi];
    float mag = expf(dt * are), ang = dt * aim;
    float abr = mag * cosf(ang), abi = mag * sinf(ang);
    float den = are * are + aim * aim;
    float nre = abr - 1.f;
    s_q[tid * 2] = (nre * are + abi * aim) / den;
    s_q[tid * 2 + 1] = (abi * are - nre * aim) / den;
    float mm = expf((float)m * dt * are), am = (float)m * ang;
    float pr = mm * cosf(am), pim = mm * sinf(am);
    s_abm[tid * 2] = pr; s_abm[tid * 2 + 1] = pim;
    if (m == 64) {
      float* ab64 = (float*)(p.ws + O_AB64) + (size_t)l * 2 * 16 * 64 * 2;
      ab64[((d * 16 + g) * 64 + tid) * 2] = pr;
      ab64[((d * 16 + g) * 64 + tid) * 2 + 1] = pim;
    }
  }
  LDS_BARRIER();
  const float* bre = p.in[14] + (size_t)ldg * 64 * 16;
  const float* bim = p.in[15] + (size_t)ldg * 64 * 16;
  const float* cre = p.in[16] + (size_t)ldg * 16 * 64;
  const float* cim = p.in[17] + (size_t)ldg * 16 * 64;
  u16* bty = (u16*)(p.ws + O_BTY) + (size_t)g * 1024 * 1280;
  u16* bts = (u16*)(p.ws + O_BTS) + (size_t)g * 256 * 1024;
  if (m <= 63) {
    int ho = tid >> 4, hi = tid & 15;
    float acc = 0.f;
    for (int pp = 0; pp < 64; pp++) {
      float cr = cre[ho * 64 + pp], ci = cim[ho * 64 + pp];
      float ar = s_abm[pp * 2], ai = s_abm[pp * 2 + 1];
      float t1r = cr * ar - ci * ai, t1i = cr * ai + ci * ar;
      float qr = s_q[pp * 2], qi = s_q[pp * 2 + 1];
      float br = bre[pp * 16 + hi], bi = bim[pp * 16 + hi];
      float bbr = qr * br - qi * bi, bbi = qr * bi + qi * br;
      acc += t1r * bbr - t1i * bbi;
    }
    float* kt = (float*)(p.ws + O_KTAB);
    kt[((size_t)((g * 2 + d) * 64 + m)) * 256 + ho * 16 + hi] = acc;
  }
  if (m >= 1) {
    int t = d == 0 ? m - 1 : 64 - m;
    for (int e = tid; e < 1024; e += 256) {
      int ho = e >> 6, pp = e & 63;
      float cr = cre[ho * 64 + pp], ci = cim[ho * 64 + pp];
      float ar = s_abm[pp * 2], ai = s_abm[pp * 2 + 1];
      float xr = cr * ar - ci * ai, xi = cr * ai + ci * ar;
      size_t o = (size_t)(t * 16 + ho) * 1280 + 1024 + d * 128 + pp * 2;
      bty[o] = f2bf(xr);
      bty[o + 1] = f2bf(-xi);
    }
  }
}
__device__ __forceinline__ void s5_bts_item(const Params& p, int l, int item) {
  int tid = threadIdx.x; asm volatile("" : "+v"(tid));
  const int pp = item & 63, d = (item >> 6) & 1, g = item >> 7;
  const int sp = tid >> 2, hq = tid & 3;
  const int ldg = (l * 2 + d) * 16 + g;
  const int pi = ldg * 64 + pp;
  float dt = expf(p.in[13][ldg]);
  float are = p.in[11][pi], aim = p.in[12][pi];
  float mag = expf(dt * are), ang = dt * aim;
  float abr = mag * cosf(ang), abi = mag * sinf(ang);
  float den = are * are + aim * aim;
  float nre = abr - 1.f;
  float qr = (nre * are + abi * aim) / den, qi = (abi * are - nre * aim) / den;
  const int f = d == 0 ? 63 - sp : sp;
  float mm = expf((float)f * dt * are), am = (float)f * ang;
  float ar = mm * cosf(am), ai = mm * sinf(am);
  const float* bre = p.in[14] + (size_t)ldg * 64 * 16 + pp * 16 + hq * 4;
  const float* bim = p.in[15] + (size_t)ldg * 64 * 16 + pp * 16 + hq * 4;
  float fr_[4], fi_[4];
#pragma unroll
  for (int e = 0; e < 4; e++) {
    float br = bre[e], bi = bim[e];
    float bbr = qr * br - qi * bi, bbi = qr * bi + qi * br;
    fr_[e] = ar * bbr - ai * bbi; fi_[e] = ar * bbi + ai * bbr;
  }
  u16* bts = (u16*)(p.ws + O_BTS) + (size_t)g * 256 * 1024 + (size_t)(d * 128 + pp * 2) * 1024 + sp * 16 + hq * 4;
  *(uint2*)bts = pack4(fr_[0], fr_[1], fr_[2], fr_[3]);
  *(uint2*)(bts + 1024) = pack4(fi_[0], fi_[1], fi_[2], fi_[3]);
}
__device__ __forceinline__ void s5_expand_item(const Params& p, int l, int item) {
  int tid = threadIdx.x; asm volatile("" : "+v"(tid)); const int _tid_pad = 0;
  int g = item >> 10, n = item & 1023, t = n >> 4, ho = n & 15;
  int sp = tid >> 2, hi0 = (tid & 3) * 4;
  const float* kt = (const float*)(p.ws + O_KTAB);
  float v[4] = {0.f, 0.f, 0.f, 0.f};
  if (t >= sp) {
    const float* k0 = kt + ((size_t)((g * 2 + 0) * 64 + (t - sp))) * 256 + ho * 16 + hi0;
#pragma unroll
    for (int e = 0; e < 4; e++) v[e] += k0[e];
  }
  if (sp >= t) {
    const float* k1 = kt + ((size_t)((g * 2 + 1) * 64 + (sp - t))) * 256 + ho * 16 + hi0;
#pragma unroll
    for (int e = 0; e < 4; e++) v[e] += k1[e];
  }
  if (t == sp && ho >= hi0 && ho < hi0 + 4) v[ho - hi0] += p.in[18][l * 256 + g * 16 + ho];
  u16* bty = (u16*)(p.ws + O_BTY) + (size_t)g * 1024 * 1280 + (size_t)n * 1280 + sp * 16 + hi0;
  uint2 pk;
  pk.x = f2bf(v[0]) | ((unsigned)f2bf(v[1]) << 16);
  pk.y = f2bf(v[2]) | ((unsigned)f2bf(v[3]) << 16);
  *(uint2*)bty = pk;
}

__device__ __forceinline__ void hy_filter_item(float* sm, const Params& p, int l, int set, int tb) {
  int tid = threadIdx.x; asm volatile("" : "+v"(tid));
  const int L = 2048 << set;
  float* sz = sm;
  float* h1 = sm + 65 * 33;
  float* h2 = h1 + 65 * 64;
  const float* w1 = p.in[27] + (size_t)l * 33 * 64;
  const float* b1 = p.in[28] + l * 64;
  const float* fq_ = p.in[29] + l * 64;
  const float* w2 = p.in[30] + (size_t)l * 64 * 64;
  const float* b2 = p.in[31] + l * 64;
  const float* w3 = p.in[32] + (size_t)l * 64 * 1024;
  LDS_BARRIER();
  for (int e = tid; e < 65 * 33; e += 256) {
    int tt = e / 33, i = e % 33;
    int t = tb * 64 + tt;
    float val;
    if (i == 0) val = (float)t / (float)(L - 1);
    else {
      int b = (i - 1) & 15;
      float f = 1e-4f + (float)b * ((15.f - 1e-4f) / 15.f);
      float wang = 6.283185307179586f * (float)t / (float)L;
      val = i <= 16 ? cosf(f * wang) : -sinf(f * wang);
    }
    sz[e] = val;
  }
  LDS_BARRIER();
  {
    int j = tid & 63;
    float fj = fq_[j], bj = b1[j];
#pragma unroll 1
    for (int i = 0; i < 17; i++) {
      int tt = (tid >> 6) + 4 * i;
      if (tt < 65) {
        float a = bj;
        for (int k = 0; k < 33; k++) a += sz[tt * 33 + k] * w1[k * 64 + j];
        h1[tt * 64 + j] = sinf(fj * a);
      }
    }
  }
  LDS_BARRIER();
  {
    int j = tid & 63;
    float fj = fq_[j], bj = b2[j];
#pragma unroll 1
    for (int i = 0; i < 17; i++) {
      int tt = (tid >> 6) + 4 * i;
      if (tt < 65) {
        float a = bj;
        for (int k = 0; k < 64; k++) a += h1[tt * 64 + k] * w2[k * 64 + j];
        h2[tt * 64 + j] = sinf(fj * a);
      }
    }
  }
  LDS_BARRIER();
  const int c = tid;
  const float mind = -3.0701134573253943f, maxd = -15.350567286626972f;
  float delta = fabsf(mind + (float)c * ((maxd - mind) / 255.f));
  u16* kr = (u16*)(p.ws + O_HYKR) + (set ? HYKR1 : 0);
  float* ps = (float*)(p.ws + O_HYPS) + (size_t)(set ? 32 * 512 : 0) + (size_t)tb * 512;
#pragma unroll 1
  for (int order = 0; order < 2; order++) {
    u16* krc = kr + ((size_t)order * 256 + c) * (2 * L);
    float asum = 0.f, v00 = 0.f;
#pragma unroll 1
    for (int dir = 0; dir < 2; dir++) {
      float wc[64];
#pragma unroll
      for (int k = 0; k < 64; k++) wc[k] = w3[k * 1024 + order * 512 + dir * 256 + c];
      float hold = 0.f;
      const int ntt = dir == 0 ? 65 : 64;
#pragma unroll 1
      for (int tt = 0; tt < ntt; tt++) {
        float a = 0.f;
#pragma unroll
        for (int k = 0; k < 64; k++) a += h2[tt * 64 + k] * wc[k];
        int t = tb * 64 + tt;
        float tl = (float)t / (float)(L - 1);
        a *= expf(-tl * delta);
        if (t >= L) a = 0.f;
        if (tt < 64) asum += fabsf(a);
        if (dir == 0) {
          if (tt == 0) { if (tb == 0) v00 = a; }
          else if (tt & 1) hold = a;
          else *(unsigned*)(krc + (L - t)) = f2bf(a) | ((unsigned)f2bf(hold) << 16);
        } else {
          if (!(tt & 1)) hold = (t == 0) ? v00 + a : a;
          else *(unsigned*)(krc + (L + t - 1)) = f2bf(hold) | ((unsigned)f2bf(a) << 16);
        }
      }
    }
    ps[order * 256 + c] = asum;
  }
}

__device__ __forceinline__ void rms_rows_to_bf16(const Params& p, int l, int rowblk) {
  int tid_ = threadIdx.x; asm volatile("" : "+v"(tid_));
  const int lane = tid_ & 63, w = tid_ >> 6;
  float4 v[4][4];
#pragma unroll
  for (int j = 0; j < 4; j++) {
    const float* x = xrow(p, l, rowblk * 16 + w * 4 + j);
#pragma unroll
    for (int i = 0; i < 4; i++) v[j][i] = *(const float4*)(x + i * 256 + lane * 4);
  }
#pragma unroll
  for (int j = 0; j < 4; j++) {
    float ss = 0.f;
#pragma unroll
    for (int i = 0; i < 4; i++) ss += v[j][i].x * v[j][i].x + v[j][i].y * v[j][i].y + v[j][i].z * v[j][i].z + v[j][i].w * v[j][i].w;
    ss = wave_sum(ss);
    float rs = rsqrtf(ss * (1.f / 1024.f) + EPSF);
    u16* xn = (u16*)(p.ws + O_XN) + (size_t)(rowblk * 16 + w * 4 + j) * 1024;
#pragma unroll
    for (int i = 0; i < 4; i++) *(uint2*)(xn + i * 256 + lane * 4) = pack4(v[j][i].x * rs, v[j][i].y * rs, v[j][i].z * rs, v[j][i].w * rs);
  }
}

__device__ __forceinline__ void lru_item(char* smraw, const Params& p, int l, int item, int mode) {
  int tid = threadIdx.x; asm volatile("" : "+v"(tid)); const int _tid_pad = 0, lane = tid & 63, w = tid >> 6, fr = lane & 15, fq = lane >> 4;
  const int cki = item >> 2, head = item & 3;
  const int t0 = cki * 32;
  int lo, hi; seq_bounds(t0, lo, hi);
  float* xc = (float*)smraw;
  u16* xcb = (u16*)(smraw + 8192);
  float* sa = (float*)(smraw + 8192 + 4608);
  float* su = sa + 2 * 32 * 64;
  float* sx = su + 2 * 32 * 64;
  const u16* zA = (const u16*)(p.ws + O_ZA);
  LDS_BARRIER();
  {
    int ch = tid & 63, tq = tid >> 6;
    int gch = head * 64 + ch;
    const float* cw = p.in[4] + l * 4 * 256;
    float w0 = cw[gch], w1 = cw[256 + gch], w2 = cw[512 + gch], w3 = cw[768 + gch];
    float cb = p.in[5][l * 256 + gch];
    float win[11];
#pragma unroll
    for (int i = 0; i < 11; i++) {
      int tok = t0 + tq * 8 + i - 2;
      win[i] = (tok >= lo && tok < hi) ? bf2f(zA[(size_t)tok * 512 + gch]) : 0.f;
    }
#pragma unroll
    for (int i = 0; i < 8; i++) {
      float v = w0 * win[i] + w1 * win[i + 1] + w2 * win[i + 2] + w3 * win[i + 3] + cb;
      int tt = tq * 8 + i;
      xc[tt * 64 + ch] = v;
      xcb[tt * 72 + ch] = f2bf(v);
    }
  }
  LDS_BARRIER();
  {
    const int d = w >> 1, half = w & 1;
    const u16* wl = (const u16*)(p.ws + O_WLRU) + (size_t)head * 256 * 64;
    f32x4 accr[2][2], acci[2][2];
#pragma unroll
    for (int a = 0; a < 2; a++)
#pragma unroll
      for (int b = 0; b < 2; b++) { accr[a][b] = (f32x4){0, 0, 0, 0}; acci[a][b] = (f32x4){0, 0, 0, 0}; }
#pragma unroll
    for (int ks = 0; ks < 2; ks++) {
      bf16x8 af[2], br[2], bi[2];
#pragma unroll
      for (int mt = 0; mt < 2; mt++) af[mt] = *(const bf16x8*)(xcb + (16 * mt + fr) * 72 + ks * 32 + fq * 8);
#pragma unroll
      for (int nt = 0; nt < 2; nt++) {
        int nr = d * 128 + 32 * half + 16 * nt + fr;
        br[nt] = *(const bf16x8*)(wl + (size_t)nr * 64 + ks * 32 + fq * 8);
        bi[nt] = *(const bf16x8*)(wl + (size_t)(nr + 64) * 64 + ks * 32 + fq * 8);
      }
#pragma unroll
      for (int mt = 0; mt < 2; mt++)
#pragma unroll
        for (int nt = 0; nt < 2; nt++) {
          accr[mt][nt] = __builtin_amdgcn_mfma_f32_16x16x32_bf16(af[mt], br[nt], accr[mt][nt], 0, 0, 0);
          acci[mt][nt] = __builtin_amdgcn_mfma_f32_16x16x32_bf16(af[mt], bi[nt], acci[mt][nt], 0, 0, 0);
        }
    }
#pragma unroll
    for (int nt = 0; nt < 2; nt++) {
      int ch = 32 * half + 16 * nt + fr;
      int gch = head * 64 + ch;
      float brr = p.in[7][(l * 2 + d) * 256 + gch], bii = p.in[9][(l * 2 + d) * 256 + gch];
      float sp = softplusf_(-p.in[10][(l * 2 + d) * 256 + gch]);
#pragma unroll
      for (int mt = 0; mt < 2; mt++)
#pragma unroll
        for (int e = 0; e < 4; e++) {
          int tt = 16 * mt + 4 * fq + e;
          float r = 1.f / (1.f + expf(-(accr[mt][nt][e] + brr)));
          float ig = 1.f / (1.f + expf(-(acci[mt][nt][e] + bii)));
          float la = -8.f * r * sp;
          float a = expf(la);
          float u = sqrtf(-expm1f(2.f * la)) * (ig * xc[tt * 64 + ch]);
          sa[(d * 32 + tt) * 64 + ch] = a;
          su[(d * 32 + tt) * 64 + ch] = u;
        }
    }
  }
  LDS_BARRIER();
  {
    const int ch = tid & 63, d = (tid >> 6) & 1, half = tid >> 7;
    float A = 1.f, B = 0.f;
#pragma unroll
    for (int i = 0; i < 16; i++) {
      int tt = d == 0 ? half * 16 + i : half * 16 + 15 - i;
      float a = sa[(d * 32 + tt) * 64 + ch], u = su[(d * 32 + tt) * 64 + ch];
      A = a * A; B = a * B + u;
    }
    sx[((d * 2 + half) * 64 + ch) * 2] = A;
    sx[((d * 2 + half) * 64 + ch) * 2 + 1] = B;
  }
  LDS_BARRIER();
  if (mode == 0) {
    if (tid < 128) {
      int ch = tid & 63, d = tid >> 6;
      int first = d == 0 ? 0 : 1, second = 1 - first;
      float A1 = sx[((d * 2 + first) * 64 + ch) * 2], B1 = sx[((d * 2 + first) * 64 + ch) * 2 + 1];
      float A2 = sx[((d * 2 + second) * 64 + ch) * 2], B2 = sx[((d * 2 + second) * 64 + ch) * 2 + 1];
      float2 cr; cr.x = A2 * A1; cr.y = A2 * B1 + B2;
      ((float2*)(p.ws + O_LCAR))[((size_t)cki * 2 + d) * 256 + head * 64 + ch] = cr;
    }
    return;
  }
  {
    const int ch = tid & 63, d = (tid >> 6) & 1, half = tid >> 7;
    float h = ((const float*)(p.ws + O_LHIN))[((size_t)cki * 2 + d) * 256 + head * 64 + ch];
    int first = d == 0 ? 0 : 1;
    if (half != first) h = sx[((d * 2 + first) * 64 + ch) * 2] * h + sx[((d * 2 + first) * 64 + ch) * 2 + 1];
#pragma unroll
    for (int i = 0; i < 16; i++) {
      int tt = d == 0 ? half * 16 + i : half * 16 + 15 - i;
      float a = sa[(d * 32 + tt) * 64 + ch], u = su[(d * 32 + tt) * 64 + ch];
      h = a * h + u;
      su[(d * 32 + tt) * 64 + ch] = h;
    }
  }
  LDS_BARRIER();
  {
    int ch = tid & 63, tq = tid >> 6;
    u16* mixA = (u16*)(p.ws + O_XN);
#pragma unroll
    for (int i = 0; i < 8; i++) {
      int tt = tq * 8 + i, tok = t0 + tt;
      float hsum = su[tt * 64 + ch] + su[(32 + tt) * 64 + ch];
      float gate = bf2f(zA[(size_t)tok * 512 + 256 + head * 64 + ch]);
      mixA[(size_t)tok * 256 + head * 64 + ch] = f2bf(hsum * geluf_(gate));
    }
  }
}
__device__ __forceinline__ void lru_propagate(const Params& p, int idx) {
  int seq = idx >> 9, d = (idx >> 8) & 1, ch = idx & 255;
  int c0, nc;
  if (seq < 8) { c0 = seq * 64; nc = 64; } else { c0 = 512 + (seq - 8) * 128; nc = 128; }
  const float2* car = (const float2*)(p.ws + O_LCAR);
  float* hin = (float*)(p.ws + O_LHIN);
  float h = 0.f;
  for (int i = 0; i < nc; i++) {
    int ck = d == 0 ? c0 + i : c0 + nc - 1 - i;
    size_t o = ((size_t)ck * 2 + d) * 256 + ch;
    hin[o] = h;
    float2 ab = car[o];
    h = ab.x * h + ab.y;
  }
}
__device__ __forceinline__ void s5_propagate(const Params& p, int l, int idx) {
  int pp = idx & 63, d = (idx >> 6) & 1, g = (idx >> 7) & 15, seq = idx >> 11;
  int c0, nc;
  if (seq < 8) { c0 = seq * 32; nc = 32; } else { c0 = 256 + (seq - 8) * 64; nc = 64; }
  const float* ab64 = (const float*)(p.ws + O_AB64) + (size_t)l * 2 * 16 * 64 * 2;
  float ar = ab64[((d * 16 + g) * 64 + pp) * 2], ai = ab64[((d * 16 + g) * 64 + pp) * 2 + 1];
  const float* send = (const float*)(p.ws + O_SEND) + (size_t)g * 1280 * 256;
  u16* uh = (u16*)(p.ws + O_UH) + (size_t)g * 1280 * 1280;
  float hr = 0.f, hi = 0.f;
  for (int i = 0; i < nc; i++) {
    int ck = d == 0 ? c0 + i : c0 + nc - 1 - i;
    *(unsigned*)(uh + (size_t)ck * 1280 + 1024 + d * 128 + pp * 2) = f2bf(hr) | ((unsigned)f2bf(hi) << 16);
    float2 s = *(const float2*)(send + (size_t)ck * 256 + d * 128 + pp * 2);
    float nr = __fmaf_rn(ar, hr, __fmaf_rn(-ai, hi, s.x));
    float ni = __fmaf_rn(ar, hi, __fmaf_rn(ai, hr, s.y));
    asm volatile("" : "+v"(nr));
    asm volatile("" : "+v"(ni));
    hr = nr; hi = ni;
  }
}

#define AST 68
__device__ __forceinline__ void gdn_g1_item(char* smraw, const Params& p, int l, int item) {
  int tid = threadIdx.x; asm volatile("" : "+v"(tid)); const int _tid_pad = 0, lane = tid & 63, w = tid >> 6, fr = lane & 15, fq = lane >> 4;
  const int ck = item >> 2, h = item & 3;
  const int t0 = ck * 64;
  int lo, hi; seq_bounds(t0, lo, hi);
  u16* sk = (u16*)smraw;
  u16* sv = sk + 64 * 72;
  u16* Am = (u16*)(smraw + 2 * 64 * 72 * 2);
  float* sgc = (float*)(Am + 2 * 64 * 72);
  float* sbeta = sgc + 128;
  u16* Xs = (u16*)(sbeta + 128);
  const u16* zC = (const u16*)(p.ws + O_ZC);
  const float* ba = (const float*)(p.ws + O_BA);
  u16* qg = (u16*)(p.ws + O_XN);
  u16* kg = qg + (size_t)T_ALL * 256;
  u16* vg = kg + (size_t)T_ALL * 256;
  LDS_BARRIER();
  {
    const float* cw = p.in[21] + (size_t)l * 4 * 768;
    float wq[4], wk[4], wv[4];
#pragma unroll
    for (int j = 0; j < 4; j++) {
      wq[j] = cw[j * 768 + h * 64 + lane];
      wk[j] = cw[j * 768 + 256 + h * 64 + lane];
      wv[j] = cw[j * 768 + 512 + h * 64 + lane];
    }
#pragma unroll 4
    for (int rr = 0; rr < 16; rr++) {
      int c = w * 16 + rr, tok = t0 + c;
      float q = 0.f, k = 0.f, v = 0.f;
#pragma unroll
      for (int j = 0; j < 4; j++) {
        int tk = tok + j - 2;
        if (tk >= lo && tk < hi) {
          const u16* zr = zC + (size_t)tk * 1024 + h * 64 + lane;
          q += wq[j] * bf2f(zr[0]); k += wk[j] * bf2f(zr[256]); v += wv[j] * bf2f(zr[512]);
        }
      }
      q = siluf_(q); k = siluf_(k); v = siluf_(v);
      float sq = wave_sum(q * q), skk = wave_sum(k * k);
      q = q * rsqrtf(sq + EPSF) * 0.125f;
      k = k * rsqrtf(skk + EPSF);
      u16 kb = f2bf(k), vb = f2bf(v);
      sk[c * 72 + lane] = kb; sv[c * 72 + lane] = vb;
      qg[(size_t)tok * 256 + h * 64 + lane] = f2bf(q);
      kg[(size_t)tok * 256 + h * 64 + lane] = kb;
      vg[(size_t)tok * 256 + h * 64 + lane] = vb;
    }
  }
  if (tid < 128) {
    int d = tid >> 6, c = tid & 63;
    int tok = d == 0 ? t0 + c : t0 + 63 - c;
    float alog = p.in[22][(l * 2 + d) * 4 + h], dtb = p.in[23][(l * 2 + d) * 4 + h];
    float g = -expf(alog) * softplusf_(ba[(size_t)tok * 16 + 8 + d * 4 + h] + dtb);
    float beta = 1.f / (1.f + expf(-ba[(size_t)tok * 16 + d * 4 + h]));
    float s = g;
#pragma unroll
    for (int o = 1; o < 64; o <<= 1) { float t = __shfl_up(s, o); if (c >= o) s += t; }
    sgc[d * 64 + c] = s; sbeta[d * 64 + c] = beta;
    ((float*)(p.ws + O_GC))[(size_t)(h * 2 + d) * T_ALL + tok] = s;
  }
  LDS_BARRIER();
  {
    f32x4 acc[4];
#pragma unroll
    for (int nt = 0; nt < 4; nt++) acc[nt] = (f32x4){0, 0, 0, 0};
#pragma unroll
    for (int ks = 0; ks < 2; ks++) {
      bf16x8 af = *(const bf16x8*)(sk + (16 * w + fr) * 72 + ks * 32 + fq * 8);
#pragma unroll
      for (int nt = 0; nt < 4; nt++) {
        bf16x8 bfm = *(const bf16x8*)(sk + (16 * nt + fr) * 72 + ks * 32 + fq * 8);
        acc[nt] = __builtin_amdgcn_mfma_f32_16x16x32_bf16(af, bfm, acc[nt], 0, 0, 0);
      }
    }
#pragma unroll
    for (int nt = 0; nt < 4; nt++)
#pragma unroll
      for (int e = 0; e < 4; e++) {
        int c = 16 * w + 4 * fq + e, m = 16 * nt + fr;
        float gm = acc[nt][e];
        float a0 = c > m ? sbeta[c] * gm * expf(sgc[c] - sgc[m]) : 0.f;
        Am[m * 72 + c] = f2bf(a0);
        int c1 = 63 - c, m1 = 63 - m;
        float a1 = c1 > m1 ? sbeta[64 + c1] * gm * expf(sgc[64 + c1] - sgc[64 + m1]) : 0.f;
        Am[64 * 72 + m1 * 72 + c1] = f2bf(a1);
      }
  }
  LDS_BARRIER();
  {
    const int d = tid >> 7, col = tid & 127;
    const u16* AT = Am + d * 64 * 72;
    u16* Xd = Xs + d * 48 * 128;
    const u16* src = col < 64 ? sk : sv;
    const int e = col & 63;
    u16* wu = (u16*)(p.ws + O_WU) + ((size_t)(ck * 4 + h) * 2 + d) * 8192 + (col < 64 ? 0 : 4096);
#pragma unroll 1
    for (int b = 0; b < 4; b++) {
      float s[16];
#pragma unroll
      for (int r = 0; r < 16; r++) {
        int i = 16 * b + r;
        int tokr = d == 0 ? i : 63 - i;
        float rv = bf2f(src[tokr * 72 + e]) * sbeta[d * 64 + i];
        if (col < 64) rv *= expf(sgc[d * 64 + i]);
        s[r] = rv;
      }
#pragma unroll 4
      for (int j = 0; j < 16 * b; j++) {
        float xj = bf2f(Xd[j * 128 + col]);
        const uint4* ar = (const uint4*)(AT + j * 72 + 16 * b);
        uint4 a0 = ar[0], a1 = ar[1];
        unsigned aw[8] = {a0.x, a0.y, a0.z, a0.w, a1.x, a1.y, a1.z, a1.w};
#pragma unroll
        for (int q = 0; q < 8; q++) {
          s[2 * q] -= __uint_as_float(aw[q] << 16) * xj;
          s[2 * q + 1] -= __uint_as_float(aw[q] & 0xffff0000u) * xj;
        }
      }
#pragma unroll
      for (int rp = 0; rp < 16; rp++) {
        u16 xb = f2bf(s[rp]);
        float xj = bf2f(xb);
        wu[(16 * b + rp) * 64 + e] = xb;
        if (b < 3) Xd[(16 * b + rp) * 128 + col] = xb;
        const uint4* ar = (const uint4*)(AT + (16 * b + rp) * 72 + 16 * b);
        uint4 a0 = ar[0], a1 = ar[1];
        unsigned aw[8] = {a0.x, a0.y, a0.z, a0.w, a1.x, a1.y, a1.z, a1.w};
#pragma unroll
        for (int r = rp + 1; r < 16; r++) {
          float av = (r & 1) ? __uint_as_float(aw[r >> 1] & 0xffff0000u) : __uint_as_float(aw[r >> 1] << 16);
          s[r] -= av * xj;
        }
      }
    }
  }
}

__device__ __forceinline__ void gdn_chain(char* smraw, const Params& p, int chain) {
  int tid = threadIdx.x; asm volatile("" : "+v"(tid)); const int _tid_pad = 0, lane = tid & 63, w = tid >> 6, fr = lane & 15, fq = lane >> 4;
  const int d = chain & 1, h = (chain >> 1) & 3, seq = chain >> 3;
  int c0, nc;
  if (seq < 8) { c0 = seq * 32; nc = 32; } else { c0 = 256 + (seq - 8) * 64; nc = 64; }
  u16* qs = (u16*)smraw;
  u16* qd = qs + 64 * 72;
  u16* ks_ = qd + 64 * 72;
  u16* kdT = ks_ + 64 * 72;
  u16* at = kdT + 64 * 72;
  u16* ST = at + 64 * 72;
  u16* VT = ST + 4 * 16 * 72;
  float* sgc = (float*)(VT + 4 * 16 * 72);
  const u16* qg = (const u16*)(p.ws + O_XN);
  const u16* kg = qg + (size_t)T_ALL * 256;
  const float* gcg = (const float*)(p.ws + O_GC);
  u16* og = (u16*)(p.ws + O_OD) + (size_t)d * T_ALL * 256;
  u16* STw = ST + w * 16 * 72;
  u16* VTw = VT + w * 16 * 72;
  f32x4 accS[4];
#pragma unroll
  for (int mt = 0; mt < 4; mt++) accS[mt] = (f32x4){0, 0, 0, 0};
  LDS_BARRIER();
  for (int e = lane; e < 16 * 72; e += 64) STw[e] = 0;
  const int prow = tid >> 2, pseg = tid & 3;
  float gcv_n, gl_n; uint4 q0n, q1n, k0n, k1n;
#define CHAIN_PREFETCH(IT) do {                                                                   \
    const int ck_ = d == 0 ? c0 + (IT) : c0 + nc - 1 - (IT);                                       \
    const int t0_ = ck_ * 64;                                                                      \
    const int tok_ = d == 0 ? t0_ + prow : t0_ + 63 - prow;                                        \
    gl_n = gcg[(size_t)(h * 2 + d) * T_ALL + (d == 0 ? t0_ + 63 : t0_)];                          \
    gcv_n = gcg[(size_t)(h * 2 + d) * T_ALL + tok_];                                               \
    const u16* qr_ = qg + (size_t)tok_ * 256 + h * 64 + pseg * 16;                                 \
    const u16* kr_ = kg + (size_t)tok_ * 256 + h * 64 + pseg * 16;                                 \
    q0n = *(const uint4*)qr_; q1n = *(const uint4*)(qr_ + 8);                                      \
    k0n = *(const uint4*)kr_; k1n = *(const uint4*)(kr_ + 8); } while (0)
  CHAIN_PREFETCH(0);
#pragma unroll 1
  for (int it = 0; it < nc; it++) {
    const int ck = d == 0 ? c0 + it : c0 + nc - 1 - it;
    const int t0 = ck * 64;
    const u16* wch = (const u16*)(p.ws + O_WU) + ((size_t)(ck * 4 + h) * 2 + d) * 8192;
    const u16* uch = wch + 4096;
    const float gl = gl_n;
    bf16x8 awr[4][2];
    u16 uvr[4][4];
#pragma unroll
    for (int mt = 0; mt < 4; mt++) {
#pragma unroll
      for (int ks = 0; ks < 2; ks++) awr[mt][ks] = *(const bf16x8*)(wch + (16 * mt + fr) * 64 + ks * 32 + fq * 8);
#pragma unroll
      for (int e = 0; e < 4; e++) uvr[mt][e] = uch[(16 * mt + 4 * fq + e) * 64 + 16 * w + fr];
    }
    {
      const int row = prow, seg = pseg;
      const float gcv = gcv_n;
      if (seg == 0) sgc[row] = gcv;
      float eq = expf(gcv), ek = expf(gl - gcv);
      const uint4 q0 = q0n, q1 = q1n, k0 = k0n, k1 = k1n;
      if (it + 1 < nc) CHAIN_PREFETCH(it + 1);
      *(uint4*)(qs + row * 72 + seg * 16) = q0; *(uint4*)(qs + row * 72 + seg * 16 + 8) = q1;
      *(uint4*)(ks_ + row * 72 + seg * 16) = k0; *(uint4*)(ks_ + row * 72 + seg * 16 + 8) = k1;
      unsigned qa[8] = {q0.x, q0.y, q0.z, q0.w, q1.x, q1.y, q1.z, q1.w};
      unsigned ka[8] = {k0.x, k0.y, k0.z, k0.w, k1.x, k1.y, k1.z, k1.w};
#pragma unroll
      for (int i = 0; i < 8; i++) {
        float qa0 = bf2f((u16)(qa[i] & 0xffff)) * eq, qa1 = bf2f((u16)(qa[i] >> 16)) * eq;
        *(unsigned*)(qd + row * 72 + seg * 16 + 2 * i) = f2bf(qa0) | ((unsigned)f2bf(qa1) << 16);
        float kb0 = bf2f((u16)(ka[i] & 0xffff)) * ek, kb1 = bf2f((u16)(ka[i] >> 16)) * ek;
        kdT[(seg * 16 + 2 * i) * 72 + row] = f2bf(kb0);
        kdT[(seg * 16 + 2 * i + 1) * 72 + row] = f2bf(kb1);
      }
    }
    LDS_BARRIER();
    {
      f32x4 acc[4];
#pragma unroll
      for (int nt = 0; nt < 4; nt++) acc[nt] = (f32x4){0, 0, 0, 0};
#pragma unroll
      for (int ks = 0; ks < 2; ks++) {
        bf16x8 af = *(const bf16x8*)(qs + (16 * w + fr) * 72 + ks * 32 + fq * 8);
#pragma unroll
        for (int nt = 0; nt < 4; nt++) {
          bf16x8 bfm = *(const bf16x8*)(ks_ + (16 * nt + fr) * 72 + ks * 32 + fq * 8);
          acc[nt] = __builtin_amdgcn_mfma_f32_16x16x32_bf16(af, bfm, acc[nt], 0, 0, 0);
        }
      }
#pragma unroll
      for (int nt = 0; nt < 4; nt++)
#pragma unroll
        for (int e = 0; e < 4; e++) {
          int c = 16 * w + 4 * fq + e, m = 16 * nt + fr;
          float v = c >= m ? acc[nt][e] * expf(sgc[c] - sgc[m]) : 0.f;
          at[c * 72 + m] = f2bf(v);
        }
    }
    LDS_BARRIER();
    {
      const int e0 = 16 * w;
      f32x4 av[4];
#pragma unroll
      for (int mt = 0; mt < 4; mt++) av[mt] = (f32x4){0, 0, 0, 0};
#pragma unroll
      for (int ks = 0; ks < 2; ks++) {
        bf16x8 bS = *(const bf16x8*)(STw + fr * 72 + ks * 32 + fq * 8);
#pragma unroll
        for (int mt = 0; mt < 4; mt++) {
          av[mt] = __builtin_amdgcn_mfma_f32_16x16x32_bf16(awr[mt][ks], bS, av[mt], 0, 0, 0);
        }
      }
#pragma unroll
      for (int mt = 0; mt < 4; mt++) {
        u16 hv[4];
#pragma unroll
        for (int e = 0; e < 4; e++) {
          int c = 16 * mt + 4 * fq + e;
          float vn = bf2f(uvr[mt][e]) - av[mt][e];
          hv[e] = f2bf(vn);
        }
        uint2 pk; pk.x = hv[0] | ((unsigned)hv[1] << 16); pk.y = hv[2] | ((unsigned)hv[3] << 16);
        *(uint2*)(VTw + fr * 72 + 16 * mt + 4 * fq) = pk;
      }
      __builtin_amdgcn_wave_barrier();
      f32x4 ao[4];
#pragma unroll
      for (int mt = 0; mt < 4; mt++) ao[mt] = (f32x4){0, 0, 0, 0};
#pragma unroll
      for (int ks = 0; ks < 2; ks++) {
        bf16x8 bS = *(const bf16x8*)(STw + fr * 72 + ks * 32 + fq * 8);
        bf16x8 bV = *(const bf16x8*)(VTw + fr * 72 + ks * 32 + fq * 8);
#pragma unroll
        for (int mt = 0; mt < 4; mt++) {
          bf16x8 aq = *(const bf16x8*)(qd + (16 * mt + fr) * 72 + ks * 32 + fq * 8);
          bf16x8 aa = *(const bf16x8*)(at + (16 * mt + fr) * 72 + ks * 32 + fq * 8);
          ao[mt] = __builtin_amdgcn_mfma_f32_16x16x32_bf16(aq, bS, ao[mt], 0, 0, 0);
          ao[mt] = __builtin_amdgcn_mfma_f32_16x16x32_bf16(aa, bV, ao[mt], 0, 0, 0);
        }
      }
#pragma unroll
      for (int mt = 0; mt < 4; mt++)
#pragma unroll
        for (int e = 0; e < 4; e++) {
          int c = 16 * mt + 4 * fq + e;
          int tok = d == 0 ? t0 + c : t0 + 63 - c;
          og[(size_t)tok * 256 + h * 64 + e0 + fr] = f2bf(ao[mt][e]);
        }
      float egl = expf(gl);
#pragma unroll
      for (int mt = 0; mt < 4; mt++) accS[mt] = accS[mt] * egl;
#pragma unroll
      for (int ks = 0; ks < 2; ks++) {
        bf16x8 bV = *(const bf16x8*)(VTw + fr * 72 + ks * 32 + fq * 8);
#pragma unroll
        for (int mt = 0; mt < 4; mt++) {
          bf16x8 ak = *(const bf16x8*)(kdT + (16 * mt + fr) * 72 + ks * 32 + fq * 8);
          accS[mt] = __builtin_amdgcn_mfma_f32_16x16x32_bf16(ak, bV, accS[mt], 0, 0, 0);
        }
      }
      __builtin_amdgcn_wave_barrier();
#pragma unroll
      for (int mt = 0; mt < 4; mt++) {
        uint2 pk;
        pk.x = f2bf(accS[mt][0]) | ((unsigned)f2bf(accS[mt][1]) << 16);
        pk.y = f2bf(accS[mt][2]) | ((unsigned)f2bf(accS[mt][3]) << 16);
        *(uint2*)(STw + fr * 72 + 16 * mt + 4 * fq) = pk;
      }
    }
    LDS_BARRIER();
  }
}
__device__ __forceinline__ void gdn_final_rows(const Params& p, int l, int rowblk) {
  int tid_ = threadIdx.x; asm volatile("" : "+v"(tid_));
  const int lane = tid_ & 63, w = tid_ >> 6;
  const int tok0 = rowblk * 16 + w * 4;
  const u16* o0 = (const u16*)(p.ws + O_OD) + (size_t)tok0 * 256 + lane * 4;
  const u16* o1 = o0 + (size_t)T_ALL * 256;
  const u16* zg = (const u16*)(p.ws + O_ZC) + (size_t)tok0 * 1024 + 768 + lane * 4;
  uint2 a[4], b[4], g[4];
#pragma unroll
  for (int j = 0; j < 4; j++) { a[j] = *(const uint2*)(o0 + j * 256); b[j] = *(const uint2*)(o1 + j * 256); g[j] = *(const uint2*)(zg + j * 1024); }
  const float* nw = p.in[24] + l * 64 + (lane & 15) * 4;
  const float n0 = nw[0], n1 = nw[1], n2 = nw[2], n3 = nw[3];
  u16* dst = (u16*)(p.ws + O_XN) + (size_t)2 * T_ALL * 256 + (size_t)tok0 * 256 + lane * 4;
#pragma unroll
  for (int j = 0; j < 4; j++) {
    float o[4], gt[4];
    o[0] = bf2f(a[j].x & 0xffff) + bf2f(b[j].x & 0xffff); o[1] = bf2f(a[j].x >> 16) + bf2f(b[j].x >> 16);
    o[2] = bf2f(a[j].y & 0xffff) + bf2f(b[j].y & 0xffff); o[3] = bf2f(a[j].y >> 16) + bf2f(b[j].y >> 16);
    gt[0] = bf2f(g[j].x & 0xffff); gt[1] = bf2f(g[j].x >> 16); gt[2] = bf2f(g[j].y & 0xffff); gt[3] = bf2f(g[j].y >> 16);
    float ss = o[0] * o[0] + o[1] * o[1] + o[2] * o[2] + o[3] * o[3];
#pragma unroll
    for (int m = 8; m > 0; m >>= 1) ss += __shfl_xor(ss, m);
    float rs = rsqrtf(ss * (1.f / 64.f) + EPSF);
    if (!(MIXMASK & 4)) rs = 0.f;
    *(uint2*)(dst + j * 256) = pack4(o[0] * rs * n0 * siluf_(gt[0]), o[1] * rs * n1 * siluf_(gt[1]), o[2] * rs * n2 * siluf_(gt[2]), o[3] * rs * n3 * siluf_(gt[3]));
  }
}
__device__ __forceinline__ void grpnorm_rows(const Params& p, int l, int which, int rowblk) {
  int tid_ = threadIdx.x; asm volatile("" : "+v"(tid_));
  const int lane = tid_ & 63, w = tid_ >> 6;
  u16* m0 = (u16*)(p.ws + O_XN) + (size_t)which * T_ALL * 256 + (size_t)(rowblk * 16 + w * 4) * 256 + lane * 4;
  uint2 a[4];
#pragma unroll
  for (int j = 0; j < 4; j++) a[j] = *(const uint2*)(m0 + j * 256);
  const float* gn = p.in[34] + (l * 3 + which) * 256 + lane * 4;
  const float g0 = gn[0], g1 = gn[1], g2 = gn[2], g3 = gn[3];
#pragma unroll
  for (int j = 0; j < 4; j++) {
    float v[4] = {bf2f(a[j].x & 0xffff), bf2f(a[j].x >> 16), bf2f(a[j].y & 0xffff), bf2f(a[j].y >> 16)};
    float ss = wave_sum(v[0] * v[0] + v[1] * v[1] + v[2] * v[2] + v[3] * v[3]);
    float rs = rsqrtf(ss * (1.f / 256.f) + EPSF);
    if (!((MIXMASK >> which) & 1)) rs = 0.f;
    *(uint2*)(m0 + j * 256) = pack4(v[0] * rs * g0, v[1] * rs * g1, v[2] * rs * g2, v[3] * rs * g3);
  }
}

#define WST 1296
#define UST 264
__device__ __forceinline__ float hy_conv3(const u16* __restrict__ raw, int t, int L, float w0, float w1, float w2, float b) {
  float xm = t > 0 ? bf2f(raw[t - 1]) : 0.f;
  float x0 = bf2f(raw[t]);
  float xp = t + 1 < L ? bf2f(raw[t + 1]) : 0.f;
  return w0 * xm + w1 * x0 + w2 * xp + b;
}
__device__ __forceinline__ void hy_conv_item(char* smraw, const Params& p, int l, int stage, int set, int c, int tb) {
  int tid = threadIdx.x; asm volatile("" : "+v"(tid)); const int _tid_pad = 0, lane = tid & 63, w = tid >> 6, fr = lane & 15, fq = lane >> 4;
  const int L = 2048 << set, nb = 8 << set, base = set ? T_P : 0;
  const int T0 = tb * 1024;
  u16* win = (u16*)smraw;
  u16* su = win + 8 * WST;
  float* sinv = (float*)(su + 16 * UST);
  const u16* dt = (const u16*)(p.ws + O_DT);
  const u16* rawv = dt + (size_t)c * T_ALL + base;
  const u16* rawx = dt + (size_t)((stage + 1) * 256 + c) * T_ALL + base;
  const u16* y1 = (const u16*)(p.ws + O_Y1) + (size_t)c * T_ALL + base;
  u16* outp = stage == 0 ? (u16*)(p.ws + O_Y1) + (size_t)c * T_ALL + base
                         : (u16*)(p.ws + O_DT) + (size_t)(256 + c) * T_ALL + base;
  const u16* kr = (const u16*)(p.ws + O_HYKR) + (set ? HYKR1 : 0) + ((size_t)stage * 256 + c) * (2 * L);
  const float* cw = p.in[25] + (size_t)l * 3 * 768;
  const float* cb = p.in[26] + (size_t)l * 768;
  const float v0 = cw[c], v1 = cw[768 + c], v2 = cw[1536 + c], vb = cb[c];
  const int xc_ = (stage + 1) * 256 + c;
  const float x0w = cw[xc_], x1w = cw[768 + xc_], x2w = cw[1536 + xc_], xbw = cb[xc_];
  LDS_BARRIER();
  if (tid < 64) {
    const float* ps = (const float*)(p.ws + O_HYPS) + (size_t)(set ? 32 * 512 : 0);
    int ntb = L / 64;
    float s = 0.f;
    for (int i = lane; i < ntb; i += 64) s += ps[(size_t)i * 512 + stage * 256 + c];
    s = wave_sum(s);
    if (lane == 0) sinv[0] = 1.f / s;
  }
  f32x4 acc[16];
#pragma unroll
  for (int i = 0; i < 16; i++) acc[i] = (f32x4){0, 0, 0, 0};
  for (int S0 = 0; S0 < L; S0 += 256) {
    LDS_BARRIER();
    const int B0 = S0 - T0;
    for (int idx = tid; idx < 8 * 160; idx += 256) {
      int rho = idx / 160, gi = idx % 160;
      int ybase = B0 - 1016 + 8 * gi - rho + L;
      int a = ybase & ~1;
      uint4 pk;
      if (a >= 0 && a + 10 <= 2 * L) {
        const unsigned* kd = (const unsigned*)(kr + a);
        unsigned d0 = kd[0], d1 = kd[1], d2 = kd[2], d3 = kd[3], d4 = kd[4];
        if (ybase & 1) {
          pk.x = __builtin_amdgcn_alignbit(d1, d0, 16); pk.y = __builtin_amdgcn_alignbit(d2, d1, 16);
          pk.z = __builtin_amdgcn_alignbit(d3, d2, 16); pk.w = __builtin_amdgcn_alignbit(d4, d3, 16);
        } else { pk.x = d0; pk.y = d1; pk.z = d2; pk.w = d3; }
      } else {
        u16 hh[8];
#pragma unroll
        for (int e = 0; e < 8; e++) { int yy = ybase + e; hh[e] = (yy >= 0 && yy < 2 * L) ? kr[yy] : (u16)0; }
        pk.x = hh[0] | ((unsigned)hh[1] << 16); pk.y = hh[2] | ((unsigned)hh[3] << 16);
        pk.z = hh[4] | ((unsigned)hh[5] << 16); pk.w = hh[6] | ((unsigned)hh[7] << 16);
      }
      *(uint4*)(win + rho * WST + 8 * gi) = pk;
    }
    {
      int b = tid >> 4, seg = tid & 15;
      uint4 p0 = make_uint4(0, 0, 0, 0), p1 = make_uint4(0, 0, 0, 0);
      if (b < nb) {
        const u16* src = (stage == 0 ? rawv : y1) + (size_t)b * L;
        const int s0 = S0 + seg * 16;
        uint4 r0 = *(const uint4*)(src + s0), r1 = *(const uint4*)(src + s0 + 8);
        if (stage == 0) {
          unsigned w[8] = {r0.x, r0.y, r0.z, r0.w, r1.x, r1.y, r1.z, r1.w};
          float x[18];
          x[0] = s0 > 0 ? bf2f(src[s0 - 1]) : 0.f;
          x[17] = s0 + 16 < L ? bf2f(src[s0 + 16]) : 0.f;
#pragma unroll
          for (int q = 0; q < 8; q++) { x[1 + 2 * q] = __uint_as_float(w[q] << 16); x[2 + 2 * q] = __uint_as_float(w[q] & 0xffff0000u); }
          unsigned o[8];
#pragma unroll
          for (int q = 0; q < 8; q++) {
            float c0 = v0 * x[2 * q] + v1 * x[2 * q + 1] + v2 * x[2 * q + 2] + vb;
            float c1 = v0 * x[2 * q + 1] + v1 * x[2 * q + 2] + v2 * x[2 * q + 3] + vb;
            o[q] = f2bf(c0) | ((unsigned)f2bf(c1) << 16);
          }
          p0 = make_uint4(o[0], o[1], o[2], o[3]); p1 = make_uint4(o[4], o[5], o[6], o[7]);
        } else { p0 = r0; p1 = r1; }
      }
      *(uint4*)(su + b * UST + seg * 16) = p0;
      *(uint4*)(su + b * UST + seg * 16 + 8) = p1;
    }
    LDS_BARRIER();
    bf16x8 bfr[8];
#pragma unroll
    for (int j = 0; j < 8; j++) bfr[j] = *(const bf16x8*)(su + fr * UST + 32 * j + 8 * fq);
    const u16* wbase = win + (fr & 7) * WST + (8 * fq - 256 * w - 8 * (fr >> 3) + 1016);
#pragma unroll
    for (int dd = 0; dd < 30; dd++) {
      bf16x8 af = *(const bf16x8*)(wbase + 16 * (dd - 15));
#pragma unroll
      for (int j = 0; j < 8; j++) {
        const int i = 2 * j - (dd - 15);
        if (i >= 0 && i < 16) acc[i] = __builtin_amdgcn_mfma_f32_16x16x32_bf16(af, bfr[j], acc[i], 0, 0, 0);
      }
    }
  }
  LDS_BARRIER();
  const float inv = sinv[0];
  const float bias = p.in[33][(size_t)(l * 2 + stage) * 256 + c];
  if (fr < nb) {
#pragma unroll
    for (int i = 0; i < 16; i++) {
      u16 r[4];
#pragma unroll
      for (int e = 0; e < 4; e++) {
        int t = T0 + 256 * w + 16 * i + 4 * fq + e;
        float uval = stage == 0 ? hy_conv3(rawv + (size_t)fr * L, t, L, v0, v1, v2, vb) : bf2f(y1[(size_t)fr * L + t]);
        float xg = hy_conv3(rawx + (size_t)fr * L, t, L, x0w, x1w, x2w, xbw);
        r[e] = f2bf(xg * (acc[i][e] * inv + bias * uval));
      }
      uint2 pk; pk.x = r[0] | ((unsigned)r[1] << 16); pk.y = r[2] | ((unsigned)r[3] << 16);
      *(uint2*)(outp + (size_t)fr * L + T0 + 256 * w + 16 * i + 4 * fq) = pk;
    }
  }
}
__device__ __forceinline__ void hy_final_item(char* smraw, const Params& p, int l, int ck) {
  int tid = threadIdx.x; asm volatile("" : "+v"(tid)); const int _tid_pad = 0, lane = tid & 63, w = tid >> 6;
  float* s = (float*)smraw;
  const u16* yd = (const u16*)(p.ws + O_DT) + (size_t)256 * T_ALL;
  const int t0 = ck * 64;
  LDS_BARRIER();
#pragma unroll 16
  for (int i = 0; i < 64; i++) {
    int c = w * 64 + i;
    s[lane * 257 + c] = bf2f(yd[(size_t)c * T_ALL + t0 + lane]);
  }
  LDS_BARRIER();
  const float* gn = p.in[34] + (l * 3 + 2) * 256;
  u16* mixD = (u16*)(p.ws + O_XN) + (size_t)3 * T_ALL * 256;
  for (int i = 0; i < 16; i++) {
    int tt = w * 16 + i;
    float v[4];
#pragma unroll
    for (int e = 0; e < 4; e++) v[e] = s[tt * 257 + lane * 4 + e];
    float ss = wave_sum(v[0] * v[0] + v[1] * v[1] + v[2] * v[2] + v[3] * v[3]);
    float rs = rsqrtf(ss * (1.f / 256.f) + EPSF);
    if (!(MIXMASK & 8)) rs = 0.f;
    uint2 pk;
    pk.x = f2bf(v[0] * rs * gn[lane * 4]) | ((unsigned)f2bf(v[1] * rs * gn[lane * 4 + 1]) << 16);
    pk.y = f2bf(v[2] * rs * gn[lane * 4 + 2]) | ((unsigned)f2bf(v[3] * rs * gn[lane * 4 + 3]) << 16);
    *(uint2*)(mixD + (size_t)(t0 + tt) * 256 + lane * 4) = pk;
  }
}

#define XB_CENS(j) (64 + 64 * (j))
#define XB_XSUB(j) (1088 + 64 * (j))
#define XB_XGEN(j) (2112 + 64 * (j))
#define XB_TOP 3136
#define XB_TOPGEN 3200
__device__ __forceinline__ unsigned xb_ld(unsigned* p) { return __hip_atomic_load(p, __ATOMIC_RELAXED, __HIP_MEMORY_SCOPE_AGENT); }
__device__ __forceinline__ unsigned xb_add(unsigned* p, unsigned v) { return __hip_atomic_fetch_add(p, v, __ATOMIC_RELAXED, __HIP_MEMORY_SCOPE_AGENT); }
__device__ __forceinline__ void xcd_barrier(unsigned* bar, unsigned x, unsigned nloc, unsigned nx, unsigned k) {
  asm volatile("s_waitcnt vmcnt(0) lgkmcnt(0)" ::: "memory");
  __syncthreads();
  if (threadIdx.x == 0) {
    const unsigned old = xb_add(&bar[XB_XSUB(x)], 1u);
    if (old + 1u == k * nloc) {
      __builtin_amdgcn_fence(__ATOMIC_RELEASE, "agent");
      asm volatile("s_waitcnt vmcnt(0)" ::: "memory");
      const unsigned og = xb_add(&bar[XB_TOP], 1u);
      if (og + 1u == k * nx) xb_add(&bar[XB_TOPGEN], 1u);
      else while (xb_ld(&bar[XB_TOPGEN]) < k) __builtin_amdgcn_s_sleep(1);
      __builtin_amdgcn_fence(__ATOMIC_ACQUIRE, "agent");
      xb_add(&bar[XB_XGEN(x)], 1u);
      asm volatile("s_waitcnt vmcnt(0)" ::: "memory");
    } else {
      while (xb_ld(&bar[XB_XGEN(x)]) < k) __builtin_amdgcn_s_sleep(1);
      __builtin_amdgcn_fence(__ATOMIC_ACQUIRE, "agent");
      asm volatile("s_waitcnt vmcnt(0)" ::: "memory");
    }
  }
  __syncthreads();
}
#define GRID_SYNC() do { ++bar_k; xcd_barrier(bar, bst[0], bst[1], bst[2], bar_k); } while (0)

#define TILE_LOOP(nM_, nN_, MT, NT)                                                                  \
  const int nSN_ = ((nN_) + 7) >> 3, nS_ = (((nM_) + 7) >> 3) * nSN_, P_ = nblk >> 3;                 \
  _Pragma("unroll 1") for (int S_ = (bid & 7); S_ < nS_ && (bid >> 3) < P_; S_ += 8)                 \
  _Pragma("unroll 1") for (int q_ = (bid >> 3); q_ < 64; q_ += P_)                                   \
    for (int MT = (S_ / nSN_) * 8 + (q_ >> 3), NT = (S_ % nSN_) * 8 + (q_ & 7), once_ = 1; once_ && MT < (nM_) && NT < (nN_); once_ = 0)

__global__ void __launch_bounds__(256, 2) mega(Params p) {
  cg::grid_group grid = cg::this_grid();
  __shared__ __attribute__((aligned(16))) char smraw[SMEM_BYTES];
  u16* smem = (u16*)smraw;
  float* smf = (float*)smraw;
  const int bid = blockIdx.x, nblk = gridDim.x, tid = threadIdx.x;
  const int rbid = nblk - 1 - bid;
  const int lane = tid & 63;
  char* const ws = p.ws;
  unsigned* const bar = (unsigned*)(ws + O_BAR);
  __shared__ unsigned bst[4];
  unsigned bar_k = 0;
  if (tid == 0) { bst[0] = (unsigned)__builtin_amdgcn_s_getreg((3 << 11) | 20) & 0xFu; xb_add(&bar[XB_CENS(bst[0])], 1u); }
  __threadfence();
  grid.sync();
  if (tid == 0) {
    unsigned mine = 0, cnt = 0;
    for (unsigned j = 0; j < 16; j++) { unsigned c = xb_ld(&bar[XB_CENS(j)]); cnt += c > 0u ? 1u : 0u; if (j == bst[0]) mine = c; }
    bst[1] = mine; bst[2] = cnt;
  }
  __syncthreads();

#ifdef NANFILL
  {
    uint4 nanv = make_uint4(0x7FC07FC0u, 0x7FC07FC0u, 0x7FC07FC0u, 0x7FC07FC0u);
    uint4* w4 = (uint4*)ws;
    for (size_t i = (size_t)bid * 256 + tid; i < WS_TOTAL / 16; i += (size_t)nblk * 256) w4[i] = nanv;
    uint4* o4 = (uint4*)p.out;
    for (size_t i = (size_t)bid * 256 + tid; i < (size_t)T_ALL * DM / 4; i += (size_t)nblk * 256) o4[i] = nanv;
    __threadfence(); grid.sync(); __threadfence();
  }
#endif
#pragma unroll 1
  for (int lay = 0; lay < 2; lay++) {
    {
      int l = lay; asm volatile("" : "+s"(l));
#pragma unroll 1
      for (int i = bid; i < 42 * 16; i += nblk) transpose_tile(smf, p.in[3] + (size_t)l * 1024 * 2576, 2576, p.in[2] + l * 1024, (u16*)(ws + O_WIN), 1024, 0, (i / 16) * 64, (i % 16) * 64);
#pragma unroll 1
      for (int i = rbid; i < 16 * 16; i += nblk) transpose_tile(smf, p.in[35] + (size_t)l * 1024 * 1024, 1024, nullptr, (u16*)(ws + O_WOUT), 1024, 1, (i / 16) * 64, (i % 16) * 64);
#pragma unroll 1
      for (int i = bid; i < 88 * 16; i += nblk) transpose_tile(smf, p.in[37] + (size_t)l * 1024 * 5632, 5632, p.in[36] + l * 1024, (u16*)(ws + O_WUP), 1024, 2, (i / 16) * 64, (i % 16) * 64);
#pragma unroll 1
      for (int i = rbid; i < 16 * 44; i += nblk) transpose_tile(smf, p.in[40] + (size_t)l * 2816 * 1024, 1024, nullptr, (u16*)(ws + O_WDN), 2816, 3, (i / 44) * 64, (i % 44) * 64);
#pragma unroll 1
      for (int i = bid; i < 16; i += nblk) transpose_tile(smf, p.in[19] + (size_t)l * 256 * 256, 256, nullptr, (u16*)(ws + O_WGLU), 256, 4, (i / 4) * 64, (i % 4) * 64);
#pragma unroll 1
      for (int i = rbid; i < 64; i += nblk) {
        u16* wl = (u16*)(ws + O_WLRU);
        for (int e = i * 1024 + tid; e < (i + 1) * 1024; e += 256) {
          int k = e & 63, n = (e >> 6) & 255, head = e >> 14;
          int d = n >> 7, gate = (n >> 6) & 1, j = n & 63;
          const float* wr_ = p.in[6]; const float* wi_ = p.in[8];
          size_t off_ = ((size_t)((l * 2 + d) * 4 + head) * 64 + k) * 64 + j;
          float vr_ = wr_[off_], vi_ = wi_[off_];
          wl[e] = f2bf(gate ? vi_ : vr_);
        }
      }
#pragma unroll 1
      for (int i = bid; i < 16 * 2 * 65; i += nblk) s5_prep_item(smf, p, l, i);
#pragma unroll 1
      for (int i = rbid; i < 16 * 2 * 64; i += nblk) s5_bts_item(p, l, i);
#pragma unroll 1
      for (int i = rbid; i < 96; i += nblk) hy_filter_item(smf, p, l, i < 32 ? 0 : 1, i < 32 ? i : i - 32);
      {
        unsigned* rq = (unsigned*)(ws + O_BAR + 208) + l;
        int* rslot = (int*)(smraw + SMEM_BYTES - 16);
#pragma unroll 1
        for (;;) {
          __syncthreads();
          if (tid == 0) *rslot = (int)atomicAdd(rq, 1u);
          __syncthreads();
          const int c0 = *rslot * 4;
          if (c0 >= T_ALL / 16) break;
#pragma unroll 1
          for (int i = c0; i < c0 + 4; i++) rms_rows_to_bf16(p, l, i);
        }
      }
    }
    GRID_SYNC();
    {
      int l = lay; asm volatile("" : "+s"(l));
      TILE_LOOP(640, 21, mt, nt) {
        { const float* H = gemm_tile(smem, (const u16*)(ws + O_XN), 1024, mt * 128, 0, T_ALL, 30, 0, (const u16*)(ws + O_WIN) + (size_t)nt * 128 * 1024, 1024, 1024);
            int tid_o = threadIdx.x; asm volatile("" : "+v"(tid_o));
            const int tok0 = mt * 128;
            if (nt < 4) {
              u16* zA = (u16*)(ws + O_ZA) + (size_t)tok0 * 512 + nt * 128;
              EPI_ROWS(H, { *(uint2*)(zA + (size_t)r * 512 + c) = pack4(v.x, v.y, v.z, v.w); })
            } else if (nt < 6) {
              u16* uh = (u16*)(ws + O_UH);
              EPI_ROWS(H, {
                int tok = tok0 + r, ch = (nt - 4) * 128 + c;
                *(uint2*)(uh + ((size_t)(ch >> 4) * 1280 + (tok >> 6)) * 1280 + (tok & 63) * 16 + (ch & 15)) = pack4(v.x, v.y, v.z, v.w); })
            } else if (nt < 14) {
              u16* zC = (u16*)(ws + O_ZC) + (size_t)tok0 * 1024 + (nt - 6) * 128;
              EPI_ROWS(H, { *(uint2*)(zC + (size_t)r * 1024 + c) = pack4(v.x, v.y, v.z, v.w); })
            } else if (nt < 20) {
              u16* dt = (u16*)(ws + O_DT) + (size_t)((nt - 14) * 128 + (tid_o & 127)) * T_ALL + tok0 + (tid_o >> 7) * 64;
              const float* Hc = H + (tid_o >> 7) * 64 * HST + (tid_o & 127);
#pragma unroll 2
              for (int k = 0; k < 8; k++) {
                uint2 a = pack4(Hc[(8 * k) * HST], Hc[(8 * k + 1) * HST], Hc[(8 * k + 2) * HST], Hc[(8 * k + 3) * HST]);
                uint2 b = pack4(Hc[(8 * k + 4) * HST], Hc[(8 * k + 5) * HST], Hc[(8 * k + 6) * HST], Hc[(8 * k + 7) * HST]);
                uint4 pk; pk.x = a.x; pk.y = a.y; pk.z = b.x; pk.w = b.y;
                *(uint4*)(dt + 8 * k) = pk;
              }
            } else {
              float* ba = (float*)(ws + O_BA) + (size_t)tok0 * 16;
#pragma unroll 2
              for (int k = 0; k < 8; k++) { int idx = tid_o + 256 * k; ba[idx] = H[(idx >> 4) * HST + (idx & 15)]; }
            }
          }
      }
#pragma unroll 1
      for (int it = rbid; it < 16 * 1024; it += nblk) s5_expand_item(p, l, it);
    }
    GRID_SYNC();
    {
      int l = lay; asm volatile("" : "+s"(l));
#pragma unroll 1
      for (int it = bid; it < NCH64 * 4; it += nblk) gdn_g1_item(smraw, p, l, it);
#pragma unroll 1
      for (int it = rbid; it < 16 * 10 * 2; it += nblk) {
        const int g = it / 20, mt = (it % 20) >> 1, nt = it & 1;
        { const float* H = gemm_tile(smem, (const u16*)(ws + O_UH) + (size_t)g * 1280 * 1280, 1280, mt * 128, 0, 1280, 30, 0,
                  (const u16*)(ws + O_BTS) + (size_t)g * 256 * 1024 + (size_t)nt * 128 * 1024, 1024, 1024);
            int tid_o = threadIdx.x; asm volatile("" : "+v"(tid_o));
            float* send = (float*)(ws + O_SEND) + (size_t)g * 1280 * 256 + (size_t)mt * 128 * 256 + nt * 128;
            EPI_ROWS(H, { *(float4*)(send + (size_t)r * 256 + c) = v; })
          }
      }
#pragma unroll 1
      for (int it = bid; it < NCH32 * 4; it += nblk) lru_item(smraw, p, l, it, 0);
    }
    GRID_SYNC();
    {
      int l = lay; asm volatile("" : "+s"(l));
#pragma unroll 1
      for (int it = bid; it < 192; it += nblk) gdn_chain(smraw, p, it);
#pragma unroll 1
      for (int it = rbid; it < 48; it += nblk) lru_propagate(p, it * 256 + tid);
#pragma unroll 1
      for (int it = rbid - 48; it < 192; it += nblk) { if (it >= 0) s5_propagate(p, l, it * 256 + tid); }
      unsigned* hq = (unsigned*)(ws + O_BAR + 192) + l;
      int* hslot = (int*)(smraw + SMEM_BYTES - 16);
#pragma unroll 1
      for (;;) {
        __syncthreads();
        if (tid == 0) *hslot = (int)atomicAdd(hq, 1u);
        __syncthreads();
        const int item = *hslot;
        if (item >= 512) break;
        const int set = item < 256 ? 1 : 0, c = item & 255, ntb = set ? 4 : 2;
#pragma unroll 1
        for (int tb = 0; tb < ntb; tb++) hy_conv_item(smraw, p, l, 0, set, c, tb);
        __threadfence();
        __syncthreads();
#pragma unroll 1
        for (int tb = 0; tb < ntb; tb++) hy_conv_item(smraw, p, l, 1, set, c, tb);
      }
    }
    GRID_SYNC();
    {
      int l = lay; asm volatile("" : "+s"(l));
#pragma unroll 1
      for (int it = rbid; it < 16 * 10 * 8; it += nblk) {
        const int g = it / 80, mt = (it % 80) >> 3, nt = it & 7;
        { const float* H = gemm_tile(smem, (const u16*)(ws + O_UH) + (size_t)g * 1280 * 1280, 1280, mt * 128, 0, 1280, 30, 0,
                  (const u16*)(ws + O_BTY) + (size_t)g * 1024 * 1280 + (size_t)nt * 128 * 1280, 1280, 1280);
            int tid_o = threadIdx.x; asm volatile("" : "+v"(tid_o));
            u16* zb = (u16*)(ws + O_XN) + (size_t)3 * T_ALL * 256;
            EPI_ROWS(H, {
              int ck = mt * 128 + r, n = nt * 128 + c;
              *(uint2*)(zb + ((size_t)g * T_ALL + ck * 64 + (n >> 4)) * 16 + (n & 15)) = pack4(geluf_(v.x), geluf_(v.y), geluf_(v.z), geluf_(v.w)); })
          }
      }
#pragma unroll 1
      for (int it = bid; it < NCH32 * 4; it += nblk) lru_item(smraw, p, l, it, 1);
#pragma unroll 1
      for (int it = rbid; it < T_ALL / 16; it += nblk) gdn_final_rows(p, l, it);
    }
    GRID_SYNC();
    {
      int l = lay; asm volatile("" : "+s"(l));
#pragma unroll 1
      for (int it = bid; it < 640 * 2; it += nblk) {
        const int mt = it >> 1, nt = it & 1;
        const u16* zb = (const u16*)(ws + O_XN) + (size_t)3 * T_ALL * 256;
        { const float* H = gemm_tile(smem, zb, 16, mt * 128, 0, T_ALL, 4, (size_t)T_ALL * 16, (const u16*)(ws + O_WGLU) + (size_t)nt * 128 * 256, 256, 256);
            int tid_o = threadIdx.x; asm volatile("" : "+v"(tid_o));
            u16* mixB = (u16*)(ws + O_XN) + (size_t)T_ALL * 256 + (size_t)mt * 128 * 256 + nt * 128;
            const u16* zr = zb + (size_t)mt * 128 * 16;
            const float* gb = p.in[20] + l * 256 + nt * 128;
            EPI_ROWS(H, {
              uint2 zz = *(const uint2*)(zr + ((size_t)((nt * 128 + c) >> 4) * T_ALL + r) * 16 + (c & 15));
              float4 g4 = *(const float4*)(gb + c);
              float z0 = bf2f(zz.x & 0xffff), z1 = bf2f(zz.x >> 16), z2 = bf2f(zz.y & 0xffff), z3 = bf2f(zz.y >> 16);
              *(uint2*)(mixB + (size_t)r * 256 + c) = pack4(z0 * sigmoidf_(v.x + g4.x), z1 * sigmoidf_(v.y + g4.y), z2 * sigmoidf_(v.z + g4.z), z3 * sigmoidf_(v.w + g4.w)); })
          }
      }
#pragma unroll 1
      for (int it = rbid; it < T_ALL / 16; it += nblk) grpnorm_rows(p, l, 0, it);
    }
    GRID_SYNC();
    {
      int l = lay; asm volatile("" : "+s"(l));
#pragma unroll 1
      for (int it = bid; it < NCH64; it += nblk) hy_final_item(smraw, p, l, it);
#pragma unroll 1
      for (int it = rbid; it < T_ALL / 16; it += nblk) grpnorm_rows(p, l, 1, it);
    }
    GRID_SYNC();
    {
      int l = lay; asm volatile("" : "+s"(l));
      TILE_LOOP(640, 8, mt, nt) {
        { const float* H = gemm_tile(smem, (const u16*)(ws + O_XN), 256, mt * 128, 0, T_ALL, 8, (size_t)T_ALL * 256,
                  (const u16*)(ws + O_WOUT) + (size_t)nt * 128 * 1024, 1024, 1024);
            int tid_o = threadIdx.x; asm volatile("" : "+v"(tid_o));
            float* o = p.out + (size_t)mt * 128 * DM + nt * 128;
            const int er = tid_o >> 5, ec = (tid_o & 31) * 4;
#pragma unroll 1
            for (int half = 0; half < 2; half++) {
              float4 b4[8];
#pragma unroll
              for (int q = 0; q < 8; q++) b4[q] = *(const float4*)(xrow(p, l, mt * 128 + er + 8 * (half * 8 + q)) + nt * 128 + ec);
#pragma unroll
              for (int q = 0; q < 8; q++) {
                const int r = er + 8 * (half * 8 + q);
                const float4 v = *(const float4*)(H + r * HST + ec);
                float4 o4; o4.x = b4[q].x + v.x; o4.y = b4[q].y + v.y; o4.z = b4[q].z + v.z; o4.w = b4[q].w + v.w;
                *(float4*)(o + (size_t)r * DM + ec) = o4;
              }
            }
          }
      }
    }
    GRID_SYNC();
    {
      int l = lay; asm volatile("" : "+s"(l));
#pragma unroll 1
      for (int it = bid; it < T_ALL / 16; it += nblk) rms_rows_to_bf16(p, 1, it);
    }
    GRID_SYNC();
    {
      int l = lay; asm volatile("" : "+s"(l));
      const int nM = 8 * 17 + 16 * 33;
      TILE_LOOP(nM, 44, mi, nt) {
        int seq, ti, L;
        if (mi < 136) { seq = mi / 17; ti = mi % 17; L = 2048; }
        else { seq = 8 + (mi - 136) / 33; ti = (mi - 136) % 33; L = 4096; }
        const int s0 = seq < 8 ? seq * 2048 : T_P + (seq - 8) * 4096;
        const int arow0 = s0 + 126 * ti - 1;
        const int nvalid = min(126, L - 126 * ti);
        { const float* H = gemm_tile(smem, (const u16*)(ws + O_XN), 1024, arow0, s0, s0 + L, 30, 0, (const u16*)(ws + O_WUP) + (size_t)nt * 128 * 1024, 1024, 1024);
            int tid_o = threadIdx.x; asm volatile("" : "+v"(tid_o));
            const int j = tid_o & 63, rg = tid_o >> 6;
            const float* cw = p.in[38] + (size_t)l * 3 * 5632;
            const float* cb = p.in[39] + (size_t)l * 5632;
            const int cg_ = nt * 64 + j, cv_ = DFF + nt * 64 + j;
            const float g0 = cw[cg_], g1 = cw[5632 + cg_], g2 = cw[2 * 5632 + cg_], gb = cb[cg_];
            const float u0 = cw[cv_], u1 = cw[5632 + cv_], u2 = cw[2 * 5632 + cv_], ub = cb[cv_];
            u16* hm = (u16*)(ws + O_HMID) + (size_t)arow0 * DFF + nt * 64 + j;
#pragma unroll 2
            for (int r = 1 + rg; r <= nvalid; r += 4) {
              float gate = g0 * H[(r - 1) * HST + j] + g1 * H[r * HST + j] + g2 * H[(r + 1) * HST + j] + gb;
              float val = u0 * H[(r - 1) * HST + 64 + j] + u1 * H[r * HST + 64 + j] + u2 * H[(r + 1) * HST + 64 + j] + ub;
              hm[(size_t)r * DFF] = f2bf(siluf_(gate) * val);
            }
          }
      }
    }
    GRID_SYNC();
    {
      int l = lay; asm volatile("" : "+s"(l));
      TILE_LOOP(640, 8, mt, nt) {
        { const float* H = gemm_tile(smem, (const u16*)(ws + O_HMID), DFF, mt * 128, 0, T_ALL, 30, 0, (const u16*)(ws + O_WDN) + (size_t)nt * 128 * DFF, DFF, DFF);
            int tid_o = threadIdx.x; asm volatile("" : "+v"(tid_o));
            float* o = p.out + (size_t)mt * 128 * DM + nt * 128;
            const int er = tid_o >> 5, ec = (tid_o & 31) * 4;
#pragma unroll 1
            for (int half = 0; half < 2; half++) {
              float4 b4[8];
#pragma unroll
              for (int q = 0; q < 8; q++) b4[q] = *(const float4*)(o + (size_t)(er + 8 * (half * 8 + q)) * DM + ec);
#pragma unroll
              for (int q = 0; q < 8; q++) {
                const int r = er + 8 * (half * 8 + q);
                const float4 v = *(const float4*)(H + r * HST + ec);
                float4 o4; o4.x = b4[q].x + v.x; o4.y = b4[q].y + v.y; o4.z = b4[q].z + v.z; o4.w = b4[q].w + v.w;
                *(float4*)(o + (size_t)r * DM + ec) = o4;
              }
            }
          }
      }
    }
    GRID_SYNC();
  }
  {
    const int w = tid >> 6;
    const float* fn = p.in[41];
#pragma unroll 1
    for (int it = bid; it < T_ALL / 16; it += nblk) {
      float* x0 = p.out + (size_t)(it * 16 + w * 4) * DM;
      float4 v[4][4];
#pragma unroll
      for (int j = 0; j < 4; j++)
#pragma unroll
        for (int i = 0; i < 4; i++) v[j][i] = *(const float4*)(x0 + (size_t)j * DM + i * 256 + lane * 4);
#pragma unroll
      for (int j = 0; j < 4; j++) {
        float ss = 0.f;
#pragma unroll
        for (int i = 0; i < 4; i++) ss += v[j][i].x * v[j][i].x + v[j][i].y * v[j][i].y + v[j][i].z * v[j][i].z + v[j][i].w * v[j][i].w;
        ss = wave_sum(ss);
        float rs = rsqrtf(ss * (1.f / 1024.f) + EPSF);
#pragma unroll
        for (int i = 0; i < 4; i++) {
          float4 g = *(const float4*)(fn + i * 256 + lane * 4);
          float4 o; o.x = v[j][i].x * rs * g.x; o.y = v[j][i].y * rs * g.y; o.z = v[j][i].z * rs * g.z; o.w = v[j][i].w * rs * g.w;
          *(float4*)(x0 + (size_t)j * DM + i * 256 + lane * 4) = o;
        }
      }
    }
  }
}

extern "C" void kernel_launch(void* const* d_in, const int* in_sizes, int n_in,
                              void* d_out, int out_size, void* d_ws, size_t ws_size,
                              hipStream_t stream) {
  static int grid_blocks = 0;
  if (!grid_blocks) {
    int dev = 0, cus = 0, per_cu = 0;
    (void)hipGetDevice(&dev);
    (void)hipDeviceGetAttribute(&cus, hipDeviceAttributeMultiprocessorCount, dev);
    (void)hipOccupancyMaxActiveBlocksPerMultiprocessor(&per_cu, mega, 256, 0);
    if (per_cu > 2) per_cu = 2;
    if (per_cu < 1) per_cu = 1;
    grid_blocks = cus * per_cu;
  }
  if (ws_size < WS_TOTAL) fprintf(stderr, "workspace too small: %zu < %zu\n", ws_size, (size_t)WS_TOTAL);
  Params p{};
  for (int i = 0; i < 42; i++) p.in[i] = (const float*)d_in[i];
  p.out = (float*)d_out;
  p.ws = (char*)d_ws;
  (void)hipMemsetAsync((char*)d_ws + O_BAR, 0, 16384, stream);
  void* args[] = {&p};
  hipError_t e = hipLaunchCooperativeKernel((void*)mega, dim3(grid_blocks), dim3(256), args, 0, stream);
  if (e != hipSuccess) fprintf(stderr, "coop launch failed: %s (grid %d)\n", hipGetErrorString(e), grid_blocks);
}
```

```cpp
#include <hip/hip_runtime.h>
#include <hip/hip_bf16.h>
#include <hip/hip_cooperative_groups.h>
#include <cstdio>
namespace cg = cooperative_groups;

typedef unsigned short u16;
using bf16x8 = __attribute__((ext_vector_type(8))) short;
using f32x4 = __attribute__((ext_vector_type(4))) float;

#define T_ALL 81920
#define T_P 16384
#define DM 1024
#define NZ 2688
#define DFF 2816
#define NCH32 2560
#define NCH64 1280
#define EPSF 1e-6f

constexpr size_t al(size_t x) { return (x + 255) & ~(size_t)255; }
constexpr size_t O_WIN = 0;
constexpr size_t O_WOUT = O_WIN + al((size_t)NZ * 1024 * 2);
constexpr size_t O_WUP = O_WOUT + al((size_t)1024 * 1024 * 2);
constexpr size_t O_WDN = O_WUP + al((size_t)5632 * 1024 * 2);
constexpr size_t O_WLRU = O_WDN + al((size_t)1024 * 2816 * 2);
constexpr size_t O_WGLU = O_WLRU + al((size_t)4 * 256 * 64 * 2);
constexpr size_t O_AB64 = O_WGLU + al((size_t)256 * 256 * 2);
constexpr size_t O_KTAB = O_AB64 + 2 * al((size_t)2 * 16 * 64 * 2 * 4);
constexpr size_t O_BTY = O_KTAB + al((size_t)16 * 2 * 64 * 256 * 4);
constexpr size_t O_BTS = O_BTY + al((size_t)16 * 1024 * 1280 * 2);
constexpr size_t O_HYKR = O_BTS + al((size_t)16 * 256 * 1024 * 2);
constexpr size_t HYKR1 = (size_t)2 * 256 * 4096;
constexpr size_t O_HYPS = O_HYKR + al((size_t)2 * 256 * (4096 + 8192) * 2);
constexpr size_t O_XN = O_HYPS + al((size_t)(32 + 64) * 512 * 4);
constexpr size_t O_ZA = O_XN + al((size_t)T_ALL * 1024 * 2);
constexpr size_t O_UH = O_ZA + al((size_t)T_ALL * 512 * 2);
constexpr size_t O_ZC = O_UH + al((size_t)16 * 1280 * 1280 * 2);
constexpr size_t O_BA = O_ZC + al((size_t)T_ALL * 1024 * 2);
constexpr size_t O_DT = O_BA + al((size_t)T_ALL * 16 * 4);
constexpr size_t O_WU = O_DT + al((size_t)768 * T_ALL * 2);
constexpr size_t O_GC = O_WU + al((size_t)NCH64 * 4 * 2 * 2 * 4096 * 2);
constexpr size_t O_OD = O_GC + al((size_t)T_ALL * 8 * 4);
constexpr size_t O_Y1 = O_OD + al((size_t)2 * T_ALL * 256 * 2);
constexpr size_t O_SEND = O_Y1 + al((size_t)256 * T_ALL * 2);
constexpr size_t O_LCAR = O_SEND + al((size_t)16 * 1280 * 256 * 4);
constexpr size_t O_LHIN = O_LCAR + al((size_t)NCH32 * 512 * 8);
constexpr size_t O_BAR = O_LHIN + al((size_t)NCH32 * 512 * 4);
constexpr size_t WS_TOTAL = O_BAR + 16384;
static_assert(WS_TOTAL <= (size_t)1073741824, "ws");
constexpr size_t O_HMID = O_ZA;
static_assert(O_HMID + (size_t)T_ALL * DFF * 2 <= O_GC, "hmid alias");

struct Params {
  const float* in[42];
  float* out;
  char* ws;
};

#define SMEM_BYTES 73728
#ifndef MIXMASK
#define MIXMASK 15
#endif

__device__ __forceinline__ u16 f2bf(float f) {
  unsigned u = __float_as_uint(f);
  u += 0x7fffu + ((u >> 16) & 1u);
  return (u16)(u >> 16);
}
__device__ __forceinline__ float bf2f(u16 h) { return __uint_as_float(((unsigned)h) << 16); }
__device__ __forceinline__ float sigmoidf_(float x) { return 1.f / (1.f + __expf(-x)); }
__device__ __forceinline__ float siluf_(float x) { return x / (1.f + __expf(-x)); }
__device__ __forceinline__ float softplusf_(float x) { return x > 20.f ? x : log1pf(expf(x)); }
__device__ __forceinline__ float geluf_(float x) {
  float u2 = 1.5957691216057308f * (x + 0.044715f * x * x * x);
  return x / (1.f + __expf(-u2));
}
__device__ __forceinline__ float wave_sum(float v) {
#pragma unroll
  for (int o = 32; o > 0; o >>= 1) v += __shfl_xor(v, o);
  return v;
}
__device__ __forceinline__ const float* xrow(const Params& p, int l, int tok) {
  const float* a = p.in[0]; const float* b = p.in[1]; const float* o = p.out;
  const float* r0 = a + (size_t)tok * DM;
  const float* r1 = b + (size_t)(tok - T_P) * DM;
  const float* r2 = o + (size_t)tok * DM;
  return l == 0 ? (tok < T_P ? r0 : r1) : r2;
}
__device__ __forceinline__ void seq_bounds(int tok, int& lo, int& hi) {
  if (tok < T_P) { lo = tok & ~2047; hi = lo + 2048; }
  else { lo = T_P + ((tok - T_P) & ~4095); hi = lo + 4096; }
}

#define LDS_BARRIER() asm volatile("s_waitcnt lgkmcnt(0)\n\ts_barrier" ::: "memory")

#define GST 72
#define HST 132
__device__ __forceinline__ const float* gemm_tile(u16* smem, const u16* __restrict__ A, long lda, int arow0, int alo, int ahi,
                                          int segShift, size_t segStride,
                                          const u16* __restrict__ Bt, long ldb, int K) {
  u16* sA = smem;
  u16* sB = smem + 2 * 128 * GST;
  int tid = threadIdx.x; asm volatile("" : "+v"(tid)); const int _tid_pad = 0, lane = tid & 63, w = tid >> 6;
  const int wm = w >> 1, wn = w & 1, fr = lane & 15, fq = lane >> 4;
  const int cc = tid & 7, r0 = tid >> 3;
  f32x4 acc[4][4];
#pragma unroll
  for (int i = 0; i < 4; i++)
#pragma unroll
    for (int j = 0; j < 4; j++) acc[i][j] = (f32x4){0.f, 0.f, 0.f, 0.f};
  uint4 ra0x, ra1x, ra2x, ra3x, rb0x, rb1x, rb2x, rb3x;
  const int nk = K >> 6;
#define GROW(i_, AP, BP, OK) const bool OK = (arow0 + r0 + 32 * i_) >= alo && (arow0 + r0 + 32 * i_) < ahi;        \
    const u16* AP = A + (long)(OK ? (arow0 + r0 + 32 * i_) : alo) * lda;                                             \
    const u16* BP = Bt + (long)(r0 + 32 * i_) * ldb + cc * 8;
  GROW(0, ap0, bp0, ok0) GROW(1, ap1, bp1, ok1) GROW(2, ap2, bp2, ok2) GROW(3, ap3, bp3, ok3)
#define GLOAD1(AP, BP, OK, RA, RB) {                                                \
      uint4 t_ = *(const uint4*)(AP + aoff_);                                         \
      RA = OK ? t_ : make_uint4(0, 0, 0, 0);                                          \
      RB = *(const uint4*)(BP + k0_); }
#define GLOAD(kt_, S) do {                                                         \
    const int k0_ = (kt_) << 6;                                                       \
    const int kk_ = k0_ + cc * 8;                                                     \
    const int sg_ = kk_ >> segShift;                                                  \
    const size_t aoff_ = (size_t)sg_ * segStride + (kk_ - (sg_ << segShift));         \
    GLOAD1(ap0, bp0, ok0, ra0##S, rb0##S) GLOAD1(ap1, bp1, ok1, ra1##S, rb1##S)       \
    GLOAD1(ap2, bp2, ok2, ra2##S, rb2##S) GLOAD1(ap3, bp3, ok3, ra3##S, rb3##S)       \
    } while (0)
#define SWRITE1(buf_, i_, RA, RB) {                                                 \
      *(uint4*)(sA + (buf_) * 128 * GST + (r0 + 32 * i_) * GST + cc * 8) = RA;        \
      *(uint4*)(sB + (buf_) * 128 * GST + (r0 + 32 * i_) * GST + cc * 8) = RB; }
#define SWRITE(buf_, S) do {                                                        \
    SWRITE1(buf_, 0, ra0##S, rb0##S) SWRITE1(buf_, 1, ra1##S, rb1##S) SWRITE1(buf_, 2, ra2##S, rb2##S) SWRITE1(buf_, 3, ra3##S, rb3##S) \
    } while (0)
#define GCOMPUTE(buf_) do {                                                         \
    const u16* a = sA + (buf_) * 128 * GST;                                           \
    const u16* b = sB + (buf_) * 128 * GST;                                           \
    _Pragma("unroll") for (int ks = 0; ks < 2; ks++) {                                \
      bf16x8 af[4], bfr[4];                                                           \
      _Pragma("unroll") for (int i = 0; i < 4; i++) {                                 \
        af[i] = *(const bf16x8*)(a + (64 * wm + 16 * i + fr) * GST + ks * 32 + fq * 8);   \
        bfr[i] = *(const bf16x8*)(b + (64 * wn + 16 * i + fr) * GST + ks * 32 + fq * 8);  \
      }                                                                               \
      _Pragma("unroll") for (int i = 0; i < 4; i++)                                   \
      _Pragma("unroll") for (int j = 0; j < 4; j++)                                   \
        acc[i][j] = __builtin_amdgcn_mfma_f32_16x16x32_bf16(af[i], bfr[j], acc[i][j], 0, 0, 0); \
    } } while (0)
  LDS_BARRIER();
  GLOAD(0, x);
  SWRITE(0, x);
  LDS_BARRIER();
#pragma unroll 1
  for (int kt = 0; kt < nk; kt += 2) {
    if (kt + 1 < nk) GLOAD(kt + 1, x);
    GCOMPUTE(0);
    if (kt + 1 < nk) SWRITE(1, x);
    LDS_BARRIER();
    if (kt + 1 >= nk) break;
    if (kt + 2 < nk) GLOAD(kt + 2, x);
    GCOMPUTE(1);
    if (kt + 2 < nk) SWRITE(0, x);
    LDS_BARRIER();
  }
  float* H = (float*)smem;
#pragma unroll
  for (int i = 0; i < 4; i++)
#pragma unroll
    for (int j = 0; j < 4; j++)
#pragma unroll
      for (int e = 0; e < 4; e++) H[(64 * wm + 16 * i + 4 * fq + e) * HST + 64 * wn + 16 * j + fr] = acc[i][j][e];
  LDS_BARRIER();
  return H;
}
__device__ __forceinline__ uint2 pack4(float a, float b, float c, float d) {
  uint2 pk; pk.x = f2bf(a) | ((unsigned)f2bf(b) << 16); pk.y = f2bf(c) | ((unsigned)f2bf(d) << 16); return pk;
}
#define EPI_ROWS(H, BODY...)                                                     \
  _Pragma("unroll 4") for (int _it = 0; _it < 16; _it++) {                       \
    const int r = (tid_o >> 5) + 8 * _it, c = (tid_o & 31) * 4;      \
    const float4 v = *(const float4*)((H) + r * HST + c); BODY }

__device__ __forceinline__ int colmap(int mode, int n) {
  if (mode == 0) {
    if (n < 1792) return n;
    if (n < 2560) return n + 16;
    if (n < 2576) return 1792 + (n - 2560);
    return -1;
  }
  if (mode == 2) { int nt = n >> 7, c = n & 127; return c < 64 ? nt * 64 + c : DFF + nt * 64 + (c - 64); }
  return n;
}
__device__ __forceinline__ void transpose_tile(float* sm, const float* __restrict__ src, int ldsrc, const float* __restrict__ gain,
                               u16* __restrict__ dst, int K, int mode, int n0, int k0) {
  int tid = threadIdx.x; asm volatile("" : "+v"(tid)); const int _tid_pad = 0;
  LDS_BARRIER();
  {
    int nn = tid & 63;
    int sc = colmap(mode, n0 + nn);
#pragma unroll
    for (int i = 0; i < 16; i++) {
      int kk = (tid >> 6) + 4 * i;
      float v = 0.f;
      if (sc >= 0) { v = src[(size_t)(k0 + kk) * ldsrc + sc]; if (gain) v *= gain[k0 + kk]; }
      sm[kk * 65 + nn] = v;
    }
  }
  LDS_BARRIER();
  {
    int c = tid & 7;
#pragma unroll
    for (int i = 0; i < 2; i++) {
      int nn = (tid >> 3) + 32 * i;
      u16 h[8];
#pragma unroll
      for (int e = 0; e < 8; e++) h[e] = f2bf(sm[(c * 8 + e) * 65 + nn]);
      uint4 pk;
      pk.x = h[0] | ((unsigned)h[1] << 16); pk.y = h[2] | ((unsigned)h[3] << 16);
      pk.z = h[4] | ((unsigned)h[5] << 16); pk.w = h[6] | ((unsigned)h[7] << 16);
      *(uint4*)(dst + (size_t)(n0 + nn) * K + k0 + c * 8) = pk;
    }
  }
}

__device__ __forceinline__ void s5_prep_item(float* sm, const Params& p, int l, int item) {
  int tid = threadIdx.x; asm volatile("" : "+v"(tid)); const int _tid_pad = 0;
  const int m = item % 65, d = (item / 65) & 1, g = item / 130;
  float* s_abm = sm;
  float* s_q = sm + 128;
  const int ldg = (l * 2 + d) * 16 + g;
  LDS_BARRIER();
  if (tid < 64) {
    int pi = ldg * 64 + tid;
    float dt = expf(p.in[13][ldg]);
    float are = p.in[11][pi], aim = p.in[12][pi];
    float mag = expf(dt * are), ang = dt * aim;
    float abr = mag * cosf(ang), abi = mag * sinf(ang);
    float den = are * are + aim * aim;
    float nre = abr - 1.f;
    s_q[tid * 2] = (nre * are + abi * aim) / den;
    s_q[tid * 2 + 1] = (abi * are - nre * aim) / den;
    float mm = expf((float)m * dt * are), am = (float)m * ang;
    float pr = mm * cosf(am), pim = mm * sinf(am);
    s_abm[tid * 2] = pr; s_abm[tid * 2 + 1] = pim;
    if (m == 64) {
      float* ab64 = (float*)(p.ws + O_AB64) + (size_t)l * 2 * 16 * 64 * 2;
      ab64[((d * 16 + g) * 64 + tid) * 2] = pr;
      ab64[((d * 16 + g) * 64 + tid) * 2 + 1] = pim;
    }
  }
  LDS_BARRIER();
  const float* bre = p.in[14] + (size_t)ldg * 64 * 16;
  const float* bim = p.in[15] + (size_t)ldg * 64 * 16;
  const float* cre = p.in[16] + (size_t)ldg * 16 * 64;
  const float* cim = p.in[17] + (size_t)ldg * 16 * 64;
  u16* bty = (u16*)(p.ws + O_BTY) + (size_t)g * 1024 * 1280;
  u16* bts = (u16*)(p.ws + O_BTS) + (size_t)g * 256 * 1024;
  if (m <= 63) {
    int ho = tid >> 4, hi = tid & 15;
    float acc = 0.f;
    for (int pp = 0; pp < 64; pp++) {
      float cr = cre[ho * 64 + pp], ci = cim[ho * 64 + pp];
      float ar = s_abm[pp * 2], ai = s_abm[pp * 2 + 1];
      float t1r = cr * ar - ci * ai, t1i = cr * ai + ci * ar;
      float qr = s_q[pp * 2], qi = s_q[pp * 2 + 1];
      float br = bre[pp * 16 + hi], bi = bim[pp * 16 + hi];
      float bbr = qr * br - qi * bi, bbi = qr * bi + qi * br;
      acc += t1r * bbr - t1i * bbi;
    }
    float* kt = (float*)(p.ws + O_KTAB);
    kt[((size_t)((g * 2 + d) * 64 + m)) * 256 + ho * 16 + hi] = acc;
  }
  if (m >= 1) {
    int t = d == 0 ? m - 1 : 64 - m;
    for (int e = tid; e < 1024; e += 256) {
      int ho = e >> 6, pp = e & 63;
      float cr = cre[ho * 64 + pp], ci = cim[ho * 64 + pp];
      float ar = s_abm[pp * 2], ai = s_abm[pp * 2 + 1];
      float xr = cr * ar - ci * ai, xi = cr * ai + ci * ar;
      size_t o = (size_t)(t * 16 + ho) * 1280 + 1024 + d * 128 + pp * 2;
      bty[o] = f2bf(xr);
      bty[o + 1] = f2bf(-xi);
    }
  }
}
__device__ __forceinline__ void s5_bts_item(const Params& p, int l, int item) {
  int tid = threadIdx.x; asm volatile("" : "+v"(tid));
  const int pp = item & 63, d = (item >> 6) & 1, g = item >> 7;
  const int sp = tid >> 2, hq = tid & 3;
  const int ldg = (l * 2 + d) * 16 + g;
  const int pi = ldg * 64 + pp;
  float dt = expf(p.in[13][ldg]);
  float are = p.in[11][pi], aim = p.in[12][pi];
  float mag = expf(dt * are), ang = dt * aim;
  float abr = mag * cosf(ang), abi = mag * sinf(ang);
  float den = are * are + aim * aim;
  float nre = abr - 1.f;
  float qr = (nre * are + abi * aim) / den, qi = (abi * are - nre * aim) / den;
  const int f = d == 0 ? 63 - sp : sp;
  float mm = expf((float)f * dt * are), am = (float)f * ang;
  float ar = mm * cosf(am), ai = mm * sinf(am);
  const float* bre = p.in[14] + (size_t)ldg * 64 * 16 + pp * 16 + hq * 4;
  const float* bim = p.in[15] + (size_t)ldg * 64 * 16 + pp * 16 + hq * 4;
  float fr_[4], fi_[4];
#pragma unroll
  for (int e = 0; e < 4; e++) {
    float br = bre[e], bi = bim[e];
    float bbr = qr * br - qi * bi, bbi = qr * bi + qi * br;
    fr_[e] = ar * bbr - ai * bbi; fi_[e] = ar * bbi + ai * bbr;
  }
  u16* bts = (u16*)(p.ws + O_BTS) + (size_t)g * 256 * 1024 + (size_t)(d * 128 + pp * 2) * 1024 + sp * 16 + hq * 4;
  *(uint2*)bts = pack4(fr_[0], fr_[1], fr_[2], fr_[3]);
  *(uint2*)(bts + 1024) = pack4(fi_[0], fi_[1], fi_[2], fi_[3]);
}
__device__ __forceinline__ void s5_expand_item(const Params& p, int l, int item) {
  int tid = threadIdx.x; asm volatile("" : "+v"(tid)); const int _tid_pad = 0;
  int g = item >> 10, n = item & 1023, t = n >> 4, ho = n & 15;
  int sp = tid >> 2, hi0 = (tid & 3) * 4;
  const float* kt = (const float*)(p.ws + O_KTAB);
  float v[4] = {0.f, 0.f, 0.f, 0.f};
  if (t >= sp) {
    const float* k0 = kt + ((size_t)((g * 2 + 0) * 64 + (t - sp))) * 256 + ho * 16 + hi0;
#pragma unroll
    for (int e = 0; e < 4; e++) v[e] += k0[e];
  }
  if (sp >= t) {
    const float* k1 = kt + ((size_t)((g * 2 + 1) * 64 + (sp - t))) * 256 + ho * 16 + hi0;
#pragma unroll
    for (int e = 0; e < 4; e++) v[e] += k1[e];
  }
  if (t == sp && ho >= hi0 && ho < hi0 + 4) v[ho - hi0] += p.in[18][l * 256 + g * 16 + ho];
  u16* bty = (u16*)(p.ws + O_BTY) + (size_t)g * 1024 * 1280 + (size_t)n * 1280 + sp * 16 + hi0;
  uint2 pk;
  pk.x = f2bf(v[0]) | ((unsigned)f2bf(v[1]) << 16);
  pk.y = f2bf(v[2]) | ((unsigned)f2bf(v[3]) << 16);
  *(uint2*)bty = pk;
}

__device__ __forceinline__ void hy_filter_item(float* sm, const Params& p, int l, int set, int tb) {
  int tid = threadIdx.x; asm volatile("" : "+v"(tid));
  const int L = 2048 << set;
  float* sz = sm;
  float* h1 = sm + 65 * 33;
  float* h2 = h1 + 65 * 64;
  const float* w1 = p.in[27] + (size_t)l * 33 * 64;
  const float* b1 = p.in[28] + l * 64;
  const float* fq_ = p.in[29] + l * 64;
  const float* w2 = p.in[30] + (size_t)l * 64 * 64;
  const float* b2 = p.in[31] + l * 64;
  const float* w3 = p.in[32] + (size_t)l * 64 * 1024;
  LDS_BARRIER();
  for (int e = tid; e < 65 * 33; e += 256) {
    int tt = e / 33, i = e % 33;
    int t = tb * 64 + tt;
    float val;
    if (i == 0) val = (float)t / (float)(L - 1);
    else {
      int b = (i - 1) & 15;
      float f = 1e-4f + (float)b * ((15.f - 1e-4f) / 15.f);
      float wang = 6.283185307179586f * (float)t / (float)L;
      val = i <= 16 ? cosf(f * wang) : -sinf(f * wang);
    }
    sz[e] = val;
  }
  LDS_BARRIER();
  {
    int j = tid & 63;
    float fj = fq_[j], bj = b1[j];
#pragma unroll 1
    for (int i = 0; i < 17; i++) {
      int tt = (tid >> 6) + 4 * i;
      if (tt < 65) {
        float a = bj;
        for (int k = 0; k < 33; k++) a += sz[tt * 33 + k] * w1[k * 64 + j];
        h1[tt * 64 + j] = sinf(fj * a);
      }
    }
  }
  LDS_BARRIER();
  {
    int j = tid & 63;
    float fj = fq_[j], bj = b2[j];
#pragma unroll 1
    for (int i = 0; i < 17; i++) {
      int tt = (tid >> 6) + 4 * i;
      if (tt < 65) {
        float a = bj;
        for (int k = 0; k < 64; k++) a += h1[tt * 64 + k] * w2[k * 64 + j];
        h2[tt * 64 + j] = sinf(fj * a);
      }
    }
  }
  LDS_BARRIER();
  const int c = tid;
  const float mind = -3.0701134573253943f, maxd = -15.350567286626972f;
  float delta = fabsf(mind + (float)c * ((maxd - mind) / 255.f));
  u16* kr = (u16*)(p.ws + O_HYKR) + (set ? HYKR1 : 0);
  float* ps = (float*)(p.ws + O_HYPS) + (size_t)(set ? 32 * 512 : 0) + (size_t)tb * 512;
#pragma unroll 1
  for (int order = 0; order < 2; order++) {
    u16* krc = kr + ((size_t)order * 256 + c) * (2 * L);
    float asum = 0.f, v00 = 0.f;
#pragma unroll 1
    for (int dir = 0; dir < 2; dir++) {
      float wc[64];
#pragma unroll
      for (int k = 0; k < 64; k++) wc[k] = w3[k * 1024 + order * 512 + dir * 256 + c];
      float hold = 0.f;
      const int ntt = dir == 0 ? 65 : 64;
#pragma unroll 1
      for (int tt = 0; tt < ntt; tt++) {
        float a = 0.f;
#pragma unroll
        for (int k = 0; k < 64; k++) a += h2[tt * 64 + k] * wc[k];
        int t = tb * 64 + tt;
        float tl = (float)t / (float)(L - 1);
        a *= expf(-tl * delta);
        if (t >= L) a = 0.f;
        if (tt < 64) asum += fabsf(a);
        if (dir == 0) {
          if (tt == 0) { if (tb == 0) v00 = a; }
          else if (tt & 1) hold = a;
          else *(unsigned*)(krc + (L - t)) = f2bf(a) | ((unsigned)f2bf(hold) << 16);
        } else {
          if (!(tt & 1)) hold = (t == 0) ? v00 + a : a;
          else *(unsigned*)(krc + (L + t - 1)) = f2bf(hold) | ((unsigned)f2bf(a) << 16);
        }
      }
    }
    ps[order * 256 + c] = asum;
  }
}

__device__ __forceinline__ void rms_rows_to_bf16(const Params& p, int l, int rowblk) {
  int tid_ = threadIdx.x; asm volatile("" : "+v"(tid_));
  const int lane = tid_ & 63, w = tid_ >> 6;
  float4 v[4][4];
#pragma unroll
  for (int j = 0; j < 4; j++) {
    const float* x = xrow(p, l, rowblk * 16 + w * 4 + j);
#pragma unroll
    for (int i = 0; i < 4; i++) v[j][i] = *(const float4*)(x + i * 256 + lane * 4);
  }
#pragma unroll
  for (int j = 0; j < 4; j++) {
    float ss = 0.f;
#pragma unroll
    for (int i = 0; i < 4; i++) ss += v[j][i].x * v[j][i].x + v[j][i].y * v[j][i].y + v[j][i].z * v[j][i].z + v[j][i].w * v[j][i].w;
    ss = wave_sum(ss);
    float rs = rsqrtf(ss * (1.f / 1024.f) + EPSF);
    u16* xn = (u16*)(p.ws + O_XN) + (size_t)(rowblk * 16 + w * 4 + j) * 1024;
#pragma unroll
    for (int i = 0; i < 4; i++) *(uint2*)(xn + i * 256 + lane * 4) = pack4(v[j][i].x * rs, v[j][i].y * rs, v[j][i].z * rs, v[j][i].w * rs);
  }
}

__device__ __forceinline__ void lru_item(char* smraw, const Params& p, int l, int item, int mode) {
  int tid = threadIdx.x; asm volatile("" : "+v"(tid)); const int _tid_pad = 0, lane = tid & 63, w = tid >> 6, fr = lane & 15, fq = lane >> 4;
  const int cki = item >> 2, head = item & 3;
  const int t0 = cki * 32;
  int lo, hi; seq_bounds(t0, lo, hi);
  float* xc = (float*)smraw;
  u16* xcb = (u16*)(smraw + 8192);
  float* sa = (float*)(smraw + 8192 + 4608);
  float* su = sa + 2 * 32 * 64;
  float* sx = su + 2 * 32 * 64;
  const u16* zA = (const u16*)(p.ws + O_ZA);
  LDS_BARRIER();
  {
    int ch = tid & 63, tq = tid >> 6;
    int gch = head * 64 + ch;
    const float* cw = p.in[4] + l * 4 * 256;
    float w0 = cw[gch], w1 = cw[256 + gch], w2 = cw[512 + gch], w3 = cw[768 + gch];
    float cb = p.in[5][l * 256 + gch];
    float win[11];
#pragma unroll
    for (int i = 0; i < 11; i++) {
      int tok = t0 + tq * 8 + i - 2;
      win[i] = (tok >= lo && tok < hi) ? bf2f(zA[(size_t)tok * 512 + gch]) : 0.f;
    }
#pragma unroll
    for (int i = 0; i < 8; i++) {
      float v = w0 * win[i] + w1 * win[i + 1] + w2 * win[i + 2] + w3 * win[i + 3] + cb;
      int tt = tq * 8 + i;
      xc[tt * 64 + ch] = v;
      xcb[tt * 72 + ch] = f2bf(v);
    }
  }
  LDS_BARRIER();
  {
    const int d = w >> 1, half = w & 1;
    const u16* wl = (const u16*)(p.ws + O_WLRU) + (size_t)head * 256 * 64;
    f32x4 accr[2][2], acci[2][2];
#pragma unroll
    for (int a = 0; a < 2; a++)
#pragma unroll
      for (int b = 0; b < 2; b++) { accr[a][b] = (f32x4){0, 0, 0, 0}; acci[a][b] = (f32x4){0, 0, 0, 0}; }
#pragma unroll
    for (int ks = 0; ks < 2; ks++) {
      bf16x8 af[2], br[2], bi[2];
#pragma unroll
      for (int mt = 0; mt < 2; mt++) af[mt] = *(const bf16x8*)(xcb + (16 * mt + fr) * 72 + ks * 32 + fq * 8);
#pragma unroll
      for (int nt = 0; nt < 2; nt++) {
        int nr = d * 128 + 32 * half + 16 * nt + fr;
        br[nt] = *(const bf16x8*)(wl + (size_t)nr * 64 + ks * 32 + fq * 8);
        bi[nt] = *(const bf16x8*)(wl + (size_t)(nr + 64) * 64 + ks * 32 + fq * 8);
      }
#pragma unroll
      for (int mt = 0; mt < 2; mt++)
#pragma unroll
        for (int nt = 0; nt < 2; nt++) {
          accr[mt][nt] = __builtin_amdgcn_mfma_f32_16x16x32_bf16(af[mt], br[nt], accr[mt][nt], 0, 0, 0);
          acci[mt][nt] = __builtin_amdgcn_mfma_f32_16x16x32_bf16(af[mt], bi[nt], acci[mt][nt], 0, 0, 0);
        }
    }
#pragma unroll
    for (int nt = 0; nt < 2; nt++) {
      int ch = 32 * half + 16 * nt + fr;
      int gch = head * 64 + ch;
      float brr = p.in[7][(l * 2 + d) * 256 + gch], bii = p.in[9][(l * 2 + d) * 256 + gch];
      float sp = softplusf_(-p.in[10][(l * 2 + d) * 256 + gch]);
#pragma unroll
      for (int mt = 0; mt < 2; mt++)
#pragma unroll
        for (int e = 0; e < 4; e++) {
          int tt = 16 * mt + 4 * fq + e;
          float r = 1.f / (1.f + __expf(-(accr[mt][nt][e] + brr)));
          float ig = 1.f / (1.f + __expf(-(acci[mt][nt][e] + bii)));
          float la = -8.f * r * sp;
          float a = __expf(la);
          float om = -la * (2.f + la * (2.f + la * (1.3333333f + la * (0.6666667f + la * 0.26666667f))));
          if (la < -0.25f) om = 1.f - a * a;
          float u = sqrtf(om) * (ig * xc[tt * 64 + ch]);
          sa[(d * 32 + tt) * 64 + ch] = a;
          su[(d * 32 + tt) * 64 + ch] = u;
        }
    }
  }
  LDS_BARRIER();
  {
    const int ch = tid & 63, d = (tid >> 6) & 1, half = tid >> 7;
    float A = 1.f, B = 0.f;
#pragma unroll
    for (int i = 0; i < 16; i++) {
      int tt = d == 0 ? half * 16 + i : half * 16 + 15 - i;
      float a = sa[(d * 32 + tt) * 64 + ch], u = su[(d * 32 + tt) * 64 + ch];
      A = a * A; B = a * B + u;
    }
    sx[((d * 2 + half) * 64 + ch) * 2] = A;
    sx[((d * 2 + half) * 64 + ch) * 2 + 1] = B;
  }
  LDS_BARRIER();
  if (mode == 0) {
    if (tid < 128) {
      int ch = tid & 63, d = tid >> 6;
      int first = d == 0 ? 0 : 1, second = 1 - first;
      float A1 = sx[((d * 2 + first) * 64 + ch) * 2], B1 = sx[((d * 2 + first) * 64 + ch) * 2 + 1];
      float A2 = sx[((d * 2 + second) * 64 + ch) * 2], B2 = sx[((d * 2 + second) * 64 + ch) * 2 + 1];
      float2 cr; cr.x = A2 * A1; cr.y = A2 * B1 + B2;
      ((float2*)(p.ws + O_LCAR))[((size_t)cki * 2 + d) * 256 + head * 64 + ch] = cr;
    }
    return;
  }
  {
    const int ch = tid & 63, d = (tid >> 6) & 1, half = tid >> 7;
    float h = ((const float*)(p.ws + O_LHIN))[((size_t)cki * 2 + d) * 256 + head * 64 + ch];
    int first = d == 0 ? 0 : 1;
    if (half != first) h = sx[((d * 2 + first) * 64 + ch) * 2] * h + sx[((d * 2 + first) * 64 + ch) * 2 + 1];
#pragma unroll
    for (int i = 0; i < 16; i++) {
      int tt = d == 0 ? half * 16 + i : half * 16 + 15 - i;
      float a = sa[(d * 32 + tt) * 64 + ch], u = su[(d * 32 + tt) * 64 + ch];
      h = a * h + u;
      su[(d * 32 + tt) * 64 + ch] = h;
    }
  }
  LDS_BARRIER();
  {
    int ch = tid & 63, tq = tid >> 6;
    u16* mixA = (u16*)(p.ws + O_XN);
#pragma unroll
    for (int i = 0; i < 8; i++) {
      int tt = tq * 8 + i, tok = t0 + tt;
      float hsum = su[tt * 64 + ch] + su[(32 + tt) * 64 + ch];
      float gate = bf2f(zA[(size_t)tok * 512 + 256 + head * 64 + ch]);
      mixA[(size_t)tok * 256 + head * 64 + ch] = f2bf(hsum * geluf_(gate));
    }
  }
}
__device__ __forceinline__ void lru_propagate(const Params& p, int idx) {
  int seq = idx >> 9, d = (idx >> 8) & 1, ch = idx & 255;
  int c0, nc;
  if (seq < 8) { c0 = seq * 64; nc = 64; } else { c0 = 512 + (seq - 8) * 128; nc = 128; }
  const float2* car = (const float2*)(p.ws + O_LCAR);
  float* hin = (float*)(p.ws + O_LHIN);
  float h = 0.f;
  for (int i = 0; i < nc; i++) {
    int ck = d == 0 ? c0 + i : c0 + nc - 1 - i;
    size_t o = ((size_t)ck * 2 + d) * 256 + ch;
    hin[o] = h;
    float2 ab = car[o];
    h = ab.x * h + ab.y;
  }
}
__device__ __forceinline__ void s5_propagate(const Params& p, int l, int idx) {
  int pp = idx & 63, d = (idx >> 6) & 1, g = (idx >> 7) & 15, seq = idx >> 11;
  int c0, nc;
  if (seq < 8) { c0 = seq * 32; nc = 32; } else { c0 = 256 + (seq - 8) * 64; nc = 64; }
  const float* ab64 = (const float*)(p.ws + O_AB64) + (size_t)l * 2 * 16 * 64 * 2;
  float ar = ab64[((d * 16 + g) * 64 + pp) * 2], ai = ab64[((d * 16 + g) * 64 + pp) * 2 + 1];
  const float* send = (const float*)(p.ws + O_SEND) + (size_t)g * 1280 * 256;
  u16* uh = (u16*)(p.ws + O_UH) + (size_t)g * 1280 * 1280;
  float hr = 0.f, hi = 0.f;
  for (int i = 0; i < nc; i++) {
    int ck = d == 0 ? c0 + i : c0 + nc - 1 - i;
    *(unsigned*)(uh + (size_t)ck * 1280 + 1024 + d * 128 + pp * 2) = f2bf(hr) | ((unsigned)f2bf(hi) << 16);
    float2 s = *(const float2*)(send + (size_t)ck * 256 + d * 128 + pp * 2);
    float nr = __fmaf_rn(ar, hr, __fmaf_rn(-ai, hi, s.x));
    float ni = __fmaf_rn(ar, hi, __fmaf_rn(ai, hr, s.y));
    asm volatile("" : "+v"(nr));
    asm volatile("" : "+v"(ni));
    hr = nr; hi = ni;
  }
}

#define AST 68
__device__ __forceinline__ void gdn_g1_item(char* smraw, const Params& p, int l, int item) {
  int tid = threadIdx.x; asm volatile("" : "+v"(tid)); const int _tid_pad = 0, lane = tid & 63, w = tid >> 6, fr = lane & 15, fq = lane >> 4;
  const int ck = item >> 2, h = item & 3;
  const int t0 = ck * 64;
  int lo, hi; seq_bounds(t0, lo, hi);
  u16* sk = (u16*)smraw;
  u16* sv = sk + 64 * 72;
  u16* Am = (u16*)(smraw + 2 * 64 * 72 * 2);
  float* sgc = (float*)(Am + 2 * 64 * 72);
  float* sbeta = sgc + 128;
  u16* Xs = (u16*)(sbeta + 128);
  const u16* zC = (const u16*)(p.ws + O_ZC);
  const float* ba = (const float*)(p.ws + O_BA);
  u16* qg = (u16*)(p.ws + O_XN);
  u16* kg = qg + (size_t)T_ALL * 256;
  u16* vg = kg + (size_t)T_ALL * 256;
  LDS_BARRIER();
  {
    const float* cw = p.in[21] + (size_t)l * 4 * 768;
    float wq[4], wk[4], wv[4];
#pragma unroll
    for (int j = 0; j < 4; j++) {
      wq[j] = cw[j * 768 + h * 64 + lane];
      wk[j] = cw[j * 768 + 256 + h * 64 + lane];
      wv[j] = cw[j * 768 + 512 + h * 64 + lane];
    }
#pragma unroll 4
    for (int rr = 0; rr < 16; rr++) {
      int c = w * 16 + rr, tok = t0 + c;
      float q = 0.f, k = 0.f, v = 0.f;
#pragma unroll
      for (int j = 0; j < 4; j++) {
        int tk = tok + j - 2;
        if (tk >= lo && tk < hi) {
          const u16* zr = zC + (size_t)tk * 1024 + h * 64 + lane;
          q += wq[j] * bf2f(zr[0]); k += wk[j] * bf2f(zr[256]); v += wv[j] * bf2f(zr[512]);
        }
      }
      q = siluf_(q); k = siluf_(k); v = siluf_(v);
      float sq = wave_sum(q * q), skk = wave_sum(k * k);
      q = q * rsqrtf(sq + EPSF) * 0.125f;
      k = k * rsqrtf(skk + EPSF);
      u16 kb = f2bf(k), vb = f2bf(v);
      sk[c * 72 + lane] = kb; sv[c * 72 + lane] = vb;
      qg[(size_t)tok * 256 + h * 64 + lane] = f2bf(q);
      kg[(size_t)tok * 256 + h * 64 + lane] = kb;
      vg[(size_t)tok * 256 + h * 64 + lane] = vb;
    }
  }
  if (tid < 128) {
    int d = tid >> 6, c = tid & 63;
    int tok = d == 0 ? t0 + c : t0 + 63 - c;
    float alog = p.in[22][(l * 2 + d) * 4 + h], dtb = p.in[23][(l * 2 + d) * 4 + h];
    float g = -__expf(alog) * softplusf_(ba[(size_t)tok * 16 + 8 + d * 4 + h] + dtb);
    float beta = 1.f / (1.f + __expf(-ba[(size_t)tok * 16 + d * 4 + h]));
    float s = g;
#pragma unroll
    for (int o = 1; o < 64; o <<= 1) { float t = __shfl_up(s, o); if (c >= o) s += t; }
    sgc[d * 64 + c] = s; sbeta[d * 64 + c] = beta;
    ((float*)(p.ws + O_GC))[(size_t)(h * 2 + d) * T_ALL + tok] = s;
  }
  LDS_BARRIER();
  {
    f32x4 acc[4];
#pragma unroll
    for (int nt = 0; nt < 4; nt++) acc[nt] = (f32x4){0, 0, 0, 0};
#pragma unroll
    for (int ks = 0; ks < 2; ks++) {
      bf16x8 af = *(const bf16x8*)(sk + (16 * w + fr) * 72 + ks * 32 + fq * 8);
#pragma unroll
      for (int nt = 0; nt < 4; nt++) {
        bf16x8 bfm = *(const bf16x8*)(sk + (16 * nt + fr) * 72 + ks * 32 + fq * 8);
        acc[nt] = __builtin_amdgcn_mfma_f32_16x16x32_bf16(af, bfm, acc[nt], 0, 0, 0);
      }
    }
#pragma unroll
    for (int nt = 0; nt < 4; nt++)
#pragma unroll
      for (int e = 0; e < 4; e++) {
        int c = 16 * w + 4 * fq + e, m = 16 * nt + fr;
        float gm = acc[nt][e];
        float a0 = c > m ? sbeta[c] * gm * __expf(sgc[c] - sgc[m]) : 0.f;
        Am[m * 72 + c] = f2bf(a0);
        int c1 = 63 - c, m1 = 63 - m;
        float a1 = c1 > m1 ? sbeta[64 + c1] * gm * __expf(sgc[64 + c1] - sgc[64 + m1]) : 0.f;
        Am[64 * 72 + m1 * 72 + c1] = f2bf(a1);
      }
  }
  LDS_BARRIER();
  {
    const int d = tid >> 7, col = tid & 127;
    const u16* AT = Am + d * 64 * 72;
    u16* Xd = Xs + d * 48 * 128;
    const u16* src = col < 64 ? sk : sv;
    const int e = col & 63;
    u16* wu = (u16*)(p.ws + O_WU) + ((size_t)(ck * 4 + h) * 2 + d) * 8192 + (col < 64 ? 0 : 4096);
#pragma unroll 1
    for (int b = 0; b < 4; b++) {
      float s[16];
#pragma unroll
      for (int r = 0; r < 16; r++) {
        int i = 16 * b + r;
        int tokr = d == 0 ? i : 63 - i;
        float rv = bf2f(src[tokr * 72 + e]) * sbeta[d * 64 + i];
        if (col < 64) rv *= __expf(sgc[d * 64 + i]);
        s[r] = rv;
      }
#pragma unroll 4
      for (int j = 0; j < 16 * b; j++) {
        float xj = bf2f(Xd[j * 128 + col]);
        const uint4* ar = (const uint4*)(AT + j * 72 + 16 * b);
        uint4 a0 = ar[0], a1 = ar[1];
        unsigned aw[8] = {a0.x, a0.y, a0.z, a0.w, a1.x, a1.y, a1.z, a1.w};
#pragma unroll
        for (int q = 0; q < 8; q++) {
          s[2 * q] -= __uint_as_float(aw[q] << 16) * xj;
          s[2 * q + 1] -= __uint_as_float(aw[q] & 0xffff0000u) * xj;
        }
      }
#pragma unroll
      for (int rp = 0; rp < 16; rp++) {
        u16 xb = f2bf(s[rp]);
        float xj = bf2f(xb);
        wu[(16 * b + rp) * 64 + e] = xb;
        if (b < 3) Xd[(16 * b + rp) * 128 + col] = xb;
        const uint4* ar = (const uint4*)(AT + (16 * b + rp) * 72 + 16 * b);
        uint4 a0 = ar[0], a1 = ar[1];
        unsigned aw[8] = {a0.x, a0.y, a0.z, a0.w, a1.x, a1.y, a1.z, a1.w};
#pragma unroll
        for (int r = rp + 1; r < 16; r++) {
          float av = (r & 1) ? __uint_as_float(aw[r >> 1] & 0xffff0000u) : __uint_as_float(aw[r >> 1] << 16);
          s[r] -= av * xj;
        }
      }
    }
  }
}

__device__ __forceinline__ void gdn_chain(char* smraw, const Params& p, int chain) {
  int tid = threadIdx.x; asm volatile("" : "+v"(tid)); const int _tid_pad = 0, lane = tid & 63, w = tid >> 6, fr = lane & 15, fq = lane >> 4;
  const int d = chain & 1, h = (chain >> 1) & 3, seq = chain >> 3;
  int c0, nc;
  if (seq < 8) { c0 = seq * 32; nc = 32; } else { c0 = 256 + (seq - 8) * 64; nc = 64; }
  u16* qs = (u16*)smraw;
  u16* qd = qs + 64 * 72;
  u16* ks_ = qd + 64 * 72;
  u16* kdT = ks_ + 64 * 72;
  u16* at = kdT + 64 * 72;
  u16* ST = at + 64 * 72;
  u16* VT = ST + 4 * 16 * 72;
  float* sgc = (float*)(VT + 4 * 16 * 72);
  const u16* qg = (const u16*)(p.ws + O_XN);
  const u16* kg = qg + (size_t)T_ALL * 256;
  const float* gcg = (const float*)(p.ws + O_GC);
  u16* og = (u16*)(p.ws + O_OD) + (size_t)d * T_ALL * 256;
  u16* STw = ST + w * 16 * 72;
  u16* VTw = VT + w * 16 * 72;
  f32x4 accS[4];
#pragma unroll
  for (int mt = 0; mt < 4; mt++) accS[mt] = (f32x4){0, 0, 0, 0};
  LDS_BARRIER();
  for (int e = lane; e < 16 * 72; e += 64) STw[e] = 0;
  const int prow = tid >> 2, pseg = tid & 3;
  float gcv_n, gl_n; uint4 q0n, q1n, k0n, k1n;
#define CHAIN_PREFETCH(IT) do {                                                                   \
    const int ck_ = d == 0 ? c0 + (IT) : c0 + nc - 1 - (IT);                                       \
    const int t0_ = ck_ * 64;                                                                      \
    const int tok_ = d == 0 ? t0_ + prow : t0_ + 63 - prow;                                        \
    gl_n = gcg[(size_t)(h * 2 + d) * T_ALL + (d == 0 ? t0_ + 63 : t0_)];                          \
    gcv_n = gcg[(size_t)(h * 2 + d) * T_ALL + tok_];                                               \
    const u16* qr_ = qg + (size_t)tok_ * 256 + h * 64 + pseg * 16;                                 \
    const u16* kr_ = kg + (size_t)tok_ * 256 + h * 64 + pseg * 16;                                 \
    q0n = *(const uint4*)qr_; q1n = *(const uint4*)(qr_ + 8);                                      \
    k0n = *(const uint4*)kr_; k1n = *(const uint4*)(kr_ + 8); } while (0)
  CHAIN_PREFETCH(0);
#pragma unroll 1
  for (int it = 0; it < nc; it++) {
    const int ck = d == 0 ? c0 + it : c0 + nc - 1 - it;
    const int t0 = ck * 64;
    const u16* wch = (const u16*)(p.ws + O_WU) + ((size_t)(ck * 4 + h) * 2 + d) * 8192;
    const u16* uch = wch + 4096;
    const float gl = gl_n;
    bf16x8 awr[4][2];
    u16 uvr[4][4];
#pragma unroll
    for (int mt = 0; mt < 4; mt++) {
#pragma unroll
      for (int ks = 0; ks < 2; ks++) awr[mt][ks] = *(const bf16x8*)(wch + (16 * mt + fr) * 64 + ks * 32 + fq * 8);
#pragma unroll
      for (int e = 0; e < 4; e++) uvr[mt][e] = uch[(16 * mt + 4 * fq + e) * 64 + 16 * w + fr];
    }
    {
      const int row = prow, seg = pseg;
      const float gcv = gcv_n;
      if (seg == 0) sgc[row] = gcv;
      float eq = __expf(gcv), ek = __expf(gl - gcv);
      const uint4 q0 = q0n, q1 = q1n, k0 = k0n, k1 = k1n;
      if (it + 1 < nc) CHAIN_PREFETCH(it + 1);
      *(uint4*)(qs + row * 72 + seg * 16) = q0; *(uint4*)(qs + row * 72 + seg * 16 + 8) = q1;
      *(uint4*)(ks_ + row * 72 + seg * 16) = k0; *(uint4*)(ks_ + row * 72 + seg * 16 + 8) = k1;
      unsigned qa[8] = {q0.x, q0.y, q0.z, q0.w, q1.x, q1.y, q1.z, q1.w};
      unsigned ka[8] = {k0.x, k0.y, k0.z, k0.w, k1.x, k1.y, k1.z, k1.w};
#pragma unroll
      for (int i = 0; i < 8; i++) {
        float qa0 = bf2f((u16)(qa[i] & 0xffff)) * eq, qa1 = bf2f((u16)(qa[i] >> 16)) * eq;
        *(unsigned*)(qd + row * 72 + seg * 16 + 2 * i) = f2bf(qa0) | ((unsigned)f2bf(qa1) << 16);
        float kb0 = bf2f((u16)(ka[i] & 0xffff)) * ek, kb1 = bf2f((u16)(ka[i] >> 16)) * ek;
        kdT[(seg * 16 + 2 * i) * 72 + row] = f2bf(kb0);
        kdT[(seg * 16 + 2 * i + 1) * 72 + row] = f2bf(kb1);
      }
    }
    LDS_BARRIER();
    {
      f32x4 acc[4];
#pragma unroll
      for (int nt = 0; nt < 4; nt++) acc[nt] = (f32x4){0, 0, 0, 0};
#pragma unroll
      for (int ks = 0; ks < 2; ks++) {
        bf16x8 af = *(const bf16x8*)(qs + (16 * w + fr) * 72 + ks * 32 + fq * 8);
#pragma unroll
        for (int nt = 0; nt < 4; nt++) {
          bf16x8 bfm = *(const bf16x8*)(ks_ + (16 * nt + fr) * 72 + ks * 32 + fq * 8);
          acc[nt] = __builtin_amdgcn_mfma_f32_16x16x32_bf16(af, bfm, acc[nt], 0, 0, 0);
        }
      }
#pragma unroll
      for (int nt = 0; nt < 4; nt++)
#pragma unroll
        for (int e = 0; e < 4; e++) {
          int c = 16 * w + 4 * fq + e, m = 16 * nt + fr;
          float v = c >= m ? acc[nt][e] * __expf(sgc[c] - sgc[m]) : 0.f;
          at[c * 72 + m] = f2bf(v);
        }
    }
    LDS_BARRIER();
    {
      const int e0 = 16 * w;
      f32x4 av[4];
#pragma unroll
      for (int mt = 0; mt < 4; mt++) av[mt] = (f32x4){0, 0, 0, 0};
#pragma unroll
      for (int ks = 0; ks < 2; ks++) {
        bf16x8 bS = *(const bf16x8*)(STw + fr * 72 + ks * 32 + fq * 8);
#pragma unroll
        for (int mt = 0; mt < 4; mt++) {
          av[mt] = __builtin_amdgcn_mfma_f32_16x16x32_bf16(awr[mt][ks], bS, av[mt], 0, 0, 0);
        }
      }
#pragma unroll
      for (int mt = 0; mt < 4; mt++) {
        u16 hv[4];
#pragma unroll
        for (int e = 0; e < 4; e++) {
          int c = 16 * mt + 4 * fq + e;
          float vn = bf2f(uvr[mt][e]) - av[mt][e];
          hv[e] = f2bf(vn);
        }
        uint2 pk; pk.x = hv[0] | ((unsigned)hv[1] << 16); pk.y = hv[2] | ((unsigned)hv[3] << 16);
        *(uint2*)(VTw + fr * 72 + 16 * mt + 4 * fq) = pk;
      }
      __builtin_amdgcn_wave_barrier();
      f32x4 ao[4];
#pragma unroll
      for (int mt = 0; mt < 4; mt++) ao[mt] = (f32x4){0, 0, 0, 0};
#pragma unroll
      for (int ks = 0; ks < 2; ks++) {
        bf16x8 bS = *(const bf16x8*)(STw + fr * 72 + ks * 32 + fq * 8);
        bf16x8 bV = *(const bf16x8*)(VTw + fr * 72 + ks * 32 + fq * 8);
#pragma unroll
        for (int mt = 0; mt < 4; mt++) {
          bf16x8 aq = *(const bf16x8*)(qd + (16 * mt + fr) * 72 + ks * 32 + fq * 8);
          bf16x8 aa = *(const bf16x8*)(at + (16 * mt + fr) * 72 + ks * 32 + fq * 8);
          ao[mt] = __builtin_amdgcn_mfma_f32_16x16x32_bf16(aq, bS, ao[mt], 0, 0, 0);
          ao[mt] = __builtin_amdgcn_mfma_f32_16x16x32_bf16(aa, bV, ao[mt], 0, 0, 0);
        }
      }
#pragma unroll
      for (int mt = 0; mt < 4; mt++)
#pragma unroll
        for (int e = 0; e < 4; e++) {
          int c = 16 * mt + 4 * fq + e;
          int tok = d == 0 ? t0 + c : t0 + 63 - c;
          og[(size_t)tok * 256 + h * 64 + e0 + fr] = f2bf(ao[mt][e]);
        }
      float egl = __expf(gl);
#pragma unroll
      for (int mt = 0; mt < 4; mt++) accS[mt] = accS[mt] * egl;
#pragma unroll
      for (int ks = 0; ks < 2; ks++) {
        bf16x8 bV = *(const bf16x8*)(VTw + fr * 72 + ks * 32 + fq * 8);
#pragma unroll
        for (int mt = 0; mt < 4; mt++) {
          bf16x8 ak = *(const bf16x8*)(kdT + (16 * mt + fr) * 72 + ks * 32 + fq * 8);
          accS[mt] = __builtin_amdgcn_mfma_f32_16x16x32_bf16(ak, bV, accS[mt], 0, 0, 0);
        }
      }
      __builtin_amdgcn_wave_barrier();
#pragma unroll
      for (int mt = 0; mt < 4; mt++) {
        uint2 pk;
        pk.x = f2bf(accS[mt][0]) | ((unsigned)f2bf(accS[mt][1]) << 16);
        pk.y = f2bf(accS[mt][2]) | ((unsigned)f2bf(accS[mt][3]) << 16);
        *(uint2*)(STw + fr * 72 + 16 * mt + 4 * fq) = pk;
      }
    }
    LDS_BARRIER();
  }
}
__device__ __forceinline__ void gdn_final_rows(const Params& p, int l, int rowblk) {
  int tid_ = threadIdx.x; asm volatile("" : "+v"(tid_));
  const int lane = tid_ & 63, w = tid_ >> 6;
  const int tok0 = rowblk * 16 + w * 4;
  const u16* o0 = (const u16*)(p.ws + O_OD) + (size_t)tok0 * 256 + lane * 4;
  const u16* o1 = o0 + (size_t)T_ALL * 256;
  const u16* zg = (const u16*)(p.ws + O_ZC) + (size_t)tok0 * 1024 + 768 + lane * 4;
  uint2 a[4], b[4], g[4];
#pragma unroll
  for (int j = 0; j < 4; j++) { a[j] = *(const uint2*)(o0 + j * 256); b[j] = *(const uint2*)(o1 + j * 256); g[j] = *(const uint2*)(zg + j * 1024); }
  const float* nw = p.in[24] + l * 64 + (lane & 15) * 4;
  const float n0 = nw[0], n1 = nw[1], n2 = nw[2], n3 = nw[3];
  u16* dst = (u16*)(p.ws + O_XN) + (size_t)2 * T_ALL * 256 + (size_t)tok0 * 256 + lane * 4;
#pragma unroll
  for (int j = 0; j < 4; j++) {
    float o[4], gt[4];
    o[0] = bf2f(a[j].x & 0xffff) + bf2f(b[j].x & 0xffff); o[1] = bf2f(a[j].x >> 16) + bf2f(b[j].x >> 16);
    o[2] = bf2f(a[j].y & 0xffff) + bf2f(b[j].y & 0xffff); o[3] = bf2f(a[j].y >> 16) + bf2f(b[j].y >> 16);
    gt[0] = bf2f(g[j].x & 0xffff); gt[1] = bf2f(g[j].x >> 16); gt[2] = bf2f(g[j].y & 0xffff); gt[3] = bf2f(g[j].y >> 16);
    float ss = o[0] * o[0] + o[1] * o[1] + o[2] * o[2] + o[3] * o[3];
#pragma unroll
    for (int m = 8; m > 0; m >>= 1) ss += __shfl_xor(ss, m);
    float rs = rsqrtf(ss * (1.f / 64.f) + EPSF);
    if (!(MIXMASK & 4)) rs = 0.f;
    *(uint2*)(dst + j * 256) = pack4(o[0] * rs * n0 * siluf_(gt[0]), o[1] * rs * n1 * siluf_(gt[1]), o[2] * rs * n2 * siluf_(gt[2]), o[3] * rs * n3 * siluf_(gt[3]));
  }
}
__device__ __forceinline__ void grpnorm_rows(const Params& p, int l, int which, int rowblk) {
  int tid_ = threadIdx.x; asm volatile("" : "+v"(tid_));
  const int lane = tid_ & 63, w = tid_ >> 6;
  u16* m0 = (u16*)(p.ws + O_XN) + (size_t)which * T_ALL * 256 + (size_t)(rowblk * 16 + w * 4) * 256 + lane * 4;
  uint2 a[4];
#pragma unroll
  for (int j = 0; j < 4; j++) a[j] = *(const uint2*)(m0 + j * 256);
  const float* gn = p.in[34] + (l * 3 + which) * 256 + lane * 4;
  const float g0 = gn[0], g1 = gn[1], g2 = gn[2], g3 = gn[3];
#pragma unroll
  for (int j = 0; j < 4; j++) {
    float v[4] = {bf2f(a[j].x & 0xffff), bf2f(a[j].x >> 16), bf2f(a[j].y & 0xffff), bf2f(a[j].y >> 16)};
    float ss = wave_sum(v[0] * v[0] + v[1] * v[1] + v[2] * v[2] + v[3] * v[3]);
    float rs = rsqrtf(ss * (1.f / 256.f) + EPSF);
    if (!((MIXMASK >> which) & 1)) rs = 0.f;
    *(uint2*)(m0 + j * 256) = pack4(v[0] * rs * g0, v[1] * rs * g1, v[2] * rs * g2, v[3] * rs * g3);
  }
}

#define WST 1296
#define UST 264
__device__ __forceinline__ float hy_conv3(const u16* __restrict__ raw, int t, int L, float w0, float w1, float w2, float b) {
  float xm = t > 0 ? bf2f(raw[t - 1]) : 0.f;
  float x0 = bf2f(raw[t]);
  float xp = t + 1 < L ? bf2f(raw[t + 1]) : 0.f;
  return w0 * xm + w1 * x0 + w2 * xp + b;
}
__device__ __forceinline__ void hy_conv_item(char* smraw, const Params& p, int l, int stage, int set, int c, int tb) {
  int tid = threadIdx.x; asm volatile("" : "+v"(tid)); const int _tid_pad = 0, lane = tid & 63, w = tid >> 6, fr = lane & 15, fq = lane >> 4;
  const int L = 2048 << set, nb = 8 << set, base = set ? T_P : 0;
  const int T0 = tb * 1024;
  u16* win = (u16*)smraw;
  u16* su = win + 8 * WST;
  float* sinv = (float*)(su + 16 * UST);
  const u16* dt = (const u16*)(p.ws + O_DT);
  const u16* rawv = dt + (size_t)c * T_ALL + base;
  const u16* rawx = dt + (size_t)((stage + 1) * 256 + c) * T_ALL + base;
  const u16* y1 = (const u16*)(p.ws + O_Y1) + (size_t)c * T_ALL + base;
  u16* outp = stage == 0 ? (u16*)(p.ws + O_Y1) + (size_t)c * T_ALL + base
                         : (u16*)(p.ws + O_DT) + (size_t)(256 + c) * T_ALL + base;
  const u16* kr = (const u16*)(p.ws + O_HYKR) + (set ? HYKR1 : 0) + ((size_t)stage * 256 + c) * (2 * L);
  const float* cw = p.in[25] + (size_t)l * 3 * 768;
  const float* cb = p.in[26] + (size_t)l * 768;
  const float v0 = cw[c], v1 = cw[768 + c], v2 = cw[1536 + c], vb = cb[c];
  const int xc_ = (stage + 1) * 256 + c;
  const float x0w = cw[xc_], x1w = cw[768 + xc_], x2w = cw[1536 + xc_], xbw = cb[xc_];
  LDS_BARRIER();
  if (tid < 64) {
    const float* ps = (const float*)(p.ws + O_HYPS) + (size_t)(set ? 32 * 512 : 0);
    int ntb = L / 64;
    float s = 0.f;
    for (int i = lane; i < ntb; i += 64) s += ps[(size_t)i * 512 + stage * 256 + c];
    s = wave_sum(s);
    if (lane == 0) sinv[0] = 1.f / s;
  }
  f32x4 acc[16];
#pragma unroll
  for (int i = 0; i < 16; i++) acc[i] = (f32x4){0, 0, 0, 0};
  for (int S0 = 0; S0 < L; S0 += 256) {
    LDS_BARRIER();
    const int B0 = S0 - T0;
    for (int idx = tid; idx < 8 * 160; idx += 256) {
      int rho = idx / 160, gi = idx % 160;
      int ybase = B0 - 1016 + 8 * gi - rho + L;
      int a = ybase & ~1;
      uint4 pk;
      if (a >= 0 && a + 10 <= 2 * L) {
        const unsigned* kd = (const unsigned*)(kr + a);
        unsigned d0 = kd[0], d1 = kd[1], d2 = kd[2], d3 = kd[3], d4 = kd[4];
        if (ybase & 1) {
          pk.x = __builtin_amdgcn_alignbit(d1, d0, 16); pk.y = __builtin_amdgcn_alignbit(d2, d1, 16);
          pk.z = __builtin_amdgcn_alignbit(d3, d2, 16); pk.w = __builtin_amdgcn_alignbit(d4, d3, 16);
        } else { pk.x = d0; pk.y = d1; pk.z = d2; pk.w = d3; }
      } else {
        u16 hh[8];
#pragma unroll
        for (int e = 0; e < 8; e++) { int yy = ybase + e; hh[e] = (yy >= 0 && yy < 2 * L) ? kr[yy] : (u16)0; }
        pk.x = hh[0] | ((unsigned)hh[1] << 16); pk.y = hh[2] | ((unsigned)hh[3] << 16);
        pk.z = hh[4] | ((unsigned)hh[5] << 16); pk.w = hh[6] | ((unsigned)hh[7] << 16);
      }
      *(uint4*)(win + rho * WST + 8 * gi) = pk;
    }
    {
      int b = tid >> 4, seg = tid & 15;
      uint4 p0 = make_uint4(0, 0, 0, 0), p1 = make_uint4(0, 0, 0, 0);
      if (b < nb) {
        const u16* src = (stage == 0 ? rawv : y1) + (size_t)b * L;
        const int s0 = S0 + seg * 16;
        uint4 r0 = *(const uint4*)(src + s0), r1 = *(const uint4*)(src + s0 + 8);
        if (stage == 0) {
          unsigned w[8] = {r0.x, r0.y, r0.z, r0.w, r1.x, r1.y, r1.z, r1.w};
          float x[18];
          x[0] = s0 > 0 ? bf2f(src[s0 - 1]) : 0.f;
          x[17] = s0 + 16 < L ? bf2f(src[s0 + 16]) : 0.f;
#pragma unroll
          for (int q = 0; q < 8; q++) { x[1 + 2 * q] = __uint_as_float(w[q] << 16); x[2 + 2 * q] = __uint_as_float(w[q] & 0xffff0000u); }
          unsigned o[8];
#pragma unroll
          for (int q = 0; q < 8; q++) {
            float c0 = v0 * x[2 * q] + v1 * x[2 * q + 1] + v2 * x[2 * q + 2] + vb;
            float c1 = v0 * x[2 * q + 1] + v1 * x[2 * q + 2] + v2 * x[2 * q + 3] + vb;
            o[q] = f2bf(c0) | ((unsigned)f2bf(c1) << 16);
          }
          p0 = make_uint4(o[0], o[1], o[2], o[3]); p1 = make_uint4(o[4], o[5], o[6], o[7]);
        } else { p0 = r0; p1 = r1; }
      }
      *(uint4*)(su + b * UST + seg * 16) = p0;
      *(uint4*)(su + b * UST + seg * 16 + 8) = p1;
    }
    LDS_BARRIER();
    bf16x8 bfr[8];
#pragma unroll
    for (int j = 0; j < 8; j++) bfr[j] = *(const bf16x8*)(su + fr * UST + 32 * j + 8 * fq);
    const u16* wbase = win + (fr & 7) * WST + (8 * fq - 256 * w - 8 * (fr >> 3) + 1016);
#pragma unroll
    for (int dd = 0; dd < 30; dd++) {
      bf16x8 af = *(const bf16x8*)(wbase + 16 * (dd - 15));
#pragma unroll
      for (int j = 0; j < 8; j++) {
        const int i = 2 * j - (dd - 15);
        if (i >= 0 && i < 16) acc[i] = __builtin_amdgcn_mfma_f32_16x16x32_bf16(af, bfr[j], acc[i], 0, 0, 0);
      }
    }
  }
  LDS_BARRIER();
  const float inv = sinv[0];
  const float bias = p.in[33][(size_t)(l * 2 + stage) * 256 + c];
  if (fr < nb) {
#pragma unroll
    for (int i = 0; i < 16; i++) {
      u16 r[4];
#pragma unroll
      for (int e = 0; e < 4; e++) {
        int t = T0 + 256 * w + 16 * i + 4 * fq + e;
        float uval = stage == 0 ? hy_conv3(rawv + (size_t)fr * L, t, L, v0, v1, v2, vb) : bf2f(y1[(size_t)fr * L + t]);
        float xg = hy_conv3(rawx + (size_t)fr * L, t, L, x0w, x1w, x2w, xbw);
        r[e] = f2bf(xg * (acc[i][e] * inv + bias * uval));
      }
      uint2 pk; pk.x = r[0] | ((unsigned)r[1] << 16); pk.y = r[2] | ((unsigned)r[3] << 16);
      *(uint2*)(outp + (size_t)fr * L + T0 + 256 * w + 16 * i + 4 * fq) = pk;
    }
  }
}
__device__ __forceinline__ void hy_final_item(char* smraw, const Params& p, int l, int ck) {
  int tid = threadIdx.x; asm volatile("" : "+v"(tid)); const int _tid_pad = 0, lane = tid & 63, w = tid >> 6;
  float* s = (float*)smraw;
  const u16* yd = (const u16*)(p.ws + O_DT) + (size_t)256 * T_ALL;
  const int t0 = ck * 64;
  LDS_BARRIER();
#pragma unroll 16
  for (int i = 0; i < 64; i++) {
    int c = w * 64 + i;
    s[lane * 257 + c] = bf2f(yd[(size_t)c * T_ALL + t0 + lane]);
  }
  LDS_BARRIER();
  const float* gn = p.in[34] + (l * 3 + 2) * 256;
  u16* mixD = (u16*)(p.ws + O_XN) + (size_t)3 * T_ALL * 256;
  for (int i = 0; i < 16; i++) {
    int tt = w * 16 + i;
    float v[4];
#pragma unroll
    for (int e = 0; e < 4; e++) v[e] = s[tt * 257 + lane * 4 + e];
    float ss = wave_sum(v[0] * v[0] + v[1] * v[1] + v[2] * v[2] + v[3] * v[3]);
    float rs = rsqrtf(ss * (1.f / 256.f) + EPSF);
    if (!(MIXMASK & 8)) rs = 0.f;
    uint2 pk;
    pk.x = f2bf(v[0] * rs * gn[lane * 4]) | ((unsigned)f2bf(v[1] * rs * gn[lane * 4 + 1]) << 16);
    pk.y = f2bf(v[2] * rs * gn[lane * 4 + 2]) | ((unsigned)f2bf(v[3] * rs * gn[lane * 4 + 3]) << 16);
    *(uint2*)(mixD + (size_t)(t0 + tt) * 256 + lane * 4) = pk;
  }
}

#define XB_CENS(j) (64 + 64 * (j))
#define XB_XSUB(j) (1088 + 64 * (j))
#define XB_XGEN(j) (2112 + 64 * (j))
#define XB_TOP 3136
#define XB_TOPGEN 3200
__device__ __forceinline__ unsigned xb_ld(unsigned* p) { return __hip_atomic_load(p, __ATOMIC_RELAXED, __HIP_MEMORY_SCOPE_AGENT); }
__device__ __forceinline__ unsigned xb_add(unsigned* p, unsigned v) { return __hip_atomic_fetch_add(p, v, __ATOMIC_RELAXED, __HIP_MEMORY_SCOPE_AGENT); }
__device__ __forceinline__ void xcd_barrier(unsigned* bar, unsigned x, unsigned nloc, unsigned nx, unsigned k) {
  asm volatile("s_waitcnt vmcnt(0) lgkmcnt(0)" ::: "memory");
  __syncthreads();
  if (threadIdx.x == 0) {
    const unsigned old = xb_add(&bar[XB_XSUB(x)], 1u);
    if (old + 1u == k * nloc) {
      __builtin_amdgcn_fence(__ATOMIC_RELEASE, "agent");
      asm volatile("s_waitcnt vmcnt(0)" ::: "memory");
      const unsigned og = xb_add(&bar[XB_TOP], 1u);
      if (og + 1u == k * nx) xb_add(&bar[XB_TOPGEN], 1u);
      else while (xb_ld(&bar[XB_TOPGEN]) < k) __builtin_amdgcn_s_sleep(1);
      __builtin_amdgcn_fence(__ATOMIC_ACQUIRE, "agent");
      xb_add(&bar[XB_XGEN(x)], 1u);
      asm volatile("s_waitcnt vmcnt(0)" ::: "memory");
    } else {
      while (xb_ld(&bar[XB_XGEN(x)]) < k) __builtin_amdgcn_s_sleep(1);
      __builtin_amdgcn_fence(__ATOMIC_ACQUIRE, "agent");
      asm volatile("s_waitcnt vmcnt(0)" ::: "memory");
    }
  }
  __syncthreads();
}
#define GRID_SYNC() do { ++bar_k; xcd_barrier(bar, bst[0], bst[1], bst[2], bar_k); } while (0)

#define TILE_LOOP(nM_, nN_, MT, NT)                                                                  \
  const int nSN_ = ((nN_) + 7) >> 3, nS_ = (((nM_) + 7) >> 3) * nSN_, P_ = nblk >> 3;                 \
  _Pragma("unroll 1") for (int S_ = (bid & 7); S_ < nS_ && (bid >> 3) < P_; S_ += 8)                 \
  _Pragma("unroll 1") for (int q_ = (bid >> 3); q_ < 64; q_ += P_)                                   \
    for (int MT = (S_ / nSN_) * 8 + (q_ >> 3), NT = (S_ % nSN_) * 8 + (q_ & 7), once_ = 1; once_ && MT < (nM_) && NT < (nN_); once_ = 0)

__global__ void __launch_bounds__(256, 2) mega(Params p) {
  cg::grid_group grid = cg::this_grid();
  __shared__ __attribute__((aligned(16))) char smraw[SMEM_BYTES];
  u16* smem = (u16*)smraw;
  float* smf = (float*)smraw;
  const int bid = blockIdx.x, nblk = gridDim.x, tid = threadIdx.x;
  const int rbid = nblk - 1 - bid;
  const int lane = tid & 63;
  char* const ws = p.ws;
  unsigned* const bar = (unsigned*)(ws + O_BAR);
  __shared__ unsigned bst[4];
  unsigned bar_k = 0;
  if (tid == 0) { bst[0] = (unsigned)__builtin_amdgcn_s_getreg((3 << 11) | 20) & 0xFu; xb_add(&bar[XB_CENS(bst[0])], 1u); }
  __threadfence();
  grid.sync();
  if (tid == 0) {
    unsigned mine = 0, cnt = 0;
    for (unsigned j = 0; j < 16; j++) { unsigned c = xb_ld(&bar[XB_CENS(j)]); cnt += c > 0u ? 1u : 0u; if (j == bst[0]) mine = c; }
    bst[1] = mine; bst[2] = cnt;
  }
  __syncthreads();

#ifdef NANFILL
  {
    uint4 nanv = make_uint4(0x7FC07FC0u, 0x7FC07FC0u, 0x7FC07FC0u, 0x7FC07FC0u);
    uint4* w4 = (uint4*)ws;
    for (size_t i = (size_t)bid * 256 + tid; i < WS_TOTAL / 16; i += (size_t)nblk * 256) w4[i] = nanv;
    uint4* o4 = (uint4*)p.out;
    for (size_t i = (size_t)bid * 256 + tid; i < (size_t)T_ALL * DM / 4; i += (size_t)nblk * 256) o4[i] = nanv;
    __threadfence(); grid.sync(); __threadfence();
  }
#endif
#pragma unroll 1
  for (int lay = 0; lay < 2; lay++) {
    {
      int l = lay; asm volatile("" : "+s"(l));
#pragma unroll 1
      for (int i = bid; i < 42 * 16; i += nblk) transpose_tile(smf, p.in[3] + (size_t)l * 1024 * 2576, 2576, p.in[2] + l * 1024, (u16*)(ws + O_WIN), 1024, 0, (i / 16) * 64, (i % 16) * 64);
#pragma unroll 1
      for (int i = rbid; i < 16 * 16; i += nblk) transpose_tile(smf, p.in[35] + (size_t)l * 1024 * 1024, 1024, nullptr, (u16*)(ws + O_WOUT), 1024, 1, (i / 16) * 64, (i % 16) * 64);
#pragma unroll 1
      for (int i = bid; i < 88 * 16; i += nblk) transpose_tile(smf, p.in[37] + (size_t)l * 1024 * 5632, 5632, p.in[36] + l * 1024, (u16*)(ws + O_WUP), 1024, 2, (i / 16) * 64, (i % 16) * 64);
#pragma unroll 1
      for (int i = rbid; i < 16 * 44; i += nblk) transpose_tile(smf, p.in[40] + (size_t)l * 2816 * 1024, 1024, nullptr, (u16*)(ws + O_WDN), 2816, 3, (i / 44) * 64, (i % 44) * 64);
#pragma unroll 1
      for (int i = bid; i < 16; i += nblk) transpose_tile(smf, p.in[19] + (size_t)l * 256 * 256, 256, nullptr, (u16*)(ws + O_WGLU), 256, 4, (i / 4) * 64, (i % 4) * 64);
#pragma unroll 1
      for (int i = rbid; i < 64; i += nblk) {
        u16* wl = (u16*)(ws + O_WLRU);
        for (int e = i * 1024 + tid; e < (i + 1) * 1024; e += 256) {
          int k = e & 63, n = (e >> 6) & 255, head = e >> 14;
          int d = n >> 7, gate = (n >> 6) & 1, j = n & 63;
          const float* wr_ = p.in[6]; const float* wi_ = p.in[8];
          size_t off_ = ((size_t)((l * 2 + d) * 4 + head) * 64 + k) * 64 + j;
          float vr_ = wr_[off_], vi_ = wi_[off_];
          wl[e] = f2bf(gate ? vi_ : vr_);
        }
      }
#pragma unroll 1
      for (int i = bid; i < 16 * 2 * 65; i += nblk) s5_prep_item(smf, p, l, i);
#pragma unroll 1
      for (int i = rbid; i < 16 * 2 * 64; i += nblk) s5_bts_item(p, l, i);
#pragma unroll 1
      for (int i = rbid; i < 96; i += nblk) hy_filter_item(smf, p, l, i < 32 ? 0 : 1, i < 32 ? i : i - 32);
      {
        unsigned* rq = (unsigned*)(ws + O_BAR + 208) + l;
        int* rslot = (int*)(smraw + SMEM_BYTES - 16);
#pragma unroll 1
        for (;;) {
          __syncthreads();
          if (tid == 0) *rslot = (int)atomicAdd(rq, 1u);
          __syncthreads();
          const int c0 = *rslot * 4;
          if (c0 >= T_ALL / 16) break;
#pragma unroll 1
          for (int i = c0; i < c0 + 4; i++) rms_rows_to_bf16(p, l, i);
        }
      }
    }
    GRID_SYNC();
    {
      int l = lay; asm volatile("" : "+s"(l));
      TILE_LOOP(640, 21, mt, nt) {
        { const float* H = gemm_tile(smem, (const u16*)(ws + O_XN), 1024, mt * 128, 0, T_ALL, 30, 0, (const u16*)(ws + O_WIN) + (size_t)nt * 128 * 1024, 1024, 1024);
            int tid_o = threadIdx.x; asm volatile("" : "+v"(tid_o));
            const int tok0 = mt * 128;
            if (nt < 4) {
              u16* zA = (u16*)(ws + O_ZA) + (size_t)tok0 * 512 + nt * 128;
              EPI_ROWS(H, { *(uint2*)(zA + (size_t)r * 512 + c) = pack4(v.x, v.y, v.z, v.w); })
            } else if (nt < 6) {
              u16* uh = (u16*)(ws + O_UH);
              EPI_ROWS(H, {
                int tok = tok0 + r, ch = (nt - 4) * 128 + c;
                *(uint2*)(uh + ((size_t)(ch >> 4) * 1280 + (tok >> 6)) * 1280 + (tok & 63) * 16 + (ch & 15)) = pack4(v.x, v.y, v.z, v.w); })
            } else if (nt < 14) {
              u16* zC = (u16*)(ws + O_ZC) + (size_t)tok0 * 1024 + (nt - 6) * 128;
              EPI_ROWS(H, { *(uint2*)(zC + (size_t)r * 1024 + c) = pack4(v.x, v.y, v.z, v.w); })
            } else if (nt < 20) {
              u16* dt = (u16*)(ws + O_DT) + (size_t)((nt - 14) * 128 + (tid_o & 127)) * T_ALL + tok0 + (tid_o >> 7) * 64;
              const float* Hc = H + (tid_o >> 7) * 64 * HST + (tid_o & 127);
#pragma unroll 2
              for (int k = 0; k < 8; k++) {
                uint2 a = pack4(Hc[(8 * k) * HST], Hc[(8 * k + 1) * HST], Hc[(8 * k + 2) * HST], Hc[(8 * k + 3) * HST]);
                uint2 b = pack4(Hc[(8 * k + 4) * HST], Hc[(8 * k + 5) * HST], Hc[(8 * k + 6) * HST], Hc[(8 * k + 7) * HST]);
                uint4 pk; pk.x = a.x; pk.y = a.y; pk.z = b.x; pk.w = b.y;
                *(uint4*)(dt + 8 * k) = pk;
              }
            } else {
              float* ba = (float*)(ws + O_BA) + (size_t)tok0 * 16;
#pragma unroll 2
              for (int k = 0; k < 8; k++) { int idx = tid_o + 256 * k; ba[idx] = H[(idx >> 4) * HST + (idx & 15)]; }
            }
          }
      }
#pragma unroll 1
      for (int it = rbid; it < 16 * 1024; it += nblk) s5_expand_item(p, l, it);
    }
    GRID_SYNC();
    {
      int l = lay; asm volatile("" : "+s"(l));
#pragma unroll 1
      for (int it = bid; it < NCH64 * 4; it += nblk) gdn_g1_item(smraw, p, l, it);
#pragma unroll 1
      for (int it = rbid; it < 16 * 10 * 2; it += nblk) {
        const int g = it / 20, mt = (it % 20) >> 1, nt = it & 1;
        { const float* H = gemm_tile(smem, (const u16*)(ws + O_UH) + (size_t)g * 1280 * 1280, 1280, mt * 128, 0, 1280, 30, 0,
                  (const u16*)(ws + O_BTS) + (size_t)g * 256 * 1024 + (size_t)nt * 128 * 1024, 1024, 1024);
            int tid_o = threadIdx.x; asm volatile("" : "+v"(tid_o));
            float* send = (float*)(ws + O_SEND) + (size_t)g * 1280 * 256 + (size_t)mt * 128 * 256 + nt * 128;
            EPI_ROWS(H, { *(float4*)(send + (size_t)r * 256 + c) = v; })
          }
      }
#pragma unroll 1
      for (int it = bid; it < NCH32 * 4; it += nblk) lru_item(smraw, p, l, it, 0);
    }
    GRID_SYNC();
    {
      int l = lay; asm volatile("" : "+s"(l));
#pragma unroll 1
      for (int it = bid; it < 192; it += nblk) gdn_chain(smraw, p, it);
#pragma unroll 1
      for (int it = rbid; it < 48; it += nblk) lru_propagate(p, it * 256 + tid);
#pragma unroll 1
      for (int it = rbid - 48; it < 192; it += nblk) { if (it >= 0) s5_propagate(p, l, it * 256 + tid); }
      unsigned* hq = (unsigned*)(ws + O_BAR + 192) + l;
      int* hslot = (int*)(smraw + SMEM_BYTES - 16);
#pragma unroll 1
      for (;;) {
        __syncthreads();
        if (tid == 0) *hslot = (int)atomicAdd(hq, 1u);
        __syncthreads();
        const int item = *hslot;
        if (item >= 512) break;
        const int set = item < 256 ? 1 : 0, c = item & 255, ntb = set ? 4 : 2;
#pragma unroll 1
        for (int tb = 0; tb < ntb; tb++) hy_conv_item(smraw, p, l, 0, set, c, tb);
        __threadfence();
        __syncthreads();
#pragma unroll 1
        for (int tb = 0; tb < ntb; tb++) hy_conv_item(smraw, p, l, 1, set, c, tb);
      }
    }
    GRID_SYNC();
    {
      int l = lay; asm volatile("" : "+s"(l));
#pragma unroll 1
      for (int it = rbid; it < 16 * 10 * 8; it += nblk) {
        const int g = it / 80, mt = (it % 80) >> 3, nt = it & 7;
        { const float* H = gemm_tile(smem, (const u16*)(ws + O_UH) + (size_t)g * 1280 * 1280, 1280, mt * 128, 0, 1280, 30, 0,
                  (const u16*)(ws + O_BTY) + (size_t)g * 1024 * 1280 + (size_t)nt * 128 * 1280, 1280, 1280);
            int tid_o = threadIdx.x; asm volatile("" : "+v"(tid_o));
            u16* zb = (u16*)(ws + O_XN) + (size_t)3 * T_ALL * 256;
            EPI_ROWS(H, {
              int ck = mt * 128 + r, n = nt * 128 + c;
              *(uint2*)(zb + ((size_t)g * T_ALL + ck * 64 + (n >> 4)) * 16 + (n & 15)) = pack4(geluf_(v.x), geluf_(v.y), geluf_(v.z), geluf_(v.w)); })
          }
      }
#pragma unroll 1
      for (int it = bid; it < NCH32 * 4; it += nblk) lru_item(smraw, p, l, it, 1);
#pragma unroll 1
      for (int it = rbid; it < T_ALL / 16; it += nblk) gdn_final_rows(p, l, it);
    }
    GRID_SYNC();
    {
      int l = lay; asm volatile("" : "+s"(l));
#pragma unroll 1
      for (int it = bid; it < 640 * 2; it += nblk) {
        const int mt = it >> 1, nt = it & 1;
        const u16* zb = (const u16*)(ws + O_XN) + (size_t)3 * T_ALL * 256;
        { const float* H = gemm_tile(smem, zb, 16, mt * 128, 0, T_ALL, 4, (size_t)T_ALL * 16, (const u16*)(ws + O_WGLU) + (size_t)nt * 128 * 256, 256, 256);
            int tid_o = threadIdx.x; asm volatile("" : "+v"(tid_o));
            u16* mixB = (u16*)(ws + O_XN) + (size_t)T_ALL * 256 + (size_t)mt * 128 * 256 + nt * 128;
            const u16* zr = zb + (size_t)mt * 128 * 16;
            const float* gb = p.in[20] + l * 256 + nt * 128;
            EPI_ROWS(H, {
              uint2 zz = *(const uint2*)(zr + ((size_t)((nt * 128 + c) >> 4) * T_ALL + r) * 16 + (c & 15));
              float4 g4 = *(const float4*)(gb + c);
              float z0 = bf2f(zz.x & 0xffff), z1 = bf2f(zz.x >> 16), z2 = bf2f(zz.y & 0xffff), z3 = bf2f(zz.y >> 16);
              *(uint2*)(mixB + (size_t)r * 256 + c) = pack4(z0 * sigmoidf_(v.x + g4.x), z1 * sigmoidf_(v.y + g4.y), z2 * sigmoidf_(v.z + g4.z), z3 * sigmoidf_(v.w + g4.w)); })
          }
      }
#pragma unroll 1
      for (int it = rbid; it < T_ALL / 16; it += nblk) grpnorm_rows(p, l, 0, it);
    }
    GRID_SYNC();
    {
      int l = lay; asm volatile("" : "+s"(l));
#pragma unroll 1
      for (int it = bid; it < NCH64; it += nblk) hy_final_item(smraw, p, l, it);
#pragma unroll 1
      for (int it = rbid; it < T_ALL / 16; it += nblk) grpnorm_rows(p, l, 1, it);
    }
    GRID_SYNC();
    {
      int l = lay; asm volatile("" : "+s"(l));
      TILE_LOOP(640, 8, mt, nt) {
        { const float* H = gemm_tile(smem, (const u16*)(ws + O_XN), 256, mt * 128, 0, T_ALL, 8, (size_t)T_ALL * 256,
                  (const u16*)(ws + O_WOUT) + (size_t)nt * 128 * 1024, 1024, 1024);
            int tid_o = threadIdx.x; asm volatile("" : "+v"(tid_o));
            float* o = p.out + (size_t)mt * 128 * DM + nt * 128;
            const int er = tid_o >> 5, ec = (tid_o & 31) * 4;
#pragma unroll 1
            for (int half = 0; half < 2; half++) {
              float4 b4[8];
#pragma unroll
              for (int q = 0; q < 8; q++) b4[q] = *(const float4*)(xrow(p, l, mt * 128 + er + 8 * (half * 8 + q)) + nt * 128 + ec);
#pragma unroll
              for (int q = 0; q < 8; q++) {
                const int r = er + 8 * (half * 8 + q);
                const float4 v = *(const float4*)(H + r * HST + ec);
                float4 o4; o4.x = b4[q].x + v.x; o4.y = b4[q].y + v.y; o4.z = b4[q].z + v.z; o4.w = b4[q].w + v.w;
                *(float4*)(o + (size_t)r * DM + ec) = o4;
              }
            }
          }
      }
    }
    GRID_SYNC();
    {
      int l = lay; asm volatile("" : "+s"(l));
#pragma unroll 1
      for (int it = bid; it < T_ALL / 16; it += nblk) rms_rows_to_bf16(p, 1, it);
    }
    GRID_SYNC();
    {
      int l = lay; asm volatile("" : "+s"(l));
      const int nM = 8 * 17 + 16 * 33;
      TILE_LOOP(nM, 44, mi, nt) {
        int seq, ti, L;
        if (mi < 136) { seq = mi / 17; ti = mi % 17; L = 2048; }
        else { seq = 8 + (mi - 136) / 33; ti = (mi - 136) % 33; L = 4096; }
        const int s0 = seq < 8 ? seq * 2048 : T_P + (seq - 8) * 4096;
        const int arow0 = s0 + 126 * ti - 1;
        const int nvalid = min(126, L - 126 * ti);
        { const float* H = gemm_tile(smem, (const u16*)(ws + O_XN), 1024, arow0, s0, s0 + L, 30, 0, (const u16*)(ws + O_WUP) + (size_t)nt * 128 * 1024, 1024, 1024);
            int tid_o = threadIdx.x; asm volatile("" : "+v"(tid_o));
            const int j = tid_o & 63, rg = tid_o >> 6;
            const float* cw = p.in[38] + (size_t)l * 3 * 5632;
            const float* cb = p.in[39] + (size_t)l * 5632;
            const int cg_ = nt * 64 + j, cv_ = DFF + nt * 64 + j;
            const float g0 = cw[cg_], g1 = cw[5632 + cg_], g2 = cw[2 * 5632 + cg_], gb = cb[cg_];
            const float u0 = cw[cv_], u1 = cw[5632 + cv_], u2 = cw[2 * 5632 + cv_], ub = cb[cv_];
            u16* hm = (u16*)(ws + O_HMID) + (size_t)arow0 * DFF + nt * 64 + j;
#pragma unroll 2
            for (int r = 1 + rg; r <= nvalid; r += 4) {
              float gate = g0 * H[(r - 1) * HST + j] + g1 * H[r * HST + j] + g2 * H[(r + 1) * HST + j] + gb;
              float val = u0 * H[(r - 1) * HST + 64 + j] + u1 * H[r * HST + 64 + j] + u2 * H[(r + 1) * HST + 64 + j] + ub;
              hm[(size_t)r * DFF] = f2bf(siluf_(gate) * val);
            }
          }
      }
    }
    GRID_SYNC();
    {
      int l = lay; asm volatile("" : "+s"(l));
      TILE_LOOP(640, 8, mt, nt) {
        { const float* H = gemm_tile(smem, (const u16*)(ws + O_HMID), DFF, mt * 128, 0, T_ALL, 30, 0, (const u16*)(ws + O_WDN) + (size_t)nt * 128 * DFF, DFF, DFF);
            int tid_o = threadIdx.x; asm volatile("" : "+v"(tid_o));
            float* o = p.out + (size_t)mt * 128 * DM + nt * 128;
            const int er = tid_o >> 5, ec = (tid_o & 31) * 4;
#pragma unroll 1
            for (int half = 0; half < 2; half++) {
              float4 b4[8];
#pragma unroll
              for (int q = 0; q < 8; q++) b4[q] = *(const float4*)(o + (size_t)(er + 8 * (half * 8 + q)) * DM + ec);
#pragma unroll
              for (int q = 0; q < 8; q++) {
                const int r = er + 8 * (half * 8 + q);
                const float4 v = *(const float4*)(H + r * HST + ec);
                float4 o4; o4.x = b4[q].x + v.x; o4.y = b4[q].y + v.y; o4.z = b4[q].z + v.z; o4.w = b4[q].w + v.w;
                *(float4*)(o + (size_t)r * DM + ec) = o4;
              }
            }
          }
      }
    }
    GRID_SYNC();
  }
  {
    const int w = tid >> 6;
    const float* fn = p.in[41];
#pragma unroll 1
    for (int it = bid; it < T_ALL / 16; it += nblk) {
      float* x0 = p.out + (size_t)(it * 16 + w * 4) * DM;
      float4 v[4][4];
#pragma unroll
      for (int j = 0; j < 4; j++)
#pragma unroll
        for (int i = 0; i < 4; i++) v[j][i] = *(const float4*)(x0 + (size_t)j * DM + i * 256 + lane * 4);
#pragma unroll
      for (int j = 0; j < 4; j++) {
        float ss = 0.f;
#pragma unroll
        for (int i = 0; i < 4; i++) ss += v[j][i].x * v[j][i].x + v[j][i].y * v[j][i].y + v[j][i].z * v[j][i].z + v[j][i].w * v[j][i].w;
        ss = wave_sum(ss);
        float rs = rsqrtf(ss * (1.f / 1024.f) + EPSF);
#pragma unroll
        for (int i = 0; i < 4; i++) {
          float4 g = *(const float4*)(fn + i * 256 + lane * 4);
          float4 o; o.x = v[j][i].x * rs * g.x; o.y = v[j][i].y * rs * g.y; o.z = v[j][i].z * rs * g.z; o.w = v[j][i].w * rs * g.w;
          *(float4*)(x0 + (size_t)j * DM + i * 256 + lane * 4) = o;
        }
      }
    }
  }
}

extern "C" void kernel_launch(void* const* d_in, const int* in_sizes, int n_in,
                              void* d_out, int out_size, void* d_ws, size_t ws_size,
                              hipStream_t stream) {
  static int grid_blocks = 0;
  if (!grid_blocks) {
    int dev = 0, cus = 0, per_cu = 0;
    (void)hipGetDevice(&dev);
    (void)hipDeviceGetAttribute(&cus, hipDeviceAttributeMultiprocessorCount, dev);
    (void)hipOccupancyMaxActiveBlocksPerMultiprocessor(&per_cu, mega, 256, 0);
    if (per_cu > 2) per_cu = 2;
    if (per_cu < 1) per_cu = 1;
    grid_blocks = cus * per_cu;
  }
  if (ws_size < WS_TOTAL) fprintf(stderr, "workspace too small: %zu < %zu\n", ws_size, (size_t)WS_TOTAL);
  Params p{};
  for (int i = 0; i < 42; i++) p.in[i] = (const float*)d_in[i];
  p.out = (float*)d_out;
  p.ws = (char*)d_ws;
  (void)hipMemsetAsync((char*)d_ws + O_BAR, 0, 16384, stream);
  void* args[] = {&p};
  hipError_t e = hipLaunchCooperativeKernel((void*)mega, dim3(grid_blocks), dim3(256), args, 0, stream);
  if (e != hipSuccess) fprintf(stderr, "coop launch failed: %s (grid %d)\n", hipGetErrorString(e), grid_blocks);
}
```

```cpp
#include <hip/hip_runtime.h>
#include <hip/hip_bf16.h>
#include <hip/hip_cooperative_groups.h>
#include <cstdio>
namespace cg = cooperative_groups;

typedef unsigned short u16;
using bf16x8 = __attribute__((ext_vector_type(8))) short;
using f32x4 = __attribute__((ext_vector_type(4))) float;

#define T_ALL 81920
#define T_P 16384
#define DM 1024
#define NZ 2688
#define DFF 2816
#define NCH32 2560
#define NCH64 1280
#define EPSF 1e-6f

constexpr size_t al(size_t x) { return (x + 255) & ~(size_t)255; }
constexpr size_t O_WIN = 0;
constexpr size_t O_WOUT = O_WIN + al((size_t)NZ * 1024 * 2);
constexpr size_t O_WUP = O_WOUT + al((size_t)1024 * 1024 * 2);
constexpr size_t O_WDN = O_WUP + al((size_t)5632 * 1024 * 2);
constexpr size_t O_WLRU = O_WDN + al((size_t)1024 * 2816 * 2);
constexpr size_t O_WGLU = O_WLRU + al((size_t)4 * 256 * 64 * 2);
constexpr size_t O_AB64 = O_WGLU + al((size_t)256 * 256 * 2);
constexpr size_t O_KTAB = O_AB64 + 2 * al((size_t)2 * 16 * 64 * 2 * 4);
constexpr size_t O_BTY = O_KTAB + al((size_t)16 * 2 * 64 * 256 * 4);
constexpr size_t O_BTS = O_BTY + al((size_t)16 * 1024 * 1280 * 2);
constexpr size_t O_HYKR = O_BTS + al((size_t)16 * 256 * 1024 * 2);
constexpr size_t HYKR1 = (size_t)2 * 256 * 4096;
constexpr size_t O_HYPS = O_HYKR + al((size_t)2 * 256 * (4096 + 8192) * 2);
constexpr size_t O_XN = O_HYPS + al((size_t)(32 + 64) * 512 * 4);
constexpr size_t O_ZA = O_XN + al((size_t)T_ALL * 1024 * 2);
constexpr size_t O_UH = O_ZA + al((size_t)T_ALL * 512 * 2);
constexpr size_t O_ZC = O_UH + al((size_t)16 * 1280 * 1280 * 2);
constexpr size_t O_BA = O_ZC + al((size_t)T_ALL * 1024 * 2);
constexpr size_t O_DT = O_BA + al((size_t)T_ALL * 16 * 4);
constexpr size_t O_WU = O_DT + al((size_t)768 * T_ALL * 2);
constexpr size_t O_GC = O_WU + al((size_t)NCH64 * 4 * 2 * 2 * 4096 * 2);
constexpr size_t O_OD = O_GC + al((size_t)T_ALL * 8 * 4);
constexpr size_t O_Y1 = O_OD + al((size_t)2 * T_ALL * 256 * 2);
constexpr size_t O_SEND = O_Y1 + al((size_t)256 * T_ALL * 2);
constexpr size_t O_LCAR = O_SEND + al((size_t)16 * 1280 * 256 * 4);
constexpr size_t O_LHIN = O_LCAR + al((size_t)NCH32 * 512 * 8);
constexpr size_t O_BAR = O_LHIN + al((size_t)NCH32 * 512 * 4);
constexpr size_t WS_TOTAL = O_BAR + 16384;
static_assert(WS_TOTAL <= (size_t)1073741824, "ws");
constexpr size_t O_HMID = O_ZA;
static_assert(O_HMID + (size_t)T_ALL * DFF * 2 <= O_GC, "hmid alias");

struct Params {
  const float* in[42];
  float* out;
  char* ws;
};

#define SMEM_BYTES 73728
#ifndef MIXMASK
#define MIXMASK 15
#endif

__device__ __forceinline__ u16 f2bf(float f) {
  unsigned u = __float_as_uint(f);
  u += 0x7fffu + ((u >> 16) & 1u);
  return (u16)(u >> 16);
}
__device__ __forceinline__ float bf2f(u16 h) { return __uint_as_float(((unsigned)h) << 16); }
__device__ __forceinline__ float sigmoidf_(float x) { return 1.f / (1.f + __expf(-x)); }
__device__ __forceinline__ float siluf_(float x) { return x / (1.f + __expf(-x)); }
__device__ __forceinline__ float softplusf_(float x) { return x > 20.f ? x : log1pf(expf(x)); }
__device__ __forceinline__ float geluf_(float x) {
  float u2 = 1.5957691216057308f * (x + 0.044715f * x * x * x);
  return x / (1.f + __expf(-u2));
}
__device__ __forceinline__ float wave_sum(float v) {
#pragma unroll
  for (int o = 32; o > 0; o >>= 1) v += __shfl_xor(v, o);
  return v;
}
__device__ __forceinline__ const float* xrow(const Params& p, int l, int tok) {
  const float* a = p.in[0]; const float* b = p.in[1]; const float* o = p.out;
  const float* r0 = a + (size_t)tok * DM;
  const float* r1 = b + (size_t)(tok - T_P) * DM;
  const float* r2 = o + (size_t)tok * DM;
  return l == 0 ? (tok < T_P ? r0 : r1) : r2;
}
__device__ __forceinline__ void seq_bounds(int tok, int& lo, int& hi) {
  if (tok < T_P) { lo = tok & ~2047; hi = lo + 2048; }
  else { lo = T_P + ((tok - T_P) & ~4095); hi = lo + 4096; }
}

#define LDS_BARRIER() asm volatile("s_waitcnt lgkmcnt(0)\n\ts_barrier" ::: "memory")

#define GST 72
#define HST 132
template <bool MASK = false>
__device__ __forceinline__ const float* gemm_tile(u16* smem, const u16* __restrict__ A, long lda, int arow0, int alo, int ahi,
                                          int segShift, size_t segStride,
                                          const u16* __restrict__ Bt, long ldb, int K) {
  u16* sA = smem;
  u16* sB = smem + 2 * 128 * GST;
  int tid = threadIdx.x; asm volatile("" : "+v"(tid)); const int _tid_pad = 0, lane = tid & 63, w = tid >> 6;
  const int wm = w >> 1, wn = w & 1, fr = lane & 15, fq = lane >> 4;
  const int cc = tid & 7, r0 = tid >> 3;
  f32x4 acc[4][4];
#pragma unroll
  for (int i = 0; i < 4; i++)
#pragma unroll
    for (int j = 0; j < 4; j++) acc[i][j] = (f32x4){0.f, 0.f, 0.f, 0.f};
  uint4 ra0x, ra1x, ra2x, ra3x, rb0x, rb1x, rb2x, rb3x;
  const int nk = K >> 6;
#define GROW(i_, AP, BP, OK) const bool OK = !MASK || ((arow0 + r0 + 32 * i_) >= alo && (arow0 + r0 + 32 * i_) < ahi);        \
    const u16* AP = A + (long)(OK ? (arow0 + r0 + 32 * i_) : alo) * lda;                                             \
    const u16* BP = Bt + (long)(r0 + 32 * i_) * ldb + cc * 8;
  GROW(0, ap0, bp0, ok0) GROW(1, ap1, bp1, ok1) GROW(2, ap2, bp2, ok2) GROW(3, ap3, bp3, ok3)
#define GLOAD1(AP, BP, OK, RA, RB) {                                                \
      uint4 t_ = *(const uint4*)(AP + aoff_);                                         \
      RA = (!MASK || OK) ? t_ : make_uint4(0, 0, 0, 0);                               \
      RB = *(const uint4*)(BP + k0_); }
#define GLOAD(kt_, S) do {                                                         \
    const int k0_ = (kt_) << 6;                                                       \
    const int kk_ = k0_ + cc * 8;                                                     \
    const int sg_ = kk_ >> segShift;                                                  \
    const size_t aoff_ = (size_t)sg_ * segStride + (kk_ - (sg_ << segShift));         \
    GLOAD1(ap0, bp0, ok0, ra0##S, rb0##S) GLOAD1(ap1, bp1, ok1, ra1##S, rb1##S)       \
    GLOAD1(ap2, bp2, ok2, ra2##S, rb2##S) GLOAD1(ap3, bp3, ok3, ra3##S, rb3##S)       \
    } while (0)
#define SWRITE1(buf_, i_, RA, RB) {                                                 \
      *(uint4*)(sA + (buf_) * 128 * GST + (r0 + 32 * i_) * GST + cc * 8) = RA;        \
      *(uint4*)(sB + (buf_) * 128 * GST + (r0 + 32 * i_) * GST + cc * 8) = RB; }
#define SWRITE(buf_, S) do {                                                        \
    SWRITE1(buf_, 0, ra0##S, rb0##S) SWRITE1(buf_, 1, ra1##S, rb1##S) SWRITE1(buf_, 2, ra2##S, rb2##S) SWRITE1(buf_, 3, ra3##S, rb3##S) \
    } while (0)
#define GCOMPUTE(buf_) do {                                                         \
    const u16* a = sA + (buf_) * 128 * GST;                                           \
    const u16* b = sB + (buf_) * 128 * GST;                                           \
    _Pragma("unroll") for (int ks = 0; ks < 2; ks++) {                                \
      bf16x8 af[4], bfr[4];                                                           \
      _Pragma("unroll") for (int i = 0; i < 4; i++) {                                 \
        af[i] = *(const bf16x8*)(a + (64 * wm + 16 * i + fr) * GST + ks * 32 + fq * 8);   \
        bfr[i] = *(const bf16x8*)(b + (64 * wn + 16 * i + fr) * GST + ks * 32 + fq * 8);  \
      }                                                                               \
      __builtin_amdgcn_s_setprio(1);                                                  \
      _Pragma("unroll") for (int i = 0; i < 4; i++)                                   \
      _Pragma("unroll") for (int j = 0; j < 4; j++)                                   \
        acc[i][j] = __builtin_amdgcn_mfma_f32_16x16x32_bf16(af[i], bfr[j], acc[i][j], 0, 0, 0); \
      __builtin_amdgcn_s_setprio(0);                                                  \
    } } while (0)
  LDS_BARRIER();
  GLOAD(0, x);
  SWRITE(0, x);
  LDS_BARRIER();
#pragma unroll 1
  for (int kt = 0; kt < nk; kt += 2) {
    if (kt + 1 < nk) GLOAD(kt + 1, x);
    GCOMPUTE(0);
    if (kt + 1 < nk) SWRITE(1, x);
    LDS_BARRIER();
    if (kt + 1 >= nk) break;
    if (kt + 2 < nk) GLOAD(kt + 2, x);
    GCOMPUTE(1);
    if (kt + 2 < nk) SWRITE(0, x);
    LDS_BARRIER();
  }
  float* H = (float*)smem;
#pragma unroll
  for (int i = 0; i < 4; i++)
#pragma unroll
    for (int j = 0; j < 4; j++)
#pragma unroll
      for (int e = 0; e < 4; e++) H[(64 * wm + 16 * i + 4 * fq + e) * HST + 64 * wn + 16 * j + fr] = acc[i][j][e];
  LDS_BARRIER();
  return H;
}
__device__ __forceinline__ uint2 pack4(float a, float b, float c, float d) {
  uint2 pk; pk.x = f2bf(a) | ((unsigned)f2bf(b) << 16); pk.y = f2bf(c) | ((unsigned)f2bf(d) << 16); return pk;
}
#define EPI_ROWS(H, BODY...)                                                     \
  _Pragma("unroll 4") for (int _it = 0; _it < 16; _it++) {                       \
    const int r = (tid_o >> 5) + 8 * _it, c = (tid_o & 31) * 4;      \
    const float4 v = *(const float4*)((H) + r * HST + c); BODY }

__device__ __forceinline__ int colmap(int mode, int n) {
  if (mode == 0) {
    if (n < 1792) return n;
    if (n < 2560) return n + 16;
    if (n < 2576) return 1792 + (n - 2560);
    return -1;
  }
  if (mode == 2) { int nt = n >> 7, c = n & 127; return c < 64 ? nt * 64 + c : DFF + nt * 64 + (c - 64); }
  return n;
}
__device__ __forceinline__ void transpose_tile(float* sm, const float* __restrict__ src, int ldsrc, const float* __restrict__ gain,
                               u16* __restrict__ dst, int K, int mode, int n0, int k0) {
  int tid = threadIdx.x; asm volatile("" : "+v"(tid)); const int _tid_pad = 0;
  LDS_BARRIER();
  {
    int nn = tid & 63;
    int sc = colmap(mode, n0 + nn);
#pragma unroll
    for (int i = 0; i < 16; i++) {
      int kk = (tid >> 6) + 4 * i;
      float v = 0.f;
      if (sc >= 0) { v = src[(size_t)(k0 + kk) * ldsrc + sc]; if (gain) v *= gain[k0 + kk]; }
      sm[kk * 65 + nn] = v;
    }
  }
  LDS_BARRIER();
  {
    int c = tid & 7;
#pragma unroll
    for (int i = 0; i < 2; i++) {
      int nn = (tid >> 3) + 32 * i;
      u16 h[8];
#pragma unroll
      for (int e = 0; e < 8; e++) h[e] = f2bf(sm[(c * 8 + e) * 65 + nn]);
      uint4 pk;
      pk.x = h[0] | ((unsigned)h[1] << 16); pk.y = h[2] | ((unsigned)h[3] << 16);
      pk.z = h[4] | ((unsigned)h[5] << 16); pk.w = h[6] | ((unsigned)h[7] << 16);
      *(uint4*)(dst + (size_t)(n0 + nn) * K + k0 + c * 8) = pk;
    }
  }
}

__device__ __forceinline__ void s5_prep_item(float* sm, const Params& p, int l, int item) {
  int tid = threadIdx.x; asm volatile("" : "+v"(tid)); const int _tid_pad = 0;
  const int m = item % 65, d = (item / 65) & 1, g = item / 130;
  float* s_abm = sm;
  float* s_q = sm + 128;
  const int ldg = (l * 2 + d) * 16 + g;
  LDS_BARRIER();
  if (tid < 64) {
    int pi = ldg * 64 + tid;
    float dt = expf(p.in[13][ldg]);
    float are = p.in[11][pi], aim = p.in[12][pi];
    float mag = expf(dt * are), ang = dt * aim;
    float abr = mag * cosf(ang), abi = mag * sinf(ang);
    float den = are * are + aim * aim;
    float nre = abr - 1.f;
    s_q[tid * 2] = (nre * are + abi * aim) / den;
    s_q[tid * 2 + 1] = (abi * are - nre * aim) / den;
    float mm = expf((float)m * dt * are), am = (float)m * ang;
    float pr = mm * cosf(am), pim = mm * sinf(am);
    s_abm[tid * 2] = pr; s_abm[tid * 2 + 1] = pim;
    if (m == 64) {
      float* ab64 = (float*)(p.ws + O_AB64) + (size_t)l * 2 * 16 * 64 * 2;
      ab64[((d * 16 + g) * 64 + tid) * 2] = pr;
      ab64[((d * 16 + g) * 64 + tid) * 2 + 1] = pim;
    }
  }
  LDS_BARRIER();
  const float* bre = p.in[14] + (size_t)ldg * 64 * 16;
  const float* bim = p.in[15] + (size_t)ldg * 64 * 16;
  const float* cre = p.in[16] + (size_t)ldg * 16 * 64;
  const float* cim = p.in[17] + (size_t)ldg * 16 * 64;
  u16* bty = (u16*)(p.ws + O_BTY) + (size_t)g * 1024 * 1280;
  u16* bts = (u16*)(p.ws + O_BTS) + (size_t)g * 256 * 1024;
  if (m <= 63) {
    int ho = tid >> 4, hi = tid & 15;
    float acc = 0.f;
    for (int pp = 0; pp < 64; pp++) {
      float cr = cre[ho * 64 + pp], ci = cim[ho * 64 + pp];
      float ar = s_abm[pp * 2], ai = s_abm[pp * 2 + 1];
      float t1r = cr * ar - ci * ai, t1i = cr * ai + ci * ar;
      float qr = s_q[pp * 2], qi = s_q[pp * 2 + 1];
      float br = bre[pp * 16 + hi], bi = bim[pp * 16 + hi];
      float bbr = qr * br - qi * bi, bbi = qr * bi + qi * br;
      acc += t1r * bbr - t1i * bbi;
    }
    float* kt = (float*)(p.ws + O_KTAB);
    kt[((size_t)((g * 2 + d) * 64 + m)) * 256 + ho * 16 + hi] = acc;
  }
  if (m >= 1) {
    int t = d == 0 ? m - 1 : 64 - m;
    for (int e = tid; e < 1024; e += 256) {
      int ho = e >> 6, pp = e & 63;
      float cr = cre[ho * 64 + pp], ci = cim[ho * 64 + pp];
      float ar = s_abm[pp * 2], ai = s_abm[pp * 2 + 1];
      float xr = cr * ar - ci * ai, xi = cr * ai + ci * ar;
      size_t o = (size_t)(t * 16 + ho) * 1280 + 1024 + d * 128 + pp * 2;
      bty[o] = f2bf(xr);
      bty[o + 1] = f2bf(-xi);
    }
  }
}
__device__ __forceinline__ void s5_bts_item(const Params& p, int l, int item) {
  int tid = threadIdx.x; asm volatile("" : "+v"(tid));
  const int pp = item & 63, d = (item >> 6) & 1, g = item >> 7;
  const int sp = tid >> 2, hq = tid & 3;
  const int ldg = (l * 2 + d) * 16 + g;
  const int pi = ldg * 64 + pp;
  float dt = expf(p.in[13][ldg]);
  float are = p.in[11][pi], aim = p.in[12][pi];
  float mag = expf(dt * are), ang = dt * aim;
  float abr = mag * cosf(ang), abi = mag * sinf(ang);
  float den = are * are + aim * aim;
  float nre = abr - 1.f;
  float qr = (nre * are + abi * aim) / den, qi = (abi * are - nre * aim) / den;
  const int f = d == 0 ? 63 - sp : sp;
  float mm = expf((float)f * dt * are), am = (float)f * ang;
  float ar = mm * cosf(am), ai = mm * sinf(am);
  const float* bre = p.in[14] + (size_t)ldg * 64 * 16 + pp * 16 + hq * 4;
  const float* bim = p.in[15] + (size_t)ldg * 64 * 16 + pp * 16 + hq * 4;
  float fr_[4], fi_[4];
#pragma unroll
  for (int e = 0; e < 4; e++) {
    float br = bre[e], bi = bim[e];
    float bbr = qr * br - qi * bi, bbi = qr * bi + qi * br;
    fr_[e] = ar * bbr - ai * bbi; fi_[e] = ar * bbi + ai * bbr;
  }
  u16* bts = (u16*)(p.ws + O_BTS) + (size_t)g * 256 * 1024 + (size_t)(d * 128 + pp * 2) * 1024 + sp * 16 + hq * 4;
  *(uint2*)bts = pack4(fr_[0], fr_[1], fr_[2], fr_[3]);
  *(uint2*)(bts + 1024) = pack4(fi_[0], fi_[1], fi_[2], fi_[3]);
}
__device__ __forceinline__ void s5_expand_item(const Params& p, int l, int item) {
  int tid = threadIdx.x; asm volatile("" : "+v"(tid)); const int _tid_pad = 0;
  int g = item >> 10, n = item & 1023, t = n >> 4, ho = n & 15;
  int sp = tid >> 2, hi0 = (tid & 3) * 4;
  const float* kt = (const float*)(p.ws + O_KTAB);
  float v[4] = {0.f, 0.f, 0.f, 0.f};
  if (t >= sp) {
    const float* k0 = kt + ((size_t)((g * 2 + 0) * 64 + (t - sp))) * 256 + ho * 16 + hi0;
#pragma unroll
    for (int e = 0; e < 4; e++) v[e] += k0[e];
  }
  if (sp >= t) {
    const float* k1 = kt + ((size_t)((g * 2 + 1) * 64 + (sp - t))) * 256 + ho * 16 + hi0;
#pragma unroll
    for (int e = 0; e < 4; e++) v[e] += k1[e];
  }
  if (t == sp && ho >= hi0 && ho < hi0 + 4) v[ho - hi0] += p.in[18][l * 256 + g * 16 + ho];
  u16* bty = (u16*)(p.ws + O_BTY) + (size_t)g * 1024 * 1280 + (size_t)n * 1280 + sp * 16 + hi0;
  uint2 pk;
  pk.x = f2bf(v[0]) | ((unsigned)f2bf(v[1]) << 16);
  pk.y = f2bf(v[2]) | ((unsigned)f2bf(v[3]) << 16);
  *(uint2*)bty = pk;
}

__device__ __forceinline__ void hy_filter_item(float* sm, const Params& p, int l, int set, int tb) {
  int tid = threadIdx.x; asm volatile("" : "+v"(tid));
  const int L = 2048 << set;
  float* sz = sm;
  float* h1 = sm + 65 * 33;
  float* h2 = h1 + 65 * 64;
  const float* w1 = p.in[27] + (size_t)l * 33 * 64;
  const float* b1 = p.in[28] + l * 64;
  const float* fq_ = p.in[29] + l * 64;
  const float* w2 = p.in[30] + (size_t)l * 64 * 64;
  const float* b2 = p.in[31] + l * 64;
  const float* w3 = p.in[32] + (size_t)l * 64 * 1024;
  LDS_BARRIER();
  for (int e = tid; e < 65 * 33; e += 256) {
    int tt = e / 33, i = e % 33;
    int t = tb * 64 + tt;
    float val;
    if (i == 0) val = (float)t / (float)(L - 1);
    else {
      int b = (i - 1) & 15;
      float f = 1e-4f + (float)b * ((15.f - 1e-4f) / 15.f);
      float wang = 6.283185307179586f * (float)t / (float)L;
      val = i <= 16 ? cosf(f * wang) : -sinf(f * wang);
    }
    sz[e] = val;
  }
  LDS_BARRIER();
  {
    int j = tid & 63;
    float fj = fq_[j], bj = b1[j];
#pragma unroll 1
    for (int i = 0; i < 17; i++) {
      int tt = (tid >> 6) + 4 * i;
      if (tt < 65) {
        float a = bj;
        for (int k = 0; k < 33; k++) a += sz[tt * 33 + k] * w1[k * 64 + j];
        h1[tt * 64 + j] = sinf(fj * a);
      }
    }
  }
  LDS_BARRIER();
  {
    int j = tid & 63;
    float fj = fq_[j], bj = b2[j];
#pragma unroll 1
    for (int i = 0; i < 17; i++) {
      int tt = (tid >> 6) + 4 * i;
      if (tt < 65) {
        float a = bj;
        for (int k = 0; k < 64; k++) a += h1[tt * 64 + k] * w2[k * 64 + j];
        h2[tt * 64 + j] = sinf(fj * a);
      }
    }
  }
  LDS_BARRIER();
  const int c = tid;
  const float mind = -3.0701134573253943f, maxd = -15.350567286626972f;
  float delta = fabsf(mind + (float)c * ((maxd - mind) / 255.f));
  u16* kr = (u16*)(p.ws + O_HYKR) + (set ? HYKR1 : 0);
  float* ps = (float*)(p.ws + O_HYPS) + (size_t)(set ? 32 * 512 : 0) + (size_t)tb * 512;
#pragma unroll 1
  for (int order = 0; order < 2; order++) {
    u16* krc = kr + ((size_t)order * 256 + c) * (2 * L);
    float asum = 0.f, v00 = 0.f;
#pragma unroll 1
    for (int dir = 0; dir < 2; dir++) {
      float wc[64];
#pragma unroll
      for (int k = 0; k < 64; k++) wc[k] = w3[k * 1024 + order * 512 + dir * 256 + c];
      float hold = 0.f;
      const int ntt = dir == 0 ? 65 : 64;
#pragma unroll 1
      for (int tt = 0; tt < ntt; tt++) {
        float a = 0.f;
#pragma unroll
        for (int k = 0; k < 64; k++) a += h2[tt * 64 + k] * wc[k];
        int t = tb * 64 + tt;
        float tl = (float)t / (float)(L - 1);
        a *= expf(-tl * delta);
        if (t >= L) a = 0.f;
        if (tt < 64) asum += fabsf(a);
        if (dir == 0) {
          if (tt == 0) { if (tb == 0) v00 = a; }
          else if (tt & 1) hold = a;
          else *(unsigned*)(krc + (L - t)) = f2bf(a) | ((unsigned)f2bf(hold) << 16);
        } else {
          if (!(tt & 1)) hold = (t == 0) ? v00 + a : a;
          else *(unsigned*)(krc + (L + t - 1)) = f2bf(hold) | ((unsigned)f2bf(a) << 16);
        }
      }
    }
    ps[order * 256 + c] = asum;
  }
}

__device__ __forceinline__ void rms_rows_to_bf16(const Params& p, int l, int rowblk) {
  int tid_ = threadIdx.x; asm volatile("" : "+v"(tid_));
  const int lane = tid_ & 63, w = tid_ >> 6;
  float4 v[4][4];
#pragma unroll
  for (int j = 0; j < 4; j++) {
    const float* x = xrow(p, l, rowblk * 16 + w * 4 + j);
#pragma unroll
    for (int i = 0; i < 4; i++) v[j][i] = *(const float4*)(x + i * 256 + lane * 4);
  }
#pragma unroll
  for (int j = 0; j < 4; j++) {
    float ss = 0.f;
#pragma unroll
    for (int i = 0; i < 4; i++) ss += v[j][i].x * v[j][i].x + v[j][i].y * v[j][i].y + v[j][i].z * v[j][i].z + v[j][i].w * v[j][i].w;
    ss = wave_sum(ss);
    float rs = rsqrtf(ss * (1.f / 1024.f) + EPSF);
    u16* xn = (u16*)(p.ws + O_XN) + (size_t)(rowblk * 16 + w * 4 + j) * 1024;
#pragma unroll
    for (int i = 0; i < 4; i++) *(uint2*)(xn + i * 256 + lane * 4) = pack4(v[j][i].x * rs, v[j][i].y * rs, v[j][i].z * rs, v[j][i].w * rs);
  }
}

__device__ __forceinline__ void lru_item(char* smraw, const Params& p, int l, int item, int mode) {
  int tid = threadIdx.x; asm volatile("" : "+v"(tid)); const int _tid_pad = 0, lane = tid & 63, w = tid >> 6, fr = lane & 15, fq = lane >> 4;
  const int cki = item >> 2, head = item & 3;
  const int t0 = cki * 32;
  int lo, hi; seq_bounds(t0, lo, hi);
  float* xc = (float*)smraw;
  u16* xcb = (u16*)(smraw + 8192);
  float* sa = (float*)(smraw + 8192 + 4608);
  float* su = sa + 2 * 32 * 64;
  float* sx = su + 2 * 32 * 64;
  const u16* zA = (const u16*)(p.ws + O_ZA);
  LDS_BARRIER();
  {
    int ch = tid & 63, tq = tid >> 6;
    int gch = head * 64 + ch;
    const float* cw = p.in[4] + l * 4 * 256;
    float w0 = cw[gch], w1 = cw[256 + gch], w2 = cw[512 + gch], w3 = cw[768 + gch];
    float cb = p.in[5][l * 256 + gch];
    float win[11];
#pragma unroll
    for (int i = 0; i < 11; i++) {
      int tok = t0 + tq * 8 + i - 2;
      win[i] = (tok >= lo && tok < hi) ? bf2f(zA[(size_t)tok * 512 + gch]) : 0.f;
    }
#pragma unroll
    for (int i = 0; i < 8; i++) {
      float v = w0 * win[i] + w1 * win[i + 1] + w2 * win[i + 2] + w3 * win[i + 3] + cb;
      int tt = tq * 8 + i;
      xc[tt * 64 + ch] = v;
      xcb[tt * 72 + ch] = f2bf(v);
    }
  }
  LDS_BARRIER();
  {
    const int d = w >> 1, half = w & 1;
    const u16* wl = (const u16*)(p.ws + O_WLRU) + (size_t)head * 256 * 64;
    f32x4 accr[2][2], acci[2][2];
#pragma unroll
    for (int a = 0; a < 2; a++)
#pragma unroll
      for (int b = 0; b < 2; b++) { accr[a][b] = (f32x4){0, 0, 0, 0}; acci[a][b] = (f32x4){0, 0, 0, 0}; }
#pragma unroll
    for (int ks = 0; ks < 2; ks++) {
      bf16x8 af[2], br[2], bi[2];
#pragma unroll
      for (int mt = 0; mt < 2; mt++) af[mt] = *(const bf16x8*)(xcb + (16 * mt + fr) * 72 + ks * 32 + fq * 8);
#pragma unroll
      for (int nt = 0; nt < 2; nt++) {
        int nr = d * 128 + 32 * half + 16 * nt + fr;
        br[nt] = *(const bf16x8*)(wl + (size_t)nr * 64 + ks * 32 + fq * 8);
        bi[nt] = *(const bf16x8*)(wl + (size_t)(nr + 64) * 64 + ks * 32 + fq * 8);
      }
#pragma unroll
      for (int mt = 0; mt < 2; mt++)
#pragma unroll
        for (int nt = 0; nt < 2; nt++) {
          accr[mt][nt] = __builtin_amdgcn_mfma_f32_16x16x32_bf16(af[mt], br[nt], accr[mt][nt], 0, 0, 0);
          acci[mt][nt] = __builtin_amdgcn_mfma_f32_16x16x32_bf16(af[mt], bi[nt], acci[mt][nt], 0, 0, 0);
        }
    }
#pragma unroll
    for (int nt = 0; nt < 2; nt++) {
      int ch = 32 * half + 16 * nt + fr;
      int gch = head * 64 + ch;
      float brr = p.in[7][(l * 2 + d) * 256 + gch], bii = p.in[9][(l * 2 + d) * 256 + gch];
      float sp = softplusf_(-p.in[10][(l * 2 + d) * 256 + gch]);
#pragma unroll
      for (int mt = 0; mt < 2; mt++)
#pragma unroll
        for (int e = 0; e < 4; e++) {
          int tt = 16 * mt + 4 * fq + e;
          float r = 1.f / (1.f + __expf(-(accr[mt][nt][e] + brr)));
          float ig = 1.f / (1.f + __expf(-(acci[mt][nt][e] + bii)));
          float la = -8.f * r * sp;
          float a = __expf(la);
          float om = -la * (2.f + la * (2.f + la * (1.3333333f + la * (0.6666667f + la * 0.26666667f))));
          if (la < -0.25f) om = 1.f - a * a;
          float u = sqrtf(om) * (ig * xc[tt * 64 + ch]);
          sa[(d * 32 + tt) * 64 + ch] = a;
          su[(d * 32 + tt) * 64 + ch] = u;
        }
    }
  }
  LDS_BARRIER();
  {
    const int ch = tid & 63, d = (tid >> 6) & 1, half = tid >> 7;
    float A = 1.f, B = 0.f;
#pragma unroll
    for (int i = 0; i < 16; i++) {
      int tt = d == 0 ? half * 16 + i : half * 16 + 15 - i;
      float a = sa[(d * 32 + tt) * 64 + ch], u = su[(d * 32 + tt) * 64 + ch];
      A = a * A; B = a * B + u;
    }
    sx[((d * 2 + half) * 64 + ch) * 2] = A;
    sx[((d * 2 + half) * 64 + ch) * 2 + 1] = B;
  }
  LDS_BARRIER();
  if (mode == 0) {
    if (tid < 128) {
      int ch = tid & 63, d = tid >> 6;
      int first = d == 0 ? 0 : 1, second = 1 - first;
      float A1 = sx[((d * 2 + first) * 64 + ch) * 2], B1 = sx[((d * 2 + first) * 64 + ch) * 2 + 1];
      float A2 = sx[((d * 2 + second) * 64 + ch) * 2], B2 = sx[((d * 2 + second) * 64 + ch) * 2 + 1];
      float2 cr; cr.x = A2 * A1; cr.y = A2 * B1 + B2;
      ((float2*)(p.ws + O_LCAR))[((size_t)cki * 2 + d) * 256 + head * 64 + ch] = cr;
    }
    return;
  }
  {
    const int ch = tid & 63, d = (tid >> 6) & 1, half = tid >> 7;
    float h = ((const float*)(p.ws + O_LHIN))[((size_t)cki * 2 + d) * 256 + head * 64 + ch];
    int first = d == 0 ? 0 : 1;
    if (half != first) h = sx[((d * 2 + first) * 64 + ch) * 2] * h + sx[((d * 2 + first) * 64 + ch) * 2 + 1];
#pragma unroll
    for (int i = 0; i < 16; i++) {
      int tt = d == 0 ? half * 16 + i : half * 16 + 15 - i;
      float a = sa[(d * 32 + tt) * 64 + ch], u = su[(d * 32 + tt) * 64 + ch];
      h = a * h + u;
      su[(d * 32 + tt) * 64 + ch] = h;
    }
  }
  LDS_BARRIER();
  {
    int ch = tid & 63, tq = tid >> 6;
    u16* mixA = (u16*)(p.ws + O_XN);
#pragma unroll
    for (int i = 0; i < 8; i++) {
      int tt = tq * 8 + i, tok = t0 + tt;
      float hsum = su[tt * 64 + ch] + su[(32 + tt) * 64 + ch];
      float gate = bf2f(zA[(size_t)tok * 512 + 256 + head * 64 + ch]);
      mixA[(size_t)tok * 256 + head * 64 + ch] = f2bf(hsum * geluf_(gate));
    }
  }
}
__device__ __forceinline__ void lru_propagate(const Params& p, int idx) {
  int seq = idx >> 9, d = (idx >> 8) & 1, ch = idx & 255;
  int c0, nc;
  if (seq < 8) { c0 = seq * 64; nc = 64; } else { c0 = 512 + (seq - 8) * 128; nc = 128; }
  const float2* car = (const float2*)(p.ws + O_LCAR);
  float* hin = (float*)(p.ws + O_LHIN);
  float h = 0.f;
  for (int i = 0; i < nc; i++) {
    int ck = d == 0 ? c0 + i : c0 + nc - 1 - i;
    size_t o = ((size_t)ck * 2 + d) * 256 + ch;
    hin[o] = h;
    float2 ab = car[o];
    h = ab.x * h + ab.y;
  }
}
__device__ __forceinline__ void s5_propagate(const Params& p, int l, int idx) {
  int pp = idx & 63, d = (idx >> 6) & 1, g = (idx >> 7) & 15, seq = idx >> 11;
  int c0, nc;
  if (seq < 8) { c0 = seq * 32; nc = 32; } else { c0 = 256 + (seq - 8) * 64; nc = 64; }
  const float* ab64 = (const float*)(p.ws + O_AB64) + (size_t)l * 2 * 16 * 64 * 2;
  float ar = ab64[((d * 16 + g) * 64 + pp) * 2], ai = ab64[((d * 16 + g) * 64 + pp) * 2 + 1];
  const float* send = (const float*)(p.ws + O_SEND) + (size_t)g * 1280 * 256;
  u16* uh = (u16*)(p.ws + O_UH) + (size_t)g * 1280 * 1280;
  float hr = 0.f, hi = 0.f;
  for (int i = 0; i < nc; i++) {
    int ck = d == 0 ? c0 + i : c0 + nc - 1 - i;
    *(unsigned*)(uh + (size_t)ck * 1280 + 1024 + d * 128 + pp * 2) = f2bf(hr) | ((unsigned)f2bf(hi) << 16);
    float2 s = *(const float2*)(send + (size_t)ck * 256 + d * 128 + pp * 2);
    float nr = __fmaf_rn(ar, hr, __fmaf_rn(-ai, hi, s.x));
    float ni = __fmaf_rn(ar, hi, __fmaf_rn(ai, hr, s.y));
    asm volatile("" : "+v"(nr));
    asm volatile("" : "+v"(ni));
    hr = nr; hi = ni;
  }
}

#define AST 68
__device__ __forceinline__ void gdn_g1_item(char* smraw, const Params& p, int l, int item) {
  int tid = threadIdx.x; asm volatile("" : "+v"(tid)); const int _tid_pad = 0, lane = tid & 63, w = tid >> 6, fr = lane & 15, fq = lane >> 4;
  const int ck = item >> 2, h = item & 3;
  const int t0 = ck * 64;
  int lo, hi; seq_bounds(t0, lo, hi);
  u16* sk = (u16*)smraw;
  u16* sv = sk + 64 * 72;
  u16* Am = (u16*)(smraw + 2 * 64 * 72 * 2);
  float* sgc = (float*)(Am + 2 * 64 * 72);
  float* sbeta = sgc + 128;
  u16* Xs = (u16*)(sbeta + 128);
  const u16* zC = (const u16*)(p.ws + O_ZC);
  const float* ba = (const float*)(p.ws + O_BA);
  u16* qg = (u16*)(p.ws + O_XN);
  u16* kg = qg + (size_t)T_ALL * 256;
  u16* vg = kg + (size_t)T_ALL * 256;
  LDS_BARRIER();
  {
    const float* cw = p.in[21] + (size_t)l * 4 * 768;
    float wq[4], wk[4], wv[4];
#pragma unroll
    for (int j = 0; j < 4; j++) {
      wq[j] = cw[j * 768 + h * 64 + lane];
      wk[j] = cw[j * 768 + 256 + h * 64 + lane];
      wv[j] = cw[j * 768 + 512 + h * 64 + lane];
    }
#pragma unroll 4
    for (int rr = 0; rr < 16; rr++) {
      int c = w * 16 + rr, tok = t0 + c;
      float q = 0.f, k = 0.f, v = 0.f;
#pragma unroll
      for (int j = 0; j < 4; j++) {
        int tk = tok + j - 2;
        if (tk >= lo && tk < hi) {
          const u16* zr = zC + (size_t)tk * 1024 + h * 64 + lane;
          q += wq[j] * bf2f(zr[0]); k += wk[j] * bf2f(zr[256]); v += wv[j] * bf2f(zr[512]);
        }
      }
      q = siluf_(q); k = siluf_(k); v = siluf_(v);
      float sq = wave_sum(q * q), skk = wave_sum(k * k);
      q = q * rsqrtf(sq + EPSF) * 0.125f;
      k = k * rsqrtf(skk + EPSF);
      u16 kb = f2bf(k), vb = f2bf(v);
      sk[c * 72 + lane] = kb; sv[c * 72 + lane] = vb;
      qg[(size_t)tok * 256 + h * 64 + lane] = f2bf(q);
      kg[(size_t)tok * 256 + h * 64 + lane] = kb;
      vg[(size_t)tok * 256 + h * 64 + lane] = vb;
    }
  }
  if (tid < 128) {
    int d = tid >> 6, c = tid & 63;
    int tok = d == 0 ? t0 + c : t0 + 63 - c;
    float alog = p.in[22][(l * 2 + d) * 4 + h], dtb = p.in[23][(l * 2 + d) * 4 + h];
    float g = -__expf(alog) * softplusf_(ba[(size_t)tok * 16 + 8 + d * 4 + h] + dtb);
    float beta = 1.f / (1.f + __expf(-ba[(size_t)tok * 16 + d * 4 + h]));
    float s = g;
#pragma unroll
    for (int o = 1; o < 64; o <<= 1) { float t = __shfl_up(s, o); if (c >= o) s += t; }
    sgc[d * 64 + c] = s; sbeta[d * 64 + c] = beta;
    ((float*)(p.ws + O_GC))[(size_t)(h * 2 + d) * T_ALL + tok] = s;
  }
  LDS_BARRIER();
  {
    f32x4 acc[4];
#pragma unroll
    for (int nt = 0; nt < 4; nt++) acc[nt] = (f32x4){0, 0, 0, 0};
#pragma unroll
    for (int ks = 0; ks < 2; ks++) {
      bf16x8 af = *(const bf16x8*)(sk + (16 * w + fr) * 72 + ks * 32 + fq * 8);
#pragma unroll
      for (int nt = 0; nt < 4; nt++) {
        bf16x8 bfm = *(const bf16x8*)(sk + (16 * nt + fr) * 72 + ks * 32 + fq * 8);
        acc[nt] = __builtin_amdgcn_mfma_f32_16x16x32_bf16(af, bfm, acc[nt], 0, 0, 0);
      }
    }
#pragma unroll
    for (int nt = 0; nt < 4; nt++)
#pragma unroll
      for (int e = 0; e < 4; e++) {
        int c = 16 * w + 4 * fq + e, m = 16 * nt + fr;
        float gm = acc[nt][e];
        float a0 = c > m ? sbeta[c] * gm * __expf(sgc[c] - sgc[m]) : 0.f;
        Am[m * 72 + c] = f2bf(a0);
        int c1 = 63 - c, m1 = 63 - m;
        float a1 = c1 > m1 ? sbeta[64 + c1] * gm * __expf(sgc[64 + c1] - sgc[64 + m1]) : 0.f;
        Am[64 * 72 + m1 * 72 + c1] = f2bf(a1);
      }
  }
  LDS_BARRIER();
  {
    const int d = tid >> 7, col = tid & 127;
    const u16* AT = Am + d * 64 * 72;
    u16* Xd = Xs + d * 48 * 128;
    const u16* src = col < 64 ? sk : sv;
    const int e = col & 63;
    u16* wu = (u16*)(p.ws + O_WU) + ((size_t)(ck * 4 + h) * 2 + d) * 8192 + (col < 64 ? 0 : 4096);
#pragma unroll 1
    for (int b = 0; b < 4; b++) {
      float s[16];
#pragma unroll
      for (int r = 0; r < 16; r++) {
        int i = 16 * b + r;
        int tokr = d == 0 ? i : 63 - i;
        float rv = bf2f(src[tokr * 72 + e]) * sbeta[d * 64 + i];
        if (col < 64) rv *= __expf(sgc[d * 64 + i]);
        s[r] = rv;
      }
#pragma unroll 4
      for (int j = 0; j < 16 * b; j++) {
        float xj = bf2f(Xd[j * 128 + col]);
        const uint4* ar = (const uint4*)(AT + j * 72 + 16 * b);
        uint4 a0 = ar[0], a1 = ar[1];
        unsigned aw[8] = {a0.x, a0.y, a0.z, a0.w, a1.x, a1.y, a1.z, a1.w};
#pragma unroll
        for (int q = 0; q < 8; q++) {
          s[2 * q] -= __uint_as_float(aw[q] << 16) * xj;
          s[2 * q + 1] -= __uint_as_float(aw[q] & 0xffff0000u) * xj;
        }
      }
#pragma unroll
      for (int rp = 0; rp < 16; rp++) {
        u16 xb = f2bf(s[rp]);
        float xj = bf2f(xb);
        wu[(16 * b + rp) * 64 + e] = xb;
        if (b < 3) Xd[(16 * b + rp) * 128 + col] = xb;
        const uint4* ar = (const uint4*)(AT + (16 * b + rp) * 72 + 16 * b);
        uint4 a0 = ar[0], a1 = ar[1];
        unsigned aw[8] = {a0.x, a0.y, a0.z, a0.w, a1.x, a1.y, a1.z, a1.w};
#pragma unroll
        for (int r = rp + 1; r < 16; r++) {
          float av = (r & 1) ? __uint_as_float(aw[r >> 1] & 0xffff0000u) : __uint_as_float(aw[r >> 1] << 16);
          s[r] -= av * xj;
        }
      }
    }
  }
}

__device__ __forceinline__ void gdn_chain(char* smraw, const Params& p, int chain) {
  int tid = threadIdx.x; asm volatile("" : "+v"(tid)); const int _tid_pad = 0, lane = tid & 63, w = tid >> 6, fr = lane & 15, fq = lane >> 4;
  const int d = chain & 1, h = (chain >> 1) & 3, seq = chain >> 3;
  int c0, nc;
  if (seq < 8) { c0 = seq * 32; nc = 32; } else { c0 = 256 + (seq - 8) * 64; nc = 64; }
  u16* qs = (u16*)smraw;
  u16* qd = qs + 64 * 72;
  u16* ks_ = qd + 64 * 72;
  u16* kdT = ks_ + 64 * 72;
  u16* at = kdT + 64 * 72;
  u16* ST = at + 64 * 72;
  u16* VT = ST + 4 * 16 * 72;
  float* sgc = (float*)(VT + 4 * 16 * 72);
  const u16* qg = (const u16*)(p.ws + O_XN);
  const u16* kg = qg + (size_t)T_ALL * 256;
  const float* gcg = (const float*)(p.ws + O_GC);
  u16* og = (u16*)(p.ws + O_OD) + (size_t)d * T_ALL * 256;
  u16* STw = ST + w * 16 * 72;
  u16* VTw = VT + w * 16 * 72;
  f32x4 accS[4];
#pragma unroll
  for (int mt = 0; mt < 4; mt++) accS[mt] = (f32x4){0, 0, 0, 0};
  LDS_BARRIER();
  for (int e = lane; e < 16 * 72; e += 64) STw[e] = 0;
  const int prow = tid >> 2, pseg = tid & 3;
  float gcv_n, gl_n; uint4 q0n, q1n, k0n, k1n;
#define CHAIN_PREFETCH(IT) do {                                                                   \
    const int ck_ = d == 0 ? c0 + (IT) : c0 + nc - 1 - (IT);                                       \
    const int t0_ = ck_ * 64;                                                                      \
    const int tok_ = d == 0 ? t0_ + prow : t0_ + 63 - prow;                                        \
    gl_n = gcg[(size_t)(h * 2 + d) * T_ALL + (d == 0 ? t0_ + 63 : t0_)];                          \
    gcv_n = gcg[(size_t)(h * 2 + d) * T_ALL + tok_];                                               \
    const u16* qr_ = qg + (size_t)tok_ * 256 + h * 64 + pseg * 16;                                 \
    const u16* kr_ = kg + (size_t)tok_ * 256 + h * 64 + pseg * 16;                                 \
    q0n = *(const uint4*)qr_; q1n = *(const uint4*)(qr_ + 8);                                      \
    k0n = *(const uint4*)kr_; k1n = *(const uint4*)(kr_ + 8); } while (0)
  CHAIN_PREFETCH(0);
#pragma unroll 1
  for (int it = 0; it < nc; it++) {
    const int ck = d == 0 ? c0 + it : c0 + nc - 1 - it;
    const int t0 = ck * 64;
    const u16* wch = (const u16*)(p.ws + O_WU) + ((size_t)(ck * 4 + h) * 2 + d) * 8192;
    const u16* uch = wch + 4096;
    const float gl = gl_n;
    bf16x8 awr[4][2];
    u16 uvr[4][4];
#pragma unroll
    for (int mt = 0; mt < 4; mt++) {
#pragma unroll
      for (int ks = 0; ks < 2; ks++) awr[mt][ks] = *(const bf16x8*)(wch + (16 * mt + fr) * 64 + ks * 32 + fq * 8);
#pragma unroll
      for (int e = 0; e < 4; e++) uvr[mt][e] = uch[(16 * mt + 4 * fq + e) * 64 + 16 * w + fr];
    }
    {
      const int row = prow, seg = pseg;
      const float gcv = gcv_n;
      if (seg == 0) sgc[row] = gcv;
      float eq = __expf(gcv), ek = __expf(gl - gcv);
      const uint4 q0 = q0n, q1 = q1n, k0 = k0n, k1 = k1n;
      if (it + 1 < nc) CHAIN_PREFETCH(it + 1);
      *(uint4*)(qs + row * 72 + seg * 16) = q0; *(uint4*)(qs + row * 72 + seg * 16 + 8) = q1;
      *(uint4*)(ks_ + row * 72 + seg * 16) = k0; *(uint4*)(ks_ + row * 72 + seg * 16 + 8) = k1;
      unsigned qa[8] = {q0.x, q0.y, q0.z, q0.w, q1.x, q1.y, q1.z, q1.w};
      unsigned ka[8] = {k0.x, k0.y, k0.z, k0.w, k1.x, k1.y, k1.z, k1.w};
#pragma unroll
      for (int i = 0; i < 8; i++) {
        float qa0 = bf2f((u16)(qa[i] & 0xffff)) * eq, qa1 = bf2f((u16)(qa[i] >> 16)) * eq;
        *(unsigned*)(qd + row * 72 + seg * 16 + 2 * i) = f2bf(qa0) | ((unsigned)f2bf(qa1) << 16);
        float kb0 = bf2f((u16)(ka[i] & 0xffff)) * ek, kb1 = bf2f((u16)(ka[i] >> 16)) * ek;
        kdT[(seg * 16 + 2 * i) * 72 + row] = f2bf(kb0);
        kdT[(seg * 16 + 2 * i + 1) * 72 + row] = f2bf(kb1);
      }
    }
    LDS_BARRIER();
    {
      f32x4 acc[4];
#pragma unroll
      for (int nt = 0; nt < 4; nt++) acc[nt] = (f32x4){0, 0, 0, 0};
#pragma unroll
      for (int ks = 0; ks < 2; ks++) {
        bf16x8 af = *(const bf16x8*)(qs + (16 * w + fr) * 72 + ks * 32 + fq * 8);
#pragma unroll
        for (int nt = 0; nt < 4; nt++) {
          bf16x8 bfm = *(const bf16x8*)(ks_ + (16 * nt + fr) * 72 + ks * 32 + fq * 8);
          acc[nt] = __builtin_amdgcn_mfma_f32_16x16x32_bf16(af, bfm, acc[nt], 0, 0, 0);
        }
      }
#pragma unroll
      for (int nt = 0; nt < 4; nt++)
#pragma unroll
        for (int e = 0; e < 4; e++) {
          int c = 16 * w + 4 * fq + e, m = 16 * nt + fr;
          float v = c >= m ? acc[nt][e] * __expf(sgc[c] - sgc[m]) : 0.f;
          at[c * 72 + m] = f2bf(v);
        }
    }
    LDS_BARRIER();
    {
      const int e0 = 16 * w;
      f32x4 av[4];
#pragma unroll
      for (int mt = 0; mt < 4; mt++) av[mt] = (f32x4){0, 0, 0, 0};
#pragma unroll
      for (int ks = 0; ks < 2; ks++) {
        bf16x8 bS = *(const bf16x8*)(STw + fr * 72 + ks * 32 + fq * 8);
#pragma unroll
        for (int mt = 0; mt < 4; mt++) {
          av[mt] = __builtin_amdgcn_mfma_f32_16x16x32_bf16(awr[mt][ks], bS, av[mt], 0, 0, 0);
        }
      }
#pragma unroll
      for (int mt = 0; mt < 4; mt++) {
        u16 hv[4];
#pragma unroll
        for (int e = 0; e < 4; e++) {
          int c = 16 * mt + 4 * fq + e;
          float vn = bf2f(uvr[mt][e]) - av[mt][e];
          hv[e] = f2bf(vn);
        }
        uint2 pk; pk.x = hv[0] | ((unsigned)hv[1] << 16); pk.y = hv[2] | ((unsigned)hv[3] << 16);
        *(uint2*)(VTw + fr * 72 + 16 * mt + 4 * fq) = pk;
      }
      __builtin_amdgcn_wave_barrier();
      f32x4 ao[4];
#pragma unroll
      for (int mt = 0; mt < 4; mt++) ao[mt] = (f32x4){0, 0, 0, 0};
#pragma unroll
      for (int ks = 0; ks < 2; ks++) {
        bf16x8 bS = *(const bf16x8*)(STw + fr * 72 + ks * 32 + fq * 8);
        bf16x8 bV = *(const bf16x8*)(VTw + fr * 72 + ks * 32 + fq * 8);
#pragma unroll
        for (int mt = 0; mt < 4; mt++) {
          bf16x8 aq = *(const bf16x8*)(qd + (16 * mt + fr) * 72 + ks * 32 + fq * 8);
          bf16x8 aa = *(const bf16x8*)(at + (16 * mt + fr) * 72 + ks * 32 + fq * 8);
          ao[mt] = __builtin_amdgcn_mfma_f32_16x16x32_bf16(aq, bS, ao[mt], 0, 0, 0);
          ao[mt] = __builtin_amdgcn_mfma_f32_16x16x32_bf16(aa, bV, ao[mt], 0, 0, 0);
        }
      }
#pragma unroll
      for (int mt = 0; mt < 4; mt++)
#pragma unroll
        for (int e = 0; e < 4; e++) {
          int c = 16 * mt + 4 * fq + e;
          int tok = d == 0 ? t0 + c : t0 + 63 - c;
          og[(size_t)tok * 256 + h * 64 + e0 + fr] = f2bf(ao[mt][e]);
        }
      float egl = __expf(gl);
#pragma unroll
      for (int mt = 0; mt < 4; mt++) accS[mt] = accS[mt] * egl;
#pragma unroll
      for (int ks = 0; ks < 2; ks++) {
        bf16x8 bV = *(const bf16x8*)(VTw + fr * 72 + ks * 32 + fq * 8);
#pragma unroll
        for (int mt = 0; mt < 4; mt++) {
          bf16x8 ak = *(const bf16x8*)(kdT + (16 * mt + fr) * 72 + ks * 32 + fq * 8);
          accS[mt] = __builtin_amdgcn_mfma_f32_16x16x32_bf16(ak, bV, accS[mt], 0, 0, 0);
        }
      }
      __builtin_amdgcn_wave_barrier();
#pragma unroll
      for (int mt = 0; mt < 4; mt++) {
        uint2 pk;
        pk.x = f2bf(accS[mt][0]) | ((unsigned)f2bf(accS[mt][1]) << 16);
        pk.y = f2bf(accS[mt][2]) | ((unsigned)f2bf(accS[mt][3]) << 16);
        *(uint2*)(STw + fr * 72 + 16 * mt + 4 * fq) = pk;
      }
    }
    LDS_BARRIER();
  }
}
__device__ __forceinline__ void gdn_final_rows(const Params& p, int l, int rowblk) {
  int tid_ = threadIdx.x; asm volatile("" : "+v"(tid_));
  const int lane = tid_ & 63, w = tid_ >> 6;
  const int tok0 = rowblk * 16 + w * 4;
  const u16* o0 = (const u16*)(p.ws + O_OD) + (size_t)tok0 * 256 + lane * 4;
  const u16* o1 = o0 + (size_t)T_ALL * 256;
  const u16* zg = (const u16*)(p.ws + O_ZC) + (size_t)tok0 * 1024 + 768 + lane * 4;
  uint2 a[4], b[4], g[4];
#pragma unroll
  for (int j = 0; j < 4; j++) { a[j] = *(const uint2*)(o0 + j * 256); b[j] = *(const uint2*)(o1 + j * 256); g[j] = *(const uint2*)(zg + j * 1024); }
  const float* nw = p.in[24] + l * 64 + (lane & 15) * 4;
  const float n0 = nw[0], n1 = nw[1], n2 = nw[2], n3 = nw[3];
  u16* dst = (u16*)(p.ws + O_XN) + (size_t)2 * T_ALL * 256 + (size_t)tok0 * 256 + lane * 4;
#pragma unroll
  for (int j = 0; j < 4; j++) {
    float o[4], gt[4];
    o[0] = bf2f(a[j].x & 0xffff) + bf2f(b[j].x & 0xffff); o[1] = bf2f(a[j].x >> 16) + bf2f(b[j].x >> 16);
    o[2] = bf2f(a[j].y & 0xffff) + bf2f(b[j].y & 0xffff); o[3] = bf2f(a[j].y >> 16) + bf2f(b[j].y >> 16);
    gt[0] = bf2f(g[j].x & 0xffff); gt[1] = bf2f(g[j].x >> 16); gt[2] = bf2f(g[j].y & 0xffff); gt[3] = bf2f(g[j].y >> 16);
    float ss = o[0] * o[0] + o[1] * o[1] + o[2] * o[2] + o[3] * o[3];
#pragma unroll
    for (int m = 8; m > 0; m >>= 1) ss += __shfl_xor(ss, m);
    float rs = rsqrtf(ss * (1.f / 64.f) + EPSF);
    if (!(MIXMASK & 4)) rs = 0.f;
    *(uint2*)(dst + j * 256) = pack4(o[0] * rs * n0 * siluf_(gt[0]), o[1] * rs * n1 * siluf_(gt[1]), o[2] * rs * n2 * siluf_(gt[2]), o[3] * rs * n3 * siluf_(gt[3]));
  }
}
__device__ __forceinline__ void grpnorm_rows(const Params& p, int l, int which, int rowblk) {
  int tid_ = threadIdx.x; asm volatile("" : "+v"(tid_));
  const int lane = tid_ & 63, w = tid_ >> 6;
  u16* m0 = (u16*)(p.ws + O_XN) + (size_t)which * T_ALL * 256 + (size_t)(rowblk * 16 + w * 4) * 256 + lane * 4;
  uint2 a[4];
#pragma unroll
  for (int j = 0; j < 4; j++) a[j] = *(const uint2*)(m0 + j * 256);
  const float* gn = p.in[34] + (l * 3 + which) * 256 + lane * 4;
  const float g0 = gn[0], g1 = gn[1], g2 = gn[2], g3 = gn[3];
#pragma unroll
  for (int j = 0; j < 4; j++) {
    float v[4] = {bf2f(a[j].x & 0xffff), bf2f(a[j].x >> 16), bf2f(a[j].y & 0xffff), bf2f(a[j].y >> 16)};
    float ss = wave_sum(v[0] * v[0] + v[1] * v[1] + v[2] * v[2] + v[3] * v[3]);
    float rs = rsqrtf(ss * (1.f / 256.f) + EPSF);
    if (!((MIXMASK >> which) & 1)) rs = 0.f;
    *(uint2*)(m0 + j * 256) = pack4(v[0] * rs * g0, v[1] * rs * g1, v[2] * rs * g2, v[3] * rs * g3);
  }
}

#define WST 1296
#define UST 264
__device__ __forceinline__ float hy_conv3(const u16* __restrict__ raw, int t, int L, float w0, float w1, float w2, float b) {
  float xm = t > 0 ? bf2f(raw[t - 1]) : 0.f;
  float x0 = bf2f(raw[t]);
  float xp = t + 1 < L ? bf2f(raw[t + 1]) : 0.f;
  return w0 * xm + w1 * x0 + w2 * xp + b;
}
__device__ __forceinline__ void hy_conv_item(char* smraw, const Params& p, int l, int stage, int set, int c, int tb) {
  int tid = threadIdx.x; asm volatile("" : "+v"(tid)); const int _tid_pad = 0, lane = tid & 63, w = tid >> 6, fr = lane & 15, fq = lane >> 4;
  const int L = 2048 << set, nb = 8 << set, base = set ? T_P : 0;
  const int T0 = tb * 1024;
  u16* win = (u16*)smraw;
  u16* su = win + 8 * WST;
  float* sinv = (float*)(su + 16 * UST);
  const u16* dt = (const u16*)(p.ws + O_DT);
  const u16* rawv = dt + (size_t)c * T_ALL + base;
  const u16* rawx = dt + (size_t)((stage + 1) * 256 + c) * T_ALL + base;
  const u16* y1 = (const u16*)(p.ws + O_Y1) + (size_t)c * T_ALL + base;
  u16* outp = stage == 0 ? (u16*)(p.ws + O_Y1) + (size_t)c * T_ALL + base
                         : (u16*)(p.ws + O_DT) + (size_t)(256 + c) * T_ALL + base;
  const u16* kr = (const u16*)(p.ws + O_HYKR) + (set ? HYKR1 : 0) + ((size_t)stage * 256 + c) * (2 * L);
  const float* cw = p.in[25] + (size_t)l * 3 * 768;
  const float* cb = p.in[26] + (size_t)l * 768;
  const float v0 = cw[c], v1 = cw[768 + c], v2 = cw[1536 + c], vb = cb[c];
  const int xc_ = (stage + 1) * 256 + c;
  const float x0w = cw[xc_], x1w = cw[768 + xc_], x2w = cw[1536 + xc_], xbw = cb[xc_];
  LDS_BARRIER();
  if (tid < 64) {
    const float* ps = (const float*)(p.ws + O_HYPS) + (size_t)(set ? 32 * 512 : 0);
    int ntb = L / 64;
    float s = 0.f;
    for (int i = lane; i < ntb; i += 64) s += ps[(size_t)i * 512 + stage * 256 + c];
    s = wave_sum(s);
    if (lane == 0) sinv[0] = 1.f / s;
  }
  f32x4 acc[16];
#pragma unroll
  for (int i = 0; i < 16; i++) acc[i] = (f32x4){0, 0, 0, 0};
  for (int S0 = 0; S0 < L; S0 += 256) {
    LDS_BARRIER();
    const int B0 = S0 - T0;
    for (int idx = tid; idx < 8 * 160; idx += 256) {
      int rho = idx / 160, gi = idx % 160;
      int ybase = B0 - 1016 + 8 * gi - rho + L;
      int a = ybase & ~1;
      uint4 pk;
      if (a >= 0 && a + 10 <= 2 * L) {
        const unsigned* kd = (const unsigned*)(kr + a);
        unsigned d0 = kd[0], d1 = kd[1], d2 = kd[2], d3 = kd[3], d4 = kd[4];
        if (ybase & 1) {
          pk.x = __builtin_amdgcn_alignbit(d1, d0, 16); pk.y = __builtin_amdgcn_alignbit(d2, d1, 16);
          pk.z = __builtin_amdgcn_alignbit(d3, d2, 16); pk.w = __builtin_amdgcn_alignbit(d4, d3, 16);
        } else { pk.x = d0; pk.y = d1; pk.z = d2; pk.w = d3; }
      } else {
        u16 hh[8];
#pragma unroll
        for (int e = 0; e < 8; e++) { int yy = ybase + e; hh[e] = (yy >= 0 && yy < 2 * L) ? kr[yy] : (u16)0; }
        pk.x = hh[0] | ((unsigned)hh[1] << 16); pk.y = hh[2] | ((unsigned)hh[3] << 16);
        pk.z = hh[4] | ((unsigned)hh[5] << 16); pk.w = hh[6] | ((unsigned)hh[7] << 16);
      }
      *(uint4*)(win + rho * WST + 8 * gi) = pk;
    }
    {
      int b = tid >> 4, seg = tid & 15;
      uint4 p0 = make_uint4(0, 0, 0, 0), p1 = make_uint4(0, 0, 0, 0);
      if (b < nb) {
        const u16* src = (stage == 0 ? rawv : y1) + (size_t)b * L;
        const int s0 = S0 + seg * 16;
        uint4 r0 = *(const uint4*)(src + s0), r1 = *(const uint4*)(src + s0 + 8);
        if (stage == 0) {
          unsigned w[8] = {r0.x, r0.y, r0.z, r0.w, r1.x, r1.y, r1.z, r1.w};
          float x[18];
          x[0] = s0 > 0 ? bf2f(src[s0 - 1]) : 0.f;
          x[17] = s0 + 16 < L ? bf2f(src[s0 + 16]) : 0.f;
#pragma unroll
          for (int q = 0; q < 8; q++) { x[1 + 2 * q] = __uint_as_float(w[q] << 16); x[2 + 2 * q] = __uint_as_float(w[q] & 0xffff0000u); }
          unsigned o[8];
#pragma unroll
          for (int q = 0; q < 8; q++) {
            float c0 = v0 * x[2 * q] + v1 * x[2 * q + 1] + v2 * x[2 * q + 2] + vb;
            float c1 = v0 * x[2 * q + 1] + v1 * x[2 * q + 2] + v2 * x[2 * q + 3] + vb;
            o[q] = f2bf(c0) | ((unsigned)f2bf(c1) << 16);
          }
          p0 = make_uint4(o[0], o[1], o[2], o[3]); p1 = make_uint4(o[4], o[5], o[6], o[7]);
        } else { p0 = r0; p1 = r1; }
      }
      *(uint4*)(su + b * UST + seg * 16) = p0;
      *(uint4*)(su + b * UST + seg * 16 + 8) = p1;
    }
    LDS_BARRIER();
    bf16x8 bfr[8];
#pragma unroll
    for (int j = 0; j < 8; j++) bfr[j] = *(const bf16x8*)(su + fr * UST + 32 * j + 8 * fq);
    const u16* wbase = win + (fr & 7) * WST + (8 * fq - 256 * w - 8 * (fr >> 3) + 1016);
    __builtin_amdgcn_s_setprio(1);
#pragma unroll
    for (int dd = 0; dd < 30; dd++) {
      bf16x8 af = *(const bf16x8*)(wbase + 16 * (dd - 15));
#pragma unroll
      for (int j = 0; j < 8; j++) {
        const int i = 2 * j - (dd - 15);
        if (i >= 0 && i < 16) acc[i] = __builtin_amdgcn_mfma_f32_16x16x32_bf16(af, bfr[j], acc[i], 0, 0, 0);
      }
    }
    __builtin_amdgcn_s_setprio(0);
  }
  LDS_BARRIER();
  const float inv = sinv[0];
  const float bias = p.in[33][(size_t)(l * 2 + stage) * 256 + c];
  if (fr < nb) {
#pragma unroll
    for (int i = 0; i < 16; i++) {
      u16 r[4];
#pragma unroll
      for (int e = 0; e < 4; e++) {
        int t = T0 + 256 * w + 16 * i + 4 * fq + e;
        float uval = stage == 0 ? hy_conv3(rawv + (size_t)fr * L, t, L, v0, v1, v2, vb) : bf2f(y1[(size_t)fr * L + t]);
        float xg = hy_conv3(rawx + (size_t)fr * L, t, L, x0w, x1w, x2w, xbw);
        r[e] = f2bf(xg * (acc[i][e] * inv + bias * uval));
      }
      uint2 pk; pk.x = r[0] | ((unsigned)r[1] << 16); pk.y = r[2] | ((unsigned)r[3] << 16);
      *(uint2*)(outp + (size_t)fr * L + T0 + 256 * w + 16 * i + 4 * fq) = pk;
    }
  }
}
__device__ __forceinline__ void hy_final_item(char* smraw, const Params& p, int l, int ck) {
  int tid = threadIdx.x; asm volatile("" : "+v"(tid)); const int _tid_pad = 0, lane = tid & 63, w = tid >> 6;
  float* s = (float*)smraw;
  const u16* yd = (const u16*)(p.ws + O_DT) + (size_t)256 * T_ALL;
  const int t0 = ck * 64;
  LDS_BARRIER();
#pragma unroll 16
  for (int i = 0; i < 64; i++) {
    int c = w * 64 + i;
    s[lane * 257 + c] = bf2f(yd[(size_t)c * T_ALL + t0 + lane]);
  }
  LDS_BARRIER();
  const float* gn = p.in[34] + (l * 3 + 2) * 256;
  u16* mixD = (u16*)(p.ws + O_XN) + (size_t)3 * T_ALL * 256;
  for (int i = 0; i < 16; i++) {
    int tt = w * 16 + i;
    float v[4];
#pragma unroll
    for (int e = 0; e < 4; e++) v[e] = s[tt * 257 + lane * 4 + e];
    float ss = wave_sum(v[0] * v[0] + v[1] * v[1] + v[2] * v[2] + v[3] * v[3]);
    float rs = rsqrtf(ss * (1.f / 256.f) + EPSF);
    if (!(MIXMASK & 8)) rs = 0.f;
    uint2 pk;
    pk.x = f2bf(v[0] * rs * gn[lane * 4]) | ((unsigned)f2bf(v[1] * rs * gn[lane * 4 + 1]) << 16);
    pk.y = f2bf(v[2] * rs * gn[lane * 4 + 2]) | ((unsigned)f2bf(v[3] * rs * gn[lane * 4 + 3]) << 16);
    *(uint2*)(mixD + (size_t)(t0 + tt) * 256 + lane * 4) = pk;
  }
}

#define XB_CENS(j) (64 + 64 * (j))
#define XB_XSUB(j) (1088 + 64 * (j))
#define XB_XGEN(j) (2112 + 64 * (j))
#define XB_TOP 3136
#define XB_TOPGEN 3200
__device__ __forceinline__ unsigned xb_ld(unsigned* p) { return __hip_atomic_load(p, __ATOMIC_RELAXED, __HIP_MEMORY_SCOPE_AGENT); }
__device__ __forceinline__ unsigned xb_add(unsigned* p, unsigned v) { return __hip_atomic_fetch_add(p, v, __ATOMIC_RELAXED, __HIP_MEMORY_SCOPE_AGENT); }
__device__ __forceinline__ void xcd_barrier(unsigned* bar, unsigned x, unsigned nloc, unsigned nx, unsigned k) {
  asm volatile("s_waitcnt vmcnt(0) lgkmcnt(0)" ::: "memory");
  __syncthreads();
  if (threadIdx.x == 0) {
    const unsigned old = xb_add(&bar[XB_XSUB(x)], 1u);
    if (old + 1u == k * nloc) {
      __builtin_amdgcn_fence(__ATOMIC_RELEASE, "agent");
      asm volatile("s_waitcnt vmcnt(0)" ::: "memory");
      const unsigned og = xb_add(&bar[XB_TOP], 1u);
      if (og + 1u == k * nx) xb_add(&bar[XB_TOPGEN], 1u);
      else while (xb_ld(&bar[XB_TOPGEN]) < k) __builtin_amdgcn_s_sleep(1);
      __builtin_amdgcn_fence(__ATOMIC_ACQUIRE, "agent");
      xb_add(&bar[XB_XGEN(x)], 1u);
      asm volatile("s_waitcnt vmcnt(0)" ::: "memory");
    } else {
      while (xb_ld(&bar[XB_XGEN(x)]) < k) __builtin_amdgcn_s_sleep(1);
      __builtin_amdgcn_fence(__ATOMIC_ACQUIRE, "agent");
      asm volatile("s_waitcnt vmcnt(0)" ::: "memory");
    }
  }
  __syncthreads();
}
#define GRID_SYNC() do { ++bar_k; xcd_barrier(bar, bst[0], bst[1], bst[2], bar_k); } while (0)

#define TILE_LOOP(nM_, nN_, MT, NT)                                                                  \
  const int nSN_ = ((nN_) + 7) >> 3, nS_ = (((nM_) + 7) >> 3) * nSN_, P_ = nblk >> 3;                 \
  _Pragma("unroll 1") for (int S_ = (bid & 7); S_ < nS_ && (bid >> 3) < P_; S_ += 8)                 \
  _Pragma("unroll 1") for (int q_ = (bid >> 3); q_ < 64; q_ += P_)                                   \
    for (int MT = (S_ / nSN_) * 8 + (q_ >> 3), NT = (S_ % nSN_) * 8 + (q_ & 7), once_ = 1; once_ && MT < (nM_) && NT < (nN_); once_ = 0)

__global__ void __launch_bounds__(256, 2) mega(Params p) {
  cg::grid_group grid = cg::this_grid();
  __shared__ __attribute__((aligned(16))) char smraw[SMEM_BYTES];
  u16* smem = (u16*)smraw;
  float* smf = (float*)smraw;
  const int bid = blockIdx.x, nblk = gridDim.x, tid = threadIdx.x;
  const int rbid = nblk - 1 - bid;
  const int lane = tid & 63;
  char* const ws = p.ws;
  unsigned* const bar = (unsigned*)(ws + O_BAR);
  __shared__ unsigned bst[4];
  unsigned bar_k = 0;
  if (tid == 0) { bst[0] = (unsigned)__builtin_amdgcn_s_getreg((3 << 11) | 20) & 0xFu; xb_add(&bar[XB_CENS(bst[0])], 1u); }
  __threadfence();
  grid.sync();
  if (tid == 0) {
    unsigned mine = 0, cnt = 0;
    for (unsigned j = 0; j < 16; j++) { unsigned c = xb_ld(&bar[XB_CENS(j)]); cnt += c > 0u ? 1u : 0u; if (j == bst[0]) mine = c; }
    bst[1] = mine; bst[2] = cnt;
  }
  __syncthreads();

#ifdef NANFILL
  {
    uint4 nanv = make_uint4(0x7FC07FC0u, 0x7FC07FC0u, 0x7FC07FC0u, 0x7FC07FC0u);
    uint4* w4 = (uint4*)ws;
    for (size_t i = (size_t)bid * 256 + tid; i < WS_TOTAL / 16; i += (size_t)nblk * 256) w4[i] = nanv;
    uint4* o4 = (uint4*)p.out;
    for (size_t i = (size_t)bid * 256 + tid; i < (size_t)T_ALL * DM / 4; i += (size_t)nblk * 256) o4[i] = nanv;
    __threadfence(); grid.sync(); __threadfence();
  }
#endif
#pragma unroll 1
  for (int lay = 0; lay < 2; lay++) {
    {
      int l = lay; asm volatile("" : "+s"(l));
#pragma unroll 1
      for (int i = bid; i < 42 * 16; i += nblk) transpose_tile(smf, p.in[3] + (size_t)l * 1024 * 2576, 2576, p.in[2] + l * 1024, (u16*)(ws + O_WIN), 1024, 0, (i / 16) * 64, (i % 16) * 64);
#pragma unroll 1
      for (int i = rbid; i < 16 * 16; i += nblk) transpose_tile(smf, p.in[35] + (size_t)l * 1024 * 1024, 1024, nullptr, (u16*)(ws + O_WOUT), 1024, 1, (i / 16) * 64, (i % 16) * 64);
#pragma unroll 1
      for (int i = bid; i < 88 * 16; i += nblk) transpose_tile(smf, p.in[37] + (size_t)l * 1024 * 5632, 5632, p.in[36] + l * 1024, (u16*)(ws + O_WUP), 1024, 2, (i / 16) * 64, (i % 16) * 64);
#pragma unroll 1
      for (int i = rbid; i < 16 * 44; i += nblk) transpose_tile(smf, p.in[40] + (size_t)l * 2816 * 1024, 1024, nullptr, (u16*)(ws + O_WDN), 2816, 3, (i / 44) * 64, (i % 44) * 64);
#pragma unroll 1
      for (int i = bid; i < 16; i += nblk) transpose_tile(smf, p.in[19] + (size_t)l * 256 * 256, 256, nullptr, (u16*)(ws + O_WGLU), 256, 4, (i / 4) * 64, (i % 4) * 64);
#pragma unroll 1
      for (int i = rbid; i < 64; i += nblk) {
        u16* wl = (u16*)(ws + O_WLRU);
        for (int e = i * 1024 + tid; e < (i + 1) * 1024; e += 256) {
          int k = e & 63, n = (e >> 6) & 255, head = e >> 14;
          int d = n >> 7, gate = (n >> 6) & 1, j = n & 63;
          const float* wr_ = p.in[6]; const float* wi_ = p.in[8];
          size_t off_ = ((size_t)((l * 2 + d) * 4 + head) * 64 + k) * 64 + j;
          float vr_ = wr_[off_], vi_ = wi_[off_];
          wl[e] = f2bf(gate ? vi_ : vr_);
        }
      }
#pragma unroll 1
      for (int i = bid; i < 16 * 2 * 65; i += nblk) s5_prep_item(smf, p, l, i);
#pragma unroll 1
      for (int i = rbid; i < 16 * 2 * 64; i += nblk) s5_bts_item(p, l, i);
#pragma unroll 1
      for (int i = rbid; i < 96; i += nblk) hy_filter_item(smf, p, l, i < 32 ? 0 : 1, i < 32 ? i : i - 32);
      {
        unsigned* rq = (unsigned*)(ws + O_BAR + 208) + l;
        int* rslot = (int*)(smraw + SMEM_BYTES - 16);
#pragma unroll 1
        for (;;) {
          __syncthreads();
          if (tid == 0) *rslot = (int)atomicAdd(rq, 1u);
          __syncthreads();
          const int c0 = *rslot * 4;
          if (c0 >= T_ALL / 16) break;
#pragma unroll 1
          for (int i = c0; i < c0 + 4; i++) rms_rows_to_bf16(p, l, i);
        }
      }
    }
    GRID_SYNC();
    {
      int l = lay; asm volatile("" : "+s"(l));
      TILE_LOOP(640, 21, mt, nt) {
        { const float* H = gemm_tile(smem, (const u16*)(ws + O_XN), 1024, mt * 128, 0, T_ALL, 30, 0, (const u16*)(ws + O_WIN) + (size_t)nt * 128 * 1024, 1024, 1024);
            int tid_o = threadIdx.x; asm volatile("" : "+v"(tid_o));
            const int tok0 = mt * 128;
            if (nt < 4) {
              u16* zA = (u16*)(ws + O_ZA) + (size_t)tok0 * 512 + nt * 128;
              EPI_ROWS(H, { *(uint2*)(zA + (size_t)r * 512 + c) = pack4(v.x, v.y, v.z, v.w); })
            } else if (nt < 6) {
              u16* uh = (u16*)(ws + O_UH);
              EPI_ROWS(H, {
                int tok = tok0 + r, ch = (nt - 4) * 128 + c;
                *(uint2*)(uh + ((size_t)(ch >> 4) * 1280 + (tok >> 6)) * 1280 + (tok & 63) * 16 + (ch & 15)) = pack4(v.x, v.y, v.z, v.w); })
            } else if (nt < 14) {
              u16* zC = (u16*)(ws + O_ZC) + (size_t)tok0 * 1024 + (nt - 6) * 128;
              EPI_ROWS(H, { *(uint2*)(zC + (size_t)r * 1024 + c) = pack4(v.x, v.y, v.z, v.w); })
            } else if (nt < 20) {
              u16* dt = (u16*)(ws + O_DT) + (size_t)((nt - 14) * 128 + (tid_o & 127)) * T_ALL + tok0 + (tid_o >> 7) * 64;
              const float* Hc = H + (tid_o >> 7) * 64 * HST + (tid_o & 127);
#pragma unroll 2
              for (int k = 0; k < 8; k++) {
                uint2 a = pack4(Hc[(8 * k) * HST], Hc[(8 * k + 1) * HST], Hc[(8 * k + 2) * HST], Hc[(8 * k + 3) * HST]);
                uint2 b = pack4(Hc[(8 * k + 4) * HST], Hc[(8 * k + 5) * HST], Hc[(8 * k + 6) * HST], Hc[(8 * k + 7) * HST]);
                uint4 pk; pk.x = a.x; pk.y = a.y; pk.z = b.x; pk.w = b.y;
                *(uint4*)(dt + 8 * k) = pk;
              }
            } else {
              float* ba = (float*)(ws + O_BA) + (size_t)tok0 * 16;
#pragma unroll 2
              for (int k = 0; k < 8; k++) { int idx = tid_o + 256 * k; ba[idx] = H[(idx >> 4) * HST + (idx & 15)]; }
            }
          }
      }
#pragma unroll 1
      for (int it = rbid; it < 16 * 1024; it += nblk) s5_expand_item(p, l, it);
    }
    GRID_SYNC();
    {
      int l = lay; asm volatile("" : "+s"(l));
#pragma unroll 1
      for (int it = bid; it < NCH64 * 4; it += nblk) gdn_g1_item(smraw, p, l, it);
#pragma unroll 1
      for (int it = rbid; it < 16 * 10 * 2; it += nblk) {
        const int g = it / 20, mt = (it % 20) >> 1, nt = it & 1;
        { const float* H = gemm_tile(smem, (const u16*)(ws + O_UH) + (size_t)g * 1280 * 1280, 1280, mt * 128, 0, 1280, 30, 0,
                  (const u16*)(ws + O_BTS) + (size_t)g * 256 * 1024 + (size_t)nt * 128 * 1024, 1024, 1024);
            int tid_o = threadIdx.x; asm volatile("" : "+v"(tid_o));
            float* send = (float*)(ws + O_SEND) + (size_t)g * 1280 * 256 + (size_t)mt * 128 * 256 + nt * 128;
            EPI_ROWS(H, { *(float4*)(send + (size_t)r * 256 + c) = v; })
          }
      }
#pragma unroll 1
      for (int it = bid; it < NCH32 * 4; it += nblk) lru_item(smraw, p, l, it, 0);
    }
    GRID_SYNC();
    {
      int l = lay; asm volatile("" : "+s"(l));
#pragma unroll 1
      for (int it = bid; it < 192; it += nblk) gdn_chain(smraw, p, it);
#pragma unroll 1
      for (int it = rbid; it < 48; it += nblk) lru_propagate(p, it * 256 + tid);
#pragma unroll 1
      for (int it = rbid - 48; it < 192; it += nblk) { if (it >= 0) s5_propagate(p, l, it * 256 + tid); }
      unsigned* hq = (unsigned*)(ws + O_BAR + 192) + l;
      int* hslot = (int*)(smraw + SMEM_BYTES - 16);
#pragma unroll 1
      for (;;) {
        __syncthreads();
        if (tid == 0) *hslot = (int)atomicAdd(hq, 1u);
        __syncthreads();
        const int item = *hslot;
        if (item >= 512) break;
        const int set = item < 256 ? 1 : 0, c = item & 255, ntb = set ? 4 : 2;
#pragma unroll 1
        for (int tb = 0; tb < ntb; tb++) hy_conv_item(smraw, p, l, 0, set, c, tb);
        __threadfence();
        __syncthreads();
#pragma unroll 1
        for (int tb = 0; tb < ntb; tb++) hy_conv_item(smraw, p, l, 1, set, c, tb);
      }
    }
    GRID_SYNC();
    {
      int l = lay; asm volatile("" : "+s"(l));
#pragma unroll 1
      for (int it = rbid; it < 16 * 10 * 8; it += nblk) {
        const int g = it / 80, mt = (it % 80) >> 3, nt = it & 7;
        { const float* H = gemm_tile(smem, (const u16*)(ws + O_UH) + (size_t)g * 1280 * 1280, 1280, mt * 128, 0, 1280, 30, 0,
                  (const u16*)(ws + O_BTY) + (size_t)g * 1024 * 1280 + (size_t)nt * 128 * 1280, 1280, 1280);
            int tid_o = threadIdx.x; asm volatile("" : "+v"(tid_o));
            u16* zb = (u16*)(ws + O_XN) + (size_t)3 * T_ALL * 256;
            EPI_ROWS(H, {
              int ck = mt * 128 + r, n = nt * 128 + c;
              *(uint2*)(zb + ((size_t)g * T_ALL + ck * 64 + (n >> 4)) * 16 + (n & 15)) = pack4(geluf_(v.x), geluf_(v.y), geluf_(v.z), geluf_(v.w)); })
          }
      }
#pragma unroll 1
      for (int it = bid; it < NCH32 * 4; it += nblk) lru_item(smraw, p, l, it, 1);
#pragma unroll 1
      for (int it = rbid; it < T_ALL / 16; it += nblk) gdn_final_rows(p, l, it);
    }
    GRID_SYNC();
    {
      int l = lay; asm volatile("" : "+s"(l));
#pragma unroll 1
      for (int it = bid; it < 640 * 2; it += nblk) {
        const int mt = it >> 1, nt = it & 1;
        const u16* zb = (const u16*)(ws + O_XN) + (size_t)3 * T_ALL * 256;
        { const float* H = gemm_tile(smem, zb, 16, mt * 128, 0, T_ALL, 4, (size_t)T_ALL * 16, (const u16*)(ws + O_WGLU) + (size_t)nt * 128 * 256, 256, 256);
            int tid_o = threadIdx.x; asm volatile("" : "+v"(tid_o));
            u16* mixB = (u16*)(ws + O_XN) + (size_t)T_ALL * 256 + (size_t)mt * 128 * 256 + nt * 128;
            const u16* zr = zb + (size_t)mt * 128 * 16;
            const float* gb = p.in[20] + l * 256 + nt * 128;
            EPI_ROWS(H, {
              uint2 zz = *(const uint2*)(zr + ((size_t)((nt * 128 + c) >> 4) * T_ALL + r) * 16 + (c & 15));
              float4 g4 = *(const float4*)(gb + c);
              float z0 = bf2f(zz.x & 0xffff), z1 = bf2f(zz.x >> 16), z2 = bf2f(zz.y & 0xffff), z3 = bf2f(zz.y >> 16);
              *(uint2*)(mixB + (size_t)r * 256 + c) = pack4(z0 * sigmoidf_(v.x + g4.x), z1 * sigmoidf_(v.y + g4.y), z2 * sigmoidf_(v.z + g4.z), z3 * sigmoidf_(v.w + g4.w)); })
          }
      }
#pragma unroll 1
      for (int it = rbid; it < T_ALL / 16; it += nblk) grpnorm_rows(p, l, 0, it);
    }
    GRID_SYNC();
    {
      int l = lay; asm volatile("" : "+s"(l));
#pragma unroll 1
      for (int it = bid; it < NCH64; it += nblk) hy_final_item(smraw, p, l, it);
#pragma unroll 1
      for (int it = rbid; it < T_ALL / 16; it += nblk) grpnorm_rows(p, l, 1, it);
    }
    GRID_SYNC();
    {
      int l = lay; asm volatile("" : "+s"(l));
      TILE_LOOP(640, 8, mt, nt) {
        { const float* H = gemm_tile(smem, (const u16*)(ws + O_XN), 256, mt * 128, 0, T_ALL, 8, (size_t)T_ALL * 256,
                  (const u16*)(ws + O_WOUT) + (size_t)nt * 128 * 1024, 1024, 1024);
            int tid_o = threadIdx.x; asm volatile("" : "+v"(tid_o));
            float* o = p.out + (size_t)mt * 128 * DM + nt * 128;
            const int er = tid_o >> 5, ec = (tid_o & 31) * 4;
#pragma unroll 1
            for (int half = 0; half < 2; half++) {
              float4 b4[8];
#pragma unroll
              for (int q = 0; q < 8; q++) b4[q] = *(const float4*)(xrow(p, l, mt * 128 + er + 8 * (half * 8 + q)) + nt * 128 + ec);
#pragma unroll
              for (int q = 0; q < 8; q++) {
                const int r = er + 8 * (half * 8 + q);
                const float4 v = *(const float4*)(H + r * HST + ec);
                float4 o4; o4.x = b4[q].x + v.x; o4.y = b4[q].y + v.y; o4.z = b4[q].z + v.z; o4.w = b4[q].w + v.w;
                *(float4*)(o + (size_t)r * DM + ec) = o4;
              }
            }
          }
      }
    }
    GRID_SYNC();
    {
      int l = lay; asm volatile("" : "+s"(l));
#pragma unroll 1
      for (int it = bid; it < T_ALL / 16; it += nblk) rms_rows_to_bf16(p, 1, it);
    }
    GRID_SYNC();
    {
      int l = lay; asm volatile("" : "+s"(l));
      const int nM = 8 * 17 + 16 * 33;
      TILE_LOOP(nM, 44, mi, nt) {
        int seq, ti, L;
        if (mi < 136) { seq = mi / 17; ti = mi % 17; L = 2048; }
        else { seq = 8 + (mi - 136) / 33; ti = (mi - 136) % 33; L = 4096; }
        const int s0 = seq < 8 ? seq * 2048 : T_P + (seq - 8) * 4096;
        const int arow0 = s0 + 126 * ti - 1;
        const int nvalid = min(126, L - 126 * ti);
        { const float* H = gemm_tile<true>(smem, (const u16*)(ws + O_XN), 1024, arow0, s0, s0 + L, 30, 0, (const u16*)(ws + O_WUP) + (size_t)nt * 128 * 1024, 1024, 1024);
            int tid_o = threadIdx.x; asm volatile("" : "+v"(tid_o));
            const int j = tid_o & 63, rg = tid_o >> 6;
            const float* cw = p.in[38] + (size_t)l * 3 * 5632;
            const float* cb = p.in[39] + (size_t)l * 5632;
            const int cg_ = nt * 64 + j, cv_ = DFF + nt * 64 + j;
            const float g0 = cw[cg_], g1 = cw[5632 + cg_], g2 = cw[2 * 5632 + cg_], gb = cb[cg_];
            const float u0 = cw[cv_], u1 = cw[5632 + cv_], u2 = cw[2 * 5632 + cv_], ub = cb[cv_];
            u16* hm = (u16*)(ws + O_HMID) + (size_t)arow0 * DFF + nt * 64 + j;
#pragma unroll 2
            for (int r = 1 + rg; r <= nvalid; r += 4) {
              float gate = g0 * H[(r - 1) * HST + j] + g1 * H[r * HST + j] + g2 * H[(r + 1) * HST + j] + gb;
              float val = u0 * H[(r - 1) * HST + 64 + j] + u1 * H[r * HST + 64 + j] + u2 * H[(r + 1) * HST + 64 + j] + ub;
              hm[(size_t)r * DFF] = f2bf(siluf_(gate) * val);
            }
          }
      }
    }
    GRID_SYNC();
    {
      int l = lay; asm volatile("" : "+s"(l));
      TILE_LOOP(640, 8, mt, nt) {
        { const float* H = gemm_tile(smem, (const u16*)(ws + O_HMID), DFF, mt * 128, 0, T_ALL, 30, 0, (const u16*)(ws + O_WDN) + (size_t)nt * 128 * DFF, DFF, DFF);
            int tid_o = threadIdx.x; asm volatile("" : "+v"(tid_o));
            float* o = p.out + (size_t)mt * 128 * DM + nt * 128;
            const int er = tid_o >> 5, ec = (tid_o & 31) * 4;
#pragma unroll 1
            for (int half = 0; half < 2; half++) {
              float4 b4[8];
#pragma unroll
              for (int q = 0; q < 8; q++) b4[q] = *(const float4*)(o + (size_t)(er + 8 * (half * 8 + q)) * DM + ec);
#pragma unroll
              for (int q = 0; q < 8; q++) {
                const int r = er + 8 * (half * 8 + q);
                const float4 v = *(const float4*)(H + r * HST + ec);
                float4 o4; o4.x = b4[q].x + v.x; o4.y = b4[q].y + v.y; o4.z = b4[q].z + v.z; o4.w = b4[q].w + v.w;
                *(float4*)(o + (size_t)r * DM + ec) = o4;
              }
            }
          }
      }
    }
    GRID_SYNC();
  }
  {
    const int w = tid >> 6;
    const float* fn = p.in[41];
#pragma unroll 1
    for (int it = bid; it < T_ALL / 16; it += nblk) {
      float* x0 = p.out + (size_t)(it * 16 + w * 4) * DM;
      float4 v[4][4];
#pragma unroll
      for (int j = 0; j < 4; j++)
#pragma unroll
        for (int i = 0; i < 4; i++) v[j][i] = *(const float4*)(x0 + (size_t)j * DM + i * 256 + lane * 4);
#pragma unroll
      for (int j = 0; j < 4; j++) {
        float ss = 0.f;
#pragma unroll
        for (int i = 0; i < 4; i++) ss += v[j][i].x * v[j][i].x + v[j][i].y * v[j][i].y + v[j][i].z * v[j][i].z + v[j][i].w * v[j][i].w;
        ss = wave_sum(ss);
        float rs = rsqrtf(ss * (1.f / 1024.f) + EPSF);
#pragma unroll
        for (int i = 0; i < 4; i++) {
          float4 g = *(const float4*)(fn + i * 256 + lane * 4);
          float4 o; o.x = v[j][i].x * rs * g.x; o.y = v[j][i].y * rs * g.y; o.z = v[j][i].z * rs * g.z; o.w = v[j][i].w * rs * g.w;
          *(float4*)(x0 + (size_t)j * DM + i * 256 + lane * 4) = o;
        }
      }
    }
  }
}

extern "C" void kernel_launch(void* const* d_in, const int* in_sizes, int n_in,
                              void* d_out, int out_size, void* d_ws, size_t ws_size,
                              hipStream_t stream) {
  static int grid_blocks = 0;
  if (!grid_blocks) {
    int dev = 0, cus = 0, per_cu = 0;
    (void)hipGetDevice(&dev);
    (void)hipDeviceGetAttribute(&cus, hipDeviceAttributeMultiprocessorCount, dev);
    (void)hipOccupancyMaxActiveBlocksPerMultiprocessor(&per_cu, mega, 256, 0);
    if (per_cu > 2) per_cu = 2;
    if (per_cu < 1) per_cu = 1;
    grid_blocks = cus * per_cu;
  }
  if (ws_size < WS_TOTAL) fprintf(stderr, "workspace too small: %zu < %zu\n", ws_size, (size_t)WS_TOTAL);
  Params p{};
  for (int i = 0; i < 42; i++) p.in[i] = (const float*)d_in[i];
  p.out = (float*)d_out;
  p.ws = (char*)d_ws;
  (void)hipMemsetAsync((char*)d_ws + O_BAR, 0, 16384, stream);
  void* args[] = {&p};
  hipError_t e = hipLaunchCooperativeKernel((void*)mega, dim3(grid_blocks), dim3(256), args, 0, stream);
  if (e != hipSuccess) fprintf(stderr, "coop launch failed: %s (grid %d)\n", hipGetErrorString(e), grid_blocks);
}
```

```cpp
#include <hip/hip_runtime.h>
#include <hip/hip_bf16.h>
#include <hip/hip_cooperative_groups.h>
#include <cstdio>
namespace cg = cooperative_groups;

typedef unsigned short u16;
using bf16x8 = __attribute__((ext_vector_type(8))) short;
using f32x4 = __attribute__((ext_vector_type(4))) float;

#define T_ALL 81920
#define T_P 16384
#define DM 1024
#define NZ 2688
#define DFF 2816
#define NCH32 2560
#define NCH64 1280
#define EPSF 1e-6f

constexpr size_t al(size_t x) { return (x + 255) & ~(size_t)255; }
constexpr size_t O_WIN = 0;
constexpr size_t O_WOUT = O_WIN + al((size_t)NZ * 1024 * 2);
constexpr size_t O_WUP = O_WOUT + al((size_t)1024 * 1024 * 2);
constexpr size_t O_WDN = O_WUP + al((size_t)5632 * 1024 * 2);
constexpr size_t O_WLRU = O_WDN + al((size_t)1024 * 2816 * 2);
constexpr size_t O_WGLU = O_WLRU + al((size_t)4 * 256 * 64 * 2);
constexpr size_t O_AB64 = O_WGLU + al((size_t)256 * 256 * 2);
constexpr size_t O_KTAB = O_AB64 + 2 * al((size_t)2 * 16 * 64 * 2 * 4);
constexpr size_t O_BTY = O_KTAB + al((size_t)16 * 2 * 64 * 256 * 4);
constexpr size_t O_BTS = O_BTY + al((size_t)16 * 1024 * 1280 * 2);
constexpr size_t O_HYKR = O_BTS + al((size_t)16 * 256 * 1024 * 2);
constexpr size_t HYKR1 = (size_t)2 * 256 * 4096;
constexpr size_t O_HYPS = O_HYKR + al((size_t)2 * 256 * (4096 + 8192) * 2);
constexpr size_t O_XN = O_HYPS + al((size_t)(32 + 64) * 512 * 4);
constexpr size_t O_ZA = O_XN + al((size_t)T_ALL * 1024 * 2);
constexpr size_t O_UH = O_ZA + al((size_t)T_ALL * 512 * 2);
constexpr size_t O_ZC = O_UH + al((size_t)16 * 1280 * 1280 * 2);
constexpr size_t O_BA = O_ZC + al((size_t)T_ALL * 1024 * 2);
constexpr size_t O_DT = O_BA + al((size_t)T_ALL * 16 * 4);
constexpr size_t O_WU = O_DT + al((size_t)768 * T_ALL * 2);
constexpr size_t O_GC = O_WU + al((size_t)NCH64 * 4 * 2 * 2 * 4096 * 2);
constexpr size_t O_OD = O_GC + al((size_t)T_ALL * 8 * 4);
constexpr size_t O_Y1 = O_OD + al((size_t)2 * T_ALL * 256 * 2);
constexpr size_t O_SEND = O_Y1 + al((size_t)256 * T_ALL * 2);
constexpr size_t O_LCAR = O_SEND + al((size_t)16 * 1280 * 256 * 4);
constexpr size_t O_LHIN = O_LCAR + al((size_t)NCH32 * 512 * 8);
constexpr size_t O_BAR = O_LHIN + al((size_t)NCH32 * 512 * 4);
constexpr size_t WS_TOTAL = O_BAR + 16384;
static_assert(WS_TOTAL <= (size_t)1073741824, "ws");
constexpr size_t O_HMID = O_ZA;
static_assert(O_HMID + (size_t)T_ALL * DFF * 2 <= O_GC, "hmid alias");

struct Params {
  const float* in[42];
  float* out;
  char* ws;
};

#define SMEM_BYTES 73728
#ifndef MIXMASK
#define MIXMASK 15
#endif

__device__ __forceinline__ u16 f2bf(float f) {
  unsigned u = __float_as_uint(f);
  u += 0x7fffu + ((u >> 16) & 1u);
  return (u16)(u >> 16);
}
__device__ __forceinline__ float bf2f(u16 h) { return __uint_as_float(((unsigned)h) << 16); }
__device__ __forceinline__ float sigmoidf_(float x) { return 1.f / (1.f + __expf(-x)); }
__device__ __forceinline__ float siluf_(float x) { return x / (1.f + __expf(-x)); }
__device__ __forceinline__ float softplusf_(float x) { return x > 20.f ? x : log1pf(expf(x)); }
__device__ __forceinline__ float geluf_(float x) {
  float u2 = 1.5957691216057308f * (x + 0.044715f * x * x * x);
  return x / (1.f + __expf(-u2));
}
__device__ __forceinline__ float wave_sum(float v) {
#pragma unroll
  for (int o = 32; o > 0; o >>= 1) v += __shfl_xor(v, o);
  return v;
}
__device__ __forceinline__ const float* xrow(const Params& p, int l, int tok) {
  const float* a = p.in[0]; const float* b = p.in[1]; const float* o = p.out;
  const float* r0 = a + (size_t)tok * DM;
  const float* r1 = b + (size_t)(tok - T_P) * DM;
  const float* r2 = o + (size_t)tok * DM;
  return l == 0 ? (tok < T_P ? r0 : r1) : r2;
}
__device__ __forceinline__ void seq_bounds(int tok, int& lo, int& hi) {
  if (tok < T_P) { lo = tok & ~2047; hi = lo + 2048; }
  else { lo = T_P + ((tok - T_P) & ~4095); hi = lo + 4096; }
}

#define LDS_BARRIER() asm volatile("s_waitcnt lgkmcnt(0)\n\ts_barrier" ::: "memory")

#define GST 72
#define HST 132
template <bool MASK = false>
__device__ __forceinline__ const float* gemm_tile(u16* smem, const u16* __restrict__ A, long lda, int arow0, int alo, int ahi,
                                          int segShift, size_t segStride,
                                          const u16* __restrict__ Bt, long ldb, int K) {
  u16* sA = smem;
  u16* sB = smem + 2 * 128 * GST;
  int tid = threadIdx.x; asm volatile("" : "+v"(tid)); const int _tid_pad = 0, lane = tid & 63, w = tid >> 6;
  const int wm = w >> 1, wn = w & 1, fr = lane & 15, fq = lane >> 4;
  const int cc = tid & 7, r0 = tid >> 3;
  f32x4 acc[4][4];
#pragma unroll
  for (int i = 0; i < 4; i++)
#pragma unroll
    for (int j = 0; j < 4; j++) acc[i][j] = (f32x4){0.f, 0.f, 0.f, 0.f};
  uint4 ra0x, ra1x, ra2x, ra3x, rb0x, rb1x, rb2x, rb3x;
  const int nk = K >> 6;
#define GROW(i_, AP, BP, OK) const bool OK = !MASK || ((arow0 + r0 + 32 * i_) >= alo && (arow0 + r0 + 32 * i_) < ahi);        \
    const u16* AP = A + (long)(OK ? (arow0 + r0 + 32 * i_) : alo) * lda;                                             \
    const u16* BP = Bt + (long)(r0 + 32 * i_) * ldb + cc * 8;
  GROW(0, ap0, bp0, ok0) GROW(1, ap1, bp1, ok1) GROW(2, ap2, bp2, ok2) GROW(3, ap3, bp3, ok3)
#define GLOAD1(AP, BP, OK, RA, RB) {                                                \
      uint4 t_ = *(const uint4*)(AP + aoff_);                                         \
      RA = (!MASK || OK) ? t_ : make_uint4(0, 0, 0, 0);                               \
      RB = *(const uint4*)(BP + k0_); }
#define GLOAD(kt_, S) do {                                                         \
    const int k0_ = (kt_) << 6;                                                       \
    const int kk_ = k0_ + cc * 8;                                                     \
    const int sg_ = kk_ >> segShift;                                                  \
    const size_t aoff_ = (size_t)sg_ * segStride + (kk_ - (sg_ << segShift));         \
    GLOAD1(ap0, bp0, ok0, ra0##S, rb0##S) GLOAD1(ap1, bp1, ok1, ra1##S, rb1##S)       \
    GLOAD1(ap2, bp2, ok2, ra2##S, rb2##S) GLOAD1(ap3, bp3, ok3, ra3##S, rb3##S)       \
    } while (0)
#define SWRITE1(buf_, i_, RA, RB) {                                                 \
      *(uint4*)(sA + (buf_) * 128 * GST + (r0 + 32 * i_) * GST + cc * 8) = RA;        \
      *(uint4*)(sB + (buf_) * 128 * GST + (r0 + 32 * i_) * GST + cc * 8) = RB; }
#define SWRITE(buf_, S) do {                                                        \
    SWRITE1(buf_, 0, ra0##S, rb0##S) SWRITE1(buf_, 1, ra1##S, rb1##S) SWRITE1(buf_, 2, ra2##S, rb2##S) SWRITE1(buf_, 3, ra3##S, rb3##S) \
    } while (0)
#define GCOMPUTE(buf_) do {                                                         \
    const u16* a = sA + (buf_) * 128 * GST;                                           \
    const u16* b = sB + (buf_) * 128 * GST;                                           \
    _Pragma("unroll") for (int ks = 0; ks < 2; ks++) {                                \
      bf16x8 af[4], bfr[4];                                                           \
      _Pragma("unroll") for (int i = 0; i < 4; i++) {                                 \
        af[i] = *(const bf16x8*)(a + (64 * wm + 16 * i + fr) * GST + ks * 32 + fq * 8);   \
        bfr[i] = *(const bf16x8*)(b + (64 * wn + 16 * i + fr) * GST + ks * 32 + fq * 8);  \
      }                                                                               \
      __builtin_amdgcn_s_setprio(1);                                                  \
      _Pragma("unroll") for (int i = 0; i < 4; i++)                                   \
      _Pragma("unroll") for (int j = 0; j < 4; j++)                                   \
        acc[i][j] = __builtin_amdgcn_mfma_f32_16x16x32_bf16(af[i], bfr[j], acc[i][j], 0, 0, 0); \
      __builtin_amdgcn_s_setprio(0);                                                  \
    } } while (0)
  LDS_BARRIER();
  GLOAD(0, x);
  SWRITE(0, x);
  LDS_BARRIER();
#pragma unroll 1
  for (int kt = 0; kt < nk; kt += 2) {
    if (kt + 1 < nk) GLOAD(kt + 1, x);
    GCOMPUTE(0);
    if (kt + 1 < nk) SWRITE(1, x);
    LDS_BARRIER();
    if (kt + 1 >= nk) break;
    if (kt + 2 < nk) GLOAD(kt + 2, x);
    GCOMPUTE(1);
    if (kt + 2 < nk) SWRITE(0, x);
    LDS_BARRIER();
  }
  float* H = (float*)smem;
#pragma unroll
  for (int i = 0; i < 4; i++)
#pragma unroll
    for (int j = 0; j < 4; j++)
#pragma unroll
      for (int e = 0; e < 4; e++) H[(64 * wm + 16 * i + 4 * fq + e) * HST + 64 * wn + 16 * j + fr] = acc[i][j][e];
  LDS_BARRIER();
  return H;
}
__device__ __forceinline__ uint2 pack4(float a, float b, float c, float d) {
  uint2 pk; pk.x = f2bf(a) | ((unsigned)f2bf(b) << 16); pk.y = f2bf(c) | ((unsigned)f2bf(d) << 16); return pk;
}
#define EPI_ROWS(H, BODY...)                                                     \
  _Pragma("unroll 4") for (int _it = 0; _it < 16; _it++) {                       \
    const int r = (tid_o >> 5) + 8 * _it, c = (tid_o & 31) * 4;      \
    const float4 v = *(const float4*)((H) + r * HST + c); BODY }

__device__ __forceinline__ int colmap(int mode, int n) {
  if (mode == 0) {
    if (n < 1792) return n;
    if (n < 2560) return n + 16;
    if (n < 2576) return 1792 + (n - 2560);
    return -1;
  }
  if (mode == 2) { int nt = n >> 7, c = n & 127; return c < 64 ? nt * 64 + c : DFF + nt * 64 + (c - 64); }
  return n;
}
__device__ __forceinline__ void transpose_tile(float* sm, const float* __restrict__ src, int ldsrc, const float* __restrict__ gain,
                               u16* __restrict__ dst, int K, int mode, int n0, int k0) {
  int tid = threadIdx.x; asm volatile("" : "+v"(tid)); const int _tid_pad = 0;
  LDS_BARRIER();
  {
    int nn = tid & 63;
    int sc = colmap(mode, n0 + nn);
#pragma unroll
    for (int i = 0; i < 16; i++) {
      int kk = (tid >> 6) + 4 * i;
      float v = 0.f;
      if (sc >= 0) { v = src[(size_t)(k0 + kk) * ldsrc + sc]; if (gain) v *= gain[k0 + kk]; }
      sm[kk * 65 + nn] = v;
    }
  }
  LDS_BARRIER();
  {
    int c = tid & 7;
#pragma unroll
    for (int i = 0; i < 2; i++) {
      int nn = (tid >> 3) + 32 * i;
      u16 h[8];
#pragma unroll
      for (int e = 0; e < 8; e++) h[e] = f2bf(sm[(c * 8 + e) * 65 + nn]);
      uint4 pk;
      pk.x = h[0] | ((unsigned)h[1] << 16); pk.y = h[2] | ((unsigned)h[3] << 16);
      pk.z = h[4] | ((unsigned)h[5] << 16); pk.w = h[6] | ((unsigned)h[7] << 16);
      *(uint4*)(dst + (size_t)(n0 + nn) * K + k0 + c * 8) = pk;
    }
  }
}

__device__ __forceinline__ void s5_prep_item(float* sm, const Params& p, int l, int item) {
  int tid = threadIdx.x; asm volatile("" : "+v"(tid)); const int _tid_pad = 0;
  const int m = item % 65, d = (item / 65) & 1, g = item / 130;
  float* s_abm = sm;
  float* s_q = sm + 128;
  const int ldg = (l * 2 + d) * 16 + g;
  LDS_BARRIER();
  if (tid < 64) {
    int pi = ldg * 64 + tid;
    float dt = expf(p.in[13][ldg]);
    float are = p.in[11][pi], aim = p.in[12][pi];
    float mag = expf(dt * are), ang = dt * aim;
    float abr = mag * cosf(ang), abi = mag * sinf(ang);
    float den = are * are + aim * aim;
    float nre = abr - 1.f;
    s_q[tid * 2] = (nre * are + abi * aim) / den;
    s_q[tid * 2 + 1] = (abi * are - nre * aim) / den;
    float mm = expf((float)m * dt * are), am = (float)m * ang;
    float pr = mm * cosf(am), pim = mm * sinf(am);
    s_abm[tid * 2] = pr; s_abm[tid * 2 + 1] = pim;
    if (m == 64) {
      float* ab64 = (float*)(p.ws + O_AB64) + (size_t)l * 2 * 16 * 64 * 2;
      ab64[((d * 16 + g) * 64 + tid) * 2] = pr;
      ab64[((d * 16 + g) * 64 + tid) * 2 + 1] = pim;
    }
  }
  LDS_BARRIER();
  const float* bre = p.in[14] + (size_t)ldg * 64 * 16;
  const float* bim = p.in[15] + (size_t)ldg * 64 * 16;
  const float* cre = p.in[16] + (size_t)ldg * 16 * 64;
  const float* cim = p.in[17] + (size_t)ldg * 16 * 64;
  u16* bty = (u16*)(p.ws + O_BTY) + (size_t)g * 1024 * 1280;
  u16* bts = (u16*)(p.ws + O_BTS) + (size_t)g * 256 * 1024;
  if (m <= 63) {
    int ho = tid >> 4, hi = tid & 15;
    float acc = 0.f;
    for (int pp = 0; pp < 64; pp++) {
      float cr = cre[ho * 64 + pp], ci = cim[ho * 64 + pp];
      float ar = s_abm[pp * 2], ai = s_abm[pp * 2 + 1];
      float t1r = cr * ar - ci * ai, t1i = cr * ai + ci * ar;
      float qr = s_q[pp * 2], qi = s_q[pp * 2 + 1];
      float br = bre[pp * 16 + hi], bi = bim[pp * 16 + hi];
      float bbr = qr * br - qi * bi, bbi = qr * bi + qi * br;
      acc += t1r * bbr - t1i * bbi;
    }
    float* kt = (float*)(p.ws + O_KTAB);
    kt[((size_t)((g * 2 + d) * 64 + m)) * 256 + ho * 16 + hi] = acc;
  }
  if (m >= 1) {
    int t = d == 0 ? m - 1 : 64 - m;
    for (int e = tid; e < 1024; e += 256) {
      int ho = e >> 6, pp = e & 63;
      float cr = cre[ho * 64 + pp], ci = cim[ho * 64 + pp];
      float ar = s_abm[pp * 2], ai = s_abm[pp * 2 + 1];
      float xr = cr * ar - ci * ai, xi = cr * ai + ci * ar;
      size_t o = (size_t)(t * 16 + ho) * 1280 + 1024 + d * 128 + pp * 2;
      bty[o] = f2bf(xr);
      bty[o + 1] = f2bf(-xi);
    }
  }
}
__device__ __forceinline__ void s5_bts_item(const Params& p, int l, int item) {
  int tid = threadIdx.x; asm volatile("" : "+v"(tid));
  const int pp = item & 63, d = (item >> 6) & 1, g = item >> 7;
  const int sp = tid >> 2, hq = tid & 3;
  const int ldg = (l * 2 + d) * 16 + g;
  const int pi = ldg * 64 + pp;
  float dt = expf(p.in[13][ldg]);
  float are = p.in[11][pi], aim = p.in[12][pi];
  float mag = expf(dt * are), ang = dt * aim;
  float abr = mag * cosf(ang), abi = mag * sinf(ang);
  float den = are * are + aim * aim;
  float nre = abr - 1.f;
  float qr = (nre * are + abi * aim) / den, qi = (abi * are - nre * aim) / den;
  const int f = d == 0 ? 63 - sp : sp;
  float mm = expf((float)f * dt * are), am = (float)f * ang;
  float ar = mm * cosf(am), ai = mm * sinf(am);
  const float* bre = p.in[14] + (size_t)ldg * 64 * 16 + pp * 16 + hq * 4;
  const float* bim = p.in[15] + (size_t)ldg * 64 * 16 + pp * 16 + hq * 4;
  float fr_[4], fi_[4];
#pragma unroll
  for (int e = 0; e < 4; e++) {
    float br = bre[e], bi = bim[e];
    float bbr = qr * br - qi * bi, bbi = qr * bi + qi * br;
    fr_[e] = ar * bbr - ai * bbi; fi_[e] = ar * bbi + ai * bbr;
  }
  u16* bts = (u16*)(p.ws + O_BTS) + (size_t)g * 256 * 1024 + (size_t)(d * 128 + pp * 2) * 1024 + sp * 16 + hq * 4;
  *(uint2*)bts = pack4(fr_[0], fr_[1], fr_[2], fr_[3]);
  *(uint2*)(bts + 1024) = pack4(fi_[0], fi_[1], fi_[2], fi_[3]);
}
__device__ __forceinline__ void s5_expand_item(const Params& p, int l, int item) {
  int tid = threadIdx.x; asm volatile("" : "+v"(tid)); const int _tid_pad = 0;
  int g = item >> 10, n = item & 1023, t = n >> 4, ho = n & 15;
  int sp = tid >> 2, hi0 = (tid & 3) * 4;
  const float* kt = (const float*)(p.ws + O_KTAB);
  float v[4] = {0.f, 0.f, 0.f, 0.f};
  if (t >= sp) {
    const float* k0 = kt + ((size_t)((g * 2 + 0) * 64 + (t - sp))) * 256 + ho * 16 + hi0;
#pragma unroll
    for (int e = 0; e < 4; e++) v[e] += k0[e];
  }
  if (sp >= t) {
    const float* k1 = kt + ((size_t)((g * 2 + 1) * 64 + (sp - t))) * 256 + ho * 16 + hi0;
#pragma unroll
    for (int e = 0; e < 4; e++) v[e] += k1[e];
  }
  if (t == sp && ho >= hi0 && ho < hi0 + 4) v[ho - hi0] += p.in[18][l * 256 + g * 16 + ho];
  u16* bty = (u16*)(p.ws + O_BTY) + (size_t)g * 1024 * 1280 + (size_t)n * 1280 + sp * 16 + hi0;
  uint2 pk;
  pk.x = f2bf(v[0]) | ((unsigned)f2bf(v[1]) << 16);
  pk.y = f2bf(v[2]) | ((unsigned)f2bf(v[3]) << 16);
  *(uint2*)bty = pk;
}

__device__ __forceinline__ void hy_filter_item(float* sm, const Params& p, int l, int set, int tb) {
  int tid = threadIdx.x; asm volatile("" : "+v"(tid));
  const int L = 2048 << set;
  float* sz = sm;
  float* h1 = sm + 65 * 33;
  float* h2 = h1 + 65 * 64;
  const float* w1 = p.in[27] + (size_t)l * 33 * 64;
  const float* b1 = p.in[28] + l * 64;
  const float* fq_ = p.in[29] + l * 64;
  const float* w2 = p.in[30] + (size_t)l * 64 * 64;
  const float* b2 = p.in[31] + l * 64;
  const float* w3 = p.in[32] + (size_t)l * 64 * 1024;
  LDS_BARRIER();
  for (int e = tid; e < 65 * 33; e += 256) {
    int tt = e / 33, i = e % 33;
    int t = tb * 64 + tt;
    float val;
    if (i == 0) val = (float)t / (float)(L - 1);
    else {
      int b = (i - 1) & 15;
      float f = 1e-4f + (float)b * ((15.f - 1e-4f) / 15.f);
      float wang = 6.283185307179586f * (float)t / (float)L;
      val = i <= 16 ? cosf(f * wang) : -sinf(f * wang);
    }
    sz[e] = val;
  }
  LDS_BARRIER();
  {
    int j = tid & 63;
    float fj = fq_[j], bj = b1[j];
#pragma unroll 1
    for (int i = 0; i < 17; i++) {
      int tt = (tid >> 6) + 4 * i;
      if (tt < 65) {
        float a = bj;
        for (int k = 0; k < 33; k++) a += sz[tt * 33 + k] * w1[k * 64 + j];
        h1[tt * 64 + j] = sinf(fj * a);
      }
    }
  }
  LDS_BARRIER();
  {
    int j = tid & 63;
    float fj = fq_[j], bj = b2[j];
#pragma unroll 1
    for (int i = 0; i < 17; i++) {
      int tt = (tid >> 6) + 4 * i;
      if (tt < 65) {
        float a = bj;
        for (int k = 0; k < 64; k++) a += h1[tt * 64 + k] * w2[k * 64 + j];
        h2[tt * 64 + j] = sinf(fj * a);
      }
    }
  }
  LDS_BARRIER();
  const int c = tid;
  const float mind = -3.0701134573253943f, maxd = -15.350567286626972f;
  float delta = fabsf(mind + (float)c * ((maxd - mind) / 255.f));
  u16* kr = (u16*)(p.ws + O_HYKR) + (set ? HYKR1 : 0);
  float* ps = (float*)(p.ws + O_HYPS) + (size_t)(set ? 32 * 512 : 0) + (size_t)tb * 512;
#pragma unroll 1
  for (int order = 0; order < 2; order++) {
    u16* krc = kr + ((size_t)order * 256 + c) * (2 * L);
    float asum = 0.f, v00 = 0.f;
#pragma unroll 1
    for (int dir = 0; dir < 2; dir++) {
      float wc[64];
#pragma unroll
      for (int k = 0; k < 64; k++) wc[k] = w3[k * 1024 + order * 512 + dir * 256 + c];
      float hold = 0.f;
      const int ntt = dir == 0 ? 65 : 64;
#pragma unroll 1
      for (int tt = 0; tt < ntt; tt++) {
        float a = 0.f;
#pragma unroll
        for (int k = 0; k < 64; k++) a += h2[tt * 64 + k] * wc[k];
        int t = tb * 64 + tt;
        float tl = (float)t / (float)(L - 1);
        a *= expf(-tl * delta);
        if (t >= L) a = 0.f;
        if (tt < 64) asum += fabsf(a);
        if (dir == 0) {
          if (tt == 0) { if (tb == 0) v00 = a; }
          else if (tt & 1) hold = a;
          else *(unsigned*)(krc + (L - t)) = f2bf(a) | ((unsigned)f2bf(hold) << 16);
        } else {
          if (!(tt & 1)) hold = (t == 0) ? v00 + a : a;
          else *(unsigned*)(krc + (L + t - 1)) = f2bf(hold) | ((unsigned)f2bf(a) << 16);
        }
      }
    }
    ps[order * 256 + c] = asum;
  }
}

__device__ __forceinline__ void rms_rows_to_bf16(const Params& p, int l, int rowblk) {
  int tid_ = threadIdx.x; asm volatile("" : "+v"(tid_));
  const int lane = tid_ & 63, w = tid_ >> 6;
  float4 v[4][4];
#pragma unroll
  for (int j = 0; j < 4; j++) {
    const float* x = xrow(p, l, rowblk * 16 + w * 4 + j);
#pragma unroll
    for (int i = 0; i < 4; i++) v[j][i] = *(const float4*)(x + i * 256 + lane * 4);
  }
#pragma unroll
  for (int j = 0; j < 4; j++) {
    float ss = 0.f;
#pragma unroll
    for (int i = 0; i < 4; i++) ss += v[j][i].x * v[j][i].x + v[j][i].y * v[j][i].y + v[j][i].z * v[j][i].z + v[j][i].w * v[j][i].w;
    ss = wave_sum(ss);
    float rs = rsqrtf(ss * (1.f / 1024.f) + EPSF);
    u16* xn = (u16*)(p.ws + O_XN) + (size_t)(rowblk * 16 + w * 4 + j) * 1024;
#pragma unroll
    for (int i = 0; i < 4; i++) *(uint2*)(xn + i * 256 + lane * 4) = pack4(v[j][i].x * rs, v[j][i].y * rs, v[j][i].z * rs, v[j][i].w * rs);
  }
}

__device__ __forceinline__ void lru_item(char* smraw, const Params& p, int l, int item, int mode) {
  int tid = threadIdx.x; asm volatile("" : "+v"(tid)); const int _tid_pad = 0, lane = tid & 63, w = tid >> 6, fr = lane & 15, fq = lane >> 4;
  const int cki = item >> 2, head = item & 3;
  const int t0 = cki * 32;
  int lo, hi; seq_bounds(t0, lo, hi);
  float* xc = (float*)smraw;
  u16* xcb = (u16*)(smraw + 8192);
  float* sa = (float*)(smraw + 8192 + 4608);
  float* su = sa + 2 * 32 * 64;
  float* sx = su + 2 * 32 * 64;
  const u16* zA = (const u16*)(p.ws + O_ZA);
  bf16x8 brf[2][2], bif[2][2];
  {
    const int d_ = w >> 1, half_ = w & 1;
    const u16* wl_ = (const u16*)(p.ws + O_WLRU) + (size_t)head * 256 * 64;
#pragma unroll
    for (int ks = 0; ks < 2; ks++)
#pragma unroll
      for (int nt = 0; nt < 2; nt++) {
        int nr = d_ * 128 + 32 * half_ + 16 * nt + fr;
        brf[ks][nt] = *(const bf16x8*)(wl_ + (size_t)nr * 64 + ks * 32 + fq * 8);
        bif[ks][nt] = *(const bf16x8*)(wl_ + (size_t)(nr + 64) * 64 + ks * 32 + fq * 8);
      }
  }
  LDS_BARRIER();
  {
    int ch = tid & 63, tq = tid >> 6;
    int gch = head * 64 + ch;
    const float* cw = p.in[4] + l * 4 * 256;
    float w0 = cw[gch], w1 = cw[256 + gch], w2 = cw[512 + gch], w3 = cw[768 + gch];
    float cb = p.in[5][l * 256 + gch];
    float win[11];
#pragma unroll
    for (int i = 0; i < 11; i++) {
      int tok = t0 + tq * 8 + i - 2;
      win[i] = (tok >= lo && tok < hi) ? bf2f(zA[(size_t)tok * 512 + gch]) : 0.f;
    }
#pragma unroll
    for (int i = 0; i < 8; i++) {
      float v = w0 * win[i] + w1 * win[i + 1] + w2 * win[i + 2] + w3 * win[i + 3] + cb;
      int tt = tq * 8 + i;
      xc[tt * 64 + ch] = v;
      xcb[tt * 72 + ch] = f2bf(v);
    }
  }
  LDS_BARRIER();
  {
    const int d = w >> 1, half = w & 1;
    const u16* wl = (const u16*)(p.ws + O_WLRU) + (size_t)head * 256 * 64;
    f32x4 accr[2][2], acci[2][2];
#pragma unroll
    for (int a = 0; a < 2; a++)
#pragma unroll
      for (int b = 0; b < 2; b++) { accr[a][b] = (f32x4){0, 0, 0, 0}; acci[a][b] = (f32x4){0, 0, 0, 0}; }
#pragma unroll
    for (int ks = 0; ks < 2; ks++) {
      bf16x8 af[2], br[2], bi[2];
#pragma unroll
      for (int mt = 0; mt < 2; mt++) af[mt] = *(const bf16x8*)(xcb + (16 * mt + fr) * 72 + ks * 32 + fq * 8);
#pragma unroll
      for (int nt = 0; nt < 2; nt++) { br[nt] = brf[ks][nt]; bi[nt] = bif[ks][nt]; }
#pragma unroll
      for (int mt = 0; mt < 2; mt++)
#pragma unroll
        for (int nt = 0; nt < 2; nt++) {
          accr[mt][nt] = __builtin_amdgcn_mfma_f32_16x16x32_bf16(af[mt], br[nt], accr[mt][nt], 0, 0, 0);
          acci[mt][nt] = __builtin_amdgcn_mfma_f32_16x16x32_bf16(af[mt], bi[nt], acci[mt][nt], 0, 0, 0);
        }
    }
#pragma unroll
    for (int nt = 0; nt < 2; nt++) {
      int ch = 32 * half + 16 * nt + fr;
      int gch = head * 64 + ch;
      float brr = p.in[7][(l * 2 + d) * 256 + gch], bii = p.in[9][(l * 2 + d) * 256 + gch];
      float sp = softplusf_(-p.in[10][(l * 2 + d) * 256 + gch]);
#pragma unroll
      for (int mt = 0; mt < 2; mt++)
#pragma unroll
        for (int e = 0; e < 4; e++) {
          int tt = 16 * mt + 4 * fq + e;
          float r = 1.f / (1.f + __expf(-(accr[mt][nt][e] + brr)));
          float ig = 1.f / (1.f + __expf(-(acci[mt][nt][e] + bii)));
          float la = -8.f * r * sp;
          float a = __expf(la);
          float om = -la * (2.f + la * (2.f + la * (1.3333333f + la * (0.6666667f + la * 0.26666667f))));
          if (la < -0.25f) om = 1.f - a * a;
          float u = sqrtf(om) * (ig * xc[tt * 64 + ch]);
          sa[(d * 32 + tt) * 64 + ch] = a;
          su[(d * 32 + tt) * 64 + ch] = u;
        }
    }
  }
  LDS_BARRIER();
  {
    const int ch = tid & 63, d = (tid >> 6) & 1, half = tid >> 7;
    float A = 1.f, B = 0.f;
#pragma unroll
    for (int i = 0; i < 16; i++) {
      int tt = d == 0 ? half * 16 + i : half * 16 + 15 - i;
      float a = sa[(d * 32 + tt) * 64 + ch], u = su[(d * 32 + tt) * 64 + ch];
      A = a * A; B = a * B + u;
    }
    sx[((d * 2 + half) * 64 + ch) * 2] = A;
    sx[((d * 2 + half) * 64 + ch) * 2 + 1] = B;
  }
  LDS_BARRIER();
  if (mode == 0) {
    if (tid < 128) {
      int ch = tid & 63, d = tid >> 6;
      int first = d == 0 ? 0 : 1, second = 1 - first;
      float A1 = sx[((d * 2 + first) * 64 + ch) * 2], B1 = sx[((d * 2 + first) * 64 + ch) * 2 + 1];
      float A2 = sx[((d * 2 + second) * 64 + ch) * 2], B2 = sx[((d * 2 + second) * 64 + ch) * 2 + 1];
      float2 cr; cr.x = A2 * A1; cr.y = A2 * B1 + B2;
      ((float2*)(p.ws + O_LCAR))[((size_t)cki * 2 + d) * 256 + head * 64 + ch] = cr;
    }
    return;
  }
  {
    const int ch = tid & 63, d = (tid >> 6) & 1, half = tid >> 7;
    float h = ((const float*)(p.ws + O_LHIN))[((size_t)cki * 2 + d) * 256 + head * 64 + ch];
    int first = d == 0 ? 0 : 1;
    if (half != first) h = sx[((d * 2 + first) * 64 + ch) * 2] * h + sx[((d * 2 + first) * 64 + ch) * 2 + 1];
#pragma unroll
    for (int i = 0; i < 16; i++) {
      int tt = d == 0 ? half * 16 + i : half * 16 + 15 - i;
      float a = sa[(d * 32 + tt) * 64 + ch], u = su[(d * 32 + tt) * 64 + ch];
      h = a * h + u;
      su[(d * 32 + tt) * 64 + ch] = h;
    }
  }
  LDS_BARRIER();
  {
    int ch = tid & 63, tq = tid >> 6;
    u16* mixA = (u16*)(p.ws + O_XN);
#pragma unroll
    for (int i = 0; i < 8; i++) {
      int tt = tq * 8 + i, tok = t0 + tt;
      float hsum = su[tt * 64 + ch] + su[(32 + tt) * 64 + ch];
      float gate = bf2f(zA[(size_t)tok * 512 + 256 + head * 64 + ch]);
      mixA[(size_t)tok * 256 + head * 64 + ch] = f2bf(hsum * geluf_(gate));
    }
  }
}
__device__ __forceinline__ void lru_propagate(const Params& p, int idx) {
  int seq = idx >> 9, d = (idx >> 8) & 1, ch = idx & 255;
  int c0, nc;
  if (seq < 8) { c0 = seq * 64; nc = 64; } else { c0 = 512 + (seq - 8) * 128; nc = 128; }
  const float2* car = (const float2*)(p.ws + O_LCAR);
  float* hin = (float*)(p.ws + O_LHIN);
  float h = 0.f;
  for (int i = 0; i < nc; i++) {
    int ck = d == 0 ? c0 + i : c0 + nc - 1 - i;
    size_t o = ((size_t)ck * 2 + d) * 256 + ch;
    hin[o] = h;
    float2 ab = car[o];
    h = ab.x * h + ab.y;
  }
}
__device__ __forceinline__ void s5_propagate(const Params& p, int l, int idx) {
  int pp = idx & 63, d = (idx >> 6) & 1, g = (idx >> 7) & 15, seq = idx >> 11;
  int c0, nc;
  if (seq < 8) { c0 = seq * 32; nc = 32; } else { c0 = 256 + (seq - 8) * 64; nc = 64; }
  const float* ab64 = (const float*)(p.ws + O_AB64) + (size_t)l * 2 * 16 * 64 * 2;
  float ar = ab64[((d * 16 + g) * 64 + pp) * 2], ai = ab64[((d * 16 + g) * 64 + pp) * 2 + 1];
  const float* send = (const float*)(p.ws + O_SEND) + (size_t)g * 1280 * 256;
  u16* uh = (u16*)(p.ws + O_UH) + (size_t)g * 1280 * 1280;
  float hr = 0.f, hi = 0.f;
  for (int i = 0; i < nc; i++) {
    int ck = d == 0 ? c0 + i : c0 + nc - 1 - i;
    *(unsigned*)(uh + (size_t)ck * 1280 + 1024 + d * 128 + pp * 2) = f2bf(hr) | ((unsigned)f2bf(hi) << 16);
    float2 s = *(const float2*)(send + (size_t)ck * 256 + d * 128 + pp * 2);
    float nr = __fmaf_rn(ar, hr, __fmaf_rn(-ai, hi, s.x));
    float ni = __fmaf_rn(ar, hi, __fmaf_rn(ai, hr, s.y));
    asm volatile("" : "+v"(nr));
    asm volatile("" : "+v"(ni));
    hr = nr; hi = ni;
  }
}

#define AST 68
__device__ __forceinline__ void gdn_g1_item(char* smraw, const Params& p, int l, int item) {
  int tid = threadIdx.x; asm volatile("" : "+v"(tid)); const int _tid_pad = 0, lane = tid & 63, w = tid >> 6, fr = lane & 15, fq = lane >> 4;
  const int ck = item >> 2, h = item & 3;
  const int t0 = ck * 64;
  int lo, hi; seq_bounds(t0, lo, hi);
  u16* sk = (u16*)smraw;
  u16* sv = sk + 64 * 72;
  u16* Am = (u16*)(smraw + 2 * 64 * 72 * 2);
  float* sgc = (float*)(Am + 2 * 64 * 72);
  float* sbeta = sgc + 128;
  u16* Xs = (u16*)(sbeta + 128);
  const u16* zC = (const u16*)(p.ws + O_ZC);
  const float* ba = (const float*)(p.ws + O_BA);
  u16* qg = (u16*)(p.ws + O_XN);
  u16* kg = qg + (size_t)T_ALL * 256;
  u16* vg = kg + (size_t)T_ALL * 256;
  LDS_BARRIER();
  {
    const float* cw = p.in[21] + (size_t)l * 4 * 768;
    float wq[4], wk[4], wv[4];
#pragma unroll
    for (int j = 0; j < 4; j++) {
      wq[j] = cw[j * 768 + h * 64 + lane];
      wk[j] = cw[j * 768 + 256 + h * 64 + lane];
      wv[j] = cw[j * 768 + 512 + h * 64 + lane];
    }
#pragma unroll 4
    for (int rr = 0; rr < 16; rr++) {
      int c = w * 16 + rr, tok = t0 + c;
      float q = 0.f, k = 0.f, v = 0.f;
#pragma unroll
      for (int j = 0; j < 4; j++) {
        int tk = tok + j - 2;
        if (tk >= lo && tk < hi) {
          const u16* zr = zC + (size_t)tk * 1024 + h * 64 + lane;
          q += wq[j] * bf2f(zr[0]); k += wk[j] * bf2f(zr[256]); v += wv[j] * bf2f(zr[512]);
        }
      }
      q = siluf_(q); k = siluf_(k); v = siluf_(v);
      float sq = wave_sum(q * q), skk = wave_sum(k * k);
      q = q * rsqrtf(sq + EPSF) * 0.125f;
      k = k * rsqrtf(skk + EPSF);
      u16 kb = f2bf(k), vb = f2bf(v);
      sk[c * 72 + lane] = kb; sv[c * 72 + lane] = vb;
      qg[(size_t)tok * 256 + h * 64 + lane] = f2bf(q);
      kg[(size_t)tok * 256 + h * 64 + lane] = kb;
      vg[(size_t)tok * 256 + h * 64 + lane] = vb;
    }
  }
  if (tid < 128) {
    int d = tid >> 6, c = tid & 63;
    int tok = d == 0 ? t0 + c : t0 + 63 - c;
    float alog = p.in[22][(l * 2 + d) * 4 + h], dtb = p.in[23][(l * 2 + d) * 4 + h];
    float g = -__expf(alog) * softplusf_(ba[(size_t)tok * 16 + 8 + d * 4 + h] + dtb);
    float beta = 1.f / (1.f + __expf(-ba[(size_t)tok * 16 + d * 4 + h]));
    float s = g;
#pragma unroll
    for (int o = 1; o < 64; o <<= 1) { float t = __shfl_up(s, o); if (c >= o) s += t; }
    sgc[d * 64 + c] = s; sbeta[d * 64 + c] = beta;
    ((float*)(p.ws + O_GC))[(size_t)(h * 2 + d) * T_ALL + tok] = s;
  }
  LDS_BARRIER();
  {
    f32x4 acc[4];
#pragma unroll
    for (int nt = 0; nt < 4; nt++) acc[nt] = (f32x4){0, 0, 0, 0};
#pragma unroll
    for (int ks = 0; ks < 2; ks++) {
      bf16x8 af = *(const bf16x8*)(sk + (16 * w + fr) * 72 + ks * 32 + fq * 8);
#pragma unroll
      for (int nt = 0; nt < 4; nt++) {
        bf16x8 bfm = *(const bf16x8*)(sk + (16 * nt + fr) * 72 + ks * 32 + fq * 8);
        acc[nt] = __builtin_amdgcn_mfma_f32_16x16x32_bf16(af, bfm, acc[nt], 0, 0, 0);
      }
    }
#pragma unroll
    for (int nt = 0; nt < 4; nt++)
#pragma unroll
      for (int e = 0; e < 4; e++) {
        int c = 16 * w + 4 * fq + e, m = 16 * nt + fr;
        float gm = acc[nt][e];
        float a0 = c > m ? sbeta[c] * gm * __expf(sgc[c] - sgc[m]) : 0.f;
        Am[m * 72 + c] = f2bf(a0);
        int c1 = 63 - c, m1 = 63 - m;
        float a1 = c1 > m1 ? sbeta[64 + c1] * gm * __expf(sgc[64 + c1] - sgc[64 + m1]) : 0.f;
        Am[64 * 72 + m1 * 72 + c1] = f2bf(a1);
      }
  }
  LDS_BARRIER();
  {
    const int d = tid >> 7, col = tid & 127;
    const u16* AT = Am + d * 64 * 72;
    u16* Xd = Xs + d * 48 * 128;
    const u16* src = col < 64 ? sk : sv;
    const int e = col & 63;
    u16* wu = (u16*)(p.ws + O_WU) + ((size_t)(ck * 4 + h) * 2 + d) * 8192 + (col < 64 ? 0 : 4096);
#pragma unroll 1
    for (int b = 0; b < 4; b++) {
      float s[16];
#pragma unroll
      for (int r = 0; r < 16; r++) {
        int i = 16 * b + r;
        int tokr = d == 0 ? i : 63 - i;
        float rv = bf2f(src[tokr * 72 + e]) * sbeta[d * 64 + i];
        if (col < 64) rv *= __expf(sgc[d * 64 + i]);
        s[r] = rv;
      }
#pragma unroll 4
      for (int j = 0; j < 16 * b; j++) {
        float xj = bf2f(Xd[j * 128 + col]);
        const uint4* ar = (const uint4*)(AT + j * 72 + 16 * b);
        uint4 a0 = ar[0], a1 = ar[1];
        unsigned aw[8] = {a0.x, a0.y, a0.z, a0.w, a1.x, a1.y, a1.z, a1.w};
#pragma unroll
        for (int q = 0; q < 8; q++) {
          s[2 * q] -= __uint_as_float(aw[q] << 16) * xj;
          s[2 * q + 1] -= __uint_as_float(aw[q] & 0xffff0000u) * xj;
        }
      }
#pragma unroll
      for (int rp = 0; rp < 16; rp++) {
        u16 xb = f2bf(s[rp]);
        float xj = bf2f(xb);
        wu[(16 * b + rp) * 64 + e] = xb;
        if (b < 3) Xd[(16 * b + rp) * 128 + col] = xb;
        const uint4* ar = (const uint4*)(AT + (16 * b + rp) * 72 + 16 * b);
        uint4 a0 = ar[0], a1 = ar[1];
        unsigned aw[8] = {a0.x, a0.y, a0.z, a0.w, a1.x, a1.y, a1.z, a1.w};
#pragma unroll
        for (int r = rp + 1; r < 16; r++) {
          float av = (r & 1) ? __uint_as_float(aw[r >> 1] & 0xffff0000u) : __uint_as_float(aw[r >> 1] << 16);
          s[r] -= av * xj;
        }
      }
    }
  }
}

__device__ __forceinline__ void gdn_chain(char* smraw, const Params& p, int chain) {
  int tid = threadIdx.x; asm volatile("" : "+v"(tid)); const int _tid_pad = 0, lane = tid & 63, w = tid >> 6, fr = lane & 15, fq = lane >> 4;
  const int d = chain & 1, h = (chain >> 1) & 3, seq = chain >> 3;
  int c0, nc;
  if (seq < 8) { c0 = seq * 32; nc = 32; } else { c0 = 256 + (seq - 8) * 64; nc = 64; }
  u16* qs = (u16*)smraw;
  u16* qd = qs + 64 * 72;
  u16* ks_ = qd + 64 * 72;
  u16* kdT = ks_ + 64 * 72;
  u16* at = kdT + 64 * 72;
  u16* ST = at + 64 * 72;
  u16* VT = ST + 4 * 16 * 72;
  float* sgc = (float*)(VT + 4 * 16 * 72);
  const u16* qg = (const u16*)(p.ws + O_XN);
  const u16* kg = qg + (size_t)T_ALL * 256;
  const float* gcg = (const float*)(p.ws + O_GC);
  u16* og = (u16*)(p.ws + O_OD) + (size_t)d * T_ALL * 256;
  u16* STw = ST + w * 16 * 72;
  u16* VTw = VT + w * 16 * 72;
  f32x4 accS[4];
#pragma unroll
  for (int mt = 0; mt < 4; mt++) accS[mt] = (f32x4){0, 0, 0, 0};
  LDS_BARRIER();
  for (int e = lane; e < 16 * 72; e += 64) STw[e] = 0;
  const int prow = tid >> 2, pseg = tid & 3;
  float gcv_n, gl_n; uint4 q0n, q1n, k0n, k1n;
#define CHAIN_PREFETCH(IT) do {                                                                   \
    const int ck_ = d == 0 ? c0 + (IT) : c0 + nc - 1 - (IT);                                       \
    const int t0_ = ck_ * 64;                                                                      \
    const int tok_ = d == 0 ? t0_ + prow : t0_ + 63 - prow;                                        \
    gl_n = gcg[(size_t)(h * 2 + d) * T_ALL + (d == 0 ? t0_ + 63 : t0_)];                          \
    gcv_n = gcg[(size_t)(h * 2 + d) * T_ALL + tok_];                                               \
    const u16* qr_ = qg + (size_t)tok_ * 256 + h * 64 + pseg * 16;                                 \
    const u16* kr_ = kg + (size_t)tok_ * 256 + h * 64 + pseg * 16;                                 \
    q0n = *(const uint4*)qr_; q1n = *(const uint4*)(qr_ + 8);                                      \
    k0n = *(const uint4*)kr_; k1n = *(const uint4*)(kr_ + 8); } while (0)
  CHAIN_PREFETCH(0);
#pragma unroll 1
  for (int it = 0; it < nc; it++) {
    const int ck = d == 0 ? c0 + it : c0 + nc - 1 - it;
    const int t0 = ck * 64;
    const u16* wch = (const u16*)(p.ws + O_WU) + ((size_t)(ck * 4 + h) * 2 + d) * 8192;
    const u16* uch = wch + 4096;
    const float gl = gl_n;
    bf16x8 awr[4][2];
    u16 uvr[4][4];
#pragma unroll
    for (int mt = 0; mt < 4; mt++) {
#pragma unroll
      for (int ks = 0; ks < 2; ks++) awr[mt][ks] = *(const bf16x8*)(wch + (16 * mt + fr) * 64 + ks * 32 + fq * 8);
#pragma unroll
      for (int e = 0; e < 4; e++) uvr[mt][e] = uch[(16 * mt + 4 * fq + e) * 64 + 16 * w + fr];
    }
    {
      const int row = prow, seg = pseg;
      const float gcv = gcv_n;
      if (seg == 0) sgc[row] = gcv;
      float eq = __expf(gcv), ek = __expf(gl - gcv);
      const uint4 q0 = q0n, q1 = q1n, k0 = k0n, k1 = k1n;
      if (it + 1 < nc) CHAIN_PREFETCH(it + 1);
      *(uint4*)(qs + row * 72 + seg * 16) = q0; *(uint4*)(qs + row * 72 + seg * 16 + 8) = q1;
      *(uint4*)(ks_ + row * 72 + seg * 16) = k0; *(uint4*)(ks_ + row * 72 + seg * 16 + 8) = k1;
      unsigned qa[8] = {q0.x, q0.y, q0.z, q0.w, q1.x, q1.y, q1.z, q1.w};
      unsigned ka[8] = {k0.x, k0.y, k0.z, k0.w, k1.x, k1.y, k1.z, k1.w};
#pragma unroll
      for (int i = 0; i < 8; i++) {
        float qa0 = bf2f((u16)(qa[i] & 0xffff)) * eq, qa1 = bf2f((u16)(qa[i] >> 16)) * eq;
        *(unsigned*)(qd + row * 72 + seg * 16 + 2 * i) = f2bf(qa0) | ((unsigned)f2bf(qa1) << 16);
        float kb0 = bf2f((u16)(ka[i] & 0xffff)) * ek, kb1 = bf2f((u16)(ka[i] >> 16)) * ek;
        kdT[(seg * 16 + 2 * i) * 72 + row] = f2bf(kb0);
        kdT[(seg * 16 + 2 * i + 1) * 72 + row] = f2bf(kb1);
      }
    }
    LDS_BARRIER();
    {
      f32x4 acc[4];
#pragma unroll
      for (int nt = 0; nt < 4; nt++) acc[nt] = (f32x4){0, 0, 0, 0};
#pragma unroll
      for (int ks = 0; ks < 2; ks++) {
        bf16x8 af = *(const bf16x8*)(qs + (16 * w + fr) * 72 + ks * 32 + fq * 8);
#pragma unroll
        for (int nt = 0; nt < 4; nt++) {
          bf16x8 bfm = *(const bf16x8*)(ks_ + (16 * nt + fr) * 72 + ks * 32 + fq * 8);
          acc[nt] = __builtin_amdgcn_mfma_f32_16x16x32_bf16(af, bfm, acc[nt], 0, 0, 0);
        }
      }
#pragma unroll
      for (int nt = 0; nt < 4; nt++)
#pragma unroll
        for (int e = 0; e < 4; e++) {
          int c = 16 * w + 4 * fq + e, m = 16 * nt + fr;
          float v = c >= m ? acc[nt][e] * __expf(sgc[c] - sgc[m]) : 0.f;
          at[c * 72 + m] = f2bf(v);
        }
    }
    LDS_BARRIER();
    {
      const int e0 = 16 * w;
      f32x4 av[4];
#pragma unroll
      for (int mt = 0; mt < 4; mt++) av[mt] = (f32x4){0, 0, 0, 0};
#pragma unroll
      for (int ks = 0; ks < 2; ks++) {
        bf16x8 bS = *(const bf16x8*)(STw + fr * 72 + ks * 32 + fq * 8);
#pragma unroll
        for (int mt = 0; mt < 4; mt++) {
          av[mt] = __builtin_amdgcn_mfma_f32_16x16x32_bf16(awr[mt][ks], bS, av[mt], 0, 0, 0);
        }
      }
#pragma unroll
      for (int mt = 0; mt < 4; mt++) {
        u16 hv[4];
#pragma unroll
        for (int e = 0; e < 4; e++) {
          int c = 16 * mt + 4 * fq + e;
          float vn = bf2f(uvr[mt][e]) - av[mt][e];
          hv[e] = f2bf(vn);
        }
        uint2 pk; pk.x = hv[0] | ((unsigned)hv[1] << 16); pk.y = hv[2] | ((unsigned)hv[3] << 16);
        *(uint2*)(VTw + fr * 72 + 16 * mt + 4 * fq) = pk;
      }
      __builtin_amdgcn_wave_barrier();
      f32x4 ao[4];
#pragma unroll
      for (int mt = 0; mt < 4; mt++) ao[mt] = (f32x4){0, 0, 0, 0};
#pragma unroll
      for (int ks = 0; ks < 2; ks++) {
        bf16x8 bS = *(const bf16x8*)(STw + fr * 72 + ks * 32 + fq * 8);
        bf16x8 bV = *(const bf16x8*)(VTw + fr * 72 + ks * 32 + fq * 8);
#pragma unroll
        for (int mt = 0; mt < 4; mt++) {
          bf16x8 aq = *(const bf16x8*)(qd + (16 * mt + fr) * 72 + ks * 32 + fq * 8);
          bf16x8 aa = *(const bf16x8*)(at + (16 * mt + fr) * 72 + ks * 32 + fq * 8);
          ao[mt] = __builtin_amdgcn_mfma_f32_16x16x32_bf16(aq, bS, ao[mt], 0, 0, 0);
          ao[mt] = __builtin_amdgcn_mfma_f32_16x16x32_bf16(aa, bV, ao[mt], 0, 0, 0);
        }
      }
#pragma unroll
      for (int mt = 0; mt < 4; mt++)
#pragma unroll
        for (int e = 0; e < 4; e++) {
          int c = 16 * mt + 4 * fq + e;
          int tok = d == 0 ? t0 + c : t0 + 63 - c;
          og[(size_t)tok * 256 + h * 64 + e0 + fr] = f2bf(ao[mt][e]);
        }
      float egl = __expf(gl);
#pragma unroll
      for (int mt = 0; mt < 4; mt++) accS[mt] = accS[mt] * egl;
#pragma unroll
      for (int ks = 0; ks < 2; ks++) {
        bf16x8 bV = *(const bf16x8*)(VTw + fr * 72 + ks * 32 + fq * 8);
#pragma unroll
        for (int mt = 0; mt < 4; mt++) {
          bf16x8 ak = *(const bf16x8*)(kdT + (16 * mt + fr) * 72 + ks * 32 + fq * 8);
          accS[mt] = __builtin_amdgcn_mfma_f32_16x16x32_bf16(ak, bV, accS[mt], 0, 0, 0);
        }
      }
      __builtin_amdgcn_wave_barrier();
#pragma unroll
      for (int mt = 0; mt < 4; mt++) {
        uint2 pk;
        pk.x = f2bf(accS[mt][0]) | ((unsigned)f2bf(accS[mt][1]) << 16);
        pk.y = f2bf(accS[mt][2]) | ((unsigned)f2bf(accS[mt][3]) << 16);
        *(uint2*)(STw + fr * 72 + 16 * mt + 4 * fq) = pk;
      }
    }
    LDS_BARRIER();
  }
}
__device__ __forceinline__ void gdn_final_rows(const Params& p, int l, int rowblk) {
  int tid_ = threadIdx.x; asm volatile("" : "+v"(tid_));
  const int lane = tid_ & 63, w = tid_ >> 6;
  const int tok0 = rowblk * 16 + w * 4;
  const u16* o0 = (const u16*)(p.ws + O_OD) + (size_t)tok0 * 256 + lane * 4;
  const u16* o1 = o0 + (size_t)T_ALL * 256;
  const u16* zg = (const u16*)(p.ws + O_ZC) + (size_t)tok0 * 1024 + 768 + lane * 4;
  uint2 a[4], b[4], g[4];
#pragma unroll
  for (int j = 0; j < 4; j++) { a[j] = *(const uint2*)(o0 + j * 256); b[j] = *(const uint2*)(o1 + j * 256); g[j] = *(const uint2*)(zg + j * 1024); }
  const float* nw = p.in[24] + l * 64 + (lane & 15) * 4;
  const float n0 = nw[0], n1 = nw[1], n2 = nw[2], n3 = nw[3];
  u16* dst = (u16*)(p.ws + O_XN) + (size_t)2 * T_ALL * 256 + (size_t)tok0 * 256 + lane * 4;
#pragma unroll
  for (int j = 0; j < 4; j++) {
    float o[4], gt[4];
    o[0] = bf2f(a[j].x & 0xffff) + bf2f(b[j].x & 0xffff); o[1] = bf2f(a[j].x >> 16) + bf2f(b[j].x >> 16);
    o[2] = bf2f(a[j].y & 0xffff) + bf2f(b[j].y & 0xffff); o[3] = bf2f(a[j].y >> 16) + bf2f(b[j].y >> 16);
    gt[0] = bf2f(g[j].x & 0xffff); gt[1] = bf2f(g[j].x >> 16); gt[2] = bf2f(g[j].y & 0xffff); gt[3] = bf2f(g[j].y >> 16);
    float ss = o[0] * o[0] + o[1] * o[1] + o[2] * o[2] + o[3] * o[3];
#pragma unroll
    for (int m = 8; m > 0; m >>= 1) ss += __shfl_xor(ss, m);
    float rs = rsqrtf(ss * (1.f / 64.f) + EPSF);
    if (!(MIXMASK & 4)) rs = 0.f;
    *(uint2*)(dst + j * 256) = pack4(o[0] * rs * n0 * siluf_(gt[0]), o[1] * rs * n1 * siluf_(gt[1]), o[2] * rs * n2 * siluf_(gt[2]), o[3] * rs * n3 * siluf_(gt[3]));
  }
}
__device__ __forceinline__ void grpnorm_rows(const Params& p, int l, int which, int rowblk) {
  int tid_ = threadIdx.x; asm volatile("" : "+v"(tid_));
  const int lane = tid_ & 63, w = tid_ >> 6;
  u16* m0 = (u16*)(p.ws + O_XN) + (size_t)which * T_ALL * 256 + (size_t)(rowblk * 16 + w * 4) * 256 + lane * 4;
  uint2 a[4];
#pragma unroll
  for (int j = 0; j < 4; j++) a[j] = *(const uint2*)(m0 + j * 256);
  const float* gn = p.in[34] + (l * 3 + which) * 256 + lane * 4;
  const float g0 = gn[0], g1 = gn[1], g2 = gn[2], g3 = gn[3];
#pragma unroll
  for (int j = 0; j < 4; j++) {
    float v[4] = {bf2f(a[j].x & 0xffff), bf2f(a[j].x >> 16), bf2f(a[j].y & 0xffff), bf2f(a[j].y >> 16)};
    float ss = wave_sum(v[0] * v[0] + v[1] * v[1] + v[2] * v[2] + v[3] * v[3]);
    float rs = rsqrtf(ss * (1.f / 256.f) + EPSF);
    if (!((MIXMASK >> which) & 1)) rs = 0.f;
    *(uint2*)(m0 + j * 256) = pack4(v[0] * rs * g0, v[1] * rs * g1, v[2] * rs * g2, v[3] * rs * g3);
  }
}

#define WST 1296
#define UST 264
__device__ __forceinline__ float hy_conv3(const u16* __restrict__ raw, int t, int L, float w0, float w1, float w2, float b) {
  float xm = t > 0 ? bf2f(raw[t - 1]) : 0.f;
  float x0 = bf2f(raw[t]);
  float xp = t + 1 < L ? bf2f(raw[t + 1]) : 0.f;
  return w0 * xm + w1 * x0 + w2 * xp + b;
}
__device__ __forceinline__ void hy_conv_item(char* smraw, const Params& p, int l, int stage, int set, int c, int tb) {
  int tid = threadIdx.x; asm volatile("" : "+v"(tid)); const int _tid_pad = 0, lane = tid & 63, w = tid >> 6, fr = lane & 15, fq = lane >> 4;
  const int L = 2048 << set, nb = 8 << set, base = set ? T_P : 0;
  const int T0 = tb * 1024;
  u16* win = (u16*)smraw;
  u16* su = win + 8 * WST;
  float* sinv = (float*)(su + 16 * UST);
  const u16* dt = (const u16*)(p.ws + O_DT);
  const u16* rawv = dt + (size_t)c * T_ALL + base;
  const u16* rawx = dt + (size_t)((stage + 1) * 256 + c) * T_ALL + base;
  const u16* y1 = (const u16*)(p.ws + O_Y1) + (size_t)c * T_ALL + base;
  u16* outp = stage == 0 ? (u16*)(p.ws + O_Y1) + (size_t)c * T_ALL + base
                         : (u16*)(p.ws + O_DT) + (size_t)(256 + c) * T_ALL + base;
  const u16* kr = (const u16*)(p.ws + O_HYKR) + (set ? HYKR1 : 0) + ((size_t)stage * 256 + c) * (2 * L);
  const float* cw = p.in[25] + (size_t)l * 3 * 768;
  const float* cb = p.in[26] + (size_t)l * 768;
  const float v0 = cw[c], v1 = cw[768 + c], v2 = cw[1536 + c], vb = cb[c];
  const int xc_ = (stage + 1) * 256 + c;
  const float x0w = cw[xc_], x1w = cw[768 + xc_], x2w = cw[1536 + xc_], xbw = cb[xc_];
  LDS_BARRIER();
  if (tid < 64) {
    const float* ps = (const float*)(p.ws + O_HYPS) + (size_t)(set ? 32 * 512 : 0);
    int ntb = L / 64;
    float s = 0.f;
    for (int i = lane; i < ntb; i += 64) s += ps[(size_t)i * 512 + stage * 256 + c];
    s = wave_sum(s);
    if (lane == 0) sinv[0] = 1.f / s;
  }
  f32x4 acc[16];
#pragma unroll
  for (int i = 0; i < 16; i++) acc[i] = (f32x4){0, 0, 0, 0};
  for (int S0 = 0; S0 < L; S0 += 256) {
    LDS_BARRIER();
    const int B0 = S0 - T0;
    for (int idx = tid; idx < 8 * 160; idx += 256) {
      int rho = idx / 160, gi = idx % 160;
      int ybase = B0 - 1016 + 8 * gi - rho + L;
      int a = ybase & ~1;
      uint4 pk;
      if (a >= 0 && a + 10 <= 2 * L) {
        const unsigned* kd = (const unsigned*)(kr + a);
        unsigned d0 = kd[0], d1 = kd[1], d2 = kd[2], d3 = kd[3], d4 = kd[4];
        if (ybase & 1) {
          pk.x = __builtin_amdgcn_alignbit(d1, d0, 16); pk.y = __builtin_amdgcn_alignbit(d2, d1, 16);
          pk.z = __builtin_amdgcn_alignbit(d3, d2, 16); pk.w = __builtin_amdgcn_alignbit(d4, d3, 16);
        } else { pk.x = d0; pk.y = d1; pk.z = d2; pk.w = d3; }
      } else {
        u16 hh[8];
#pragma unroll
        for (int e = 0; e < 8; e++) { int yy = ybase + e; hh[e] = (yy >= 0 && yy < 2 * L) ? kr[yy] : (u16)0; }
        pk.x = hh[0] | ((unsigned)hh[1] << 16); pk.y = hh[2] | ((unsigned)hh[3] << 16);
        pk.z = hh[4] | ((unsigned)hh[5] << 16); pk.w = hh[6] | ((unsigned)hh[7] << 16);
      }
      *(uint4*)(win + rho * WST + 8 * gi) = pk;
    }
    {
      int b = tid >> 4, seg = tid & 15;
      uint4 p0 = make_uint4(0, 0, 0, 0), p1 = make_uint4(0, 0, 0, 0);
      if (b < nb) {
        const u16* src = (stage == 0 ? rawv : y1) + (size_t)b * L;
        const int s0 = S0 + seg * 16;
        uint4 r0 = *(const uint4*)(src + s0), r1 = *(const uint4*)(src + s0 + 8);
        if (stage == 0) {
          unsigned w[8] = {r0.x, r0.y, r0.z, r0.w, r1.x, r1.y, r1.z, r1.w};
          float x[18];
          x[0] = s0 > 0 ? bf2f(src[s0 - 1]) : 0.f;
          x[17] = s0 + 16 < L ? bf2f(src[s0 + 16]) : 0.f;
#pragma unroll
          for (int q = 0; q < 8; q++) { x[1 + 2 * q] = __uint_as_float(w[q] << 16); x[2 + 2 * q] = __uint_as_float(w[q] & 0xffff0000u); }
          unsigned o[8];
#pragma unroll
          for (int q = 0; q < 8; q++) {
            float c0 = v0 * x[2 * q] + v1 * x[2 * q + 1] + v2 * x[2 * q + 2] + vb;
            float c1 = v0 * x[2 * q + 1] + v1 * x[2 * q + 2] + v2 * x[2 * q + 3] + vb;
            o[q] = f2bf(c0) | ((unsigned)f2bf(c1) << 16);
          }
          p0 = make_uint4(o[0], o[1], o[2], o[3]); p1 = make_uint4(o[4], o[5], o[6], o[7]);
        } else { p0 = r0; p1 = r1; }
      }
      *(uint4*)(su + b * UST + seg * 16) = p0;
      *(uint4*)(su + b * UST + seg * 16 + 8) = p1;
    }
    LDS_BARRIER();
    bf16x8 bfr[8];
#pragma unroll
    for (int j = 0; j < 8; j++) bfr[j] = *(const bf16x8*)(su + fr * UST + 32 * j + 8 * fq);
    const u16* wbase = win + (fr & 7) * WST + (8 * fq - 256 * w - 8 * (fr >> 3) + 1016);
    __builtin_amdgcn_s_setprio(1);
#pragma unroll
    for (int dd = 0; dd < 30; dd++) {
      bf16x8 af = *(const bf16x8*)(wbase + 16 * (dd - 15));
#pragma unroll
      for (int j = 0; j < 8; j++) {
        const int i = 2 * j - (dd - 15);
        if (i >= 0 && i < 16) acc[i] = __builtin_amdgcn_mfma_f32_16x16x32_bf16(af, bfr[j], acc[i], 0, 0, 0);
      }
    }
    __builtin_amdgcn_s_setprio(0);
  }
  LDS_BARRIER();
  const float inv = sinv[0];
  const float bias = p.in[33][(size_t)(l * 2 + stage) * 256 + c];
  if (fr < nb) {
#pragma unroll
    for (int i = 0; i < 16; i++) {
      u16 r[4];
#pragma unroll
      for (int e = 0; e < 4; e++) {
        int t = T0 + 256 * w + 16 * i + 4 * fq + e;
        float uval = stage == 0 ? hy_conv3(rawv + (size_t)fr * L, t, L, v0, v1, v2, vb) : bf2f(y1[(size_t)fr * L + t]);
        float xg = hy_conv3(rawx + (size_t)fr * L, t, L, x0w, x1w, x2w, xbw);
        r[e] = f2bf(xg * (acc[i][e] * inv + bias * uval));
      }
      uint2 pk; pk.x = r[0] | ((unsigned)r[1] << 16); pk.y = r[2] | ((unsigned)r[3] << 16);
      *(uint2*)(outp + (size_t)fr * L + T0 + 256 * w + 16 * i + 4 * fq) = pk;
    }
  }
}
__device__ __forceinline__ void hy_final_item(char* smraw, const Params& p, int l, int ck) {
  int tid = threadIdx.x; asm volatile("" : "+v"(tid)); const int _tid_pad = 0, lane = tid & 63, w = tid >> 6;
  float* s = (float*)smraw;
  const u16* yd = (const u16*)(p.ws + O_DT) + (size_t)256 * T_ALL;
  const int t0 = ck * 64;
  LDS_BARRIER();
#pragma unroll 16
  for (int i = 0; i < 64; i++) {
    int c = w * 64 + i;
    s[lane * 257 + c] = bf2f(yd[(size_t)c * T_ALL + t0 + lane]);
  }
  LDS_BARRIER();
  const float* gn = p.in[34] + (l * 3 + 2) * 256;
  u16* mixD = (u16*)(p.ws + O_XN) + (size_t)3 * T_ALL * 256;
  for (int i = 0; i < 16; i++) {
    int tt = w * 16 + i;
    float v[4];
#pragma unroll
    for (int e = 0; e < 4; e++) v[e] = s[tt * 257 + lane * 4 + e];
    float ss = wave_sum(v[0] * v[0] + v[1] * v[1] + v[2] * v[2] + v[3] * v[3]);
    float rs = rsqrtf(ss * (1.f / 256.f) + EPSF);
    if (!(MIXMASK & 8)) rs = 0.f;
    uint2 pk;
    pk.x = f2bf(v[0] * rs * gn[lane * 4]) | ((unsigned)f2bf(v[1] * rs * gn[lane * 4 + 1]) << 16);
    pk.y = f2bf(v[2] * rs * gn[lane * 4 + 2]) | ((unsigned)f2bf(v[3] * rs * gn[lane * 4 + 3]) << 16);
    *(uint2*)(mixD + (size_t)(t0 + tt) * 256 + lane * 4) = pk;
  }
}

#define XB_CENS(j) (64 + 64 * (j))
#define XB_XSUB(j) (1088 + 64 * (j))
#define XB_XGEN(j) (2112 + 64 * (j))
#define XB_TOP 3136
#define XB_TOPGEN 3200
__device__ __forceinline__ unsigned xb_ld(unsigned* p) { return __hip_atomic_load(p, __ATOMIC_RELAXED, __HIP_MEMORY_SCOPE_AGENT); }
__device__ __forceinline__ unsigned xb_add(unsigned* p, unsigned v) { return __hip_atomic_fetch_add(p, v, __ATOMIC_RELAXED, __HIP_MEMORY_SCOPE_AGENT); }
__device__ __forceinline__ void xcd_barrier(unsigned* bar, unsigned x, unsigned nloc, unsigned nx, unsigned k) {
  asm volatile("s_waitcnt vmcnt(0) lgkmcnt(0)" ::: "memory");
  __syncthreads();
  if (threadIdx.x == 0) {
    const unsigned old = xb_add(&bar[XB_XSUB(x)], 1u);
    if (old + 1u == k * nloc) {
      __builtin_amdgcn_fence(__ATOMIC_RELEASE, "agent");
      asm volatile("s_waitcnt vmcnt(0)" ::: "memory");
      const unsigned og = xb_add(&bar[XB_TOP], 1u);
      if (og + 1u == k * nx) xb_add(&bar[XB_TOPGEN], 1u);
      else while (xb_ld(&bar[XB_TOPGEN]) < k) __builtin_amdgcn_s_sleep(1);
      __builtin_amdgcn_fence(__ATOMIC_ACQUIRE, "agent");
      xb_add(&bar[XB_XGEN(x)], 1u);
      asm volatile("s_waitcnt vmcnt(0)" ::: "memory");
    } else {
      while (xb_ld(&bar[XB_XGEN(x)]) < k) __builtin_amdgcn_s_sleep(1);
      __builtin_amdgcn_fence(__ATOMIC_ACQUIRE, "agent");
      asm volatile("s_waitcnt vmcnt(0)" ::: "memory");
    }
  }
  __syncthreads();
}
#define GRID_SYNC() do { ++bar_k; xcd_barrier(bar, bst[0], bst[1], bst[2], bar_k); } while (0)

#define TILE_LOOP(nM_, nN_, MT, NT)                                                                  \
  const int nSN_ = ((nN_) + 7) >> 3, nS_ = (((nM_) + 7) >> 3) * nSN_, P_ = nblk >> 3;                 \
  _Pragma("unroll 1") for (int S_ = (bid & 7); S_ < nS_ && (bid >> 3) < P_; S_ += 8)                 \
  _Pragma("unroll 1") for (int q_ = (bid >> 3); q_ < 64; q_ += P_)                                   \
    for (int MT = (S_ / nSN_) * 8 + (q_ >> 3), NT = (S_ % nSN_) * 8 + (q_ & 7), once_ = 1; once_ && MT < (nM_) && NT < (nN_); once_ = 0)

__global__ void __launch_bounds__(256, 2) mega(Params p) {
  cg::grid_group grid = cg::this_grid();
  __shared__ __attribute__((aligned(16))) char smraw[SMEM_BYTES];
  u16* smem = (u16*)smraw;
  float* smf = (float*)smraw;
  const int bid = blockIdx.x, nblk = gridDim.x, tid = threadIdx.x;
  const int rbid = nblk - 1 - bid;
  const int lane = tid & 63;
  char* const ws = p.ws;
  unsigned* const bar = (unsigned*)(ws + O_BAR);
  __shared__ unsigned bst[4];
  unsigned bar_k = 0;
  if (tid == 0) { bst[0] = (unsigned)__builtin_amdgcn_s_getreg((3 << 11) | 20) & 0xFu; xb_add(&bar[XB_CENS(bst[0])], 1u); }
  __threadfence();
  grid.sync();
  if (tid == 0) {
    unsigned mine = 0, cnt = 0;
    for (unsigned j = 0; j < 16; j++) { unsigned c = xb_ld(&bar[XB_CENS(j)]); cnt += c > 0u ? 1u : 0u; if (j == bst[0]) mine = c; }
    bst[1] = mine; bst[2] = cnt;
  }
  __syncthreads();

#ifdef NANFILL
  {
    uint4 nanv = make_uint4(0x7FC07FC0u, 0x7FC07FC0u, 0x7FC07FC0u, 0x7FC07FC0u);
    uint4* w4 = (uint4*)ws;
    for (size_t i = (size_t)bid * 256 + tid; i < WS_TOTAL / 16; i += (size_t)nblk * 256) w4[i] = nanv;
    uint4* o4 = (uint4*)p.out;
    for (size_t i = (size_t)bid * 256 + tid; i < (size_t)T_ALL * DM / 4; i += (size_t)nblk * 256) o4[i] = nanv;
    __threadfence(); grid.sync(); __threadfence();
  }
#endif
#pragma unroll 1
  for (int lay = 0; lay < 2; lay++) {
    {
      int l = lay; asm volatile("" : "+s"(l));
#pragma unroll 1
      for (int i = bid; i < 42 * 16; i += nblk) transpose_tile(smf, p.in[3] + (size_t)l * 1024 * 2576, 2576, p.in[2] + l * 1024, (u16*)(ws + O_WIN), 1024, 0, (i / 16) * 64, (i % 16) * 64);
#pragma unroll 1
      for (int i = rbid; i < 16 * 16; i += nblk) transpose_tile(smf, p.in[35] + (size_t)l * 1024 * 1024, 1024, nullptr, (u16*)(ws + O_WOUT), 1024, 1, (i / 16) * 64, (i % 16) * 64);
#pragma unroll 1
      for (int i = bid; i < 88 * 16; i += nblk) transpose_tile(smf, p.in[37] + (size_t)l * 1024 * 5632, 5632, p.in[36] + l * 1024, (u16*)(ws + O_WUP), 1024, 2, (i / 16) * 64, (i % 16) * 64);
#pragma unroll 1
      for (int i = rbid; i < 16 * 44; i += nblk) transpose_tile(smf, p.in[40] + (size_t)l * 2816 * 1024, 1024, nullptr, (u16*)(ws + O_WDN), 2816, 3, (i / 44) * 64, (i % 44) * 64);
#pragma unroll 1
      for (int i = bid; i < 16; i += nblk) transpose_tile(smf, p.in[19] + (size_t)l * 256 * 256, 256, nullptr, (u16*)(ws + O_WGLU), 256, 4, (i / 4) * 64, (i % 4) * 64);
#pragma unroll 1
      for (int i = rbid; i < 64; i += nblk) {
        u16* wl = (u16*)(ws + O_WLRU);
        for (int e = i * 1024 + tid; e < (i + 1) * 1024; e += 256) {
          int k = e & 63, n = (e >> 6) & 255, head = e >> 14;
          int d = n >> 7, gate = (n >> 6) & 1, j = n & 63;
          const float* wr_ = p.in[6]; const float* wi_ = p.in[8];
          size_t off_ = ((size_t)((l * 2 + d) * 4 + head) * 64 + k) * 64 + j;
          float vr_ = wr_[off_], vi_ = wi_[off_];
          wl[e] = f2bf(gate ? vi_ : vr_);
        }
      }
#pragma unroll 1
      for (int i = bid; i < 16 * 2 * 65; i += nblk) s5_prep_item(smf, p, l, i);
#pragma unroll 1
      for (int i = rbid; i < 16 * 2 * 64; i += nblk) s5_bts_item(p, l, i);
#pragma unroll 1
      for (int i = rbid; i < 96; i += nblk) hy_filter_item(smf, p, l, i < 32 ? 0 : 1, i < 32 ? i : i - 32);
      {
        unsigned* rq = (unsigned*)(ws + O_BAR + 208) + l;
        int* rslot = (int*)(smraw + SMEM_BYTES - 16);
#pragma unroll 1
        for (;;) {
          __syncthreads();
          if (tid == 0) *rslot = (int)atomicAdd(rq, 1u);
          __syncthreads();
          const int c0 = *rslot * 4;
          if (c0 >= T_ALL / 16) break;
#pragma unroll 1
          for (int i = c0; i < c0 + 4; i++) rms_rows_to_bf16(p, l, i);
        }
      }
    }
    GRID_SYNC();
    {
      int l = lay; asm volatile("" : "+s"(l));
      TILE_LOOP(640, 21, mt, nt) {
        { const float* H = gemm_tile(smem, (const u16*)(ws + O_XN), 1024, mt * 128, 0, T_ALL, 30, 0, (const u16*)(ws + O_WIN) + (size_t)nt * 128 * 1024, 1024, 1024);
            int tid_o = threadIdx.x; asm volatile("" : "+v"(tid_o));
            const int tok0 = mt * 128;
            if (nt < 4) {
              u16* zA = (u16*)(ws + O_ZA) + (size_t)tok0 * 512 + nt * 128;
              EPI_ROWS(H, { *(uint2*)(zA + (size_t)r * 512 + c) = pack4(v.x, v.y, v.z, v.w); })
            } else if (nt < 6) {
              u16* uh = (u16*)(ws + O_UH);
              EPI_ROWS(H, {
                int tok = tok0 + r, ch = (nt - 4) * 128 + c;
                *(uint2*)(uh + ((size_t)(ch >> 4) * 1280 + (tok >> 6)) * 1280 + (tok & 63) * 16 + (ch & 15)) = pack4(v.x, v.y, v.z, v.w); })
            } else if (nt < 14) {
              u16* zC = (u16*)(ws + O_ZC) + (size_t)tok0 * 1024 + (nt - 6) * 128;
              EPI_ROWS(H, { *(uint2*)(zC + (size_t)r * 1024 + c) = pack4(v.x, v.y, v.z, v.w); })
            } else if (nt < 20) {
              u16* dt = (u16*)(ws + O_DT) + (size_t)((nt - 14) * 128 + (tid_o & 127)) * T_ALL + tok0 + (tid_o >> 7) * 64;
              const float* Hc = H + (tid_o >> 7) * 64 * HST + (tid_o & 127);
#pragma unroll 2
              for (int k = 0; k < 8; k++) {
                uint2 a = pack4(Hc[(8 * k) * HST], Hc[(8 * k + 1) * HST], Hc[(8 * k + 2) * HST], Hc[(8 * k + 3) * HST]);
                uint2 b = pack4(Hc[(8 * k + 4) * HST], Hc[(8 * k + 5) * HST], Hc[(8 * k + 6) * HST], Hc[(8 * k + 7) * HST]);
                uint4 pk; pk.x = a.x; pk.y = a.y; pk.z = b.x; pk.w = b.y;
                *(uint4*)(dt + 8 * k) = pk;
              }
            } else {
              float* ba = (float*)(ws + O_BA) + (size_t)tok0 * 16;
#pragma unroll 2
              for (int k = 0; k < 8; k++) { int idx = tid_o + 256 * k; ba[idx] = H[(idx >> 4) * HST + (idx & 15)]; }
            }
          }
      }
#pragma unroll 1
      for (int it = rbid; it < 16 * 1024; it += nblk) s5_expand_item(p, l, it);
    }
    GRID_SYNC();
    {
      int l = lay; asm volatile("" : "+s"(l));
#pragma unroll 1
      for (int it = bid; it < NCH64 * 4; it += nblk) gdn_g1_item(smraw, p, l, it);
#pragma unroll 1
      for (int it = rbid; it < 16 * 10 * 2; it += nblk) {
        const int g = it / 20, mt = (it % 20) >> 1, nt = it & 1;
        { const float* H = gemm_tile(smem, (const u16*)(ws + O_UH) + (size_t)g * 1280 * 1280, 1280, mt * 128, 0, 1280, 30, 0,
                  (const u16*)(ws + O_BTS) + (size_t)g * 256 * 1024 + (size_t)nt * 128 * 1024, 1024, 1024);
            int tid_o = threadIdx.x; asm volatile("" : "+v"(tid_o));
            float* send = (float*)(ws + O_SEND) + (size_t)g * 1280 * 256 + (size_t)mt * 128 * 256 + nt * 128;
            EPI_ROWS(H, { *(float4*)(send + (size_t)r * 256 + c) = v; })
          }
      }
#pragma unroll 1
      for (int it = bid; it < NCH32 * 4; it += nblk) lru_item(smraw, p, l, it, 0);
    }
    GRID_SYNC();
    {
      int l = lay; asm volatile("" : "+s"(l));
#pragma unroll 1
      for (int it = bid; it < 192; it += nblk) gdn_chain(smraw, p, it);
#pragma unroll 1
      for (int it = rbid; it < 48; it += nblk) lru_propagate(p, it * 256 + tid);
#pragma unroll 1
      for (int it = rbid - 48; it < 192; it += nblk) { if (it >= 0) s5_propagate(p, l, it * 256 + tid); }
      unsigned* hq = (unsigned*)(ws + O_BAR + 192) + l;
      int* hslot = (int*)(smraw + SMEM_BYTES - 16);
#pragma unroll 1
      for (;;) {
        __syncthreads();
        if (tid == 0) *hslot = (int)atomicAdd(hq, 1u);
        __syncthreads();
        const int item = *hslot;
        if (item >= 512) break;
        const int set = item < 256 ? 1 : 0, c = item & 255, ntb = set ? 4 : 2;
#pragma unroll 1
        for (int tb = 0; tb < ntb; tb++) hy_conv_item(smraw, p, l, 0, set, c, tb);
        __threadfence();
        __syncthreads();
#pragma unroll 1
        for (int tb = 0; tb < ntb; tb++) hy_conv_item(smraw, p, l, 1, set, c, tb);
      }
    }
    GRID_SYNC();
    {
      int l = lay; asm volatile("" : "+s"(l));
#pragma unroll 1
      for (int it = rbid; it < 16 * 10 * 8; it += nblk) {
        const int g = it / 80, mt = (it % 80) >> 3, nt = it & 7;
        { const float* H = gemm_tile(smem, (const u16*)(ws + O_UH) + (size_t)g * 1280 * 1280, 1280, mt * 128, 0, 1280, 30, 0,
                  (const u16*)(ws + O_BTY) + (size_t)g * 1024 * 1280 + (size_t)nt * 128 * 1280, 1280, 1280);
            int tid_o = threadIdx.x; asm volatile("" : "+v"(tid_o));
            u16* zb = (u16*)(ws + O_XN) + (size_t)3 * T_ALL * 256;
            EPI_ROWS(H, {
              int ck = mt * 128 + r, n = nt * 128 + c;
              *(uint2*)(zb + ((size_t)g * T_ALL + ck * 64 + (n >> 4)) * 16 + (n & 15)) = pack4(geluf_(v.x), geluf_(v.y), geluf_(v.z), geluf_(v.w)); })
          }
      }
#pragma unroll 1
      for (int it = bid; it < NCH32 * 4; it += nblk) lru_item(smraw, p, l, it, 1);
#pragma unroll 1
      for (int it = rbid; it < T_ALL / 16; it += nblk) gdn_final_rows(p, l, it);
    }
    GRID_SYNC();
    {
      int l = lay; asm volatile("" : "+s"(l));
#pragma unroll 1
      for (int it = bid; it < 640 * 2; it += nblk) {
        const int mt = it >> 1, nt = it & 1;
        const u16* zb = (const u16*)(ws + O_XN) + (size_t)3 * T_ALL * 256;
        { const float* H = gemm_tile(smem, zb, 16, mt * 128, 0, T_ALL, 4, (size_t)T_ALL * 16, (const u16*)(ws + O_WGLU) + (size_t)nt * 128 * 256, 256, 256);
            int tid_o = threadIdx.x; asm volatile("" : "+v"(tid_o));
            u16* mixB = (u16*)(ws + O_XN) + (size_t)T_ALL * 256 + (size_t)mt * 128 * 256 + nt * 128;
            const u16* zr = zb + (size_t)mt * 128 * 16;
            const float* gb = p.in[20] + l * 256 + nt * 128;
            EPI_ROWS(H, {
              uint2 zz = *(const uint2*)(zr + ((size_t)((nt * 128 + c) >> 4) * T_ALL + r) * 16 + (c & 15));
              float4 g4 = *(const float4*)(gb + c);
              float z0 = bf2f(zz.x & 0xffff), z1 = bf2f(zz.x >> 16), z2 = bf2f(zz.y & 0xffff), z3 = bf2f(zz.y >> 16);
              *(uint2*)(mixB + (size_t)r * 256 + c) = pack4(z0 * sigmoidf_(v.x + g4.x), z1 * sigmoidf_(v.y + g4.y), z2 * sigmoidf_(v.z + g4.z), z3 * sigmoidf_(v.w + g4.w)); })
          }
      }
#pragma unroll 1
      for (int it = rbid; it < T_ALL / 16; it += nblk) grpnorm_rows(p, l, 0, it);
    }
    GRID_SYNC();
    {
      int l = lay; asm volatile("" : "+s"(l));
#pragma unroll 1
      for (int it = bid; it < NCH64; it += nblk) hy_final_item(smraw, p, l, it);
#pragma unroll 1
      for (int it = rbid; it < T_ALL / 16; it += nblk) grpnorm_rows(p, l, 1, it);
    }
    GRID_SYNC();
    {
      int l = lay; asm volatile("" : "+s"(l));
      TILE_LOOP(640, 8, mt, nt) {
        { const float* H = gemm_tile(smem, (const u16*)(ws + O_XN), 256, mt * 128, 0, T_ALL, 8, (size_t)T_ALL * 256,
                  (const u16*)(ws + O_WOUT) + (size_t)nt * 128 * 1024, 1024, 1024);
            int tid_o = threadIdx.x; asm volatile("" : "+v"(tid_o));
            float* o = p.out + (size_t)mt * 128 * DM + nt * 128;
            const int er = tid_o >> 5, ec = (tid_o & 31) * 4;
#pragma unroll 1
            for (int half = 0; half < 2; half++) {
              float4 b4[8];
#pragma unroll
              for (int q = 0; q < 8; q++) b4[q] = *(const float4*)(xrow(p, l, mt * 128 + er + 8 * (half * 8 + q)) + nt * 128 + ec);
#pragma unroll
              for (int q = 0; q < 8; q++) {
                const int r = er + 8 * (half * 8 + q);
                const float4 v = *(const float4*)(H + r * HST + ec);
                float4 o4; o4.x = b4[q].x + v.x; o4.y = b4[q].y + v.y; o4.z = b4[q].z + v.z; o4.w = b4[q].w + v.w;
                *(float4*)(o + (size_t)r * DM + ec) = o4;
              }
            }
          }
      }
    }
    GRID_SYNC();
    {
      int l = lay; asm volatile("" : "+s"(l));
#pragma unroll 1
      for (int it = bid; it < T_ALL / 16; it += nblk) rms_rows_to_bf16(p, 1, it);
    }
    GRID_SYNC();
    {
      int l = lay; asm volatile("" : "+s"(l));
      const int nM = 8 * 17 + 16 * 33;
      TILE_LOOP(nM, 44, mi, nt) {
        int seq, ti, L;
        if (mi < 136) { seq = mi / 17; ti = mi % 17; L = 2048; }
        else { seq = 8 + (mi - 136) / 33; ti = (mi - 136) % 33; L = 4096; }
        const int s0 = seq < 8 ? seq * 2048 : T_P + (seq - 8) * 4096;
        const int arow0 = s0 + 126 * ti - 1;
        const int nvalid = min(126, L - 126 * ti);
        { const float* H = gemm_tile<true>(smem, (const u16*)(ws + O_XN), 1024, arow0, s0, s0 + L, 30, 0, (const u16*)(ws + O_WUP) + (size_t)nt * 128 * 1024, 1024, 1024);
            int tid_o = threadIdx.x; asm volatile("" : "+v"(tid_o));
            const int j = tid_o & 63, rg = tid_o >> 6;
            const float* cw = p.in[38] + (size_t)l * 3 * 5632;
            const float* cb = p.in[39] + (size_t)l * 5632;
            const int cg_ = nt * 64 + j, cv_ = DFF + nt * 64 + j;
            const float g0 = cw[cg_], g1 = cw[5632 + cg_], g2 = cw[2 * 5632 + cg_], gb = cb[cg_];
            const float u0 = cw[cv_], u1 = cw[5632 + cv_], u2 = cw[2 * 5632 + cv_], ub = cb[cv_];
            u16* hm = (u16*)(ws + O_HMID) + (size_t)arow0 * DFF + nt * 64 + j;
#pragma unroll 2
            for (int r = 1 + rg; r <= nvalid; r += 4) {
              float gate = g0 * H[(r - 1) * HST + j] + g1 * H[r * HST + j] + g2 * H[(r + 1) * HST + j] + gb;
              float val = u0 * H[(r - 1) * HST + 64 + j] + u1 * H[r * HST + 64 + j] + u2 * H[(r + 1) * HST + 64 + j] + ub;
              hm[(size_t)r * DFF] = f2bf(siluf_(gate) * val);
            }
          }
      }
    }
    GRID_SYNC();
    {
      int l = lay; asm volatile("" : "+s"(l));
      TILE_LOOP(640, 8, mt, nt) {
        { const float* H = gemm_tile(smem, (const u16*)(ws + O_HMID), DFF, mt * 128, 0, T_ALL, 30, 0, (const u16*)(ws + O_WDN) + (size_t)nt * 128 * DFF, DFF, DFF);
            int tid_o = threadIdx.x; asm volatile("" : "+v"(tid_o));
            float* o = p.out + (size_t)mt * 128 * DM + nt * 128;
            const int er = tid_o >> 5, ec = (tid_o & 31) * 4;
#pragma unroll 1
            for (int half = 0; half < 2; half++) {
              float4 b4[8];
#pragma unroll
              for (int q = 0; q < 8; q++) b4[q] = *(const float4*)(o + (size_t)(er + 8 * (half * 8 + q)) * DM + ec);
#pragma unroll
              for (int q = 0; q < 8; q++) {
                const int r = er + 8 * (half * 8 + q);
                const float4 v = *(const float4*)(H + r * HST + ec);
                float4 o4; o4.x = b4[q].x + v.x; o4.y = b4[q].y + v.y; o4.z = b4[q].z + v.z; o4.w = b4[q].w + v.w;
                *(float4*)(o + (size_t)r * DM + ec) = o4;
              }
            }
          }
      }
    }
    GRID_SYNC();
  }
  {
    const int w = tid >> 6;
    const float* fn = p.in[41];
#pragma unroll 1
    for (int it = bid; it < T_ALL / 16; it += nblk) {
      float* x0 = p.out + (size_t)(it * 16 + w * 4) * DM;
      float4 v[4][4];
#pragma unroll
      for (int j = 0; j < 4; j++)
#pragma unroll
        for (int i = 0; i < 4; i++) v[j][i] = *(const float4*)(x0 + (size_t)j * DM + i * 256 + lane * 4);
#pragma unroll
      for (int j = 0; j < 4; j++) {
        float ss = 0.f;
#pragma unroll
        for (int i = 0; i < 4; i++) ss += v[j][i].x * v[j][i].x + v[j][i].y * v[j][i].y + v[j][i].z * v[j][i].z + v[j][i].w * v[j][i].w;
        ss = wave_sum(ss);
        float rs = rsqrtf(ss * (1.f / 1024.f) + EPSF);
#pragma unroll
        for (int i = 0; i < 4; i++) {
          float4 g = *(const float4*)(fn + i * 256 + lane * 4);
          float4 o; o.x = v[j][i].x * rs * g.x; o.y = v[j][i].y * rs * g.y; o.z = v[j][i].z * rs * g.z; o.w = v[j][i].w * rs * g.w;
          *(float4*)(x0 + (size_t)j * DM + i * 256 + lane * 4) = o;
        }
      }
    }
  }
}

extern "C" void kernel_launch(void* const* d_in, const int* in_sizes, int n_in,
                              void* d_out, int out_size, void* d_ws, size_t ws_size,
                              hipStream_t stream) {
  static int grid_blocks = 0;
  if (!grid_blocks) {
    int dev = 0, cus = 0, per_cu = 0;
    (void)hipGetDevice(&dev);
    (void)hipDeviceGetAttribute(&cus, hipDeviceAttributeMultiprocessorCount, dev);
    (void)hipOccupancyMaxActiveBlocksPerMultiprocessor(&per_cu, mega, 256, 0);
    if (per_cu > 2) per_cu = 2;
    if (per_cu < 1) per_cu = 1;
    grid_blocks = cus * per_cu;
  }
  if (ws_size < WS_TOTAL) fprintf(stderr, "workspace too small: %zu < %zu\n", ws_size, (size_t)WS_TOTAL);
  Params p{};
  for (int i = 0; i < 42; i++) p.in[i] = (const float*)d_in[i];
  p.out = (float*)d_out;
  p.ws = (char*)d_ws;
  (void)hipMemsetAsync((char*)d_ws + O_BAR, 0, 16384, stream);
  void* args[] = {&p};
  hipError_t e = hipLaunchCooperativeKernel((void*)mega, dim3(grid_blocks), dim3(256), args, 0, stream);
  if (e != hipSuccess) fprintf(stderr, "coop launch failed: %s (grid %d)\n", hipGetErrorString(e), grid_blocks);
}
```

```cpp
#include <hip/hip_runtime.h>
#include <hip/hip_bf16.h>
#include <hip/hip_cooperative_groups.h>
#include <cstdio>
namespace cg = cooperative_groups;

typedef unsigned short u16;
using bf16x8 = __attribute__((ext_vector_type(8))) short;
using f32x4 = __attribute__((ext_vector_type(4))) float;

#define T_ALL 81920
#define T_P 16384
#define DM 1024
#define NZ 2688
#define DFF 2816
#define NCH32 2560
#define NCH64 1280
#define EPSF 1e-6f

constexpr size_t al(size_t x) { return (x + 255) & ~(size_t)255; }
constexpr size_t O_WIN = 0;
constexpr size_t O_WOUT = O_WIN + al((size_t)NZ * 1024 * 2);
constexpr size_t O_WUP = O_WOUT + al((size_t)1024 * 1024 * 2);
constexpr size_t O_WDN = O_WUP + al((size_t)5632 * 1024 * 2);
constexpr size_t O_WLRU = O_WDN + al((size_t)1024 * 2816 * 2);
constexpr size_t O_WGLU = O_WLRU + al((size_t)4 * 256 * 64 * 2);
constexpr size_t O_AB64 = O_WGLU + al((size_t)256 * 256 * 2);
constexpr size_t O_KTAB = O_AB64 + 2 * al((size_t)2 * 16 * 64 * 2 * 4);
constexpr size_t O_BTY = O_KTAB + al((size_t)16 * 2 * 64 * 256 * 4);
constexpr size_t O_BTS = O_BTY + al((size_t)16 * 1024 * 1280 * 2);
constexpr size_t O_HYKR = O_BTS + al((size_t)16 * 256 * 1024 * 2);
constexpr size_t HYKR1 = (size_t)2 * 256 * 4096;
constexpr size_t O_HYPS = O_HYKR + al((size_t)2 * 256 * (4096 + 8192) * 2);
constexpr size_t O_XN = O_HYPS + al((size_t)(32 + 64) * 512 * 4);
constexpr size_t O_ZA = O_XN + al((size_t)T_ALL * 1024 * 2);
constexpr size_t O_UH = O_ZA + al((size_t)T_ALL * 512 * 2);
constexpr size_t O_ZC = O_UH + al((size_t)16 * 1280 * 1280 * 2);
constexpr size_t O_BA = O_ZC + al((size_t)T_ALL * 1024 * 2);
constexpr size_t O_DT = O_BA + al((size_t)T_ALL * 16 * 4);
constexpr size_t O_WU = O_DT + al((size_t)768 * T_ALL * 2);
constexpr size_t O_GC = O_WU + al((size_t)NCH64 * 4 * 2 * 2 * 4096 * 2);
constexpr size_t O_OD = O_GC + al((size_t)T_ALL * 8 * 4);
constexpr size_t O_Y1 = O_OD + al((size_t)2 * T_ALL * 256 * 2);
constexpr size_t O_SEND = O_Y1 + al((size_t)256 * T_ALL * 2);
constexpr size_t O_LCAR = O_SEND + al((size_t)16 * 1280 * 256 * 4);
constexpr size_t O_LHIN = O_LCAR + al((size_t)NCH32 * 512 * 8);
constexpr size_t O_BAR = O_LHIN + al((size_t)NCH32 * 512 * 4);
constexpr size_t WS_TOTAL = O_BAR + 16384;
static_assert(WS_TOTAL <= (size_t)1073741824, "ws");
constexpr size_t O_HMID = O_ZA;
static_assert(O_HMID + (size_t)T_ALL * DFF * 2 <= O_GC, "hmid alias");

struct Params {
  const float* in[42];
  float* out;
  char* ws;
};

#define SMEM_BYTES 73728
#ifndef MIXMASK
#define MIXMASK 15
#endif

__device__ __forceinline__ u16 f2bf(float f) {
  unsigned u = __float_as_uint(f);
  u += 0x7fffu + ((u >> 16) & 1u);
  return (u16)(u >> 16);
}
__device__ __forceinline__ float bf2f(u16 h) { return __uint_as_float(((unsigned)h) << 16); }
__device__ __forceinline__ float sigmoidf_(float x) { return 1.f / (1.f + __expf(-x)); }
__device__ __forceinline__ float siluf_(float x) { return x / (1.f + __expf(-x)); }
__device__ __forceinline__ float softplusf_(float x) { return x > 20.f ? x : log1pf(expf(x)); }
__device__ __forceinline__ float geluf_(float x) {
  float u2 = 1.5957691216057308f * (x + 0.044715f * x * x * x);
  return x / (1.f + __expf(-u2));
}
__device__ __forceinline__ float wave_sum(float v) {
#pragma unroll
  for (int o = 32; o > 0; o >>= 1) v += __shfl_xor(v, o);
  return v;
}
__device__ __forceinline__ const float* xrow(const Params& p, int l, int tok) {
  const float* a = p.in[0]; const float* b = p.in[1]; const float* o = p.out;
  const float* r0 = a + (size_t)tok * DM;
  const float* r1 = b + (size_t)(tok - T_P) * DM;
  const float* r2 = o + (size_t)tok * DM;
  return l == 0 ? (tok < T_P ? r0 : r1) : r2;
}
__device__ __forceinline__ void seq_bounds(int tok, int& lo, int& hi) {
  if (tok < T_P) { lo = tok & ~2047; hi = lo + 2048; }
  else { lo = T_P + ((tok - T_P) & ~4095); hi = lo + 4096; }
}

#define LDS_BARRIER() asm volatile("s_waitcnt lgkmcnt(0)\n\ts_barrier" ::: "memory")

#define GST 72
#define HST 132
template <bool MASK = false>
__device__ __forceinline__ const float* gemm_tile(u16* smem, const u16* __restrict__ A, long lda, int arow0, int alo, int ahi,
                                          int segShift, size_t segStride,
                                          const u16* __restrict__ Bt, long ldb, int K) {
  u16* sA = smem;
  u16* sB = smem + 2 * 128 * GST;
  int tid = threadIdx.x; asm volatile("" : "+v"(tid)); const int _tid_pad = 0, lane = tid & 63, w = tid >> 6;
  const int wm = w >> 1, wn = w & 1, fr = lane & 15, fq = lane >> 4;
  const int cc = tid & 7, r0 = tid >> 3;
  f32x4 acc[4][4];
#pragma unroll
  for (int i = 0; i < 4; i++)
#pragma unroll
    for (int j = 0; j < 4; j++) acc[i][j] = (f32x4){0.f, 0.f, 0.f, 0.f};
  uint4 ra0x, ra1x, ra2x, ra3x, rb0x, rb1x, rb2x, rb3x;
  const int nk = K >> 6;
#define GROW(i_, AP, BP, OK) const bool OK = !MASK || ((arow0 + r0 + 32 * i_) >= alo && (arow0 + r0 + 32 * i_) < ahi);        \
    const u16* AP = A + (long)(OK ? (arow0 + r0 + 32 * i_) : alo) * lda;                                             \
    const u16* BP = Bt + (long)(r0 + 32 * i_) * ldb + cc * 8;
  GROW(0, ap0, bp0, ok0) GROW(1, ap1, bp1, ok1) GROW(2, ap2, bp2, ok2) GROW(3, ap3, bp3, ok3)
#define GLOAD1(AP, BP, OK, RA, RB) {                                                \
      uint4 t_ = *(const uint4*)(AP + aoff_);                                         \
      RA = (!MASK || OK) ? t_ : make_uint4(0, 0, 0, 0);                               \
      RB = *(const uint4*)(BP + k0_); }
#define GLOAD(kt_, S) do {                                                         \
    const int k0_ = (kt_) << 6;                                                       \
    const int kk_ = k0_ + cc * 8;                                                     \
    const int sg_ = kk_ >> segShift;                                                  \
    const size_t aoff_ = (size_t)sg_ * segStride + (kk_ - (sg_ << segShift));         \
    GLOAD1(ap0, bp0, ok0, ra0##S, rb0##S) GLOAD1(ap1, bp1, ok1, ra1##S, rb1##S)       \
    GLOAD1(ap2, bp2, ok2, ra2##S, rb2##S) GLOAD1(ap3, bp3, ok3, ra3##S, rb3##S)       \
    } while (0)
#define SWRITE1(buf_, i_, RA, RB) {                                                 \
      *(uint4*)(sA + (buf_) * 128 * GST + (r0 + 32 * i_) * GST + cc * 8) = RA;        \
      *(uint4*)(sB + (buf_) * 128 * GST + (r0 + 32 * i_) * GST + cc * 8) = RB; }
#define SWRITE(buf_, S) do {                                                        \
    SWRITE1(buf_, 0, ra0##S, rb0##S) SWRITE1(buf_, 1, ra1##S, rb1##S) SWRITE1(buf_, 2, ra2##S, rb2##S) SWRITE1(buf_, 3, ra3##S, rb3##S) \
    } while (0)
#define GCOMPUTE(buf_) do {                                                         \
    const u16* a = sA + (buf_) * 128 * GST;                                           \
    const u16* b = sB + (buf_) * 128 * GST;                                           \
    _Pragma("unroll") for (int ks = 0; ks < 2; ks++) {                                \
      bf16x8 af[4], bfr[4];                                                           \
      _Pragma("unroll") for (int i = 0; i < 4; i++) {                                 \
        af[i] = *(const bf16x8*)(a + (64 * wm + 16 * i + fr) * GST + ks * 32 + fq * 8);   \
        bfr[i] = *(const bf16x8*)(b + (64 * wn + 16 * i + fr) * GST + ks * 32 + fq * 8);  \
      }                                                                               \
      __builtin_amdgcn_s_setprio(1);                                                  \
      _Pragma("unroll") for (int i = 0; i < 4; i++)                                   \
      _Pragma("unroll") for (int j = 0; j < 4; j++)                                   \
        acc[i][j] = __builtin_amdgcn_mfma_f32_16x16x32_bf16(af[i], bfr[j], acc[i][j], 0, 0, 0); \
      __builtin_amdgcn_s_setprio(0);                                                  \
    } } while (0)
  LDS_BARRIER();
  GLOAD(0, x);
  SWRITE(0, x);
  LDS_BARRIER();
#pragma unroll 1
  for (int kt = 0; kt < nk; kt += 2) {
    if (kt + 1 < nk) GLOAD(kt + 1, x);
    GCOMPUTE(0);
    if (kt + 1 < nk) SWRITE(1, x);
    LDS_BARRIER();
    if (kt + 1 >= nk) break;
    if (kt + 2 < nk) GLOAD(kt + 2, x);
    GCOMPUTE(1);
    if (kt + 2 < nk) SWRITE(0, x);
    LDS_BARRIER();
  }
  float* H = (float*)smem;
#pragma unroll
  for (int i = 0; i < 4; i++)
#pragma unroll
    for (int j = 0; j < 4; j++)
#pragma unroll
      for (int e = 0; e < 4; e++) H[(64 * wm + 16 * i + 4 * fq + e) * HST + 64 * wn + 16 * j + fr] = acc[i][j][e];
  LDS_BARRIER();
  return H;
}
__device__ __forceinline__ uint2 pack4(float a, float b, float c, float d) {
  uint2 pk; pk.x = f2bf(a) | ((unsigned)f2bf(b) << 16); pk.y = f2bf(c) | ((unsigned)f2bf(d) << 16); return pk;
}
#define EPI_ROWS(H, BODY...)                                                     \
  _Pragma("unroll 4") for (int _it = 0; _it < 16; _it++) {                       \
    const int r = (tid_o >> 5) + 8 * _it, c = (tid_o & 31) * 4;      \
    const float4 v = *(const float4*)((H) + r * HST + c); BODY }

__device__ __forceinline__ int colmap(int mode, int n) {
  if (mode == 0) {
    if (n < 1792) return n;
    if (n < 2560) return n + 16;
    if (n < 2576) return 1792 + (n - 2560);
    return -1;
  }
  if (mode == 2) { int nt = n >> 7, c = n & 127; return c < 64 ? nt * 64 + c : DFF + nt * 64 + (c - 64); }
  return n;
}
__device__ __forceinline__ void transpose_tile(float* sm, const float* __restrict__ src, int ldsrc, const float* __restrict__ gain,
                               u16* __restrict__ dst, int K, int mode, int n0, int k0) {
  int tid = threadIdx.x; asm volatile("" : "+v"(tid)); const int _tid_pad = 0;
  LDS_BARRIER();
  {
    int nn = tid & 63;
    int sc = colmap(mode, n0 + nn);
#pragma unroll
    for (int i = 0; i < 16; i++) {
      int kk = (tid >> 6) + 4 * i;
      float v = 0.f;
      if (sc >= 0) { v = src[(size_t)(k0 + kk) * ldsrc + sc]; if (gain) v *= gain[k0 + kk]; }
      sm[kk * 65 + nn] = v;
    }
  }
  LDS_BARRIER();
  {
    int c = tid & 7;
#pragma unroll
    for (int i = 0; i < 2; i++) {
      int nn = (tid >> 3) + 32 * i;
      u16 h[8];
#pragma unroll
      for (int e = 0; e < 8; e++) h[e] = f2bf(sm[(c * 8 + e) * 65 + nn]);
      uint4 pk;
      pk.x = h[0] | ((unsigned)h[1] << 16); pk.y = h[2] | ((unsigned)h[3] << 16);
      pk.z = h[4] | ((unsigned)h[5] << 16); pk.w = h[6] | ((unsigned)h[7] << 16);
      *(uint4*)(dst + (size_t)(n0 + nn) * K + k0 + c * 8) = pk;
    }
  }
}

__device__ __forceinline__ void s5_prep_item(float* sm, const Params& p, int l, int item) {
  int tid = threadIdx.x; asm volatile("" : "+v"(tid)); const int _tid_pad = 0;
  const int m = item % 65, d = (item / 65) & 1, g = item / 130;
  float* s_abm = sm;
  float* s_q = sm + 128;
  const int ldg = (l * 2 + d) * 16 + g;
  LDS_BARRIER();
  if (tid < 64) {
    int pi = ldg * 64 + tid;
    float dt = expf(p.in[13][ldg]);
    float are = p.in[11][pi], aim = p.in[12][pi];
    float mag = expf(dt * are), ang = dt * aim;
    float abr = mag * cosf(ang), abi = mag * sinf(ang);
    float den = are * are + aim * aim;
    float nre = abr - 1.f;
    s_q[tid * 2] = (nre * are + abi * aim) / den;
    s_q[tid * 2 + 1] = (abi * are - nre * aim) / den;
    float mm = expf((float)m * dt * are), am = (float)m * ang;
    float pr = mm * cosf(am), pim = mm * sinf(am);
    s_abm[tid * 2] = pr; s_abm[tid * 2 + 1] = pim;
    if (m == 64) {
      float* ab64 = (float*)(p.ws + O_AB64) + (size_t)l * 2 * 16 * 64 * 2;
      ab64[((d * 16 + g) * 64 + tid) * 2] = pr;
      ab64[((d * 16 + g) * 64 + tid) * 2 + 1] = pim;
    }
  }
  LDS_BARRIER();
  const float* bre = p.in[14] + (size_t)ldg * 64 * 16;
  const float* bim = p.in[15] + (size_t)ldg * 64 * 16;
  const float* cre = p.in[16] + (size_t)ldg * 16 * 64;
  const float* cim = p.in[17] + (size_t)ldg * 16 * 64;
  u16* bty = (u16*)(p.ws + O_BTY) + (size_t)g * 1024 * 1280;
  u16* bts = (u16*)(p.ws + O_BTS) + (size_t)g * 256 * 1024;
  if (m <= 63) {
    int ho = tid >> 4, hi = tid & 15;
    float acc = 0.f;
    for (int pp = 0; pp < 64; pp++) {
      float cr = cre[ho * 64 + pp], ci = cim[ho * 64 + pp];
      float ar = s_abm[pp * 2], ai = s_abm[pp * 2 + 1];
      float t1r = cr * ar - ci * ai, t1i = cr * ai + ci * ar;
      float qr = s_q[pp * 2], qi = s_q[pp * 2 + 1];
      float br = bre[pp * 16 + hi], bi = bim[pp * 16 + hi];
      float bbr = qr * br - qi * bi, bbi = qr * bi + qi * br;
      acc += t1r * bbr - t1i * bbi;
    }
    float* kt = (float*)(p.ws + O_KTAB);
    kt[((size_t)((g * 2 + d) * 64 + m)) * 256 + ho * 16 + hi] = acc;
  }
  if (m >= 1) {
    int t = d == 0 ? m - 1 : 64 - m;
    for (int e = tid; e < 1024; e += 256) {
      int ho = e >> 6, pp = e & 63;
      float cr = cre[ho * 64 + pp], ci = cim[ho * 64 + pp];
      float ar = s_abm[pp * 2], ai = s_abm[pp * 2 + 1];
      float xr = cr * ar - ci * ai, xi = cr * ai + ci * ar;
      size_t o = (size_t)(t * 16 + ho) * 1280 + 1024 + d * 128 + pp * 2;
      bty[o] = f2bf(xr);
      bty[o + 1] = f2bf(-xi);
    }
  }
}
__device__ __forceinline__ void s5_bts_item(const Params& p, int l, int item) {
  int tid = threadIdx.x; asm volatile("" : "+v"(tid));
  const int pp = item & 63, d = (item >> 6) & 1, g = item >> 7;
  const int sp = tid >> 2, hq = tid & 3;
  const int ldg = (l * 2 + d) * 16 + g;
  const int pi = ldg * 64 + pp;
  float dt = expf(p.in[13][ldg]);
  float are = p.in[11][pi], aim = p.in[12][pi];
  float mag = expf(dt * are), ang = dt * aim;
  float abr = mag * cosf(ang), abi = mag * sinf(ang);
  float den = are * are + aim * aim;
  float nre = abr - 1.f;
  float qr = (nre * are + abi * aim) / den, qi = (abi * are - nre * aim) / den;
  const int f = d == 0 ? 63 - sp : sp;
  float mm = expf((float)f * dt * are), am = (float)f * ang;
  float ar = mm * cosf(am), ai = mm * sinf(am);
  const float* bre = p.in[14] + (size_t)ldg * 64 * 16 + pp * 16 + hq * 4;
  const float* bim = p.in[15] + (size_t)ldg * 64 * 16 + pp * 16 + hq * 4;
  float fr_[4], fi_[4];
#pragma unroll
  for (int e = 0; e < 4; e++) {
    float br = bre[e], bi = bim[e];
    float bbr = qr * br - qi * bi, bbi = qr * bi + qi * br;
    fr_[e] = ar * bbr - ai * bbi; fi_[e] = ar * bbi + ai * bbr;
  }
  u16* bts = (u16*)(p.ws + O_BTS) + (size_t)g * 256 * 1024 + (size_t)(d * 128 + pp * 2) * 1024 + sp * 16 + hq * 4;
  *(uint2*)bts = pack4(fr_[0], fr_[1], fr_[2], fr_[3]);
  *(uint2*)(bts + 1024) = pack4(fi_[0], fi_[1], fi_[2], fi_[3]);
}
__device__ __forceinline__ void s5_expand_item(const Params& p, int l, int item) {
  int tid = threadIdx.x; asm volatile("" : "+v"(tid)); const int _tid_pad = 0;
  int g = item >> 10, n = item & 1023, t = n >> 4, ho = n & 15;
  int sp = tid >> 2, hi0 = (tid & 3) * 4;
  const float* kt = (const float*)(p.ws + O_KTAB);
  float v[4] = {0.f, 0.f, 0.f, 0.f};
  if (t >= sp) {
    const float* k0 = kt + ((size_t)((g * 2 + 0) * 64 + (t - sp))) * 256 + ho * 16 + hi0;
#pragma unroll
    for (int e = 0; e < 4; e++) v[e] += k0[e];
  }
  if (sp >= t) {
    const float* k1 = kt + ((size_t)((g * 2 + 1) * 64 + (sp - t))) * 256 + ho * 16 + hi0;
#pragma unroll
    for (int e = 0; e < 4; e++) v[e] += k1[e];
  }
  if (t == sp && ho >= hi0 && ho < hi0 + 4) v[ho - hi0] += p.in[18][l * 256 + g * 16 + ho];
  u16* bty = (u16*)(p.ws + O_BTY) + (size_t)g * 1024 * 1280 + (size_t)n * 1280 + sp * 16 + hi0;
  uint2 pk;
  pk.x = f2bf(v[0]) | ((unsigned)f2bf(v[1]) << 16);
  pk.y = f2bf(v[2]) | ((unsigned)f2bf(v[3]) << 16);
  *(uint2*)bty = pk;
}

__device__ __forceinline__ void hy_filter_item(float* sm, const Params& p, int l, int set, int tb) {
  int tid = threadIdx.x; asm volatile("" : "+v"(tid));
  const int L = 2048 << set;
  float* sz = sm;
  float* h1 = sm + 65 * 33;
  float* h2 = h1 + 65 * 64;
  const float* w1 = p.in[27] + (size_t)l * 33 * 64;
  const float* b1 = p.in[28] + l * 64;
  const float* fq_ = p.in[29] + l * 64;
  const float* w2 = p.in[30] + (size_t)l * 64 * 64;
  const float* b2 = p.in[31] + l * 64;
  const float* w3 = p.in[32] + (size_t)l * 64 * 1024;
  LDS_BARRIER();
  for (int e = tid; e < 65 * 33; e += 256) {
    int tt = e / 33, i = e % 33;
    int t = tb * 64 + tt;
    float val;
    if (i == 0) val = (float)t / (float)(L - 1);
    else {
      int b = (i - 1) & 15;
      float f = 1e-4f + (float)b * ((15.f - 1e-4f) / 15.f);
      float wang = 6.283185307179586f * (float)t / (float)L;
      val = i <= 16 ? cosf(f * wang) : -sinf(f * wang);
    }
    sz[e] = val;
  }
  LDS_BARRIER();
  {
    int j = tid & 63;
    float fj = fq_[j], bj = b1[j];
#pragma unroll 1
    for (int i = 0; i < 17; i++) {
      int tt = (tid >> 6) + 4 * i;
      if (tt < 65) {
        float a = bj;
        for (int k = 0; k < 33; k++) a += sz[tt * 33 + k] * w1[k * 64 + j];
        h1[tt * 64 + j] = sinf(fj * a);
      }
    }
  }
  LDS_BARRIER();
  {
    int j = tid & 63;
    float fj = fq_[j], bj = b2[j];
#pragma unroll 1
    for (int i = 0; i < 17; i++) {
      int tt = (tid >> 6) + 4 * i;
      if (tt < 65) {
        float a = bj;
        for (int k = 0; k < 64; k++) a += h1[tt * 64 + k] * w2[k * 64 + j];
        h2[tt * 64 + j] = sinf(fj * a);
      }
    }
  }
  LDS_BARRIER();
  const int c = tid;
  const float mind = -3.0701134573253943f, maxd = -15.350567286626972f;
  float delta = fabsf(mind + (float)c * ((maxd - mind) / 255.f));
  u16* kr = (u16*)(p.ws + O_HYKR) + (set ? HYKR1 : 0);
  float* ps = (float*)(p.ws + O_HYPS) + (size_t)(set ? 32 * 512 : 0) + (size_t)tb * 512;
#pragma unroll 1
  for (int order = 0; order < 2; order++) {
    u16* krc = kr + ((size_t)order * 256 + c) * (2 * L);
    float asum = 0.f, v00 = 0.f;
#pragma unroll 1
    for (int dir = 0; dir < 2; dir++) {
      float wc[64];
#pragma unroll
      for (int k = 0; k < 64; k++) wc[k] = w3[k * 1024 + order * 512 + dir * 256 + c];
      float hold = 0.f;
      const int ntt = dir == 0 ? 65 : 64;
#pragma unroll 1
      for (int tt = 0; tt < ntt; tt++) {
        float a = 0.f;
#pragma unroll
        for (int k = 0; k < 64; k++) a += h2[tt * 64 + k] * wc[k];
        int t = tb * 64 + tt;
        float tl = (float)t / (float)(L - 1);
        a *= expf(-tl * delta);
        if (t >= L) a = 0.f;
        if (tt < 64) asum += fabsf(a);
        if (dir == 0) {
          if (tt == 0) { if (tb == 0) v00 = a; }
          else if (tt & 1) hold = a;
          else *(unsigned*)(krc + (L - t)) = f2bf(a) | ((unsigned)f2bf(hold) << 16);
        } else {
          if (!(tt & 1)) hold = (t == 0) ? v00 + a : a;
          else *(unsigned*)(krc + (L + t - 1)) = f2bf(hold) | ((unsigned)f2bf(a) << 16);
        }
      }
    }
    ps[order * 256 + c] = asum;
  }
}

__device__ __forceinline__ void rms_rows_to_bf16(const Params& p, int l, int rowblk) {
  int tid_ = threadIdx.x; asm volatile("" : "+v"(tid_));
  const int lane = tid_ & 63, w = tid_ >> 6;
  float4 v[4][4];
#pragma unroll
  for (int j = 0; j < 4; j++) {
    const float* x = xrow(p, l, rowblk * 16 + w * 4 + j);
#pragma unroll
    for (int i = 0; i < 4; i++) v[j][i] = *(const float4*)(x + i * 256 + lane * 4);
  }
#pragma unroll
  for (int j = 0; j < 4; j++) {
    float ss = 0.f;
#pragma unroll
    for (int i = 0; i < 4; i++) ss += v[j][i].x * v[j][i].x + v[j][i].y * v[j][i].y + v[j][i].z * v[j][i].z + v[j][i].w * v[j][i].w;
    ss = wave_sum(ss);
    float rs = rsqrtf(ss * (1.f / 1024.f) + EPSF);
    u16* xn = (u16*)(p.ws + O_XN) + (size_t)(rowblk * 16 + w * 4 + j) * 1024;
#pragma unroll
    for (int i = 0; i < 4; i++) *(uint2*)(xn + i * 256 + lane * 4) = pack4(v[j][i].x * rs, v[j][i].y * rs, v[j][i].z * rs, v[j][i].w * rs);
  }
}

__device__ __forceinline__ void lru_item(char* smraw, const Params& p, int l, int item, int mode) {
  int tid = threadIdx.x; asm volatile("" : "+v"(tid)); const int _tid_pad = 0, lane = tid & 63, w = tid >> 6, fr = lane & 15, fq = lane >> 4;
  const int cki = item >> 2, head = item & 3;
  const int t0 = cki * 32;
  int lo, hi; seq_bounds(t0, lo, hi);
  float* xc = (float*)smraw;
  u16* xcb = (u16*)(smraw + 8192);
  float* sa = (float*)(smraw + 8192 + 4608);
  float* su = sa + 2 * 32 * 64;
  float* sx = su + 2 * 32 * 64;
  const u16* zA = (const u16*)(p.ws + O_ZA);
  bf16x8 brf[2][2], bif[2][2];
  {
    const int d_ = w >> 1, half_ = w & 1;
    const u16* wl_ = (const u16*)(p.ws + O_WLRU) + (size_t)head * 256 * 64;
#pragma unroll
    for (int ks = 0; ks < 2; ks++)
#pragma unroll
      for (int nt = 0; nt < 2; nt++) {
        int nr = d_ * 128 + 32 * half_ + 16 * nt + fr;
        brf[ks][nt] = *(const bf16x8*)(wl_ + (size_t)nr * 64 + ks * 32 + fq * 8);
        bif[ks][nt] = *(const bf16x8*)(wl_ + (size_t)(nr + 64) * 64 + ks * 32 + fq * 8);
      }
  }
  float hin_pre = 0.f;
  u16 gate_pre[8];
  if (mode == 1) {
    hin_pre = ((const float*)(p.ws + O_LHIN))[((size_t)cki * 2 + ((tid >> 6) & 1)) * 256 + head * 64 + (tid & 63)];
#pragma unroll
    for (int i = 0; i < 8; i++) gate_pre[i] = zA[(size_t)(t0 + (tid >> 6) * 8 + i) * 512 + 256 + head * 64 + (tid & 63)];
  }
  LDS_BARRIER();
  {
    int ch = tid & 63, tq = tid >> 6;
    int gch = head * 64 + ch;
    const float* cw = p.in[4] + l * 4 * 256;
    float w0 = cw[gch], w1 = cw[256 + gch], w2 = cw[512 + gch], w3 = cw[768 + gch];
    float cb = p.in[5][l * 256 + gch];
    float win[11];
#pragma unroll
    for (int i = 0; i < 11; i++) {
      int tok = t0 + tq * 8 + i - 2;
      win[i] = (tok >= lo && tok < hi) ? bf2f(zA[(size_t)tok * 512 + gch]) : 0.f;
    }
#pragma unroll
    for (int i = 0; i < 8; i++) {
      float v = w0 * win[i] + w1 * win[i + 1] + w2 * win[i + 2] + w3 * win[i + 3] + cb;
      int tt = tq * 8 + i;
      xc[tt * 64 + ch] = v;
      xcb[tt * 72 + ch] = f2bf(v);
    }
  }
  LDS_BARRIER();
  {
    const int d = w >> 1, half = w & 1;
    const u16* wl = (const u16*)(p.ws + O_WLRU) + (size_t)head * 256 * 64;
    f32x4 accr[2][2], acci[2][2];
#pragma unroll
    for (int a = 0; a < 2; a++)
#pragma unroll
      for (int b = 0; b < 2; b++) { accr[a][b] = (f32x4){0, 0, 0, 0}; acci[a][b] = (f32x4){0, 0, 0, 0}; }
#pragma unroll
    for (int ks = 0; ks < 2; ks++) {
      bf16x8 af[2], br[2], bi[2];
#pragma unroll
      for (int mt = 0; mt < 2; mt++) af[mt] = *(const bf16x8*)(xcb + (16 * mt + fr) * 72 + ks * 32 + fq * 8);
#pragma unroll
      for (int nt = 0; nt < 2; nt++) { br[nt] = brf[ks][nt]; bi[nt] = bif[ks][nt]; }
#pragma unroll
      for (int mt = 0; mt < 2; mt++)
#pragma unroll
        for (int nt = 0; nt < 2; nt++) {
          accr[mt][nt] = __builtin_amdgcn_mfma_f32_16x16x32_bf16(af[mt], br[nt], accr[mt][nt], 0, 0, 0);
          acci[mt][nt] = __builtin_amdgcn_mfma_f32_16x16x32_bf16(af[mt], bi[nt], acci[mt][nt], 0, 0, 0);
        }
    }
#pragma unroll
    for (int nt = 0; nt < 2; nt++) {
      int ch = 32 * half + 16 * nt + fr;
      int gch = head * 64 + ch;
      float brr = p.in[7][(l * 2 + d) * 256 + gch], bii = p.in[9][(l * 2 + d) * 256 + gch];
      float sp = softplusf_(-p.in[10][(l * 2 + d) * 256 + gch]);
#pragma unroll
      for (int mt = 0; mt < 2; mt++)
#pragma unroll
        for (int e = 0; e < 4; e++) {
          int tt = 16 * mt + 4 * fq + e;
          float r = 1.f / (1.f + __expf(-(accr[mt][nt][e] + brr)));
          float ig = 1.f / (1.f + __expf(-(acci[mt][nt][e] + bii)));
          float la = -8.f * r * sp;
          float a = __expf(la);
          float om = -la * (2.f + la * (2.f + la * (1.3333333f + la * (0.6666667f + la * 0.26666667f))));
          if (la < -0.25f) om = 1.f - a * a;
          float u = sqrtf(om) * (ig * xc[tt * 64 + ch]);
          sa[(d * 32 + tt) * 64 + ch] = a;
          su[(d * 32 + tt) * 64 + ch] = u;
        }
    }
  }
  LDS_BARRIER();
  {
    const int ch = tid & 63, d = (tid >> 6) & 1, half = tid >> 7;
    float A = 1.f, B = 0.f;
#pragma unroll
    for (int i = 0; i < 16; i++) {
      int tt = d == 0 ? half * 16 + i : half * 16 + 15 - i;
      float a = sa[(d * 32 + tt) * 64 + ch], u = su[(d * 32 + tt) * 64 + ch];
      A = a * A; B = a * B + u;
    }
    sx[((d * 2 + half) * 64 + ch) * 2] = A;
    sx[((d * 2 + half) * 64 + ch) * 2 + 1] = B;
  }
  LDS_BARRIER();
  if (mode == 0) {
    if (tid < 128) {
      int ch = tid & 63, d = tid >> 6;
      int first = d == 0 ? 0 : 1, second = 1 - first;
      float A1 = sx[((d * 2 + first) * 64 + ch) * 2], B1 = sx[((d * 2 + first) * 64 + ch) * 2 + 1];
      float A2 = sx[((d * 2 + second) * 64 + ch) * 2], B2 = sx[((d * 2 + second) * 64 + ch) * 2 + 1];
      float2 cr; cr.x = A2 * A1; cr.y = A2 * B1 + B2;
      ((float2*)(p.ws + O_LCAR))[((size_t)cki * 2 + d) * 256 + head * 64 + ch] = cr;
    }
    return;
  }
  {
    const int ch = tid & 63, d = (tid >> 6) & 1, half = tid >> 7;
    float h = hin_pre;
    int first = d == 0 ? 0 : 1;
    if (half != first) h = sx[((d * 2 + first) * 64 + ch) * 2] * h + sx[((d * 2 + first) * 64 + ch) * 2 + 1];
#pragma unroll
    for (int i = 0; i < 16; i++) {
      int tt = d == 0 ? half * 16 + i : half * 16 + 15 - i;
      float a = sa[(d * 32 + tt) * 64 + ch], u = su[(d * 32 + tt) * 64 + ch];
      h = a * h + u;
      su[(d * 32 + tt) * 64 + ch] = h;
    }
  }
  LDS_BARRIER();
  {
    int ch = tid & 63, tq = tid >> 6;
    u16* mixA = (u16*)(p.ws + O_XN);
#pragma unroll
    for (int i = 0; i < 8; i++) {
      int tt = tq * 8 + i, tok = t0 + tt;
      float hsum = su[tt * 64 + ch] + su[(32 + tt) * 64 + ch];
      float gate = bf2f(gate_pre[i]);
      mixA[(size_t)tok * 256 + head * 64 + ch] = f2bf(hsum * geluf_(gate));
    }
  }
}
__device__ __forceinline__ void lru_propagate(const Params& p, int idx) {
  int seq = idx >> 9, d = (idx >> 8) & 1, ch = idx & 255;
  int c0, nc;
  if (seq < 8) { c0 = seq * 64; nc = 64; } else { c0 = 512 + (seq - 8) * 128; nc = 128; }
  const float2* car = (const float2*)(p.ws + O_LCAR);
  float* hin = (float*)(p.ws + O_LHIN);
  float h = 0.f;
  for (int i = 0; i < nc; i++) {
    int ck = d == 0 ? c0 + i : c0 + nc - 1 - i;
    size_t o = ((size_t)ck * 2 + d) * 256 + ch;
    hin[o] = h;
    float2 ab = car[o];
    h = ab.x * h + ab.y;
  }
}
__device__ __forceinline__ void s5_propagate(const Params& p, int l, int idx) {
  int pp = idx & 63, d = (idx >> 6) & 1, g = (idx >> 7) & 15, seq = idx >> 11;
  int c0, nc;
  if (seq < 8) { c0 = seq * 32; nc = 32; } else { c0 = 256 + (seq - 8) * 64; nc = 64; }
  const float* ab64 = (const float*)(p.ws + O_AB64) + (size_t)l * 2 * 16 * 64 * 2;
  float ar = ab64[((d * 16 + g) * 64 + pp) * 2], ai = ab64[((d * 16 + g) * 64 + pp) * 2 + 1];
  const float* send = (const float*)(p.ws + O_SEND) + (size_t)g * 1280 * 256;
  u16* uh = (u16*)(p.ws + O_UH) + (size_t)g * 1280 * 1280;
  float hr = 0.f, hi = 0.f;
  for (int i = 0; i < nc; i++) {
    int ck = d == 0 ? c0 + i : c0 + nc - 1 - i;
    *(unsigned*)(uh + (size_t)ck * 1280 + 1024 + d * 128 + pp * 2) = f2bf(hr) | ((unsigned)f2bf(hi) << 16);
    float2 s = *(const float2*)(send + (size_t)ck * 256 + d * 128 + pp * 2);
    float nr = __fmaf_rn(ar, hr, __fmaf_rn(-ai, hi, s.x));
    float ni = __fmaf_rn(ar, hi, __fmaf_rn(ai, hr, s.y));
    asm volatile("" : "+v"(nr));
    asm volatile("" : "+v"(ni));
    hr = nr; hi = ni;
  }
}

#define AST 68
__device__ __forceinline__ void gdn_g1_item(char* smraw, const Params& p, int l, int item) {
  int tid = threadIdx.x; asm volatile("" : "+v"(tid)); const int _tid_pad = 0, lane = tid & 63, w = tid >> 6, fr = lane & 15, fq = lane >> 4;
  const int ck = item >> 2, h = item & 3;
  const int t0 = ck * 64;
  int lo, hi; seq_bounds(t0, lo, hi);
  u16* sk = (u16*)smraw;
  u16* sv = sk + 64 * 72;
  u16* Am = (u16*)(smraw + 2 * 64 * 72 * 2);
  float* sgc = (float*)(Am + 2 * 64 * 72);
  float* sbeta = sgc + 128;
  u16* Xs = (u16*)(sbeta + 128);
  const u16* zC = (const u16*)(p.ws + O_ZC);
  const float* ba = (const float*)(p.ws + O_BA);
  u16* qg = (u16*)(p.ws + O_XN);
  u16* kg = qg + (size_t)T_ALL * 256;
  u16* vg = kg + (size_t)T_ALL * 256;
  LDS_BARRIER();
  {
    const float* cw = p.in[21] + (size_t)l * 4 * 768;
    float wq[4], wk[4], wv[4];
#pragma unroll
    for (int j = 0; j < 4; j++) {
      wq[j] = cw[j * 768 + h * 64 + lane];
      wk[j] = cw[j * 768 + 256 + h * 64 + lane];
      wv[j] = cw[j * 768 + 512 + h * 64 + lane];
    }
#pragma unroll 4
    for (int rr = 0; rr < 16; rr++) {
      int c = w * 16 + rr, tok = t0 + c;
      float q = 0.f, k = 0.f, v = 0.f;
#pragma unroll
      for (int j = 0; j < 4; j++) {
        int tk = tok + j - 2;
        if (tk >= lo && tk < hi) {
          const u16* zr = zC + (size_t)tk * 1024 + h * 64 + lane;
          q += wq[j] * bf2f(zr[0]); k += wk[j] * bf2f(zr[256]); v += wv[j] * bf2f(zr[512]);
        }
      }
      q = siluf_(q); k = siluf_(k); v = siluf_(v);
      float sq = wave_sum(q * q), skk = wave_sum(k * k);
      q = q * rsqrtf(sq + EPSF) * 0.125f;
      k = k * rsqrtf(skk + EPSF);
      u16 kb = f2bf(k), vb = f2bf(v);
      sk[c * 72 + lane] = kb; sv[c * 72 + lane] = vb;
      qg[(size_t)tok * 256 + h * 64 + lane] = f2bf(q);
      kg[(size_t)tok * 256 + h * 64 + lane] = kb;
      vg[(size_t)tok * 256 + h * 64 + lane] = vb;
    }
  }
  if (tid < 128) {
    int d = tid >> 6, c = tid & 63;
    int tok = d == 0 ? t0 + c : t0 + 63 - c;
    float alog = p.in[22][(l * 2 + d) * 4 + h], dtb = p.in[23][(l * 2 + d) * 4 + h];
    float g = -__expf(alog) * softplusf_(ba[(size_t)tok * 16 + 8 + d * 4 + h] + dtb);
    float beta = 1.f / (1.f + __expf(-ba[(size_t)tok * 16 + d * 4 + h]));
    float s = g;
#pragma unroll
    for (int o = 1; o < 64; o <<= 1) { float t = __shfl_up(s, o); if (c >= o) s += t; }
    sgc[d * 64 + c] = s; sbeta[d * 64 + c] = beta;
    ((float*)(p.ws + O_GC))[(size_t)(h * 2 + d) * T_ALL + tok] = s;
  }
  LDS_BARRIER();
  {
    f32x4 acc[4];
#pragma unroll
    for (int nt = 0; nt < 4; nt++) acc[nt] = (f32x4){0, 0, 0, 0};
#pragma unroll
    for (int ks = 0; ks < 2; ks++) {
      bf16x8 af = *(const bf16x8*)(sk + (16 * w + fr) * 72 + ks * 32 + fq * 8);
#pragma unroll
      for (int nt = 0; nt < 4; nt++) {
        bf16x8 bfm = *(const bf16x8*)(sk + (16 * nt + fr) * 72 + ks * 32 + fq * 8);
        acc[nt] = __builtin_amdgcn_mfma_f32_16x16x32_bf16(af, bfm, acc[nt], 0, 0, 0);
      }
    }
#pragma unroll
    for (int nt = 0; nt < 4; nt++)
#pragma unroll
      for (int e = 0; e < 4; e++) {
        int c = 16 * w + 4 * fq + e, m = 16 * nt + fr;
        float gm = acc[nt][e];
        float a0 = c > m ? sbeta[c] * gm * __expf(sgc[c] - sgc[m]) : 0.f;
        Am[m * 72 + c] = f2bf(a0);
        int c1 = 63 - c, m1 = 63 - m;
        float a1 = c1 > m1 ? sbeta[64 + c1] * gm * __expf(sgc[64 + c1] - sgc[64 + m1]) : 0.f;
        Am[64 * 72 + m1 * 72 + c1] = f2bf(a1);
      }
  }
  LDS_BARRIER();
  {
    const int d = tid >> 7, col = tid & 127;
    const u16* AT = Am + d * 64 * 72;
    u16* Xd = Xs + d * 48 * 128;
    const u16* src = col < 64 ? sk : sv;
    const int e = col & 63;
    u16* wu = (u16*)(p.ws + O_WU) + ((size_t)(ck * 4 + h) * 2 + d) * 8192 + (col < 64 ? 0 : 4096);
#pragma unroll 1
    for (int b = 0; b < 4; b++) {
      float s[16];
#pragma unroll
      for (int r = 0; r < 16; r++) {
        int i = 16 * b + r;
        int tokr = d == 0 ? i : 63 - i;
        float rv = bf2f(src[tokr * 72 + e]) * sbeta[d * 64 + i];
        if (col < 64) rv *= __expf(sgc[d * 64 + i]);
        s[r] = rv;
      }
#pragma unroll 4
      for (int j = 0; j < 16 * b; j++) {
        float xj = bf2f(Xd[j * 128 + col]);
        const uint4* ar = (const uint4*)(AT + j * 72 + 16 * b);
        uint4 a0 = ar[0], a1 = ar[1];
        unsigned aw[8] = {a0.x, a0.y, a0.z, a0.w, a1.x, a1.y, a1.z, a1.w};
#pragma unroll
        for (int q = 0; q < 8; q++) {
          s[2 * q] -= __uint_as_float(aw[q] << 16) * xj;
          s[2 * q + 1] -= __uint_as_float(aw[q] & 0xffff0000u) * xj;
        }
      }
#pragma unroll
      for (int rp = 0; rp < 16; rp++) {
        u16 xb = f2bf(s[rp]);
        float xj = bf2f(xb);
        wu[(16 * b + rp) * 64 + e] = xb;
        if (b < 3) Xd[(16 * b + rp) * 128 + col] = xb;
        const uint4* ar = (const uint4*)(AT + (16 * b + rp) * 72 + 16 * b);
        uint4 a0 = ar[0], a1 = ar[1];
        unsigned aw[8] = {a0.x, a0.y, a0.z, a0.w, a1.x, a1.y, a1.z, a1.w};
#pragma unroll
        for (int r = rp + 1; r < 16; r++) {
          float av = (r & 1) ? __uint_as_float(aw[r >> 1] & 0xffff0000u) : __uint_as_float(aw[r >> 1] << 16);
          s[r] -= av * xj;
        }
      }
    }
  }
}

__device__ __forceinline__ void gdn_chain(char* smraw, const Params& p, int chain) {
  int tid = threadIdx.x; asm volatile("" : "+v"(tid)); const int _tid_pad = 0, lane = tid & 63, w = tid >> 6, fr = lane & 15, fq = lane >> 4;
  const int d = chain & 1, h = (chain >> 1) & 3, seq = chain >> 3;
  int c0, nc;
  if (seq < 8) { c0 = seq * 32; nc = 32; } else { c0 = 256 + (seq - 8) * 64; nc = 64; }
  u16* qs = (u16*)smraw;
  u16* qd = qs + 64 * 72;
  u16* ks_ = qd + 64 * 72;
  u16* kdT = ks_ + 64 * 72;
  u16* at = kdT + 64 * 72;
  u16* ST = at + 64 * 72;
  u16* VT = ST + 4 * 16 * 72;
  float* sgc = (float*)(VT + 4 * 16 * 72);
  const u16* qg = (const u16*)(p.ws + O_XN);
  const u16* kg = qg + (size_t)T_ALL * 256;
  const float* gcg = (const float*)(p.ws + O_GC);
  u16* og = (u16*)(p.ws + O_OD) + (size_t)d * T_ALL * 256;
  u16* STw = ST + w * 16 * 72;
  u16* VTw = VT + w * 16 * 72;
  f32x4 accS[4];
#pragma unroll
  for (int mt = 0; mt < 4; mt++) accS[mt] = (f32x4){0, 0, 0, 0};
  LDS_BARRIER();
  for (int e = lane; e < 16 * 72; e += 64) STw[e] = 0;
  const int prow = tid >> 2, pseg = tid & 3;
  float gcv_n, gl_n; uint4 q0n, q1n, k0n, k1n;
#define CHAIN_PREFETCH(IT) do {                                                                   \
    const int ck_ = d == 0 ? c0 + (IT) : c0 + nc - 1 - (IT);                                       \
    const int t0_ = ck_ * 64;                                                                      \
    const int tok_ = d == 0 ? t0_ + prow : t0_ + 63 - prow;                                        \
    gl_n = gcg[(size_t)(h * 2 + d) * T_ALL + (d == 0 ? t0_ + 63 : t0_)];                          \
    gcv_n = gcg[(size_t)(h * 2 + d) * T_ALL + tok_];                                               \
    const u16* qr_ = qg + (size_t)tok_ * 256 + h * 64 + pseg * 16;                                 \
    const u16* kr_ = kg + (size_t)tok_ * 256 + h * 64 + pseg * 16;                                 \
    q0n = *(const uint4*)qr_; q1n = *(const uint4*)(qr_ + 8);                                      \
    k0n = *(const uint4*)kr_; k1n = *(const uint4*)(kr_ + 8); } while (0)
  CHAIN_PREFETCH(0);
#pragma unroll 1
  for (int it = 0; it < nc; it++) {
    const int ck = d == 0 ? c0 + it : c0 + nc - 1 - it;
    const int t0 = ck * 64;
    const u16* wch = (const u16*)(p.ws + O_WU) + ((size_t)(ck * 4 + h) * 2 + d) * 8192;
    const u16* uch = wch + 4096;
    const float gl = gl_n;
    bf16x8 awr[4][2];
    u16 uvr[4][4];
#pragma unroll
    for (int mt = 0; mt < 4; mt++) {
#pragma unroll
      for (int ks = 0; ks < 2; ks++) awr[mt][ks] = *(const bf16x8*)(wch + (16 * mt + fr) * 64 + ks * 32 + fq * 8);
#pragma unroll
      for (int e = 0; e < 4; e++) uvr[mt][e] = uch[(16 * mt + 4 * fq + e) * 64 + 16 * w + fr];
    }
    {
      const int row = prow, seg = pseg;
      const float gcv = gcv_n;
      if (seg == 0) sgc[row] = gcv;
      float eq = __expf(gcv), ek = __expf(gl - gcv);
      const uint4 q0 = q0n, q1 = q1n, k0 = k0n, k1 = k1n;
      if (it + 1 < nc) CHAIN_PREFETCH(it + 1);
      *(uint4*)(qs + row * 72 + seg * 16) = q0; *(uint4*)(qs + row * 72 + seg * 16 + 8) = q1;
      *(uint4*)(ks_ + row * 72 + seg * 16) = k0; *(uint4*)(ks_ + row * 72 + seg * 16 + 8) = k1;
      unsigned qa[8] = {q0.x, q0.y, q0.z, q0.w, q1.x, q1.y, q1.z, q1.w};
      unsigned ka[8] = {k0.x, k0.y, k0.z, k0.w, k1.x, k1.y, k1.z, k1.w};
#pragma unroll
      for (int i = 0; i < 8; i++) {
        float qa0 = bf2f((u16)(qa[i] & 0xffff)) * eq, qa1 = bf2f((u16)(qa[i] >> 16)) * eq;
        *(unsigned*)(qd + row * 72 + seg * 16 + 2 * i) = f2bf(qa0) | ((unsigned)f2bf(qa1) << 16);
        float kb0 = bf2f((u16)(ka[i] & 0xffff)) * ek, kb1 = bf2f((u16)(ka[i] >> 16)) * ek;
        kdT[(seg * 16 + 2 * i) * 72 + row] = f2bf(kb0);
        kdT[(seg * 16 + 2 * i + 1) * 72 + row] = f2bf(kb1);
      }
    }
    LDS_BARRIER();
    {
      f32x4 acc[4];
#pragma unroll
      for (int nt = 0; nt < 4; nt++) acc[nt] = (f32x4){0, 0, 0, 0};
#pragma unroll
      for (int ks = 0; ks < 2; ks++) {
        bf16x8 af = *(const bf16x8*)(qs + (16 * w + fr) * 72 + ks * 32 + fq * 8);
#pragma unroll
        for (int nt = 0; nt < 4; nt++) {
          bf16x8 bfm = *(const bf16x8*)(ks_ + (16 * nt + fr) * 72 + ks * 32 + fq * 8);
          acc[nt] = __builtin_amdgcn_mfma_f32_16x16x32_bf16(af, bfm, acc[nt], 0, 0, 0);
        }
      }
#pragma unroll
      for (int nt = 0; nt < 4; nt++)
#pragma unroll
        for (int e = 0; e < 4; e++) {
          int c = 16 * w + 4 * fq + e, m = 16 * nt + fr;
          float v = c >= m ? acc[nt][e] * __expf(sgc[c] - sgc[m]) : 0.f;
          at[c * 72 + m] = f2bf(v);
        }
    }
    LDS_BARRIER();
    {
      const int e0 = 16 * w;
      f32x4 av[4];
#pragma unroll
      for (int mt = 0; mt < 4; mt++) av[mt] = (f32x4){0, 0, 0, 0};
#pragma unroll
      for (int ks = 0; ks < 2; ks++) {
        bf16x8 bS = *(const bf16x8*)(STw + fr * 72 + ks * 32 + fq * 8);
#pragma unroll
        for (int mt = 0; mt < 4; mt++) {
          av[mt] = __builtin_amdgcn_mfma_f32_16x16x32_bf16(awr[mt][ks], bS, av[mt], 0, 0, 0);
        }
      }
#pragma unroll
      for (int mt = 0; mt < 4; mt++) {
        u16 hv[4];
#pragma unroll
        for (int e = 0; e < 4; e++) {
          int c = 16 * mt + 4 * fq + e;
          float vn = bf2f(uvr[mt][e]) - av[mt][e];
          hv[e] = f2bf(vn);
        }
        uint2 pk; pk.x = hv[0] | ((unsigned)hv[1] << 16); pk.y = hv[2] | ((unsigned)hv[3] << 16);
        *(uint2*)(VTw + fr * 72 + 16 * mt + 4 * fq) = pk;
      }
      __builtin_amdgcn_wave_barrier();
      f32x4 ao[4];
#pragma unroll
      for (int mt = 0; mt < 4; mt++) ao[mt] = (f32x4){0, 0, 0, 0};
#pragma unroll
      for (int ks = 0; ks < 2; ks++) {
        bf16x8 bS = *(const bf16x8*)(STw + fr * 72 + ks * 32 + fq * 8);
        bf16x8 bV = *(const bf16x8*)(VTw + fr * 72 + ks * 32 + fq * 8);
#pragma unroll
        for (int mt = 0; mt < 4; mt++) {
          bf16x8 aq = *(const bf16x8*)(qd + (16 * mt + fr) * 72 + ks * 32 + fq * 8);
          bf16x8 aa = *(const bf16x8*)(at + (16 * mt + fr) * 72 + ks * 32 + fq * 8);
          ao[mt] = __builtin_amdgcn_mfma_f32_16x16x32_bf16(aq, bS, ao[mt], 0, 0, 0);
          ao[mt] = __builtin_amdgcn_mfma_f32_16x16x32_bf16(aa, bV, ao[mt], 0, 0, 0);
        }
      }
#pragma unroll
      for (int mt = 0; mt < 4; mt++)
#pragma unroll
        for (int e = 0; e < 4; e++) {
          int c = 16 * mt + 4 * fq + e;
          int tok = d == 0 ? t0 + c : t0 + 63 - c;
          og[(size_t)tok * 256 + h * 64 + e0 + fr] = f2bf(ao[mt][e]);
        }
      float egl = __expf(gl);
#pragma unroll
      for (int mt = 0; mt < 4; mt++) accS[mt] = accS[mt] * egl;
#pragma unroll
      for (int ks = 0; ks < 2; ks++) {
        bf16x8 bV = *(const bf16x8*)(VTw + fr * 72 + ks * 32 + fq * 8);
#pragma unroll
        for (int mt = 0; mt < 4; mt++) {
          bf16x8 ak = *(const bf16x8*)(kdT + (16 * mt + fr) * 72 + ks * 32 + fq * 8);
          accS[mt] = __builtin_amdgcn_mfma_f32_16x16x32_bf16(ak, bV, accS[mt], 0, 0, 0);
        }
      }
      __builtin_amdgcn_wave_barrier();
#pragma unroll
      for (int mt = 0; mt < 4; mt++) {
        uint2 pk;
        pk.x = f2bf(accS[mt][0]) | ((unsigned)f2bf(accS[mt][1]) << 16);
        pk.y = f2bf(accS[mt][2]) | ((unsigned)f2bf(accS[mt][3]) << 16);
        *(uint2*)(STw + fr * 72 + 16 * mt + 4 * fq) = pk;
      }
    }
    LDS_BARRIER();
  }
}
__device__ __forceinline__ void gdn_final_rows(const Params& p, int l, int rowblk) {
  int tid_ = threadIdx.x; asm volatile("" : "+v"(tid_));
  const int lane = tid_ & 63, w = tid_ >> 6;
  const int tok0 = rowblk * 16 + w * 4;
  const u16* o0 = (const u16*)(p.ws + O_OD) + (size_t)tok0 * 256 + lane * 4;
  const u16* o1 = o0 + (size_t)T_ALL * 256;
  const u16* zg = (const u16*)(p.ws + O_ZC) + (size_t)tok0 * 1024 + 768 + lane * 4;
  uint2 a[4], b[4], g[4];
#pragma unroll
  for (int j = 0; j < 4; j++) { a[j] = *(const uint2*)(o0 + j * 256); b[j] = *(const uint2*)(o1 + j * 256); g[j] = *(const uint2*)(zg + j * 1024); }
  const float* nw = p.in[24] + l * 64 + (lane & 15) * 4;
  const float n0 = nw[0], n1 = nw[1], n2 = nw[2], n3 = nw[3];
  u16* dst = (u16*)(p.ws + O_XN) + (size_t)2 * T_ALL * 256 + (size_t)tok0 * 256 + lane * 4;
#pragma unroll
  for (int j = 0; j < 4; j++) {
    float o[4], gt[4];
    o[0] = bf2f(a[j].x & 0xffff) + bf2f(b[j].x & 0xffff); o[1] = bf2f(a[j].x >> 16) + bf2f(b[j].x >> 16);
    o[2] = bf2f(a[j].y & 0xffff) + bf2f(b[j].y & 0xffff); o[3] = bf2f(a[j].y >> 16) + bf2f(b[j].y >> 16);
    gt[0] = bf2f(g[j].x & 0xffff); gt[1] = bf2f(g[j].x >> 16); gt[2] = bf2f(g[j].y & 0xffff); gt[3] = bf2f(g[j].y >> 16);
    float ss = o[0] * o[0] + o[1] * o[1] + o[2] * o[2] + o[3] * o[3];
#pragma unroll
    for (int m = 8; m > 0; m >>= 1) ss += __shfl_xor(ss, m);
    float rs = rsqrtf(ss * (1.f / 64.f) + EPSF);
    if (!(MIXMASK & 4)) rs = 0.f;
    *(uint2*)(dst + j * 256) = pack4(o[0] * rs * n0 * siluf_(gt[0]), o[1] * rs * n1 * siluf_(gt[1]), o[2] * rs * n2 * siluf_(gt[2]), o[3] * rs * n3 * siluf_(gt[3]));
  }
}
__device__ __forceinline__ void grpnorm_rows(const Params& p, int l, int which, int rowblk) {
  int tid_ = threadIdx.x; asm volatile("" : "+v"(tid_));
  const int lane = tid_ & 63, w = tid_ >> 6;
  u16* m0 = (u16*)(p.ws + O_XN) + (size_t)which * T_ALL * 256 + (size_t)(rowblk * 16 + w * 4) * 256 + lane * 4;
  uint2 a[4];
#pragma unroll
  for (int j = 0; j < 4; j++) a[j] = *(const uint2*)(m0 + j * 256);
  const float* gn = p.in[34] + (l * 3 + which) * 256 + lane * 4;
  const float g0 = gn[0], g1 = gn[1], g2 = gn[2], g3 = gn[3];
#pragma unroll
  for (int j = 0; j < 4; j++) {
    float v[4] = {bf2f(a[j].x & 0xffff), bf2f(a[j].x >> 16), bf2f(a[j].y & 0xffff), bf2f(a[j].y >> 16)};
    float ss = wave_sum(v[0] * v[0] + v[1] * v[1] + v[2] * v[2] + v[3] * v[3]);
    float rs = rsqrtf(ss * (1.f / 256.f) + EPSF);
    if (!((MIXMASK >> which) & 1)) rs = 0.f;
    *(uint2*)(m0 + j * 256) = pack4(v[0] * rs * g0, v[1] * rs * g1, v[2] * rs * g2, v[3] * rs * g3);
  }
}

#define WST 1296
#define UST 264
__device__ __forceinline__ float hy_conv3(const u16* __restrict__ raw, int t, int L, float w0, float w1, float w2, float b) {
  float xm = t > 0 ? bf2f(raw[t - 1]) : 0.f;
  float x0 = bf2f(raw[t]);
  float xp = t + 1 < L ? bf2f(raw[t + 1]) : 0.f;
  return w0 * xm + w1 * x0 + w2 * xp + b;
}
__device__ __forceinline__ void hy_conv_item(char* smraw, const Params& p, int l, int stage, int set, int c, int tb) {
  int tid = threadIdx.x; asm volatile("" : "+v"(tid)); const int _tid_pad = 0, lane = tid & 63, w = tid >> 6, fr = lane & 15, fq = lane >> 4;
  const int L = 2048 << set, nb = 8 << set, base = set ? T_P : 0;
  const int T0 = tb * 1024;
  u16* win = (u16*)smraw;
  u16* su = win + 8 * WST;
  float* sinv = (float*)(su + 16 * UST);
  const u16* dt = (const u16*)(p.ws + O_DT);
  const u16* rawv = dt + (size_t)c * T_ALL + base;
  const u16* rawx = dt + (size_t)((stage + 1) * 256 + c) * T_ALL + base;
  const u16* y1 = (const u16*)(p.ws + O_Y1) + (size_t)c * T_ALL + base;
  u16* outp = stage == 0 ? (u16*)(p.ws + O_Y1) + (size_t)c * T_ALL + base
                         : (u16*)(p.ws + O_DT) + (size_t)(256 + c) * T_ALL + base;
  const u16* kr = (const u16*)(p.ws + O_HYKR) + (set ? HYKR1 : 0) + ((size_t)stage * 256 + c) * (2 * L);
  const float* cw = p.in[25] + (size_t)l * 3 * 768;
  const float* cb = p.in[26] + (size_t)l * 768;
  const float v0 = cw[c], v1 = cw[768 + c], v2 = cw[1536 + c], vb = cb[c];
  const int xc_ = (stage + 1) * 256 + c;
  const float x0w = cw[xc_], x1w = cw[768 + xc_], x2w = cw[1536 + xc_], xbw = cb[xc_];
  LDS_BARRIER();
  if (tid < 64) {
    const float* ps = (const float*)(p.ws + O_HYPS) + (size_t)(set ? 32 * 512 : 0);
    int ntb = L / 64;
    float s = 0.f;
    for (int i = lane; i < ntb; i += 64) s += ps[(size_t)i * 512 + stage * 256 + c];
    s = wave_sum(s);
    if (lane == 0) sinv[0] = 1.f / s;
  }
  f32x4 acc[16];
#pragma unroll
  for (int i = 0; i < 16; i++) acc[i] = (f32x4){0, 0, 0, 0};
  for (int S0 = 0; S0 < L; S0 += 256) {
    LDS_BARRIER();
    const int B0 = S0 - T0;
    for (int idx = tid; idx < 8 * 160; idx += 256) {
      int rho = idx / 160, gi = idx % 160;
      int ybase = B0 - 1016 + 8 * gi - rho + L;
      int a = ybase & ~1;
      uint4 pk;
      if (a >= 0 && a + 10 <= 2 * L) {
        const unsigned* kd = (const unsigned*)(kr + a);
        unsigned d0 = kd[0], d1 = kd[1], d2 = kd[2], d3 = kd[3], d4 = kd[4];
        if (ybase & 1) {
          pk.x = __builtin_amdgcn_alignbit(d1, d0, 16); pk.y = __builtin_amdgcn_alignbit(d2, d1, 16);
          pk.z = __builtin_amdgcn_alignbit(d3, d2, 16); pk.w = __builtin_amdgcn_alignbit(d4, d3, 16);
        } else { pk.x = d0; pk.y = d1; pk.z = d2; pk.w = d3; }
      } else {
        u16 hh[8];
#pragma unroll
        for (int e = 0; e < 8; e++) { int yy = ybase + e; hh[e] = (yy >= 0 && yy < 2 * L) ? kr[yy] : (u16)0; }
        pk.x = hh[0] | ((unsigned)hh[1] << 16); pk.y = hh[2] | ((unsigned)hh[3] << 16);
        pk.z = hh[4] | ((unsigned)hh[5] << 16); pk.w = hh[6] | ((unsigned)hh[7] << 16);
      }
      *(uint4*)(win + rho * WST + 8 * gi) = pk;
    }
    {
      int b = tid >> 4, seg = tid & 15;
      uint4 p0 = make_uint4(0, 0, 0, 0), p1 = make_uint4(0, 0, 0, 0);
      if (b < nb) {
        const u16* src = (stage == 0 ? rawv : y1) + (size_t)b * L;
        const int s0 = S0 + seg * 16;
        uint4 r0 = *(const uint4*)(src + s0), r1 = *(const uint4*)(src + s0 + 8);
        if (stage == 0) {
          unsigned w[8] = {r0.x, r0.y, r0.z, r0.w, r1.x, r1.y, r1.z, r1.w};
          float x[18];
          x[0] = s0 > 0 ? bf2f(src[s0 - 1]) : 0.f;
          x[17] = s0 + 16 < L ? bf2f(src[s0 + 16]) : 0.f;
#pragma unroll
          for (int q = 0; q < 8; q++) { x[1 + 2 * q] = __uint_as_float(w[q] << 16); x[2 + 2 * q] = __uint_as_float(w[q] & 0xffff0000u); }
          unsigned o[8];
#pragma unroll
          for (int q = 0; q < 8; q++) {
            float c0 = v0 * x[2 * q] + v1 * x[2 * q + 1] + v2 * x[2 * q + 2] + vb;
            float c1 = v0 * x[2 * q + 1] + v1 * x[2 * q + 2] + v2 * x[2 * q + 3] + vb;
            o[q] = f2bf(c0) | ((unsigned)f2bf(c1) << 16);
          }
          p0 = make_uint4(o[0], o[1], o[2], o[3]); p1 = make_uint4(o[4], o[5], o[6], o[7]);
        } else { p0 = r0; p1 = r1; }
      }
      *(uint4*)(su + b * UST + seg * 16) = p0;
      *(uint4*)(su + b * UST + seg * 16 + 8) = p1;
    }
    LDS_BARRIER();
    bf16x8 bfr[8];
#pragma unroll
    for (int j = 0; j < 8; j++) bfr[j] = *(const bf16x8*)(su + fr * UST + 32 * j + 8 * fq);
    const u16* wbase = win + (fr & 7) * WST + (8 * fq - 256 * w - 8 * (fr >> 3) + 1016);
    __builtin_amdgcn_s_setprio(1);
#pragma unroll
    for (int dd = 0; dd < 30; dd++) {
      bf16x8 af = *(const bf16x8*)(wbase + 16 * (dd - 15));
#pragma unroll
      for (int j = 0; j < 8; j++) {
        const int i = 2 * j - (dd - 15);
        if (i >= 0 && i < 16) acc[i] = __builtin_amdgcn_mfma_f32_16x16x32_bf16(af, bfr[j], acc[i], 0, 0, 0);
      }
    }
    __builtin_amdgcn_s_setprio(0);
  }
  LDS_BARRIER();
  const float inv = sinv[0];
  const float bias = p.in[33][(size_t)(l * 2 + stage) * 256 + c];
  if (fr < nb) {
#pragma unroll
    for (int i = 0; i < 16; i++) {
      u16 r[4];
#pragma unroll
      for (int e = 0; e < 4; e++) {
        int t = T0 + 256 * w + 16 * i + 4 * fq + e;
        float uval = stage == 0 ? hy_conv3(rawv + (size_t)fr * L, t, L, v0, v1, v2, vb) : bf2f(y1[(size_t)fr * L + t]);
        float xg = hy_conv3(rawx + (size_t)fr * L, t, L, x0w, x1w, x2w, xbw);
        r[e] = f2bf(xg * (acc[i][e] * inv + bias * uval));
      }
      uint2 pk; pk.x = r[0] | ((unsigned)r[1] << 16); pk.y = r[2] | ((unsigned)r[3] << 16);
      *(uint2*)(outp + (size_t)fr * L + T0 + 256 * w + 16 * i + 4 * fq) = pk;
    }
  }
}
__device__ __forceinline__ void hy_final_item(char* smraw, const Params& p, int l, int ck) {
  int tid = threadIdx.x; asm volatile("" : "+v"(tid)); const int _tid_pad = 0, lane = tid & 63, w = tid >> 6;
  float* s = (float*)smraw;
  const u16* yd = (const u16*)(p.ws + O_DT) + (size_t)256 * T_ALL;
  const int t0 = ck * 64;
  LDS_BARRIER();
#pragma unroll 16
  for (int i = 0; i < 64; i++) {
    int c = w * 64 + i;
    s[lane * 257 + c] = bf2f(yd[(size_t)c * T_ALL + t0 + lane]);
  }
  LDS_BARRIER();
  const float* gn = p.in[34] + (l * 3 + 2) * 256;
  u16* mixD = (u16*)(p.ws + O_XN) + (size_t)3 * T_ALL * 256;
  for (int i = 0; i < 16; i++) {
    int tt = w * 16 + i;
    float v[4];
#pragma unroll
    for (int e = 0; e < 4; e++) v[e] = s[tt * 257 + lane * 4 + e];
    float ss = wave_sum(v[0] * v[0] + v[1] * v[1] + v[2] * v[2] + v[3] * v[3]);
    float rs = rsqrtf(ss * (1.f / 256.f) + EPSF);
    if (!(MIXMASK & 8)) rs = 0.f;
    uint2 pk;
    pk.x = f2bf(v[0] * rs * gn[lane * 4]) | ((unsigned)f2bf(v[1] * rs * gn[lane * 4 + 1]) << 16);
    pk.y = f2bf(v[2] * rs * gn[lane * 4 + 2]) | ((unsigned)f2bf(v[3] * rs * gn[lane * 4 + 3]) << 16);
    *(uint2*)(mixD + (size_t)(t0 + tt) * 256 + lane * 4) = pk;
  }
}

#define XB_CENS(j) (64 + 64 * (j))
#define XB_XSUB(j) (1088 + 64 * (j))
#define XB_XGEN(j) (2112 + 64 * (j))
#define XB_TOP 3136
#define XB_TOPGEN 3200
__device__ __forceinline__ unsigned xb_ld(unsigned* p) { return __hip_atomic_load(p, __ATOMIC_RELAXED, __HIP_MEMORY_SCOPE_AGENT); }
__device__ __forceinline__ unsigned xb_add(unsigned* p, unsigned v) { return __hip_atomic_fetch_add(p, v, __ATOMIC_RELAXED, __HIP_MEMORY_SCOPE_AGENT); }
__device__ __forceinline__ void xcd_barrier(unsigned* bar, unsigned x, unsigned nloc, unsigned nx, unsigned k) {
  asm volatile("s_waitcnt vmcnt(0) lgkmcnt(0)" ::: "memory");
  __syncthreads();
  if (threadIdx.x == 0) {
    const unsigned old = xb_add(&bar[XB_XSUB(x)], 1u);
    if (old + 1u == k * nloc) {
      __builtin_amdgcn_fence(__ATOMIC_RELEASE, "agent");
      asm volatile("s_waitcnt vmcnt(0)" ::: "memory");
      const unsigned og = xb_add(&bar[XB_TOP], 1u);
      if (og + 1u == k * nx) xb_add(&bar[XB_TOPGEN], 1u);
      else while (xb_ld(&bar[XB_TOPGEN]) < k) __builtin_amdgcn_s_sleep(1);
      __builtin_amdgcn_fence(__ATOMIC_ACQUIRE, "agent");
      xb_add(&bar[XB_XGEN(x)], 1u);
      asm volatile("s_waitcnt vmcnt(0)" ::: "memory");
    } else {
      while (xb_ld(&bar[XB_XGEN(x)]) < k) __builtin_amdgcn_s_sleep(1);
      __builtin_amdgcn_fence(__ATOMIC_ACQUIRE, "agent");
      asm volatile("s_waitcnt vmcnt(0)" ::: "memory");
    }
  }
  __syncthreads();
}
#define GRID_SYNC() do { ++bar_k; xcd_barrier(bar, bst[0], bst[1], bst[2], bar_k); } while (0)

#define TILE_LOOP(nM_, nN_, MT, NT)                                                                  \
  const int nSN_ = ((nN_) + 7) >> 3, nS_ = (((nM_) + 7) >> 3) * nSN_, P_ = nblk >> 3;                 \
  _Pragma("unroll 1") for (int S_ = (bid & 7); S_ < nS_ && (bid >> 3) < P_; S_ += 8)                 \
  _Pragma("unroll 1") for (int q_ = (bid >> 3); q_ < 64; q_ += P_)                                   \
    for (int MT = (S_ / nSN_) * 8 + (q_ >> 3), NT = (S_ % nSN_) * 8 + (q_ & 7), once_ = 1; once_ && MT < (nM_) && NT < (nN_); once_ = 0)

__global__ void __launch_bounds__(256, 2) mega(Params p) {
  cg::grid_group grid = cg::this_grid();
  __shared__ __attribute__((aligned(16))) char smraw[SMEM_BYTES];
  u16* smem = (u16*)smraw;
  float* smf = (float*)smraw;
  const int bid = blockIdx.x, nblk = gridDim.x, tid = threadIdx.x;
  const int rbid = nblk - 1 - bid;
  const int lane = tid & 63;
  char* const ws = p.ws;
  unsigned* const bar = (unsigned*)(ws + O_BAR);
  __shared__ unsigned bst[4];
  unsigned bar_k = 0;
  if (tid == 0) { bst[0] = (unsigned)__builtin_amdgcn_s_getreg((3 << 11) | 20) & 0xFu; xb_add(&bar[XB_CENS(bst[0])], 1u); }
  __threadfence();
  grid.sync();
  if (tid == 0) {
    unsigned mine = 0, cnt = 0;
    for (unsigned j = 0; j < 16; j++) { unsigned c = xb_ld(&bar[XB_CENS(j)]); cnt += c > 0u ? 1u : 0u; if (j == bst[0]) mine = c; }
    bst[1] = mine; bst[2] = cnt;
  }
  __syncthreads();

#ifdef NANFILL
  {
    uint4 nanv = make_uint4(0x7FC07FC0u, 0x7FC07FC0u, 0x7FC07FC0u, 0x7FC07FC0u);
    uint4* w4 = (uint4*)ws;
    for (size_t i = (size_t)bid * 256 + tid; i < WS_TOTAL / 16; i += (size_t)nblk * 256) w4[i] = nanv;
    uint4* o4 = (uint4*)p.out;
    for (size_t i = (size_t)bid * 256 + tid; i < (size_t)T_ALL * DM / 4; i += (size_t)nblk * 256) o4[i] = nanv;
    __threadfence(); grid.sync(); __threadfence();
  }
#endif
#pragma unroll 1
  for (int lay = 0; lay < 2; lay++) {
    {
      int l = lay; asm volatile("" : "+s"(l));
#pragma unroll 1
      for (int i = bid; i < 42 * 16; i += nblk) transpose_tile(smf, p.in[3] + (size_t)l * 1024 * 2576, 2576, p.in[2] + l * 1024, (u16*)(ws + O_WIN), 1024, 0, (i / 16) * 64, (i % 16) * 64);
#pragma unroll 1
      for (int i = rbid; i < 16 * 16; i += nblk) transpose_tile(smf, p.in[35] + (size_t)l * 1024 * 1024, 1024, nullptr, (u16*)(ws + O_WOUT), 1024, 1, (i / 16) * 64, (i % 16) * 64);
#pragma unroll 1
      for (int i = bid; i < 88 * 16; i += nblk) transpose_tile(smf, p.in[37] + (size_t)l * 1024 * 5632, 5632, p.in[36] + l * 1024, (u16*)(ws + O_WUP), 1024, 2, (i / 16) * 64, (i % 16) * 64);
#pragma unroll 1
      for (int i = rbid; i < 16 * 44; i += nblk) transpose_tile(smf, p.in[40] + (size_t)l * 2816 * 1024, 1024, nullptr, (u16*)(ws + O_WDN), 2816, 3, (i / 44) * 64, (i % 44) * 64);
#pragma unroll 1
      for (int i = bid; i < 16; i += nblk) transpose_tile(smf, p.in[19] + (size_t)l * 256 * 256, 256, nullptr, (u16*)(ws + O_WGLU), 256, 4, (i / 4) * 64, (i % 4) * 64);
#pragma unroll 1
      for (int i = rbid; i < 64; i += nblk) {
        u16* wl = (u16*)(ws + O_WLRU);
        for (int e = i * 1024 + tid; e < (i + 1) * 1024; e += 256) {
          int k = e & 63, n = (e >> 6) & 255, head = e >> 14;
          int d = n >> 7, gate = (n >> 6) & 1, j = n & 63;
          const float* wr_ = p.in[6]; const float* wi_ = p.in[8];
          size_t off_ = ((size_t)((l * 2 + d) * 4 + head) * 64 + k) * 64 + j;
          float vr_ = wr_[off_], vi_ = wi_[off_];
          wl[e] = f2bf(gate ? vi_ : vr_);
        }
      }
#pragma unroll 1
      for (int i = bid; i < 16 * 2 * 65; i += nblk) s5_prep_item(smf, p, l, i);
#pragma unroll 1
      for (int i = rbid; i < 16 * 2 * 64; i += nblk) s5_bts_item(p, l, i);
#pragma unroll 1
      for (int i = rbid; i < 96; i += nblk) hy_filter_item(smf, p, l, i < 32 ? 0 : 1, i < 32 ? i : i - 32);
      {
        unsigned* rq = (unsigned*)(ws + O_BAR + 208) + l;
        int* rslot = (int*)(smraw + SMEM_BYTES - 16);
#pragma unroll 1
        for (;;) {
          __syncthreads();
          if (tid == 0) *rslot = (int)atomicAdd(rq, 1u);
          __syncthreads();
          const int c0 = *rslot * 4;
          if (c0 >= T_ALL / 16) break;
#pragma unroll 1
          for (int i = c0; i < c0 + 4; i++) rms_rows_to_bf16(p, l, i);
        }
      }
    }
    GRID_SYNC();
    {
      int l = lay; asm volatile("" : "+s"(l));
      TILE_LOOP(640, 21, mt, nt) {
        { const float* H = gemm_tile(smem, (const u16*)(ws + O_XN), 1024, mt * 128, 0, T_ALL, 30, 0, (const u16*)(ws + O_WIN) + (size_t)nt * 128 * 1024, 1024, 1024);
            int tid_o = threadIdx.x; asm volatile("" : "+v"(tid_o));
            const int tok0 = mt * 128;
            if (nt < 4) {
              u16* zA = (u16*)(ws + O_ZA) + (size_t)tok0 * 512 + nt * 128;
              EPI_ROWS(H, { *(uint2*)(zA + (size_t)r * 512 + c) = pack4(v.x, v.y, v.z, v.w); })
            } else if (nt < 6) {
              u16* uh = (u16*)(ws + O_UH);
              EPI_ROWS(H, {
                int tok = tok0 + r, ch = (nt - 4) * 128 + c;
                *(uint2*)(uh + ((size_t)(ch >> 4) * 1280 + (tok >> 6)) * 1280 + (tok & 63) * 16 + (ch & 15)) = pack4(v.x, v.y, v.z, v.w); })
            } else if (nt < 14) {
              u16* zC = (u16*)(ws + O_ZC) + (size_t)tok0 * 1024 + (nt - 6) * 128;
              EPI_ROWS(H, { *(uint2*)(zC + (size_t)r * 1024 + c) = pack4(v.x, v.y, v.z, v.w); })
            } else if (nt < 20) {
              u16* dt = (u16*)(ws + O_DT) + (size_t)((nt - 14) * 128 + (tid_o & 127)) * T_ALL + tok0 + (tid_o >> 7) * 64;
              const float* Hc = H + (tid_o >> 7) * 64 * HST + (tid_o & 127);
#pragma unroll 2
              for (int k = 0; k < 8; k++) {
                uint2 a = pack4(Hc[(8 * k) * HST], Hc[(8 * k + 1) * HST], Hc[(8 * k + 2) * HST], Hc[(8 * k + 3) * HST]);
                uint2 b = pack4(Hc[(8 * k + 4) * HST], Hc[(8 * k + 5) * HST], Hc[(8 * k + 6) * HST], Hc[(8 * k + 7) * HST]);
                uint4 pk; pk.x = a.x; pk.y = a.y; pk.z = b.x; pk.w = b.y;
                *(uint4*)(dt + 8 * k) = pk;
              }
            } else {
              float* ba = (float*)(ws + O_BA) + (size_t)tok0 * 16;
#pragma unroll 2
              for (int k = 0; k < 8; k++) { int idx = tid_o + 256 * k; ba[idx] = H[(idx >> 4) * HST + (idx & 15)]; }
            }
          }
      }
#pragma unroll 1
      for (int it = rbid; it < 16 * 1024; it += nblk) s5_expand_item(p, l, it);
    }
    GRID_SYNC();
    {
      int l = lay; asm volatile("" : "+s"(l));
#pragma unroll 1
      for (int it = bid; it < NCH64 * 4; it += nblk) gdn_g1_item(smraw, p, l, it);
#pragma unroll 1
      for (int it = rbid; it < 16 * 10 * 2; it += nblk) {
        const int g = it / 20, mt = (it % 20) >> 1, nt = it & 1;
        { const float* H = gemm_tile(smem, (const u16*)(ws + O_UH) + (size_t)g * 1280 * 1280, 1280, mt * 128, 0, 1280, 30, 0,
                  (const u16*)(ws + O_BTS) + (size_t)g * 256 * 1024 + (size_t)nt * 128 * 1024, 1024, 1024);
            int tid_o = threadIdx.x; asm volatile("" : "+v"(tid_o));
            float* send = (float*)(ws + O_SEND) + (size_t)g * 1280 * 256 + (size_t)mt * 128 * 256 + nt * 128;
            EPI_ROWS(H, { *(float4*)(send + (size_t)r * 256 + c) = v; })
          }
      }
#pragma unroll 1
      for (int it = bid; it < NCH32 * 4; it += nblk) lru_item(smraw, p, l, it, 0);
    }
    GRID_SYNC();
    {
      int l = lay; asm volatile("" : "+s"(l));
#pragma unroll 1
      for (int it = bid; it < 192; it += nblk) gdn_chain(smraw, p, it);
#pragma unroll 1
      for (int it = rbid; it < 48; it += nblk) lru_propagate(p, it * 256 + tid);
#pragma unroll 1
      for (int it = rbid - 48; it < 192; it += nblk) { if (it >= 0) s5_propagate(p, l, it * 256 + tid); }
      unsigned* hq = (unsigned*)(ws + O_BAR + 192) + l;
      int* hslot = (int*)(smraw + SMEM_BYTES - 16);
#pragma unroll 1
      for (;;) {
        __syncthreads();
        if (tid == 0) *hslot = (int)atomicAdd(hq, 1u);
        __syncthreads();
        const int item = *hslot;
        if (item >= 512) break;
        const int set = item < 256 ? 1 : 0, c = item & 255, ntb = set ? 4 : 2;
#pragma unroll 1
        for (int tb = 0; tb < ntb; tb++) hy_conv_item(smraw, p, l, 0, set, c, tb);
        __threadfence();
        __syncthreads();
#pragma unroll 1
        for (int tb = 0; tb < ntb; tb++) hy_conv_item(smraw, p, l, 1, set, c, tb);
      }
    }
    GRID_SYNC();
    {
      int l = lay; asm volatile("" : "+s"(l));
#pragma unroll 1
      for (int it = rbid; it < 16 * 10 * 8; it += nblk) {
        const int g = it / 80, mt = (it % 80) >> 3, nt = it & 7;
        { const float* H = gemm_tile(smem, (const u16*)(ws + O_UH) + (size_t)g * 1280 * 1280, 1280, mt * 128, 0, 1280, 30, 0,
                  (const u16*)(ws + O_BTY) + (size_t)g * 1024 * 1280 + (size_t)nt * 128 * 1280, 1280, 1280);
            int tid_o = threadIdx.x; asm volatile("" : "+v"(tid_o));
            u16* zb = (u16*)(ws + O_XN) + (size_t)3 * T_ALL * 256;
            EPI_ROWS(H, {
              int ck = mt * 128 + r, n = nt * 128 + c;
              *(uint2*)(zb + ((size_t)g * T_ALL + ck * 64 + (n >> 4)) * 16 + (n & 15)) = pack4(geluf_(v.x), geluf_(v.y), geluf_(v.z), geluf_(v.w)); })
          }
      }
#pragma unroll 1
      for (int it = bid; it < NCH32 * 4; it += nblk) lru_item(smraw, p, l, it, 1);
#pragma unroll 1
      for (int it = rbid; it < T_ALL / 16; it += nblk) gdn_final_rows(p, l, it);
    }
    GRID_SYNC();
    {
      int l = lay; asm volatile("" : "+s"(l));
#pragma unroll 1
      for (int it = bid; it < 640 * 2; it += nblk) {
        const int mt = it >> 1, nt = it & 1;
        const u16* zb = (const u16*)(ws + O_XN) + (size_t)3 * T_ALL * 256;
        { const float* H = gemm_tile(smem, zb, 16, mt * 128, 0, T_ALL, 4, (size_t)T_ALL * 16, (const u16*)(ws + O_WGLU) + (size_t)nt * 128 * 256, 256, 256);
            int tid_o = threadIdx.x; asm volatile("" : "+v"(tid_o));
            u16* mixB = (u16*)(ws + O_XN) + (size_t)T_ALL * 256 + (size_t)mt * 128 * 256 + nt * 128;
            const u16* zr = zb + (size_t)mt * 128 * 16;
            const float* gb = p.in[20] + l * 256 + nt * 128;
            EPI_ROWS(H, {
              uint2 zz = *(const uint2*)(zr + ((size_t)((nt * 128 + c) >> 4) * T_ALL + r) * 16 + (c & 15));
              float4 g4 = *(const float4*)(gb + c);
              float z0 = bf2f(zz.x & 0xffff), z1 = bf2f(zz.x >> 16), z2 = bf2f(zz.y & 0xffff), z3 = bf2f(zz.y >> 16);
              *(uint2*)(mixB + (size_t)r * 256 + c) = pack4(z0 * sigmoidf_(v.x + g4.x), z1 * sigmoidf_(v.y + g4.y), z2 * sigmoidf_(v.z + g4.z), z3 * sigmoidf_(v.w + g4.w)); })
          }
      }
#pragma unroll 1
      for (int it = rbid; it < T_ALL / 16; it += nblk) grpnorm_rows(p, l, 0, it);
    }
    GRID_SYNC();
    {
      int l = lay; asm volatile("" : "+s"(l));
#pragma unroll 1
      for (int it = bid; it < NCH64; it += nblk) hy_final_item(smraw, p, l, it);
#pragma unroll 1
      for (int it = rbid; it < T_ALL / 16; it += nblk) grpnorm_rows(p, l, 1, it);
    }
    GRID_SYNC();
    {
      int l = lay; asm volatile("" : "+s"(l));
      TILE_LOOP(640, 8, mt, nt) {
        { const float* H = gemm_tile(smem, (const u16*)(ws + O_XN), 256, mt * 128, 0, T_ALL, 8, (size_t)T_ALL * 256,
                  (const u16*)(ws + O_WOUT) + (size_t)nt * 128 * 1024, 1024, 1024);
            int tid_o = threadIdx.x; asm volatile("" : "+v"(tid_o));
            float* o = p.out + (size_t)mt * 128 * DM + nt * 128;
            const int er = tid_o >> 5, ec = (tid_o & 31) * 4;
#pragma unroll 1
            for (int half = 0; half < 2; half++) {
              float4 b4[8];
#pragma unroll
              for (int q = 0; q < 8; q++) b4[q] = *(const float4*)(xrow(p, l, mt * 128 + er + 8 * (half * 8 + q)) + nt * 128 + ec);
#pragma unroll
              for (int q = 0; q < 8; q++) {
                const int r = er + 8 * (half * 8 + q);
                const float4 v = *(const float4*)(H + r * HST + ec);
                float4 o4; o4.x = b4[q].x + v.x; o4.y = b4[q].y + v.y; o4.z = b4[q].z + v.z; o4.w = b4[q].w + v.w;
                *(float4*)(o + (size_t)r * DM + ec) = o4;
              }
            }
          }
      }
    }
    GRID_SYNC();
    {
      int l = lay; asm volatile("" : "+s"(l));
#pragma unroll 1
      for (int it = bid; it < T_ALL / 16; it += nblk) rms_rows_to_bf16(p, 1, it);
    }
    GRID_SYNC();
    {
      int l = lay; asm volatile("" : "+s"(l));
      const int nM = 8 * 17 + 16 * 33;
      TILE_LOOP(nM, 44, mi, nt) {
        int seq, ti, L;
        if (mi < 136) { seq = mi / 17; ti = mi % 17; L = 2048; }
        else { seq = 8 + (mi - 136) / 33; ti = (mi - 136) % 33; L = 4096; }
        const int s0 = seq < 8 ? seq * 2048 : T_P + (seq - 8) * 4096;
        const int arow0 = s0 + 126 * ti - 1;
        const int nvalid = min(126, L - 126 * ti);
        { const float* H = gemm_tile<true>(smem, (const u16*)(ws + O_XN), 1024, arow0, s0, s0 + L, 30, 0, (const u16*)(ws + O_WUP) + (size_t)nt * 128 * 1024, 1024, 1024);
            int tid_o = threadIdx.x; asm volatile("" : "+v"(tid_o));
            const int j = tid_o & 63, rg = tid_o >> 6;
            const float* cw = p.in[38] + (size_t)l * 3 * 5632;
            const float* cb = p.in[39] + (size_t)l * 5632;
            const int cg_ = nt * 64 + j, cv_ = DFF + nt * 64 + j;
            const float g0 = cw[cg_], g1 = cw[5632 + cg_], g2 = cw[2 * 5632 + cg_], gb = cb[cg_];
            const float u0 = cw[cv_], u1 = cw[5632 + cv_], u2 = cw[2 * 5632 + cv_], ub = cb[cv_];
            u16* hm = (u16*)(ws + O_HMID) + (size_t)arow0 * DFF + nt * 64 + j;
#pragma unroll 2
            for (int r = 1 + rg; r <= nvalid; r += 4) {
              float gate = g0 * H[(r - 1) * HST + j] + g1 * H[r * HST + j] + g2 * H[(r + 1) * HST + j] + gb;
              float val = u0 * H[(r - 1) * HST + 64 + j] + u1 * H[r * HST + 64 + j] + u2 * H[(r + 1) * HST + 64 + j] + ub;
              hm[(size_t)r * DFF] = f2bf(siluf_(gate) * val);
            }
          }
      }
    }
    GRID_SYNC();
    {
      int l = lay; asm volatile("" : "+s"(l));
      TILE_LOOP(640, 8, mt, nt) {
        { const float* H = gemm_tile(smem, (const u16*)(ws + O_HMID), DFF, mt * 128, 0, T_ALL, 30, 0, (const u16*)(ws + O_WDN) + (size_t)nt * 128 * DFF, DFF, DFF);
            int tid_o = threadIdx.x; asm volatile("" : "+v"(tid_o));
            float* o = p.out + (size_t)mt * 128 * DM + nt * 128;
            const int er = tid_o >> 5, ec = (tid_o & 31) * 4;
#pragma unroll 1
            for (int half = 0; half < 2; half++) {
              float4 b4[8];
#pragma unroll
              for (int q = 0; q < 8; q++) b4[q] = *(const float4*)(o + (size_t)(er + 8 * (half * 8 + q)) * DM + ec);
#pragma unroll
              for (int q = 0; q < 8; q++) {
                const int r = er + 8 * (half * 8 + q);
                const float4 v = *(const float4*)(H + r * HST + ec);
                float4 o4; o4.x = b4[q].x + v.x; o4.y = b4[q].y + v.y; o4.z = b4[q].z + v.z; o4.w = b4[q].w + v.w;
                *(float4*)(o + (size_t)r * DM + ec) = o4;
              }
            }
          }
      }
    }
    GRID_SYNC();
  }
  {
    const int w = tid >> 6;
    const float* fn = p.in[41];
#pragma unroll 1
    for (int it = bid; it < T_ALL / 16; it += nblk) {
      float* x0 = p.out + (size_t)(it * 16 + w * 4) * DM;
      float4 v[4][4];
#pragma unroll
      for (int j = 0; j < 4; j++)
#pragma unroll
        for (int i = 0; i < 4; i++) v[j][i] = *(const float4*)(x0 + (size_t)j * DM + i * 256 + lane * 4);
#pragma unroll
      for (int j = 0; j < 4; j++) {
        float ss = 0.f;
#pragma unroll
        for (int i = 0; i < 4; i++) ss += v[j][i].x * v[j][i].x + v[j][i].y * v[j][i].y + v[j][i].z * v[j][i].z + v[j][i].w * v[j][i].w;
        ss = wave_sum(ss);
        float rs = rsqrtf(ss * (1.f / 1024.f) + EPSF);
#pragma unroll
        for (int i = 0; i < 4; i++) {
          float4 g = *(const float4*)(fn + i * 256 + lane * 4);
          float4 o; o.x = v[j][i].x * rs * g.x; o.y = v[j][i].y * rs * g.y; o.z = v[j][i].z * rs * g.z; o.w = v[j][i].w * rs * g.w;
          *(float4*)(x0 + (size_t)j * DM + i * 256 + lane * 4) = o;
        }
      }
    }
  }
}

extern "C" void kernel_launch(void* const* d_in, const int* in_sizes, int n_in,
                              void* d_out, int out_size, void* d_ws, size_t ws_size,
                              hipStream_t stream) {
  static int grid_blocks = 0;
  if (!grid_blocks) {
    int dev = 0, cus = 0, per_cu = 0;
    (void)hipGetDevice(&dev);
    (void)hipDeviceGetAttribute(&cus, hipDeviceAttributeMultiprocessorCount, dev);
    (void)hipOccupancyMaxActiveBlocksPerMultiprocessor(&per_cu, mega, 256, 0);
    if (per_cu > 2) per_cu = 2;
    if (per_cu < 1) per_cu = 1;
    grid_blocks = cus * per_cu;
  }
  if (ws_size < WS_TOTAL) fprintf(stderr, "workspace too small: %zu < %zu\n", ws_size, (size_t)WS_TOTAL);
  Params p{};
  for (int i = 0; i < 42; i++) p.in[i] = (const float*)d_in[i];
  p.out = (float*)d_out;
  p.ws = (char*)d_ws;
  (void)hipMemsetAsync((char*)d_ws + O_BAR, 0, 16384, stream);
  void* args[] = {&p};
  hipError_t e = hipLaunchCooperativeKernel((void*)mega, dim3(grid_blocks), dim3(256), args, 0, stream);
  if (e != hipSuccess) fprintf(stderr, "coop launch failed: %s (grid %d)\n", hipGetErrorString(e), grid_blocks);
}
```
